# Optimizing an MI355X kernel written in HIP

```python
import math
import jax, jax.numpy as jnp
from jax import lax
import numpy as np

D_MODEL = 1024
BATCH = 4
SEQ = 4096
DEPTH = 1

HEAD_DIM = 64
N_HEADS_MOBA = 8
N_HEADS_RWKV = 8
W_MOBA = N_HEADS_MOBA * HEAD_DIM
W_RWKV = N_HEADS_RWKV * HEAD_DIM
MOBA_BLOCK = 256
MOBA_TOPK = 3
Q_CHUNK = 32
NUM_BUCKETS = 32
MAX_DISTANCE = 1024
D_FF = 2816
DECAY_LORA = 64
AAA_LORA = 64
GATE_LORA = 160
RMS_EPS = 1e-6
GN_EPS = HEAD_DIM * 1e-5
IN_COLS = 3 * W_MOBA + 3 * W_RWKV + 2 * D_MODEL

kernel_name = "hybrid_moba_rwkv7_macaron"


def rms_norm(x, g):
    xf = x.astype(jnp.float32)
    y = xf * lax.rsqrt(jnp.mean(xf * xf, axis=-1, keepdims=True) + RMS_EPS)
    return (y * g.astype(jnp.float32)).astype(x.dtype)


def swiglu(h, w_gate, w_up, w_down):
    return (jax.nn.silu(h @ w_gate) * (h @ w_up)) @ w_down


def t5_bucket(dist):
    n = jnp.maximum(dist, 0)
    max_exact = NUM_BUCKETS // 2
    nf = jnp.maximum(n, max_exact).astype(jnp.float32)
    large = max_exact + (jnp.log(nf / max_exact) / math.log(MAX_DISTANCE / max_exact)
                         * (NUM_BUCKETS - max_exact)).astype(jnp.int32)
    large = jnp.minimum(large, NUM_BUCKETS - 1)
    return jnp.where(n < max_exact, n, large)


def shift_seq(z):
    return jnp.pad(z, ((0, 0), (1, 0), (0, 0)))[:, :-1]


def moba_attention(q, k, v, rel_bias):
    B, S, H, D = q.shape
    nb = -(-S // MOBA_BLOCK)
    s_pad = nb * MOBA_BLOCK
    pad = ((0, 0), (0, 0), (0, s_pad - S), (0, 0))
    q = jnp.pad(q.transpose(0, 2, 1, 3), pad)
    k = jnp.pad(k.transpose(0, 2, 1, 3), pad)
    v = jnp.pad(v.transpose(0, 2, 1, 3), pad)
    k_blocks = k.reshape(B, H, nb, MOBA_BLOCK, D)
    v_blocks = v.reshape(B, H, nb, MOBA_BLOCK, D)
    k_mean = jnp.mean(k_blocks.astype(jnp.float32), axis=3)
    topk = min(MOBA_TOPK, max(nb - 1, 1))
    n_chunks = s_pad // Q_CHUNK
    q_chunks = q.reshape(B, H, n_chunks, Q_CHUNK, D).transpose(2, 0, 1, 3, 4)
    bias_t = rel_bias.T
    head_ids = jnp.arange(H)[None, :, None, None, None]
    scale = D ** -0.5
    gather = jax.vmap(jax.vmap(lambda blocks, ix: blocks[ix]))
    key_off = jnp.arange(MOBA_BLOCK)

    def chunk(args):
        q_c, c = args
        start = c * Q_CHUNK
        t = start + jnp.arange(Q_CHUNK)
        blk = start // MOBA_BLOCK
        gate = jnp.einsum('bhqd,bhnd->bhqn', q_c.astype(jnp.float32), k_mean)
        gate = jnp.where(jnp.arange(nb) < blk, gate, -jnp.inf)
        _, idx = lax.top_k(gate, topk)
        valid = idx < blk
        k_sel = gather(k_blocks, idx)
        v_sel = gather(v_blocks, idx)
        kpos_sel = idx[..., None] * MOBA_BLOCK + key_off
        bias_sel = bias_t[head_ids, t5_bucket(t[:, None, None] - kpos_sel)]
        s_sel = (jnp.einsum('bhqd,bhqmkd->bhqmk', q_c, k_sel).astype(jnp.float32) * scale
                 + bias_sel.astype(jnp.float32))
        s_sel = jnp.where(valid[..., None], s_sel, -jnp.inf)
        k_own = lax.dynamic_index_in_dim(k_blocks, blk, axis=2, keepdims=False)
        v_own = lax.dynamic_index_in_dim(v_blocks, blk, axis=2, keepdims=False)
        dist_own = t[:, None] - (blk * MOBA_BLOCK + key_off)[None, :]
        bias_own = bias_t[:, t5_bucket(dist_own)]
        s_own = (jnp.einsum('bhqd,bhkd->bhqk', q_c, k_own).astype(jnp.float32) * scale
                 + bias_own.astype(jnp.float32))
        s_own = jnp.where(dist_own >= 0, s_own, -jnp.inf)
        logits = jnp.concatenate(
            [s_sel.reshape(B, H, Q_CHUNK, topk * MOBA_BLOCK), s_own], axis=-1)
        p = jax.nn.softmax(logits, axis=-1).astype(v.dtype)
        p_sel = p[..., :topk * MOBA_BLOCK].reshape(B, H, Q_CHUNK, topk, MOBA_BLOCK)
        p_own = p[..., topk * MOBA_BLOCK:]
        return (jnp.einsum('bhqmk,bhqmkd->bhqd', p_sel, v_sel)
                + jnp.einsum('bhqk,bhkd->bhqd', p_own, v_own))

    out = lax.map(chunk, (q_chunks, jnp.arange(n_chunks)))
    out = out.transpose(1, 0, 3, 2, 4).reshape(B, s_pad, H, D)[:, :S]
    return out.reshape(B, S, H * D)


def _rwkv_step(state, inp):
    r_t, w_t, k_t, v_t, a_t, b_t = inp
    sa = jnp.einsum('bhvk,bhk->bhv', state, a_t)
    state = (state * w_t[:, :, None, :] + sa[..., None] * b_t[:, :, None, :]
             + v_t[..., None] * k_t[:, :, None, :])
    y = jnp.einsum('bhvk,bhk->bhv', state, r_t)
    return state, y


def rwkv7_time_mix(h, r_p, k_p, v_p, mix_rkv, mix_wag, w_lora_a, w_lora_b, w0,
                   a_lora_a, a_lora_b, a0, g_lora_a, g_lora_b, k_k, k_a, r_k,
                   ln_x_w, ln_x_b):
    B, S, _ = h.shape
    H, N = N_HEADS_RWKV, HEAD_DIM
    r = r_p + (shift_seq(r_p) - r_p) * mix_rkv[0]
    k = k_p + (shift_seq(k_p) - k_p) * mix_rkv[1]
    v = v_p + (shift_seq(v_p) - v_p) * mix_rkv[2]
    dh = shift_seq(h) - h
    xw = h + dh * mix_wag[0]
    xa = h + dh * mix_wag[1]
    xg = h + dh * mix_wag[2]
    w_raw = -jax.nn.softplus(-(w0 + jnp.tanh(xw @ w_lora_a) @ w_lora_b)) - 0.5
    decay = jnp.exp(-jnp.exp(w_raw.astype(jnp.float32)))
    a = jax.nn.sigmoid(a0 + (xa @ a_lora_a) @ a_lora_b)
    g = jax.nn.sigmoid(xg @ g_lora_a) @ g_lora_b
    kk = (k * k_k).reshape(B, S, H, N).astype(jnp.float32)
    kk = kk / jnp.maximum(jnp.linalg.norm(kk, axis=-1, keepdims=True), 1e-12)
    k = k * (1.0 + (a - 1.0) * k_a)
    heads = lambda z: z.reshape(B, S, H, N).astype(jnp.float32)
    r_h, k_h, v_h, a_h, w_h = heads(r), heads(k), heads(v), heads(a), heads(decay)
    tb = lambda z: z.transpose(1, 0, 2, 3)
    state0 = jnp.zeros((B, H, N, N), jnp.float32)
    _, y = lax.scan(_rwkv_step, state0,
                    (tb(r_h), tb(w_h), tb(k_h), tb(v_h), tb(-kk), tb(kk * a_h)))
    y = y.transpose(1, 0, 2, 3)
    mu = jnp.mean(y, axis=-1, keepdims=True)
    var = jnp.mean(jnp.square(y - mu), axis=-1, keepdims=True)
    y = ((y - mu) * lax.rsqrt(var + GN_EPS)).reshape(B, S, H * N)
    y = y * ln_x_w.astype(jnp.float32) + ln_x_b.astype(jnp.float32)
    bonus = jnp.sum(r_h * k_h * r_k.astype(jnp.float32), axis=-1, keepdims=True) * v_h
    y = (y + bonus.reshape(B, S, H * N)).astype(h.dtype)
    return y * g


def _dense(k, shape, fan_in, scale=1.0):
    return jax.random.normal(k, shape, jnp.float32) * (scale * fan_in ** -0.5)


def setup_inputs(seed: int = 0) -> dict:
    key = jax.random.key(seed)
    ks = iter(jax.random.split(key, 48))
    L, D = DEPTH, D_MODEL
    nrm = lambda shape, s: s * jax.random.normal(next(ks), shape, jnp.float32)
    uni = lambda shape, lo, hi: jax.random.uniform(next(ks), shape, jnp.float32, lo, hi)
    return {
        "x": jax.random.normal(next(ks), (BATCH, SEQ, D), jnp.float32),
        "rel_bias": nrm((NUM_BUCKETS, N_HEADS_MOBA), 0.1),
        "norm_ffn1": 1.0 + nrm((L, D), 0.05),
        "ffn1_gate": _dense(next(ks), (L, D, D_FF), D),
        "ffn1_up": _dense(next(ks), (L, D, D_FF), D),
        "ffn1_down": _dense(next(ks), (L, D_FF, D), D_FF),
        "norm_mix": 1.0 + nrm((L, D), 0.05),
        "w_in": _dense(next(ks), (L, D, IN_COLS), D),
        "mix_rkv": uni((L, 3, W_RWKV), 0.0, 1.0),
        "mix_wag": uni((L, 3, D), 0.0, 1.0),
        "w_lora_a": _dense(next(ks), (L, D, DECAY_LORA), D),
        "w_lora_b": _dense(next(ks), (L, DECAY_LORA, W_RWKV), DECAY_LORA, 0.1),
        "w0": uni((L, W_RWKV), -6.5, -1.5),
        "a_lora_a": _dense(next(ks), (L, D, AAA_LORA), D),
        "a_lora_b": _dense(next(ks), (L, AAA_LORA, W_RWKV), AAA_LORA, 0.1),
        "a0": nrm((L, W_RWKV), 0.1),
        "g_lora_a": _dense(next(ks), (L, D, GATE_LORA), D),
        "g_lora_b": _dense(next(ks), (L, GATE_LORA, W_RWKV), GATE_LORA),
        "k_k": 0.85 + nrm((L, W_RWKV), 0.05),
        "k_a": 1.0 + nrm((L, W_RWKV), 0.05),
        "r_k": nrm((L, N_HEADS_RWKV, HEAD_DIM), 0.1),
        "ln_x_w": 1.0 + nrm((L, W_RWKV), 0.05),
        "ln_x_b": nrm((L, W_RWKV), 0.02),
        "proj_a": _dense(next(ks), (L, W_MOBA, D), W_MOBA),
        "proj_b": _dense(next(ks), (L, W_RWKV, D), W_RWKV),
        "w_out": _dense(next(ks), (L, D, D), D),
        "norm_ffn2": 1.0 + nrm((L, D), 0.05),
        "ffn2_gate": _dense(next(ks), (L, D, D_FF), D),
        "ffn2_up": _dense(next(ks), (L, D, D_FF), D),
        "ffn2_down": _dense(next(ks), (L, D_FF, D), D_FF),
        "norm_final": 1.0 + nrm((D,), 0.05),
    }


def reference(x, rel_bias, norm_ffn1, ffn1_gate, ffn1_up, ffn1_down, norm_mix, w_in,
              mix_rkv, mix_wag, w_lora_a, w_lora_b, w0, a_lora_a, a_lora_b, a0,
              g_lora_a, g_lora_b, k_k, k_a, r_k, ln_x_w, ln_x_b, proj_a, proj_b, w_out,
              norm_ffn2, ffn2_gate, ffn2_up, ffn2_down, norm_final):
    B, S, _ = x.shape
    splits = list(np.cumsum([W_MOBA, W_MOBA, W_MOBA, W_RWKV, W_RWKV, W_RWKV, D_MODEL])[:])
    for l in range(DEPTH):
        x = x + 0.5 * swiglu(rms_norm(x, norm_ffn1[l]), ffn1_gate[l], ffn1_up[l], ffn1_down[l])
        h = rms_norm(x, norm_mix[l])
        proj = h @ w_in[l]
        qa, ka, va, rb, kb, vb, ga, gb = jnp.split(proj, splits, axis=-1)
        to_heads = lambda z: z.reshape(B, S, N_HEADS_MOBA, HEAD_DIM)
        y_a = moba_attention(to_heads(qa), to_heads(ka), to_heads(va), rel_bias)
        y_b = rwkv7_time_mix(h, rb, kb, vb, mix_rkv[l], mix_wag[l], w_lora_a[l], w_lora_b[l],
                             w0[l], a_lora_a[l], a_lora_b[l], a0[l], g_lora_a[l],
                             g_lora_b[l], k_k[l], k_a[l], r_k[l], ln_x_w[l], ln_x_b[l])
        merged = jax.nn.sigmoid(ga) * (y_a @ proj_a[l]) + jax.nn.sigmoid(gb) * (y_b @ proj_b[l])
        x = x + merged @ w_out[l]
        x = x + 0.5 * swiglu(rms_norm(x, norm_ffn2[l]), ffn2_gate[l], ffn2_up[l], ffn2_down[l])
    return rms_norm(x, norm_final)
```

```cpp
#include <hip/hip_runtime.h>
#include <cstdio>
#include <cstdint>

#define LAS __attribute__((address_space(3)))
#define GAS __attribute__((address_space(1)))
typedef unsigned short bf16;
typedef short bf16x8 __attribute__((ext_vector_type(8)));
typedef float f32x4 __attribute__((ext_vector_type(4)));
typedef float f32x2 __attribute__((ext_vector_type(2)));
typedef unsigned u32x4 __attribute__((ext_vector_type(4)));
typedef unsigned u32x2 __attribute__((ext_vector_type(2)));

constexpr int M = 16384, D = 1024, FF = 2816, SEQ = 4096, NBATCH = 4, NH = 8, HD = 64, WR = 512;
constexpr int N_GU = 2 * FF;
constexpr int N_IN = 3840;
constexpr int N_GATE = 2048;
constexpr int ZP = 768;
constexpr float RMS_EPS = 1e-6f;
constexpr float LOG2E = 1.4426950408889634f;
constexpr float C2 = 0.125f * LOG2E;

constexpr size_t MiB = 1u << 20;
constexpr size_t WS_CTL = 0, CTL_ZERO_BYTES = 1 * MiB;
constexpr int CW_TMO = 0, CW_BAR = 4096;
constexpr size_t OFF_SSQ1 = 65536, OFF_SSQ2 = 131072, OFF_SSQ3 = 196608, OFF_SSQ4 = 262144, OFF_KMEAN = 327680;
constexpr size_t WS_RK = 1 * MiB;
constexpr size_t WS_BND = 1 * MiB + 512 * 1024;
constexpr size_t WS_WGU1 = 2 * MiB, WS_WD1 = 13 * MiB, WS_WIN = 18 * MiB + 512 * 1024, WS_WG = 26 * MiB, WS_WA = 30 * MiB, WS_WB = 31 * MiB,
                 WS_WOUT = 32 * MiB, WS_WGU2 = 34 * MiB, WS_WD2 = 45 * MiB, WS_LBW = 50 * MiB + 512 * 1024, WS_LBA = WS_LBW + 65536, WS_LBG = WS_LBA + 65536;
constexpr size_t WS_XB = 51 * MiB;
constexpr size_t WS_ACT = 83 * MiB;
constexpr size_t WS_Q = 83 * MiB, WS_K = 99 * MiB, WS_V = 115 * MiB, WS_R = 131 * MiB, WS_KR = 147 * MiB, WS_VR = 163 * MiB;
constexpr size_t WS_Z = 179 * MiB;
constexpr size_t WS_WDEC = 203 * MiB;
constexpr size_t WS_GB = 235 * MiB;
constexpr size_t WS_KK = WS_K, WS_BB = WS_V;
constexpr size_t WS_YRAW = WS_Z;
constexpr size_t WS_YB = WS_R;
constexpr size_t WS_SGA = 99 * MiB, WS_SGB = 203 * MiB;
constexpr size_t WS_MRG = 147 * MiB;
constexpr size_t WS_SSQ2 = 251 * MiB, WS_SSQ3 = 252 * MiB, WS_SSQ4 = 253 * MiB;
constexpr size_t WS_END = 256 * MiB;

__device__ __forceinline__ unsigned f2bf(float f) { unsigned u = __builtin_bit_cast(unsigned, f); return (u + 0x7fffu + ((u >> 16) & 1u)) >> 16; }
__device__ __forceinline__ unsigned pk2(float lo, float hi) { return f2bf(lo) | (f2bf(hi) << 16); }
__device__ __forceinline__ float bflo(unsigned w) { return __builtin_bit_cast(float, w << 16); }
__device__ __forceinline__ float bfhi(unsigned w) { return __builtin_bit_cast(float, w & 0xffff0000u); }
__device__ __forceinline__ float bf2f(bf16 h) { return __builtin_bit_cast(float, (unsigned)h << 16); }
__device__ __forceinline__ float fast_exp2(float x) { return __builtin_amdgcn_exp2f(x); }
__device__ __forceinline__ float fast_rcp(float x) { return __builtin_amdgcn_rcpf(x); }
__device__ __forceinline__ float sigmoidf_(float x) { return fast_rcp(1.0f + fast_exp2(-x * LOG2E)); }
#define LDS_WAIT() asm volatile("s_waitcnt lgkmcnt(0)" ::: "memory")
#define VM_WAIT() asm volatile("s_waitcnt vmcnt(0)" ::: "memory")

namespace pg8 {
#define PG8_LAS __attribute__((address_space(3)))
typedef unsigned short bf16_t;
constexpr int BM = 256, BK = 64, HALF = 128, HTB = HALF * BK * 2, STAGE_BYTES = 8 * HTB, NXCD = 8, WGM = 8;
__host__ __device__ __forceinline__ int lds_byte(int r, int c) { const int st = (r >> 4) * 2 + (c >> 5), rr = r & 15, cc = c & 31, ob = rr * 64 + cc * 2; return st * 1024 + (ob ^ (((ob >> 9) & 1) << 5)); }
__host__ __device__ __forceinline__ void stage_rc(int b, int& R, int& C) { const int st = b / 1024, sb = b % 1024, swz = sb ^ (((sb >> 9) & 1) << 5); R = (st >> 1) * 16 + swz / 64; C = (st & 1) * 32 + (swz % 64) / 2; }
__host__ __device__ __forceinline__ int perm32(int rho) { const int n = rho >> 4, i = rho & 15; return 8 * (i >> 2) + 4 * n + (i & 3); }
struct Unit { int pm, pn; };
struct Gemm { const bf16_t* A; const bf16_t* Bt; int M, N, K; };
struct StaticOrder {
    int nM, nN, nwg, G, c;
    __host__ __device__ void init(int M_, int N_, int G_, int c_) { nM = M_ / BM; nN = N_ / BM; nwg = nM * nN; G = G_; c = c_; }
    __host__ __device__ bool next(int i, Unit& u) const {
        const long L = (long)i * G + c; if (L >= nwg) return false;
        int wgid = (int)L; { const int q = nwg / NXCD, r = nwg % NXCD, xcd = wgid % NXCD, off = wgid / NXCD; wgid = (xcd < r ? xcd * (q + 1) : r * (q + 1) + (xcd - r) * q) + off; }
        const int nig = WGM * nN, gid = wgid / nig, fm = gid * WGM, gsz = (nM - fm) < WGM ? (nM - fm) : WGM;
        u.pm = fm + ((wgid % nig) % gsz); u.pn = (wgid % nig) / gsz; return true;
    }
    __device__ __forceinline__ void a_ready(const Unit&) const {}
    __device__ __forceinline__ void done(const Unit&) const {}
};
typedef __bf16 bf16x2_t __attribute__((ext_vector_type(2)));
__device__ __forceinline__ unsigned cvt_pk_bf16(float lo, float hi) { const f32x2 v = {lo, hi}; const bf16x2_t b = __builtin_convertvector(v, bf16x2_t); return __builtin_bit_cast(unsigned, b); }


template <int NP> __device__ __forceinline__ float row_ssq(const float* p, int row) {
    if (NP == 1) return p[row];
    const f32x4* q = (const f32x4*)(p + (size_t)row * 16); const f32x4 a = q[0], b = q[1], c = q[2], d = q[3];
    return (((a[0] + a[1]) + (a[2] + a[3])) + ((b[0] + b[1]) + (b[2] + b[3]))) + (((c[0] + c[1]) + (c[2] + c[3])) + ((d[0] + d[1]) + (d[2] + d[3])));
}
template <int NP> struct EpiSwiGLU {
    static constexpr bool PERM = true, AFTER_DRAIN = false;
    bf16_t* O; int ldc; const float* ssq;
    __device__ __forceinline__ void operator()(const f32x4 (&acc)[2][2][4][2], const Unit& u, int wr, int wc, int fr, int fq) const {
        const int row0 = u.pm * BM + wr * 64 + fr, col0 = u.pn * 128 + wc * 32 + 8 * fq;
#pragma unroll
        for (int ai = 0; ai < 2; ++ai)
#pragma unroll
            for (int m = 0; m < 4; ++m) {
                const int row = row0 + ai * HALF + m * 16;
                const float rs = 1.0f / sqrtf(row_ssq<NP>(ssq, row) * (1.0f / D) + RMS_EPS);
                float o[8];
#pragma unroll
                for (int n = 0; n < 2; ++n)
#pragma unroll
                    for (int i = 0; i < 4; ++i) { const float g = acc[ai][0][m][n][i] * rs, up = acc[ai][1][m][n][i] * rs; o[n * 4 + i] = g * sigmoidf_(g) * up; }
                u32x4 w; w.x = cvt_pk_bf16(o[0], o[1]); w.y = cvt_pk_bf16(o[2], o[3]); w.z = cvt_pk_bf16(o[4], o[5]); w.w = cvt_pk_bf16(o[6], o[7]);
                *(u32x4*)(O + (size_t)row * ldc + col0) = w;
            }
    }
};
struct EpiResid {
    static constexpr bool PERM = false, AFTER_DRAIN = false;
    const float* xin; float* xout; bf16_t* xb; float* ssq; float alpha;
    __device__ __forceinline__ void operator()(const f32x4 (&acc)[2][2][4][2], const Unit& u, int wr, int wc, int fr, int fq) const {
        const int row0 = u.pm * BM + wr * 64 + fr, col0 = u.pn * BM + wc * 32 + 4 * fq;
#pragma unroll
        for (int ai = 0; ai < 2; ++ai)
#pragma unroll
            for (int m = 0; m < 4; ++m) {
                const int row = row0 + ai * HALF + m * 16; const size_t off = (size_t)row * D + col0; float s = 0.f;
#pragma unroll
                for (int bj = 0; bj < 2; ++bj)
#pragma unroll
                    for (int n = 0; n < 2; ++n) {
                        const f32x4 v = *(const f32x4*)(xin + off + bj * HALF + n * 16) + acc[ai][bj][m][n] * alpha;
                        *(f32x4*)(xout + off + bj * HALF + n * 16) = v;
                        s += (v[0] * v[0] + v[1] * v[1]) + (v[2] * v[2] + v[3] * v[3]);
                        if (xb) { u32x2 w; w.x = cvt_pk_bf16(v[0], v[1]); w.y = cvt_pk_bf16(v[2], v[3]); *(u32x2*)(xb + off + bj * HALF + n * 16) = w; }
                    }
                s += __shfl_xor(s, 16); s += __shfl_xor(s, 32);
                if (fq == 0 && ssq) ssq[(size_t)row * 16 + u.pn * 4 + wc] = s;
                asm volatile("" ::: "memory");
            }
    }
};
struct EpiProj {
    static constexpr bool PERM = true, AFTER_DRAIN = false;
    bf16_t* arr0; bf16_t* zbuf; const float* ssq; float* kmean; bf16_t* bnd;
    __device__ __forceinline__ void operator()(const f32x4 (&acc)[2][2][4][2], const Unit& u, int wr, int wc, int fr, int fq) const {
        const int pn = u.pn; const int row0 = u.pm * BM + wr * 64 + fr;
        bf16_t* dst; int pitch, colt;
        if (pn < 12) { dst = arr0 + (size_t)(pn >> 1) * ((size_t)M * 512); pitch = 512; colt = (pn & 1) * 256; } else { dst = zbuf; pitch = ZP; colt = (pn - 12) * 256; }
        const float sc = (pn < 2) ? C2 : 1.0f; const int col0 = colt + wc * 32 + 8 * fq;
        const bool is_k = (pn == 2 || pn == 3), is_rkv = (pn >= 6 && pn < 12);
        float cs[2][8];
#pragma unroll
        for (int bj = 0; bj < 2; ++bj)
#pragma unroll
            for (int i = 0; i < 8; ++i) cs[bj][i] = 0.f;
#pragma unroll
        for (int ai = 0; ai < 2; ++ai)
#pragma unroll
            for (int m = 0; m < 4; ++m) {
                const int row = row0 + ai * HALF + m * 16;
                const float rs = sc / sqrtf(row_ssq<16>(ssq, row) * (1.0f / D) + RMS_EPS);
#pragma unroll
                for (int bj = 0; bj < 2; ++bj) {
                    float o[8];
#pragma unroll
                    for (int n = 0; n < 2; ++n)
#pragma unroll
                        for (int i = 0; i < 4; ++i) { o[n * 4 + i] = acc[ai][bj][m][n][i] * rs; cs[bj][n * 4 + i] += o[n * 4 + i]; }
                    u32x4 w; w.x = cvt_pk_bf16(o[0], o[1]); w.y = cvt_pk_bf16(o[2], o[3]); w.z = cvt_pk_bf16(o[4], o[5]); w.w = cvt_pk_bf16(o[6], o[7]);
                    *(u32x4*)(dst + (size_t)row * pitch + col0 + bj * HALF) = w;
                    if (is_rkv && ai == 1 && m == 3 && wr == 1 && fr == 15) *(u32x4*)(bnd + (size_t)u.pm * 1536 + (pn - 6) * 256 + wc * 32 + 8 * fq + bj * HALF) = w;
                }
            }
        if (is_k) {
#pragma unroll
            for (int bj = 0; bj < 2; ++bj)
#pragma unroll
                for (int i = 0; i < 8; ++i) { float v = cs[bj][i]; v += __shfl_xor(v, 1); v += __shfl_xor(v, 2); v += __shfl_xor(v, 4); v += __shfl_xor(v, 8);
                    if (fr == 0) { const int col = (pn - 2) * 256 + bj * HALF + wc * 32 + 8 * fq + i; atomicAdd(kmean + ((size_t)((u.pm >> 4) * NH + (col >> 6)) * 16 + (u.pm & 15)) * 64 + (col & 63), v); } }
        }
    }
};
template <int MODE> struct EpiGate {
    static constexpr bool PERM = true, AFTER_DRAIN = false;
    bf16_t* out; const bf16_t* gate; bf16_t* out2; const float* ssq;
    __device__ __forceinline__ void operator()(const f32x4 (&acc)[2][2][4][2], const Unit& u, int wr, int wc, int fr, int fq) const {
        const int row0 = u.pm * BM + wr * 64 + fr; int pn = u.pn; bf16_t* dst = out;
        if (MODE == 0 && pn >= 4) { pn -= 4; dst = out2; }
        const int col0 = pn * BM + wc * 32 + 8 * fq;
#pragma unroll
        for (int ai = 0; ai < 2; ++ai)
#pragma unroll
            for (int m = 0; m < 4; ++m) {
                const int row = row0 + ai * HALF + m * 16;
                float rs = 1.0f; if (MODE == 0) rs = 1.0f / sqrtf(row_ssq<16>(ssq, row) * (1.0f / D) + RMS_EPS);
#pragma unroll
                for (int bj = 0; bj < 2; ++bj) {
                    const size_t off = (size_t)row * D + col0 + bj * HALF; float o[8];
#pragma unroll
                    for (int n = 0; n < 2; ++n)
#pragma unroll
                        for (int i = 0; i < 4; ++i) o[n * 4 + i] = acc[ai][bj][m][n][i];
                    if (MODE == 0) {
#pragma unroll
                        for (int i = 0; i < 8; ++i) o[i] = sigmoidf_(o[i] * rs);
                    } else {
                        const u32x4 g = *(const u32x4*)(gate + off);
                        o[0] *= bflo(g.x); o[1] *= bfhi(g.x); o[2] *= bflo(g.y); o[3] *= bfhi(g.y); o[4] *= bflo(g.z); o[5] *= bfhi(g.z); o[6] *= bflo(g.w); o[7] *= bfhi(g.w);
                        if (MODE == 2) { const u32x4 p = *(const u32x4*)(dst + off);
                            o[0] += bflo(p.x); o[1] += bfhi(p.x); o[2] += bflo(p.y); o[3] += bfhi(p.y); o[4] += bflo(p.z); o[5] += bfhi(p.z); o[6] += bflo(p.w); o[7] += bfhi(p.w); }
                    }
                    u32x4 w; w.x = cvt_pk_bf16(o[0], o[1]); w.y = cvt_pk_bf16(o[2], o[3]); w.z = cvt_pk_bf16(o[4], o[5]); w.w = cvt_pk_bf16(o[6], o[7]);
                    *(u32x4*)(dst + off) = w;
                }
            }
    }
};

template <class Epi, class Sched, bool ALIGN_EPI = false, bool SP2 = false>
__device__ __forceinline__ void gemm_phase(PG8_LAS unsigned char* lds, const Gemm g, const Sched& S, const Epi& E) {
    const int tid = threadIdx.x, wid = __builtin_amdgcn_readfirstlane(tid >> 6), lane = tid & 63, wr = wid >> 2, wc = wid & 3, fr = lane & 15, fq = lane >> 4;
    const int K = g.K, nt = K / BK;
    unsigned voffA[2], voffB[2];
#pragma unroll
    for (int i = 0; i < 2; ++i) { int R, C; stage_rc(tid * 16 + i * 8192, R, C); const int Rb = Epi::PERM ? ((R & ~31) + perm32(R & 31)) : R;
        voffA[i] = (unsigned)(R * K + C) * 2u; voffB[i] = (unsigned)(Rb * K + C) * 2u; }
    const size_t kstep = (size_t)(BK * 2);
    const size_t hstep = (size_t)HALF * K * 2;
    const size_t tstep = 2 * hstep;
    const unsigned ldsw = (unsigned)wid * 1024u;
    const int aoff = lds_byte(wr * 64 + fr, fq * 8), boff = lds_byte(wc * 32 + fr, fq * 8);
#define PG8_SA(b, h) (((b) * 2 + (h)) * HTB)
#define PG8_SB(b, h) ((4 + (b) * 2 + (h)) * HTB)
#define PG8_STAGE(bufoff, gbase, voff) do { _Pragma("unroll") for (int _i = 0; _i < 2; ++_i) \
        __builtin_amdgcn_global_load_lds((const unsigned*)((const char*)(gbase) + (voff)[_i]), (PG8_LAS unsigned*)(lds + (bufoff) + ldsw + _i * 8192), 16, 0, 0); } while (0)
#define PG8_LDA(dst, b, h) do { _Pragma("unroll") for (int m = 0; m < 4; ++m) _Pragma("unroll") for (int k = 0; k < 2; ++k) dst[m][k] = *(const PG8_LAS bf16x8*)(lds + PG8_SA(b, h) + aoff + m * 2048 + k * 1024); } while (0)
#define PG8_LDB(dst, b, h) do { _Pragma("unroll") for (int n = 0; n < 2; ++n) _Pragma("unroll") for (int k = 0; k < 2; ++k) dst[n][k] = *(const PG8_LAS bf16x8*)(lds + PG8_SB(b, h) + boff + n * 2048 + k * 1024); } while (0)
#define PG8_MMA(ai, bj, At, Bt) do { __builtin_amdgcn_s_setprio(1); _Pragma("unroll") for (int m = 0; m < 4; ++m) _Pragma("unroll") for (int n = 0; n < 2; ++n) _Pragma("unroll") for (int k = 0; k < 2; ++k) \
        acc[ai][bj][m][n] = __builtin_amdgcn_mfma_f32_16x16x32_bf16(Bt[n][k], At[m][k], acc[ai][bj][m][n], 0, 0, 0); __builtin_amdgcn_s_setprio(0); } while (0)
#define PG8_WAIT_V(n) asm volatile("s_waitcnt vmcnt(" #n ")" ::: "memory")
#define PG8_WAIT_L(n) asm volatile("s_waitcnt lgkmcnt(" #n ")" ::: "memory")
#define PG8_BAR __builtin_amdgcn_s_barrier()
#define PG8_SCHED __builtin_amdgcn_sched_barrier(0)
    Unit cur, nxt; int ui = 0;
    if (!S.next(0, cur)) return;
    f32x4 acc[2][2][4][2];
#pragma unroll
    for (int a = 0; a < 2; ++a)
#pragma unroll
        for (int b = 0; b < 2; ++b)
#pragma unroll
            for (int m = 0; m < 4; ++m)
#pragma unroll
                for (int n = 0; n < 2; ++n) acc[a][b][m][n] = (f32x4){0.f, 0.f, 0.f, 0.f};
    bf16x8 At[4][2], B0[2][2], B1[2][2];
    const char* cA = (const char*)g.A + (size_t)cur.pm * tstep; const char* cB = (const char*)g.Bt + (size_t)cur.pn * tstep;
    S.a_ready(cur);
    if constexpr (SP2) {
        PG8_STAGE(PG8_SB(0, 0), cB, voffB); PG8_STAGE(PG8_SB(0, 1), cB + hstep, voffB); PG8_STAGE(PG8_SA(0, 0), cA, voffA); PG8_STAGE(PG8_SA(0, 1), cA + hstep, voffA);
        if (wr == 1) PG8_BAR;
        PG8_WAIT_V(2); PG8_BAR;
        PG8_STAGE(PG8_SB(1, 0), cB + kstep, voffB); PG8_STAGE(PG8_SA(1, 0), cA + kstep, voffA); PG8_STAGE(PG8_SB(1, 1), cB + hstep + kstep, voffB);
        PG8_WAIT_V(6); PG8_BAR;
    } else {
        PG8_STAGE(PG8_SB(0, 0), cB, voffB); PG8_STAGE(PG8_SA(0, 0), cA, voffA); PG8_STAGE(PG8_SB(0, 1), cB + hstep, voffB); PG8_STAGE(PG8_SA(0, 1), cA + hstep, voffA);
        if (wr == 1) PG8_BAR;
        PG8_WAIT_V(4); PG8_BAR;
        PG8_STAGE(PG8_SB(1, 0), cB + kstep, voffB); PG8_STAGE(PG8_SA(1, 0), cA + kstep, voffA); PG8_STAGE(PG8_SB(1, 1), cB + hstep + kstep, voffB);
        PG8_WAIT_V(6); PG8_BAR;
    }
    for (;;) {
        const bool has_next = S.next(ui + 1, nxt);
        const char* nA = has_next ? (const char*)g.A + (size_t)nxt.pm * tstep : cA; const char* nB = has_next ? (const char*)g.Bt + (size_t)nxt.pn * tstep : cB;
        for (int t = 0; t < nt; t += 2) {
            const bool last = (t == nt - 2);
            const char* a1 = cA + (size_t)(t + 1) * kstep;
            const char* a2 = last ? nA : cA + (size_t)(t + 2) * kstep; const char* b2 = last ? nB : cB + (size_t)(t + 2) * kstep;
            const char* a3 = a2 + kstep; const char* b3 = b2 + kstep;
            if (last && has_next) S.a_ready(nxt);
            if constexpr (SP2) {
            PG8_LDB(B0, 0, 0); PG8_LDB(B1, 0, 1); PG8_SCHED; PG8_LDA(At, 0, 0); PG8_STAGE(PG8_SA(1, 1), a1 + hstep, voffA);
            PG8_WAIT_V(8); PG8_WAIT_L(0); PG8_BAR; PG8_MMA(0, 0, At, B0); PG8_MMA(0, 1, At, B1); PG8_BAR; PG8_SCHED;
            PG8_LDA(At, 0, 1); PG8_STAGE(PG8_SB(0, 0), b2, voffB); PG8_STAGE(PG8_SB(0, 1), b2 + hstep, voffB); PG8_STAGE(PG8_SA(0, 0), a2, voffA);
            PG8_WAIT_V(8); PG8_WAIT_L(0); PG8_BAR; PG8_MMA(1, 0, At, B0); PG8_MMA(1, 1, At, B1); PG8_BAR; PG8_SCHED;
            PG8_LDB(B0, 1, 0); PG8_LDB(B1, 1, 1); PG8_SCHED; PG8_LDA(At, 1, 0); PG8_STAGE(PG8_SA(0, 1), a2 + hstep, voffA);
            PG8_WAIT_V(8); PG8_WAIT_L(0); PG8_BAR; PG8_MMA(0, 0, At, B0); PG8_MMA(0, 1, At, B1); PG8_BAR; PG8_SCHED;
            PG8_LDA(At, 1, 1); PG8_STAGE(PG8_SB(1, 0), b3, voffB); PG8_STAGE(PG8_SB(1, 1), b3 + hstep, voffB); PG8_STAGE(PG8_SA(1, 0), a3, voffA);
            PG8_WAIT_V(8); PG8_WAIT_L(0); PG8_BAR; PG8_MMA(1, 0, At, B0); PG8_MMA(1, 1, At, B1); PG8_BAR; PG8_SCHED;
            } else {
            PG8_LDB(B0, 0, 0); PG8_SCHED; PG8_LDA(At, 0, 0); PG8_STAGE(PG8_SA(1, 1), a1 + hstep, voffA);
            PG8_WAIT_L(8); PG8_BAR; PG8_WAIT_L(0); PG8_MMA(0, 0, At, B0); PG8_BAR; PG8_SCHED;
            PG8_LDB(B1, 0, 1); PG8_STAGE(PG8_SB(0, 0), b2, voffB);
            PG8_BAR; PG8_WAIT_L(0); PG8_MMA(0, 1, At, B1); PG8_BAR;
            PG8_LDA(At, 0, 1); PG8_STAGE(PG8_SA(0, 0), a2, voffA);
            PG8_BAR; PG8_WAIT_L(0); PG8_MMA(1, 0, At, B0); PG8_BAR; PG8_SCHED;
            PG8_STAGE(PG8_SB(0, 1), b2 + hstep, voffB);
            PG8_WAIT_V(6); PG8_BAR; PG8_MMA(1, 1, At, B1); PG8_BAR;
            PG8_LDB(B0, 1, 0); PG8_SCHED; PG8_LDA(At, 1, 0); PG8_STAGE(PG8_SA(0, 1), a2 + hstep, voffA);
            PG8_WAIT_L(8); PG8_BAR; PG8_WAIT_L(0); PG8_MMA(0, 0, At, B0); PG8_BAR; PG8_SCHED;
            PG8_LDB(B1, 1, 1); PG8_STAGE(PG8_SB(1, 0), b3, voffB);
            PG8_BAR; PG8_WAIT_L(0); PG8_MMA(0, 1, At, B1); PG8_BAR;
            PG8_LDA(At, 1, 1); PG8_STAGE(PG8_SA(1, 0), a3, voffA);
            PG8_BAR; PG8_WAIT_L(0); PG8_MMA(1, 0, At, B0); PG8_BAR; PG8_SCHED;
            PG8_STAGE(PG8_SB(1, 1), b3 + hstep, voffB);
            PG8_WAIT_V(6); PG8_BAR; PG8_MMA(1, 1, At, B1); PG8_BAR;
            }
        }
        if constexpr (ALIGN_EPI) { if (wr == 0) PG8_BAR; }
        if constexpr (!Epi::AFTER_DRAIN) { E(acc, cur, wr, wc, fr, fq); S.done(cur); }
        if (!has_next) break;
#pragma unroll
        for (int a = 0; a < 2; ++a)
#pragma unroll
            for (int b = 0; b < 2; ++b)
#pragma unroll
                for (int m = 0; m < 4; ++m)
#pragma unroll
                    for (int n = 0; n < 2; ++n) acc[a][b][m][n] = (f32x4){0.f, 0.f, 0.f, 0.f};
        cur = nxt; cA = nA; cB = nB; ++ui;
        if constexpr (ALIGN_EPI) { if (wr == 1) PG8_BAR; }
    }
    PG8_WAIT_V(0);
    if constexpr (!ALIGN_EPI) { if (wr == 0) PG8_BAR; }
    PG8_BAR;
#undef PG8_SA
#undef PG8_SB
#undef PG8_STAGE
#undef PG8_LDA
#undef PG8_LDB
#undef PG8_MMA
#undef PG8_WAIT_V
#undef PG8_WAIT_L
#undef PG8_BAR
#undef PG8_SCHED
}
}

#define XB_TMO      128
#define XB_XCNT(j)  (256  + 64 * (j))
#define XB_XSUB(j)  (1280 + 64 * (j))
#define XB_XGEN(j)  (2304 + 64 * (j))
#define XB_TOP      3328
#define XB_TOPGEN   3392
#define XCD_BAR_WORDS 3456
#define XB_SPIN_CAP (1u << 18)
__device__ __forceinline__ unsigned xb_ld(unsigned* p)              { return __hip_atomic_load(p, __ATOMIC_RELAXED, __HIP_MEMORY_SCOPE_AGENT); }
__device__ __forceinline__ unsigned xb_add(unsigned* p, unsigned v) { return __hip_atomic_fetch_add(p, v, __ATOMIC_RELAXED, __HIP_MEMORY_SCOPE_AGENT); }
__device__ __forceinline__ unsigned xb_xcc_id() { return (unsigned)__builtin_amdgcn_s_getreg((3 << 11) | 20) & 0xFu; }
#define XB_SPIN(cond, bar) do { unsigned _sp = 0; while (cond) { __builtin_amdgcn_s_sleep(1); \
    if ((++_sp & 255u) == 0u) { if (xb_ld(&(bar)[XB_TMO])) break; if (_sp > XB_SPIN_CAP) { atomicAdd(&(bar)[XB_TMO], 1u); break; } } } } while (0)
struct XcdBarrier { unsigned* bar; unsigned x; volatile LAS unsigned* st; };
__device__ __forceinline__ XcdBarrier xcd_barrier_post(unsigned* bar, volatile LAS unsigned* st) {
    XcdBarrier b; b.bar = bar; b.x = xb_xcc_id(); b.st = st;
    if (threadIdx.x == 0) (void)xb_add(&bar[XB_XCNT(b.x)], 1u);
    return b;
}
__device__ __forceinline__ void xcd_barrier_complete(unsigned* bar, unsigned x, unsigned& nloc, unsigned& nx) {
    const unsigned G = gridDim.x * gridDim.y * gridDim.z;
    unsigned sum, cnt, mine, sp = 0u;
    for (;;) {
        sum = 0u; cnt = 0u; mine = 0u;
#pragma unroll
        for (unsigned j = 0; j < 16; ++j) { const unsigned c = xb_ld(&bar[XB_XCNT(j)]); sum += c; cnt += (c > 0u) ? 1u : 0u; mine = (j == x) ? c : mine; }
        if (sum == G) break;
        __builtin_amdgcn_s_sleep(1);
        if ((++sp & 255u) == 0u) { if (xb_ld(&bar[XB_TMO])) break; if (sp > XB_SPIN_CAP) { atomicAdd(&bar[XB_TMO], 1u); break; } }
    }
    nloc = mine > 0u ? mine : 1u; nx = cnt > 0u ? cnt : 1u;
}
__device__ __forceinline__ void xcd_barrier(const XcdBarrier& b) {
    asm volatile("s_waitcnt vmcnt(0)" ::: "memory");
    __syncthreads();
    if (threadIdx.x == 0) {
        unsigned* bar = b.bar;
        __builtin_amdgcn_s_waitcnt(0);
        unsigned nloc = b.st[0], nx = b.st[1];
        if (nloc == 0u) { xcd_barrier_complete(bar, b.x, nloc, nx); b.st[0] = nloc; b.st[1] = nx; }
        const unsigned old = xb_add(&bar[XB_XSUB(b.x)], 1u);
        const unsigned gen = old / nloc;
        if (old + 1u == (gen + 1u) * nloc) {
            __builtin_amdgcn_fence(__ATOMIC_RELEASE, "agent");
            asm volatile("s_waitcnt vmcnt(0)" ::: "memory");
            const unsigned og = xb_add(&bar[XB_TOP], 1u);
            const unsigned tg = og / nx;
            if (og + 1u == (tg + 1u) * nx) xb_add(&bar[XB_TOPGEN], 1u);
            else XB_SPIN(xb_ld(&bar[XB_TOPGEN]) == tg, bar);
            __builtin_amdgcn_fence(__ATOMIC_ACQUIRE, "agent");
            xb_add(&bar[XB_XGEN(b.x)], 1u);
            asm volatile("s_waitcnt vmcnt(0)" ::: "memory");
        } else {
            XB_SPIN(xb_ld(&bar[XB_XGEN(b.x)]) == gen, bar);
            __builtin_amdgcn_fence(__ATOMIC_ACQUIRE, "agent");
            asm volatile("s_waitcnt vmcnt(0)" ::: "memory");
        }
    }
    __syncthreads();
}

constexpr int NWAVES = 8;
constexpr int RING_OFF = 0, RING_BYTES = 131072;
constexpr int LDSCTL_OFF = RING_BYTES, MISC_OFF = LDSCTL_OFF + 320;
constexpr int LDS_BYTES = 147456;

struct Frame {
    LAS unsigned char* lds; volatile LAS unsigned* MISC; unsigned* ctl;
    int tid, lane, wave, vcu, G;
    const float* const* in; float* out; unsigned char* ws;
};
enum { I_X = 0, I_RELB, I_NFFN1, I_F1G, I_F1U, I_F1D, I_NMIX, I_WIN, I_MIXRKV, I_MIXWAG, I_WLA, I_WLB, I_W0, I_ALA, I_ALB, I_A0, I_GLA, I_GLB, I_KK, I_KA, I_RKP, I_LNW, I_LNB,
       I_PA, I_PB, I_WOUT, I_NFFN2, I_F2G, I_F2U, I_F2D, I_NFIN };

__device__ __forceinline__ float wave_sum(float v) {
#pragma unroll
    for (int o = 1; o < 64; o <<= 1) v += __shfl_xor(v, o);
    return v;
}

__device__ __forceinline__ void tr_item(const float* W, int ldw, int c0, bf16* WT, int K, int drow0, int k0, const float* g, const float* mix, int mode, LAS float* scr, int lane) {
#pragma unroll 8
    for (int i = 0; i < 32; ++i) { const int kk = 2 * i + (lane >> 5), k = k0 + kk; float s = g ? g[k] : 1.0f; if (mode == 1) s *= (1.0f - mix[k]); else if (mode == 2) s *= mix[k];
        scr[kk * 33 + (lane & 31)] = W[(size_t)k * ldw + c0 + (lane & 31)] * s; }
    LDS_WAIT(); asm volatile("" ::: "memory");
    const int c = lane & 7;
#pragma unroll
    for (int j = 0; j < 4; ++j) { const int n = (lane >> 3) + 8 * j; const LAS float* s = scr + (8 * c) * 33 + n;
        u32x4 o; o.x = pk2(s[0 * 33], s[1 * 33]); o.y = pk2(s[2 * 33], s[3 * 33]); o.z = pk2(s[4 * 33], s[5 * 33]); o.w = pk2(s[6 * 33], s[7 * 33]);
        *(u32x4*)(WT + (size_t)(drow0 + n) * K + k0 + 8 * c) = o; }
    LDS_WAIT(); asm volatile("" ::: "memory");
}
__device__ __forceinline__ void gu_item(const float* Wg, const float* Wu, const float* g, bf16* WT, int r, LAS float* scr, int lane) {
    const int kb = r / 176, nb = r % 176, pn = nb >> 3, bj = (nb >> 2) & 1, o = nb & 3;
    tr_item(bj ? Wu : Wg, FF, 128 * pn + 32 * o, WT, D, 32 * nb, 64 * kb, g, nullptr, 0, scr, lane);
}
__device__ __forceinline__ void p0_prologue(Frame& F) {
    LAS float* scr = (LAS float*)(F.lds + RING_OFF + F.wave * 16384);
    const int gw = F.vcu * NWAVES + F.wave, NGW = F.G * NWAVES;
    unsigned char* ws = F.ws;
    constexpr int J0 = 16 * 176, J1 = 44 * 32, J2 = 16 * 96, J3 = 16 * 18, J4 = 16 * 64, J5 = 8 * 32, J6 = 8 * 32, J7 = 16 * 32, J8 = J0, J9 = J1;
    constexpr int NITEMS = J0 + J1 + J2 + J3 + J4 + J5 + J6 + J7 + J8 + J9;
    for (int it = gw; it < NITEMS; it += NGW) {
        int r = it;
        if (r < J0) { gu_item(F.in[I_F1G], F.in[I_F1U], F.in[I_NFFN1], (bf16*)(ws + WS_WGU1), r, scr, F.lane); continue; } r -= J0;
        if (r < J1) { const int kb = r / 32, nb = r % 32; tr_item(F.in[I_F1D], D, 32 * nb, (bf16*)(ws + WS_WD1), FF, 32 * nb, 64 * kb, nullptr, nullptr, 0, scr, F.lane); continue; } r -= J1;
        if (r < J2) { const int kb = r / 96, nb = r % 96; tr_item(F.in[I_WIN], 5120, 32 * nb, (bf16*)(ws + WS_WIN), D, 32 * nb, 64 * kb, F.in[I_NMIX], nullptr, 0, scr, F.lane); continue; } r -= J2;
        if (r < J3) { const int kb = r / 18, nb = r % 18, md = nb < 9 ? 1 : 2, n9 = nb % 9;
            const float* W; int ldw, c0; const float* mix;
            if (n9 < 2) { W = F.in[I_WLA]; ldw = 64; c0 = 32 * n9; mix = F.in[I_MIXWAG]; }
            else if (n9 < 4) { W = F.in[I_ALA]; ldw = 64; c0 = 32 * (n9 - 2); mix = F.in[I_MIXWAG] + D; }
            else { W = F.in[I_GLA]; ldw = 160; c0 = 32 * (n9 - 4); mix = F.in[I_MIXWAG] + 2 * D; }
            tr_item(W, ldw, c0, (bf16*)(ws + WS_WIN), D, 3072 + 32 * nb, 64 * kb, F.in[I_NMIX], mix, md, scr, F.lane); continue; } r -= J3;
        if (r < J4) { const int kb = r / 64, nb = r % 64; tr_item(F.in[I_WIN], 5120, 3072 + 32 * nb, (bf16*)(ws + WS_WG), D, 32 * nb, 64 * kb, F.in[I_NMIX], nullptr, 0, scr, F.lane); continue; } r -= J4;
        if (r < J5) { const int kb = r / 32, nb = r % 32; tr_item(F.in[I_PA], D, 32 * nb, (bf16*)(ws + WS_WA), 512, 32 * nb, 64 * kb, nullptr, nullptr, 0, scr, F.lane); continue; } r -= J5;
        if (r < J6) { const int kb = r / 32, nb = r % 32; tr_item(F.in[I_PB], D, 32 * nb, (bf16*)(ws + WS_WB), 512, 32 * nb, 64 * kb, nullptr, nullptr, 0, scr, F.lane); continue; } r -= J6;
        if (r < J7) { const int kb = r / 32, nb = r % 32; tr_item(F.in[I_WOUT], D, 32 * nb, (bf16*)(ws + WS_WOUT), D, 32 * nb, 64 * kb, nullptr, nullptr, 0, scr, F.lane); continue; } r -= J7;
        if (r < J8) { gu_item(F.in[I_F2G], F.in[I_F2U], F.in[I_NFFN2], (bf16*)(ws + WS_WGU2), r, scr, F.lane); continue; } r -= J8;
        { const int kb = r / 32, nb = r % 32; tr_item(F.in[I_F2D], D, 32 * nb, (bf16*)(ws + WS_WD2), FF, 32 * nb, 64 * kb, nullptr, nullptr, 0, scr, F.lane); }
    }
    const int gt = F.vcu * 512 + F.tid, NGT = F.G * 512;
    { u32x4* z = (u32x4*)(ws + WS_WIN + (size_t)3648 * D * 2); for (int i = gt; i < 192 * D * 2 / 16; i += NGT) z[i] = (u32x4){0u, 0u, 0u, 0u}; }
    { bf16* lw = (bf16*)(ws + WS_LBW); bf16* la = (bf16*)(ws + WS_LBA); bf16* lg = (bf16*)(ws + WS_LBG);
      for (int i = gt; i < 512 * 64; i += NGT) { const int n = i >> 6, k = i & 63; lw[i] = (bf16)f2bf(F.in[I_WLB][k * 512 + n]); la[i] = (bf16)f2bf(F.in[I_ALB][k * 512 + n]); }
      for (int i = gt; i < 512 * 160; i += NGT) { const int n = i / 160, k = i % 160; lg[i] = (bf16)f2bf(F.in[I_GLB][k * 512 + n]); } }
    { const float* x = F.in[I_X]; bf16* xb = (bf16*)(ws + WS_XB); float* ssq = (float*)(ws + OFF_SSQ1);
      for (int m = gw; m < M; m += NGW) {
          const f32x4* xr = (const f32x4*)(x + (size_t)m * D) + F.lane; f32x4 v[4]; float s = 0.f;
#pragma unroll
          for (int j = 0; j < 4; ++j) { v[j] = xr[64 * j]; s += (v[j].x * v[j].x + v[j].y * v[j].y) + (v[j].z * v[j].z + v[j].w * v[j].w); }
          s = wave_sum(s); if (F.lane == 0) ssq[m] = s;
          unsigned long long* o8 = (unsigned long long*)(xb + (size_t)m * D) + F.lane;
#pragma unroll
          for (int j = 0; j < 4; ++j) o8[64 * j] = (unsigned long long)pk2(v[j].x, v[j].y) | ((unsigned long long)pk2(v[j].z, v[j].w) << 32);
      } }
}

__device__ __forceinline__ int t5_bucket(int n) {
    if (n < 16) return n < 0 ? 0 : n;
    int b = 16;
    b += (n >= 21); b += (n >= 27); b += (n >= 35); b += (n >= 46); b += (n >= 59); b += (n >= 77); b += (n >= 99); b += (n >= 128);
    b += (n >= 166); b += (n >= 216); b += (n >= 280); b += (n >= 363); b += (n >= 470); b += (n >= 609); b += (n >= 790);
    return b;
}

__device__ __forceinline__ void attn_simple(Frame& F) {
    LAS float* tab = (LAS float*)(F.lds + RING_OFF);
    const float* relb = F.in[I_RELB];
    for (int i = F.tid; i < 8 * 800; i += 512) { const int h = i / 800, d = i % 800; tab[i] = relb[t5_bucket(d) * NH + h] * LOG2E; }
    __syncthreads();
    const bf16* Q = (const bf16*)(F.ws + WS_Q); const bf16* K = (const bf16*)(F.ws + WS_K); const bf16* V = (const bf16*)(F.ws + WS_V); bf16* O = (bf16*)(F.ws + WS_Q);
    const float* kmean = (const float*)(F.ws + OFF_KMEAN);
    const int wv = blockIdx.x * NWAVES + F.wave;
    const int bh = wv >> 6, b = bh >> 3, h = bh & 7, q = (wv & 63) * 64 + F.lane, blk = q >> 8;
    const LAS float* tb = tab + h * 800;
    const size_t rowq = (size_t)(b * SEQ + q) * 512 + h * 64;
    float qf[64];
#pragma unroll
    for (int c = 0; c < 8; ++c) { const u32x4 w = *(const u32x4*)(Q + rowq + c * 8);
        qf[c * 8 + 0] = bflo(w.x); qf[c * 8 + 1] = bfhi(w.x); qf[c * 8 + 2] = bflo(w.y); qf[c * 8 + 3] = bfhi(w.y); qf[c * 8 + 4] = bflo(w.z); qf[c * 8 + 5] = bfhi(w.z); qf[c * 8 + 6] = bflo(w.w); qf[c * 8 + 7] = bfhi(w.w); }
    float g0 = -INFINITY, g1 = -INFINITY, g2 = -INFINITY; int s0 = -1, s1 = -1, s2 = -1;
    for (int n = 0; n < blk; ++n) {
        const float* km = kmean + ((size_t)bh * 16 + n) * 64; float gsum = 0.f;
#pragma unroll
        for (int d = 0; d < 64; ++d) gsum += qf[d] * km[d];
        if (gsum > g0) { g2 = g1; s2 = s1; g1 = g0; s1 = s0; g0 = gsum; s0 = n; }
        else if (gsum > g1) { g2 = g1; s2 = s1; g1 = gsum; s1 = n; }
        else if (gsum > g2) { g2 = gsum; s2 = n; }
    }
    float o[64];
#pragma unroll
    for (int d = 0; d < 64; ++d) o[d] = 0.f;
    float mx = -1e30f, l = 0.f;
    for (int pass = 0; pass < 4; ++pass) {
        const int jb = pass == 0 ? s0 : pass == 1 ? s1 : pass == 2 ? s2 : blk;
        const bool act = jb >= 0;
        const int jblk = act ? jb : 0;
        const int nkeys = (pass == 3) ? 256 : 256;
        if (pass < 3 && blk <= pass) continue;
        for (int kk = 0; kk < nkeys; ++kk) {
            const int kpos = jblk * 256 + kk;
            const size_t rowk = (size_t)(b * SEQ + kpos) * 512 + h * 64;
            float s = 0.f;
#pragma unroll
            for (int c = 0; c < 8; ++c) { const u32x4 w = *(const u32x4*)(K + rowk + c * 8);
                s += qf[c * 8 + 0] * bflo(w.x) + qf[c * 8 + 1] * bfhi(w.x) + qf[c * 8 + 2] * bflo(w.y) + qf[c * 8 + 3] * bfhi(w.y) + qf[c * 8 + 4] * bflo(w.z) + qf[c * 8 + 5] * bfhi(w.z) + qf[c * 8 + 6] * bflo(w.w) + qf[c * 8 + 7] * bfhi(w.w); }
            const int dist = q - kpos;
            const bool valid = act && dist >= 0;
            const int dcl = dist < 0 ? 0 : (dist > 799 ? 799 : dist);
            s += tb[dcl];
            if (!valid) s = -1e30f;
            const float mn = fmaxf(mx, s);
            const float f = fast_exp2(mx - mn), p = valid ? fast_exp2(s - mn) : 0.f;
            l = l * f + p; mx = mn;
#pragma unroll
            for (int c = 0; c < 8; ++c) { const u32x4 w = *(const u32x4*)(V + rowk + c * 8);
                o[c * 8 + 0] = o[c * 8 + 0] * f + p * bflo(w.x); o[c * 8 + 1] = o[c * 8 + 1] * f + p * bfhi(w.x); o[c * 8 + 2] = o[c * 8 + 2] * f + p * bflo(w.y); o[c * 8 + 3] = o[c * 8 + 3] * f + p * bfhi(w.y);
                o[c * 8 + 4] = o[c * 8 + 4] * f + p * bflo(w.z); o[c * 8 + 5] = o[c * 8 + 5] * f + p * bfhi(w.z); o[c * 8 + 6] = o[c * 8 + 6] * f + p * bflo(w.w); o[c * 8 + 7] = o[c * 8 + 7] * f + p * bfhi(w.w); }
        }
    }
    const float il = 1.0f / l;
#pragma unroll
    for (int c = 0; c < 8; ++c) { u32x4 w; w.x = pk2(o[c * 8 + 0] * il, o[c * 8 + 1] * il); w.y = pk2(o[c * 8 + 2] * il, o[c * 8 + 3] * il); w.z = pk2(o[c * 8 + 4] * il, o[c * 8 + 5] * il); w.w = pk2(o[c * 8 + 6] * il, o[c * 8 + 7] * il);
        *(u32x4*)(O + rowq + c * 8) = w; }
}

__device__ __forceinline__ void mix_phase(Frame& F) {
    unsigned char* ws = F.ws;
    const bf16* Z = (const bf16*)(ws + WS_Z);
    bf16* R = (bf16*)(ws + WS_R); bf16* KR = (bf16*)(ws + WS_KR); bf16* VR = (bf16*)(ws + WS_VR);
    bf16* KKo = (bf16*)(ws + WS_KK); bf16* BBo = (bf16*)(ws + WS_BB); float* WD = (float*)(ws + WS_WDEC); bf16* GB = (bf16*)(ws + WS_GB); float* RK = (float*)(ws + WS_RK);
    const bf16* bnd = (const bf16*)(ws + WS_BND);
    const bf16* LBW = (const bf16*)(ws + WS_LBW); const bf16* LBA = (const bf16*)(ws + WS_LBA); const bf16* LBG = (const bf16*)(ws + WS_LBG);
    const float* mixrkv = F.in[I_MIXRKV]; const float* w0 = F.in[I_W0]; const float* a0 = F.in[I_A0]; const float* k_k = F.in[I_KK]; const float* k_a = F.in[I_KA]; const float* r_k = F.in[I_RKP];
    const int lane = F.lane, n = lane & 15, q4 = lane >> 4;
    LAS float* stash = (LAS float*)(F.lds + RING_OFF) + F.wave * 2560;
    LAS float* keep = stash + 384;
    for (int item = blockIdx.x; item < 256; item += F.G) {
        const int pm = item >> 2, hp = item & 3;
        const int R0 = pm * 256 + F.wave * 32;
        if (q4 == 0) {
#pragma unroll
            for (int hh = 0; hh < 2; ++hh)
#pragma unroll
                for (int c = 0; c < 4; ++c) {
                    const int ch = (2 * hp + hh) * 64 + 16 * c + n; float vr = 0.f, vk = 0.f, vv = 0.f;
                    if ((R0 & (SEQ - 1)) != 0) {
                        if (F.wave == 0) { const bf16* bp = bnd + (size_t)(pm - 1) * 1536; vr = bf2f(bp[ch]); vk = bf2f(bp[512 + ch]); vv = bf2f(bp[1024 + ch]); }
                        else { const size_t o = (size_t)(R0 - 1) * 512 + ch; vr = bf2f(R[o]); vk = bf2f(KR[o]); vv = bf2f(VR[o]); }
                    }
                    stash[((hh * 4 + c) * 3 + 0) * 16 + n] = vr; stash[((hh * 4 + c) * 3 + 1) * 16 + n] = vk; stash[((hh * 4 + c) * 3 + 2) * 16 + n] = vv;
                }
        }
        asm volatile("s_waitcnt vmcnt(0) lgkmcnt(0)" ::: "memory"); __syncthreads();
#pragma unroll 1
        for (int g = 1; g >= 0; --g) {
            const int t0 = R0 + 16 * g;
            bf16x8 Af[9];
            {
                const int t = t0 + n; const bool first = (t & (SEQ - 1)) == 0;
#pragma unroll
                for (int s = 0; s < 9; ++s) {
                    const u32x4 z1 = *(const u32x4*)(Z + (size_t)t * ZP + 32 * s + 8 * q4);
                    u32x4 z2 = (u32x4){0u, 0u, 0u, 0u}; if (!first) z2 = *(const u32x4*)(Z + (size_t)(t - 1) * ZP + 288 + 32 * s + 8 * q4);
                    float hv[8] = { bflo(z1.x) + bflo(z2.x), bfhi(z1.x) + bfhi(z2.x), bflo(z1.y) + bflo(z2.y), bfhi(z1.y) + bfhi(z2.y), bflo(z1.z) + bflo(z2.z), bfhi(z1.z) + bfhi(z2.z), bflo(z1.w) + bflo(z2.w), bfhi(z1.w) + bfhi(z2.w) };
#pragma unroll
                    for (int i = 0; i < 8; ++i) { if (s < 2) { const float e = fast_exp2(hv[i] * (2.0f * LOG2E)); hv[i] = 1.0f - 2.0f * fast_rcp(e + 1.0f); } else if (s >= 4) hv[i] = sigmoidf_(hv[i]); }
                    u32x4 p; p.x = pk2(hv[0], hv[1]); p.y = pk2(hv[2], hv[3]); p.z = pk2(hv[4], hv[5]); p.w = pk2(hv[6], hv[7]);
                    Af[s] = __builtin_bit_cast(bf16x8, p);
                }
            }
#pragma unroll 1
            for (int hh = 0; hh < 2; ++hh) {
                const int hd = 2 * hp + hh;
                float n2[4] = {0.f, 0.f, 0.f, 0.f}, rks[4] = {0.f, 0.f, 0.f, 0.f};
#pragma unroll 1
                for (int c = 0; c < 4; ++c) {
                    const int ch = hd * 64 + 16 * c + n;
                    float oR[5], oK[5], oV[5];
                    if (q4 == 0 && g == 0) { oR[0] = stash[((hh * 4 + c) * 3 + 0) * 16 + n]; oK[0] = stash[((hh * 4 + c) * 3 + 1) * 16 + n]; oV[0] = stash[((hh * 4 + c) * 3 + 2) * 16 + n]; }
                    else { const size_t o = (size_t)(t0 + 4 * q4 - 1) * 512 + ch; oR[0] = bf2f(R[o]); oK[0] = bf2f(KR[o]); oV[0] = bf2f(VR[o]); }
#pragma unroll
                    for (int i = 0; i < 4; ++i) { const size_t o = (size_t)(t0 + 4 * q4 + i) * 512 + ch; oR[i + 1] = bf2f(R[o]); oK[i + 1] = bf2f(KR[o]); oV[i + 1] = bf2f(VR[o]); }
                    asm volatile("s_waitcnt vmcnt(0) lgkmcnt(0)" ::: "memory");
                    f32x4 aw = (f32x4){0.f, 0.f, 0.f, 0.f}, aa = aw, ag = aw;
#pragma unroll
                    for (int s = 0; s < 2; ++s) { const bf16x8 b = *(const bf16x8*)(LBW + (size_t)ch * 64 + 32 * s + 8 * q4); aw = __builtin_amdgcn_mfma_f32_16x16x32_bf16(Af[s], b, aw, 0, 0, 0); }
#pragma unroll
                    for (int s = 0; s < 2; ++s) { const bf16x8 b = *(const bf16x8*)(LBA + (size_t)ch * 64 + 32 * s + 8 * q4); aa = __builtin_amdgcn_mfma_f32_16x16x32_bf16(Af[2 + s], b, aa, 0, 0, 0); }
#pragma unroll
                    for (int s = 0; s < 5; ++s) { const bf16x8 b = *(const bf16x8*)(LBG + (size_t)ch * 160 + 32 * s + 8 * q4); ag = __builtin_amdgcn_mfma_f32_16x16x32_bf16(Af[4 + s], b, ag, 0, 0, 0); }
                    const float mr = mixrkv[ch], mk = mixrkv[512 + ch], mv = mixrkv[1024 + ch], w0c = w0[ch], a0c = a0[ch], kkc = k_k[ch], kac = k_a[ch], rkc = r_k[ch];
#pragma unroll
                    for (int i = 0; i < 4; ++i) {
                        const size_t o = (size_t)(t0 + 4 * q4 + i) * 512 + ch;
                        const float cr = oR[i + 1], ck = oK[i + 1], cv = oV[i + 1];
                        const float r_ = cr + (oR[i] - cr) * mr, k_ = ck + (oK[i] - ck) * mk, v_ = cv + (oV[i] - cv) * mv;
                        const float sg = sigmoidf_(w0c + aw[i]);
                        const float dec = fast_exp2(-0.6065306597126334f * LOG2E * sg);
                        const float a_ = sigmoidf_(a0c + aa[i]);
                        const float kr_ = k_ * kkc; n2[i] += kr_ * kr_;
                        const float kt_ = k_ * (1.0f + (a_ - 1.0f) * kac);
                        rks[i] += r_ * kt_ * rkc;
                        keep[((c * 4 + i) * 2 + 0) * 64 + lane] = kr_; keep[((c * 4 + i) * 2 + 1) * 64 + lane] = a_;
                        R[o] = (bf16)f2bf(r_); KR[o] = (bf16)f2bf(kt_); VR[o] = (bf16)f2bf(v_); WD[o] = dec; GB[o] = (bf16)f2bf(ag[i]);
                    }
                }
#pragma unroll
                for (int i = 0; i < 4; ++i) {
                    float a = n2[i], b = rks[i];
                    a += __shfl_xor(a, 1); a += __shfl_xor(a, 2); a += __shfl_xor(a, 4); a += __shfl_xor(a, 8);
                    b += __shfl_xor(b, 1); b += __shfl_xor(b, 2); b += __shfl_xor(b, 4); b += __shfl_xor(b, 8);
                    n2[i] = 1.0f / fmaxf(sqrtf(a), 1e-12f); rks[i] = b;
                }
                LDS_WAIT();
#pragma unroll 1
                for (int c = 0; c < 4; ++c) {
                    const int ch = hd * 64 + 16 * c + n;
#pragma unroll
                    for (int i = 0; i < 4; ++i) {
                        const size_t o = (size_t)(t0 + 4 * q4 + i) * 512 + ch;
                        const float kk_ = keep[((c * 4 + i) * 2 + 0) * 64 + lane] * n2[i], a_ = keep[((c * 4 + i) * 2 + 1) * 64 + lane];
                        KKo[o] = (bf16)f2bf(kk_); BBo[o] = (bf16)f2bf(kk_ * a_);
                    }
                }
                LDS_WAIT();
                if (n == 0) {
#pragma unroll
                    for (int i = 0; i < 4; ++i) RK[(size_t)(t0 + 4 * q4 + i) * 8 + hd] = rks[i];
                }
            }
        }
        __syncthreads();
    }
}

__device__ __forceinline__ float dpp_sum16(float x) {
    x += __builtin_bit_cast(float, __builtin_amdgcn_update_dpp(0, __builtin_bit_cast(int, x), 0xB1, 0xf, 0xf, true));
    x += __builtin_bit_cast(float, __builtin_amdgcn_update_dpp(0, __builtin_bit_cast(int, x), 0x4E, 0xf, 0xf, true));
    x += __builtin_bit_cast(float, __builtin_amdgcn_update_dpp(0, __builtin_bit_cast(int, x), 0x141, 0xf, 0xf, true));
    x += __builtin_bit_cast(float, __builtin_amdgcn_update_dpp(0, __builtin_bit_cast(int, x), 0x140, 0xf, 0xf, true));
    return x;
}
struct ScanBlk { u32x2 r[4], k[4], kk[4], bb[4]; f32x4 w[4]; unsigned v[4]; };
__device__ __forceinline__ void scan_phase(Frame& F) {
    if (F.wave >= 2) return;
    unsigned char* ws = F.ws;
    const bf16* R = (const bf16*)(ws + WS_R); const bf16* KR = (const bf16*)(ws + WS_KR); const bf16* VR = (const bf16*)(ws + WS_VR);
    const bf16* KK = (const bf16*)(ws + WS_KK); const bf16* BB = (const bf16*)(ws + WS_BB); const float* WD = (const float*)(ws + WS_WDEC);
    bf16* Y = (bf16*)(ws + WS_YRAW);
    for (int task = blockIdx.x * 2 + F.wave; task < 512; task += F.G * 2) {
        const int bh = task >> 4, rg = task & 15, b = bh >> 3, h = bh & 7;
        const int j = F.lane & 15, rr = F.lane >> 4, vi = 4 * rg + rr;
        const size_t base = (size_t)b * SEQ * 512 + h * 64;
        const size_t o4 = base + 4 * j, ov = base + vi;
        float s0 = 0.f, s1 = 0.f, s2 = 0.f, s3 = 0.f, ysel = 0.f;
        ScanBlk cur, nxt;
#define SCAN_LOAD(B, T0) do { _Pragma("unroll") for (int u_ = 0; u_ < 4; ++u_) { const size_t rw_ = (size_t)((T0) + u_) * 512; \
            B.r[u_] = *(const u32x2*)(R + o4 + rw_); B.k[u_] = *(const u32x2*)(KR + o4 + rw_); B.kk[u_] = *(const u32x2*)(KK + o4 + rw_); B.bb[u_] = *(const u32x2*)(BB + o4 + rw_); \
            B.w[u_] = *(const f32x4*)(WD + o4 + rw_); B.v[u_] = VR[ov + rw_]; } } while (0)
        SCAN_LOAD(cur, 0);
        for (int t0 = 0; t0 < SEQ; t0 += 4) {
            const int tn = (t0 + 4 < SEQ) ? t0 + 4 : t0;
            SCAN_LOAD(nxt, tn);
#pragma unroll
            for (int u = 0; u < 4; ++u) {
                const float kk0 = bflo(cur.kk[u].x), kk1 = bfhi(cur.kk[u].x), kk2 = bflo(cur.kk[u].y), kk3 = bfhi(cur.kk[u].y);
                float sa = (s0 * kk0 + s1 * kk1) + (s2 * kk2 + s3 * kk3);
                sa = dpp_sum16(sa);
                const float v_ = __builtin_bit_cast(float, cur.v[u] << 16);
                const float b0 = bflo(cur.bb[u].x), b1 = bfhi(cur.bb[u].x), b2 = bflo(cur.bb[u].y), b3 = bfhi(cur.bb[u].y);
                const float k0 = bflo(cur.k[u].x), k1 = bfhi(cur.k[u].x), k2 = bflo(cur.k[u].y), k3 = bfhi(cur.k[u].y);
                s0 = s0 * cur.w[u][0] + (v_ * k0 - sa * b0); s1 = s1 * cur.w[u][1] + (v_ * k1 - sa * b1); s2 = s2 * cur.w[u][2] + (v_ * k2 - sa * b2); s3 = s3 * cur.w[u][3] + (v_ * k3 - sa * b3);
                const float r0 = bflo(cur.r[u].x), r1 = bfhi(cur.r[u].x), r2 = bflo(cur.r[u].y), r3 = bfhi(cur.r[u].y);
                float y = (s0 * r0 + s1 * r1) + (s2 * r2 + s3 * r3);
                y = dpp_sum16(y);
                if (((t0 + u) & 15) == j) ysel = y;
            }
            if ((t0 & 15) == 12) Y[ov + (size_t)(t0 - 12 + j) * 512] = (bf16)f2bf(ysel);
            cur = nxt;
        }
#undef SCAN_LOAD
    }
}

__device__ __forceinline__ void e1_phase(Frame& F) {
    unsigned char* ws = F.ws;
    const bf16* Y = (const bf16*)(ws + WS_YRAW); const bf16* VR = (const bf16*)(ws + WS_VR); const bf16* GB = (const bf16*)(ws + WS_GB); const float* RK = (const float*)(ws + WS_RK);
    bf16* YB = (bf16*)(ws + WS_YB);
    const float* lnw = F.in[I_LNW]; const float* lnb = F.in[I_LNB];
    const int gw = F.vcu * NWAVES + F.wave, NGW = F.G * NWAVES, c0 = F.lane * 8;
    float lw[8], lb[8];
#pragma unroll
    for (int i = 0; i < 8; ++i) { lw[i] = lnw[c0 + i]; lb[i] = lnb[c0 + i]; }
    for (int m = gw; m < M; m += NGW) {
        const size_t o = (size_t)m * 512 + c0;
        const u32x4 yw = *(const u32x4*)(Y + o), vw = *(const u32x4*)(VR + o), gw_ = *(const u32x4*)(GB + o);
        const float rk = RK[(size_t)m * 8 + (F.lane >> 3)];
        float y[8] = { bflo(yw.x), bfhi(yw.x), bflo(yw.y), bfhi(yw.y), bflo(yw.z), bfhi(yw.z), bflo(yw.w), bfhi(yw.w) };
        const float v[8] = { bflo(vw.x), bfhi(vw.x), bflo(vw.y), bfhi(vw.y), bflo(vw.z), bfhi(vw.z), bflo(vw.w), bfhi(vw.w) };
        const float g[8] = { bflo(gw_.x), bfhi(gw_.x), bflo(gw_.y), bfhi(gw_.y), bflo(gw_.z), bfhi(gw_.z), bflo(gw_.w), bfhi(gw_.w) };
        float s = 0.f;
#pragma unroll
        for (int i = 0; i < 8; ++i) s += y[i];
        s += __shfl_xor(s, 1); s += __shfl_xor(s, 2); s += __shfl_xor(s, 4);
        const float mu = s * (1.0f / 64.0f); float q = 0.f;
#pragma unroll
        for (int i = 0; i < 8; ++i) { y[i] -= mu; q += y[i] * y[i]; }
        q += __shfl_xor(q, 1); q += __shfl_xor(q, 2); q += __shfl_xor(q, 4);
        const float rstd = 1.0f / sqrtf(q * (1.0f / 64.0f) + 64.0f * 1e-5f);
        float ov[8];
#pragma unroll
        for (int i = 0; i < 8; ++i) ov[i] = (y[i] * rstd * lw[i] + lb[i] + rk * v[i]) * g[i];
        u32x4 w; w.x = pk2(ov[0], ov[1]); w.y = pk2(ov[2], ov[3]); w.z = pk2(ov[4], ov[5]); w.w = pk2(ov[6], ov[7]);
        *(u32x4*)(YB + o) = w;
    }
}

__device__ __forceinline__ void fin_phase(Frame& F) {
    const f32x4* gf = (const f32x4*)F.in[I_NFIN] + F.lane;
    const int gw = F.vcu * NWAVES + F.wave, NGW = F.G * NWAVES;
    f32x4 gg[4];
#pragma unroll
    for (int j = 0; j < 4; ++j) gg[j] = gf[64 * j];
    for (int m = gw; m < M; m += NGW) {
        f32x4* xr = (f32x4*)(F.out + (size_t)m * D) + F.lane; f32x4 v[4]; float s = 0.f;
#pragma unroll
        for (int j = 0; j < 4; ++j) { v[j] = xr[64 * j]; s += (v[j].x * v[j].x + v[j].y * v[j].y) + (v[j].z * v[j].z + v[j].w * v[j].w); }
        s = wave_sum(s);
        const float rs = 1.0f / sqrtf(s * (1.0f / D) + RMS_EPS);
#pragma unroll
        for (int j = 0; j < 4; ++j) xr[64 * j] = v[j] * rs * gg[j];
    }
}


#ifdef DBG_OUT
__device__ __forceinline__ void dbg_phase(Frame& F) {
    const int gw = F.vcu * NWAVES + F.wave, NGW = F.G * NWAVES;
    for (int m = gw; m < M; m += NGW) {
        float* o = F.out + (size_t)m * D;
        for (int c = F.lane; c < D; c += 64) {
            bf16 v;
            if (DBG_OUT == 1) v = ((const bf16*)(F.ws + WS_MRG))[(size_t)m * D + c];
            else if (DBG_OUT == 2) v = ((const bf16*)(F.ws + WS_SGA))[(size_t)m * D + c];
            else if (DBG_OUT == 3) v = c < 512 ? ((const bf16*)(F.ws + WS_Q))[(size_t)m * 512 + c] : ((const bf16*)(F.ws + WS_K))[(size_t)m * 512 + c - 512];
            else if (DBG_OUT == 4) v = c < 512 ? ((const bf16*)(F.ws + WS_V))[(size_t)m * 512 + c] : ((const bf16*)(F.ws + WS_R))[(size_t)m * 512 + c - 512];
            else if (DBG_OUT == 5) v = c < 512 ? ((const bf16*)(F.ws + WS_KR))[(size_t)m * 512 + c] : ((const bf16*)(F.ws + WS_VR))[(size_t)m * 512 + c - 512];
            else if (DBG_OUT == 6) v = c < 768 ? ((const bf16*)(F.ws + WS_Z))[(size_t)m * ZP + c] : (bf16)0;
            else if (DBG_OUT == 7) v = ((const bf16*)(F.ws + WS_SGB))[(size_t)m * D + c];
            else if (DBG_OUT == 9) v = ((const bf16*)(F.ws + WS_WG))[(size_t)(m & 2047) * D + c];
            else v = ((const bf16*)(F.ws + WS_XB))[(size_t)m * D + c];
            o[c] = bf2f(v);
        }
    }
}
#endif
struct Args { const float* in[31]; float* out; unsigned char* ws; int ph_lo, ph_hi; };
constexpr int N_PHASES = 14;

#ifndef MK_N_LAUNCHES
#define MK_N_LAUNCHES 1
#endif

__global__ void __launch_bounds__(NWAVES * 64, 2) mk_fwd(Args args) {
    extern __shared__ __attribute__((aligned(16))) unsigned char lds[];
    Frame F;
    F.lds = (LAS unsigned char*)lds; F.MISC = (volatile LAS unsigned*)(F.lds + MISC_OFF);
    F.tid = threadIdx.x; F.lane = F.tid & 63; F.wave = __builtin_amdgcn_readfirstlane(F.tid >> 6);
    F.G = gridDim.x; { const int bx = blockIdx.x; F.vcu = (F.G % 8 == 0) ? (bx % 8) * (F.G / 8) + bx / 8 : bx; }
    F.in = args.in;
    F.out = args.out; F.ws = args.ws; F.ctl = (unsigned*)(args.ws + WS_CTL);
    unsigned char* ws = args.ws;
    for (int u = F.tid; u < (LDS_BYTES - LDSCTL_OFF) / 4; u += NWAVES * 64) ((LAS unsigned*)(F.lds + LDSCTL_OFF))[u] = 0u;
    __syncthreads();
    XcdBarrier bar; bar.bar = F.ctl + CW_BAR; bar.x = 0; bar.st = nullptr;
    if (MK_N_LAUNCHES == 1) bar = xcd_barrier_post(F.ctl + CW_BAR, F.MISC + 8);
    const int lo = args.ph_lo, hi = args.ph_hi;
#ifndef PH_MASK
#define PH_MASK 0xFFFFFFFFu
#endif
#define IN(k) (((PH_MASK >> (k)) & 1u) && lo <= (k) && (k) < hi)
#define SEAM(k) do { if (IN(k) && IN((k) + 1)) xcd_barrier(bar); } while (0)
    float* ssq1 = (float*)(ws + OFF_SSQ1); float* ssq2 = (float*)(ws + WS_SSQ2); float* ssq3 = (float*)(ws + WS_SSQ3);
#ifdef SKIP_MID
    ssq3 = ssq2;
#endif
    bf16* XB = (bf16*)(ws + WS_XB); bf16* ACT = (bf16*)(ws + WS_ACT);
    const int bx = (int)blockIdx.x;

    if (IN(0)) { p0_prologue(F); } SEAM(0);
    if (IN(1)) { pg8::Gemm g{XB, (const bf16*)(ws + WS_WGU1), M, N_GU, D}; pg8::StaticOrder S; S.init(M, N_GU, F.G, bx);
        pg8::EpiSwiGLU<1> E{ACT, FF, ssq1}; pg8::gemm_phase<pg8::EpiSwiGLU<1>, pg8::StaticOrder, true, true>(F.lds + RING_OFF, g, S, E); } SEAM(1);
    if (IN(2)) { pg8::Gemm g{ACT, (const bf16*)(ws + WS_WD1), M, D, FF}; pg8::StaticOrder S; S.init(M, D, F.G, bx);
        pg8::EpiResid E{F.in[I_X], F.out, XB, ssq2, 0.5f}; pg8::gemm_phase<pg8::EpiResid, pg8::StaticOrder, true, true>(F.lds + RING_OFF, g, S, E); } SEAM(2);
    if (IN(3)) { pg8::Gemm g{XB, (const bf16*)(ws + WS_WIN), M, N_IN, D}; pg8::StaticOrder S; S.init(M, N_IN, F.G, bx);
        pg8::EpiProj E{(bf16*)(ws + WS_Q), (bf16*)(ws + WS_Z), ssq2, (float*)(ws + OFF_KMEAN), (bf16*)(ws + WS_BND)};
        pg8::gemm_phase<pg8::EpiProj, pg8::StaticOrder, true, true>(F.lds + RING_OFF, g, S, E); } SEAM(3);
    if (IN(4)) { attn_simple(F); } SEAM(4);
    if (IN(5)) { mix_phase(F); } SEAM(5);
    if (IN(6)) { scan_phase(F); } SEAM(6);
    if (IN(7)) { e1_phase(F);
        pg8::Gemm g{XB, (const bf16*)(ws + WS_WG), M, N_GATE, D}; pg8::StaticOrder S; S.init(M, N_GATE, F.G, bx);
        pg8::EpiGate<0> E{(bf16*)(ws + WS_SGA), nullptr, (bf16*)(ws + WS_SGB), ssq2}; pg8::gemm_phase<pg8::EpiGate<0>, pg8::StaticOrder, true, true>(F.lds + RING_OFF, g, S, E); } SEAM(7);
    if (IN(8)) { pg8::Gemm g{(const bf16*)(ws + WS_Q), (const bf16*)(ws + WS_WA), M, D, 512}; pg8::StaticOrder S; S.init(M, D, F.G, bx);
        pg8::EpiGate<1> E{(bf16*)(ws + WS_MRG), (const bf16*)(ws + WS_SGA), nullptr, nullptr}; pg8::gemm_phase<pg8::EpiGate<1>, pg8::StaticOrder, true, true>(F.lds + RING_OFF, g, S, E); } SEAM(8);
    if (IN(9)) { pg8::Gemm g{(const bf16*)(ws + WS_YB), (const bf16*)(ws + WS_WB), M, D, 512}; pg8::StaticOrder S; S.init(M, D, F.G, bx);
        pg8::EpiGate<2> E{(bf16*)(ws + WS_MRG), (const bf16*)(ws + WS_SGB), nullptr, nullptr}; pg8::gemm_phase<pg8::EpiGate<2>, pg8::StaticOrder, true, true>(F.lds + RING_OFF, g, S, E); } SEAM(9);
    if (IN(10)) { pg8::Gemm g{(const bf16*)(ws + WS_MRG), (const bf16*)(ws + WS_WOUT), M, D, D}; pg8::StaticOrder S; S.init(M, D, F.G, bx);
        pg8::EpiResid E{F.out, F.out, XB, ssq3, 1.0f}; pg8::gemm_phase<pg8::EpiResid, pg8::StaticOrder, true, true>(F.lds + RING_OFF, g, S, E); } SEAM(10);
    if (IN(11)) { pg8::Gemm g{XB, (const bf16*)(ws + WS_WGU2), M, N_GU, D}; pg8::StaticOrder S; S.init(M, N_GU, F.G, bx);
        pg8::EpiSwiGLU<16> E{ACT, FF, ssq3}; pg8::gemm_phase<pg8::EpiSwiGLU<16>, pg8::StaticOrder, true, true>(F.lds + RING_OFF, g, S, E); } SEAM(11);
    if (IN(12)) { pg8::Gemm g{ACT, (const bf16*)(ws + WS_WD2), M, D, FF}; pg8::StaticOrder S; S.init(M, D, F.G, bx);
        pg8::EpiResid E{F.out, F.out, nullptr, nullptr, 0.5f}; pg8::gemm_phase<pg8::EpiResid, pg8::StaticOrder, true, true>(F.lds + RING_OFF, g, S, E); } SEAM(12);
#ifdef DBG_OUT
    if (IN(13)) { dbg_phase(F); }
#else
    if (IN(13)) { fin_phase(F); }
#endif
#undef IN
#undef SEAM
}

extern "C" void kernel_launch(void* const* d_in, const int* in_sizes, int n_in, void* d_out, int out_size, void* d_ws, size_t ws_size, hipStream_t stream) {
    static int grid = 0;
    if (grid == 0) {
        if (n_in != 31 || out_size != M * D || ws_size < WS_END) { fprintf(stderr, "kernel_launch: unexpected shapes: n_in %d out %d ws %zu\n", n_in, out_size, ws_size); grid = -1; return; }
        int dev = 0, cus = 0;
        if (hipGetDevice(&dev) != hipSuccess || hipDeviceGetAttribute(&cus, hipDeviceAttributeMultiprocessorCount, dev) != hipSuccess) { grid = -1; return; }
        if (hipFuncSetAttribute((const void*)mk_fwd, hipFuncAttributeMaxDynamicSharedMemorySize, LDS_BYTES) != hipSuccess) { fprintf(stderr, "kernel_launch: hipFuncSetAttribute failed\n"); grid = -1; return; }
        int per_cu = 0;
        if (hipOccupancyMaxActiveBlocksPerMultiprocessor(&per_cu, (const void*)mk_fwd, NWAVES * 64, LDS_BYTES) != hipSuccess || per_cu < 1) fprintf(stderr, "kernel_launch: occupancy query says %d\n", per_cu);
        (void)hipGetLastError();
        grid = cus;
    }
    if (grid < 0) return;
    (void)hipMemsetAsync((char*)d_ws + WS_CTL, 0, CTL_ZERO_BYTES, stream);
    Args a{};
    for (int i = 0; i < 31; ++i) a.in[i] = (const float*)d_in[i];
    a.out = (float*)d_out; a.ws = (unsigned char*)d_ws;
#if MK_N_LAUNCHES == 1
    a.ph_lo = 0; a.ph_hi = N_PHASES;
    hipLaunchKernelGGL(mk_fwd, dim3(grid), dim3(NWAVES * 64), LDS_BYTES, stream, a);
#else
    for (int p = 0; p < N_PHASES; ++p) { a.ph_lo = p; a.ph_hi = p + 1; hipLaunchKernelGGL(mk_fwd, dim3(grid), dim3(NWAVES * 64), LDS_BYTES, stream, a); }
#endif
}
```

```cpp
#include <hip/hip_runtime.h>
#include <cstdio>
#include <cstdint>

#define LAS __attribute__((address_space(3)))
#define GAS __attribute__((address_space(1)))
typedef unsigned short bf16;
typedef short bf16x8 __attribute__((ext_vector_type(8)));
typedef float f32x4 __attribute__((ext_vector_type(4)));
typedef float f32x2 __attribute__((ext_vector_type(2)));
typedef unsigned u32x4 __attribute__((ext_vector_type(4)));
typedef unsigned u32x2 __attribute__((ext_vector_type(2)));

constexpr int M = 16384, D = 1024, FF = 2816, SEQ = 4096, NBATCH = 4, NH = 8, HD = 64, WR = 512;
constexpr int N_GU = 2 * FF;
constexpr int N_IN = 3840;
constexpr int N_GATE = 2048;
constexpr int ZP = 768;
constexpr float RMS_EPS = 1e-6f;
constexpr float LOG2E = 1.4426950408889634f;
constexpr float C2 = 0.125f * LOG2E;

constexpr size_t MiB = 1u << 20;
constexpr size_t WS_CTL = 0, CTL_ZERO_BYTES = 1 * MiB;
constexpr int CW_TMO = 0, CW_BAR = 4096;
constexpr size_t OFF_SSQ1 = 65536, OFF_SSQ2 = 131072, OFF_SSQ3 = 196608, OFF_SSQ4 = 262144, OFF_KMEAN = 327680;
constexpr size_t WS_RK = 1 * MiB;
constexpr size_t WS_BND = 1 * MiB + 512 * 1024;
constexpr size_t WS_WGU1 = 2 * MiB, WS_WD1 = 13 * MiB, WS_WIN = 18 * MiB + 512 * 1024, WS_WG = 26 * MiB, WS_WA = 30 * MiB, WS_WB = 31 * MiB,
                 WS_WOUT = 32 * MiB, WS_WGU2 = 34 * MiB, WS_WD2 = 45 * MiB, WS_LBW = 50 * MiB + 512 * 1024, WS_LBA = WS_LBW + 65536, WS_LBG = WS_LBA + 65536;
constexpr size_t WS_XB = 51 * MiB;
constexpr size_t WS_ACT = 83 * MiB;
constexpr size_t WS_Q = 83 * MiB, WS_K = 99 * MiB, WS_V = 115 * MiB, WS_R = 131 * MiB, WS_KR = 147 * MiB, WS_VR = 163 * MiB;
constexpr size_t WS_Z = 179 * MiB;
constexpr size_t WS_WDEC = 203 * MiB;
constexpr size_t WS_GB = 235 * MiB;
constexpr size_t WS_KK = WS_K, WS_BB = WS_V;
constexpr size_t WS_YRAW = WS_Z;
constexpr size_t WS_YB = WS_R;
constexpr size_t WS_SGA = 99 * MiB, WS_SGB = 203 * MiB;
constexpr size_t WS_MRG = 147 * MiB;
constexpr size_t WS_SSQ2 = 251 * MiB, WS_SSQ3 = 252 * MiB, WS_SSQ4 = 253 * MiB;
constexpr size_t WS_END = 256 * MiB;

__device__ __forceinline__ unsigned f2bf(float f) { unsigned u = __builtin_bit_cast(unsigned, f); return (u + 0x7fffu + ((u >> 16) & 1u)) >> 16; }
__device__ __forceinline__ unsigned pk2(float lo, float hi) { return f2bf(lo) | (f2bf(hi) << 16); }
__device__ __forceinline__ float bflo(unsigned w) { return __builtin_bit_cast(float, w << 16); }
__device__ __forceinline__ float bfhi(unsigned w) { return __builtin_bit_cast(float, w & 0xffff0000u); }
__device__ __forceinline__ float bf2f(bf16 h) { return __builtin_bit_cast(float, (unsigned)h << 16); }
__device__ __forceinline__ float fast_exp2(float x) { return __builtin_amdgcn_exp2f(x); }
__device__ __forceinline__ float fast_rcp(float x) { return __builtin_amdgcn_rcpf(x); }
__device__ __forceinline__ float sigmoidf_(float x) { return fast_rcp(1.0f + fast_exp2(-x * LOG2E)); }
#define LDS_WAIT() asm volatile("s_waitcnt lgkmcnt(0)" ::: "memory")
#define VM_WAIT() asm volatile("s_waitcnt vmcnt(0)" ::: "memory")

namespace pg8 {
#define PG8_LAS __attribute__((address_space(3)))
typedef unsigned short bf16_t;
constexpr int BM = 256, BK = 64, HALF = 128, HTB = HALF * BK * 2, STAGE_BYTES = 8 * HTB, NXCD = 8, WGM = 8;
__host__ __device__ __forceinline__ int lds_byte(int r, int c) { const int st = (r >> 4) * 2 + (c >> 5), rr = r & 15, cc = c & 31, ob = rr * 64 + cc * 2; return st * 1024 + (ob ^ (((ob >> 9) & 1) << 5)); }
__host__ __device__ __forceinline__ void stage_rc(int b, int& R, int& C) { const int st = b / 1024, sb = b % 1024, swz = sb ^ (((sb >> 9) & 1) << 5); R = (st >> 1) * 16 + swz / 64; C = (st & 1) * 32 + (swz % 64) / 2; }
__host__ __device__ __forceinline__ int perm32(int rho) { const int n = rho >> 4, i = rho & 15; return 8 * (i >> 2) + 4 * n + (i & 3); }
struct Unit { int pm, pn; };
struct Gemm { const bf16_t* A; const bf16_t* Bt; int M, N, K; };
struct StaticOrder {
    int nM, nN, nwg, G, c;
    __host__ __device__ void init(int M_, int N_, int G_, int c_) { nM = M_ / BM; nN = N_ / BM; nwg = nM * nN; G = G_; c = c_; }
    __host__ __device__ bool next(int i, Unit& u) const {
        const long L = (long)i * G + c; if (L >= nwg) return false;
        int wgid = (int)L; { const int q = nwg / NXCD, r = nwg % NXCD, xcd = wgid % NXCD, off = wgid / NXCD; wgid = (xcd < r ? xcd * (q + 1) : r * (q + 1) + (xcd - r) * q) + off; }
        const int nig = WGM * nN, gid = wgid / nig, fm = gid * WGM, gsz = (nM - fm) < WGM ? (nM - fm) : WGM;
        u.pm = fm + ((wgid % nig) % gsz); u.pn = (wgid % nig) / gsz; return true;
    }
    __device__ __forceinline__ void a_ready(const Unit&) const {}
    __device__ __forceinline__ void done(const Unit&) const {}
};
typedef __bf16 bf16x2_t __attribute__((ext_vector_type(2)));
__device__ __forceinline__ unsigned cvt_pk_bf16(float lo, float hi) { const f32x2 v = {lo, hi}; const bf16x2_t b = __builtin_convertvector(v, bf16x2_t); return __builtin_bit_cast(unsigned, b); }


template <int NP> __device__ __forceinline__ float row_ssq(const float* p, int row) {
    if (NP == 1) return p[row];
    const f32x4* q = (const f32x4*)(p + (size_t)row * 16); const f32x4 a = q[0], b = q[1], c = q[2], d = q[3];
    return (((a[0] + a[1]) + (a[2] + a[3])) + ((b[0] + b[1]) + (b[2] + b[3]))) + (((c[0] + c[1]) + (c[2] + c[3])) + ((d[0] + d[1]) + (d[2] + d[3])));
}
template <int NP> struct EpiSwiGLU {
    static constexpr bool PERM = true, AFTER_DRAIN = false;
    bf16_t* O; int ldc; const float* ssq;
    __device__ __forceinline__ void operator()(const f32x4 (&acc)[2][2][4][2], const Unit& u, int wr, int wc, int fr, int fq) const {
        const int row0 = u.pm * BM + wr * 64 + fr, col0 = u.pn * 128 + wc * 32 + 8 * fq;
#pragma unroll
        for (int ai = 0; ai < 2; ++ai)
#pragma unroll
            for (int m = 0; m < 4; ++m) {
                const int row = row0 + ai * HALF + m * 16;
                const float rs = 1.0f / sqrtf(row_ssq<NP>(ssq, row) * (1.0f / D) + RMS_EPS);
                float o[8];
#pragma unroll
                for (int n = 0; n < 2; ++n)
#pragma unroll
                    for (int i = 0; i < 4; ++i) { const float g = acc[ai][0][m][n][i] * rs, up = acc[ai][1][m][n][i] * rs; o[n * 4 + i] = g * sigmoidf_(g) * up; }
                u32x4 w; w.x = cvt_pk_bf16(o[0], o[1]); w.y = cvt_pk_bf16(o[2], o[3]); w.z = cvt_pk_bf16(o[4], o[5]); w.w = cvt_pk_bf16(o[6], o[7]);
                *(u32x4*)(O + (size_t)row * ldc + col0) = w;
            }
    }
};
struct EpiResid {
    static constexpr bool PERM = false, AFTER_DRAIN = false;
    const float* xin; float* xout; bf16_t* xb; float* ssq; float alpha;
    __device__ __forceinline__ void operator()(const f32x4 (&acc)[2][2][4][2], const Unit& u, int wr, int wc, int fr, int fq) const {
        const int row0 = u.pm * BM + wr * 64 + fr, col0 = u.pn * BM + wc * 32 + 4 * fq;
#pragma unroll
        for (int ai = 0; ai < 2; ++ai)
#pragma unroll
            for (int m = 0; m < 4; ++m) {
                const int row = row0 + ai * HALF + m * 16; const size_t off = (size_t)row * D + col0; float s = 0.f;
#pragma unroll
                for (int bj = 0; bj < 2; ++bj)
#pragma unroll
                    for (int n = 0; n < 2; ++n) {
                        const f32x4 v = *(const f32x4*)(xin + off + bj * HALF + n * 16) + acc[ai][bj][m][n] * alpha;
                        *(f32x4*)(xout + off + bj * HALF + n * 16) = v;
                        s += (v[0] * v[0] + v[1] * v[1]) + (v[2] * v[2] + v[3] * v[3]);
                        if (xb) { u32x2 w; w.x = cvt_pk_bf16(v[0], v[1]); w.y = cvt_pk_bf16(v[2], v[3]); *(u32x2*)(xb + off + bj * HALF + n * 16) = w; }
                    }
                s += __shfl_xor(s, 16); s += __shfl_xor(s, 32);
                if (fq == 0 && ssq) ssq[(size_t)row * 16 + u.pn * 4 + wc] = s;
                asm volatile("" ::: "memory");
            }
    }
};
struct EpiProj {
    static constexpr bool PERM = true, AFTER_DRAIN = false;
    bf16_t* arr0; bf16_t* zbuf; const float* ssq; float* kmean; bf16_t* bnd;
    __device__ __forceinline__ void operator()(const f32x4 (&acc)[2][2][4][2], const Unit& u, int wr, int wc, int fr, int fq) const {
        const int pn = u.pn; const int row0 = u.pm * BM + wr * 64 + fr;
        bf16_t* dst; int pitch, colt;
        if (pn < 12) { dst = arr0 + (size_t)(pn >> 1) * ((size_t)M * 512); pitch = 512; colt = (pn & 1) * 256; } else { dst = zbuf; pitch = ZP; colt = (pn - 12) * 256; }
        const float sc = (pn < 2) ? C2 : 1.0f; const int col0 = colt + wc * 32 + 8 * fq;
        const bool is_k = (pn == 2 || pn == 3), is_rkv = (pn >= 6 && pn < 12);
        float cs[2][8];
#pragma unroll
        for (int bj = 0; bj < 2; ++bj)
#pragma unroll
            for (int i = 0; i < 8; ++i) cs[bj][i] = 0.f;
#pragma unroll
        for (int ai = 0; ai < 2; ++ai)
#pragma unroll
            for (int m = 0; m < 4; ++m) {
                const int row = row0 + ai * HALF + m * 16;
                const float rs = sc / sqrtf(row_ssq<16>(ssq, row) * (1.0f / D) + RMS_EPS);
#pragma unroll
                for (int bj = 0; bj < 2; ++bj) {
                    float o[8];
#pragma unroll
                    for (int n = 0; n < 2; ++n)
#pragma unroll
                        for (int i = 0; i < 4; ++i) { o[n * 4 + i] = acc[ai][bj][m][n][i] * rs; cs[bj][n * 4 + i] += o[n * 4 + i]; }
                    u32x4 w; w.x = cvt_pk_bf16(o[0], o[1]); w.y = cvt_pk_bf16(o[2], o[3]); w.z = cvt_pk_bf16(o[4], o[5]); w.w = cvt_pk_bf16(o[6], o[7]);
                    *(u32x4*)(dst + (size_t)row * pitch + col0 + bj * HALF) = w;
                    if (is_rkv && ai == 1 && m == 3 && wr == 1 && fr == 15) *(u32x4*)(bnd + (size_t)u.pm * 1536 + (pn - 6) * 256 + wc * 32 + 8 * fq + bj * HALF) = w;
                }
            }
        if (is_k) {
#pragma unroll
            for (int bj = 0; bj < 2; ++bj)
#pragma unroll
                for (int i = 0; i < 8; ++i) { float v = cs[bj][i]; v += __shfl_xor(v, 1); v += __shfl_xor(v, 2); v += __shfl_xor(v, 4); v += __shfl_xor(v, 8);
                    if (fr == 0) { const int col = (pn - 2) * 256 + bj * HALF + wc * 32 + 8 * fq + i; atomicAdd(kmean + ((size_t)((u.pm >> 4) * NH + (col >> 6)) * 16 + (u.pm & 15)) * 64 + (col & 63), v); } }
        }
    }
};
template <int MODE> struct EpiGate {
    static constexpr bool PERM = true, AFTER_DRAIN = false;
    bf16_t* out; const bf16_t* gate; bf16_t* out2; const float* ssq;
    __device__ __forceinline__ void operator()(const f32x4 (&acc)[2][2][4][2], const Unit& u, int wr, int wc, int fr, int fq) const {
        const int row0 = u.pm * BM + wr * 64 + fr; int pn = u.pn; bf16_t* dst = out;
        if (MODE == 0 && pn >= 4) { pn -= 4; dst = out2; }
        const int col0 = pn * BM + wc * 32 + 8 * fq;
#pragma unroll
        for (int ai = 0; ai < 2; ++ai)
#pragma unroll
            for (int m = 0; m < 4; ++m) {
                const int row = row0 + ai * HALF + m * 16;
                float rs = 1.0f; if (MODE == 0) rs = 1.0f / sqrtf(row_ssq<16>(ssq, row) * (1.0f / D) + RMS_EPS);
#pragma unroll
                for (int bj = 0; bj < 2; ++bj) {
                    const size_t off = (size_t)row * D + col0 + bj * HALF; float o[8];
#pragma unroll
                    for (int n = 0; n < 2; ++n)
#pragma unroll
                        for (int i = 0; i < 4; ++i) o[n * 4 + i] = acc[ai][bj][m][n][i];
                    if (MODE == 0) {
#pragma unroll
                        for (int i = 0; i < 8; ++i) o[i] = sigmoidf_(o[i] * rs);
                    } else {
                        const u32x4 g = *(const u32x4*)(gate + off);
                        o[0] *= bflo(g.x); o[1] *= bfhi(g.x); o[2] *= bflo(g.y); o[3] *= bfhi(g.y); o[4] *= bflo(g.z); o[5] *= bfhi(g.z); o[6] *= bflo(g.w); o[7] *= bfhi(g.w);
                        if (MODE == 2) { const u32x4 p = *(const u32x4*)(dst + off);
                            o[0] += bflo(p.x); o[1] += bfhi(p.x); o[2] += bflo(p.y); o[3] += bfhi(p.y); o[4] += bflo(p.z); o[5] += bfhi(p.z); o[6] += bflo(p.w); o[7] += bfhi(p.w); }
                    }
                    u32x4 w; w.x = cvt_pk_bf16(o[0], o[1]); w.y = cvt_pk_bf16(o[2], o[3]); w.z = cvt_pk_bf16(o[4], o[5]); w.w = cvt_pk_bf16(o[6], o[7]);
                    *(u32x4*)(dst + off) = w;
                }
            }
    }
};

template <class Epi, class Sched, bool ALIGN_EPI = false, bool SP2 = false>
__device__ __forceinline__ void gemm_phase(PG8_LAS unsigned char* lds, const Gemm g, const Sched& S, const Epi& E) {
    const int tid = threadIdx.x, wid = __builtin_amdgcn_readfirstlane(tid >> 6), lane = tid & 63, wr = wid >> 2, wc = wid & 3, fr = lane & 15, fq = lane >> 4;
    const int K = g.K, nt = K / BK;
    unsigned voffA[2], voffB[2];
#pragma unroll
    for (int i = 0; i < 2; ++i) { int R, C; stage_rc(tid * 16 + i * 8192, R, C); const int Rb = Epi::PERM ? ((R & ~31) + perm32(R & 31)) : R;
        voffA[i] = (unsigned)(R * K + C) * 2u; voffB[i] = (unsigned)(Rb * K + C) * 2u; }
    const size_t kstep = (size_t)(BK * 2);
    const size_t hstep = (size_t)HALF * K * 2;
    const size_t tstep = 2 * hstep;
    const unsigned ldsw = (unsigned)wid * 1024u;
    const int aoff = lds_byte(wr * 64 + fr, fq * 8), boff = lds_byte(wc * 32 + fr, fq * 8);
#define PG8_SA(b, h) (((b) * 2 + (h)) * HTB)
#define PG8_SB(b, h) ((4 + (b) * 2 + (h)) * HTB)
#define PG8_STAGE(bufoff, gbase, voff) do { _Pragma("unroll") for (int _i = 0; _i < 2; ++_i) \
        __builtin_amdgcn_global_load_lds((const unsigned*)((const char*)(gbase) + (voff)[_i]), (PG8_LAS unsigned*)(lds + (bufoff) + ldsw + _i * 8192), 16, 0, 0); } while (0)
#define PG8_LDA(dst, b, h) do { _Pragma("unroll") for (int m = 0; m < 4; ++m) _Pragma("unroll") for (int k = 0; k < 2; ++k) dst[m][k] = *(const PG8_LAS bf16x8*)(lds + PG8_SA(b, h) + aoff + m * 2048 + k * 1024); } while (0)
#define PG8_LDB(dst, b, h) do { _Pragma("unroll") for (int n = 0; n < 2; ++n) _Pragma("unroll") for (int k = 0; k < 2; ++k) dst[n][k] = *(const PG8_LAS bf16x8*)(lds + PG8_SB(b, h) + boff + n * 2048 + k * 1024); } while (0)
#define PG8_MMA(ai, bj, At, Bt) do { __builtin_amdgcn_s_setprio(1); _Pragma("unroll") for (int m = 0; m < 4; ++m) _Pragma("unroll") for (int n = 0; n < 2; ++n) _Pragma("unroll") for (int k = 0; k < 2; ++k) \
        acc[ai][bj][m][n] = __builtin_amdgcn_mfma_f32_16x16x32_bf16(Bt[n][k], At[m][k], acc[ai][bj][m][n], 0, 0, 0); __builtin_amdgcn_s_setprio(0); } while (0)
#define PG8_WAIT_V(n) asm volatile("s_waitcnt vmcnt(" #n ")" ::: "memory")
#define PG8_WAIT_L(n) asm volatile("s_waitcnt lgkmcnt(" #n ")" ::: "memory")
#define PG8_BAR __builtin_amdgcn_s_barrier()
#define PG8_SCHED __builtin_amdgcn_sched_barrier(0)
    Unit cur, nxt; int ui = 0;
    if (!S.next(0, cur)) return;
    f32x4 acc[2][2][4][2];
#pragma unroll
    for (int a = 0; a < 2; ++a)
#pragma unroll
        for (int b = 0; b < 2; ++b)
#pragma unroll
            for (int m = 0; m < 4; ++m)
#pragma unroll
                for (int n = 0; n < 2; ++n) acc[a][b][m][n] = (f32x4){0.f, 0.f, 0.f, 0.f};
    bf16x8 At[4][2], B0[2][2], B1[2][2];
    const char* cA = (const char*)g.A + (size_t)cur.pm * tstep; const char* cB = (const char*)g.Bt + (size_t)cur.pn * tstep;
    S.a_ready(cur);
    if constexpr (SP2) {
        PG8_STAGE(PG8_SB(0, 0), cB, voffB); PG8_STAGE(PG8_SB(0, 1), cB + hstep, voffB); PG8_STAGE(PG8_SA(0, 0), cA, voffA); PG8_STAGE(PG8_SA(0, 1), cA + hstep, voffA);
        if (wr == 1) PG8_BAR;
        PG8_WAIT_V(2); PG8_BAR;
        PG8_STAGE(PG8_SB(1, 0), cB + kstep, voffB); PG8_STAGE(PG8_SA(1, 0), cA + kstep, voffA); PG8_STAGE(PG8_SB(1, 1), cB + hstep + kstep, voffB);
        PG8_WAIT_V(6); PG8_BAR;
    } else {
        PG8_STAGE(PG8_SB(0, 0), cB, voffB); PG8_STAGE(PG8_SA(0, 0), cA, voffA); PG8_STAGE(PG8_SB(0, 1), cB + hstep, voffB); PG8_STAGE(PG8_SA(0, 1), cA + hstep, voffA);
        if (wr == 1) PG8_BAR;
        PG8_WAIT_V(4); PG8_BAR;
        PG8_STAGE(PG8_SB(1, 0), cB + kstep, voffB); PG8_STAGE(PG8_SA(1, 0), cA + kstep, voffA); PG8_STAGE(PG8_SB(1, 1), cB + hstep + kstep, voffB);
        PG8_WAIT_V(6); PG8_BAR;
    }
    for (;;) {
        const bool has_next = S.next(ui + 1, nxt);
        const char* nA = has_next ? (const char*)g.A + (size_t)nxt.pm * tstep : cA; const char* nB = has_next ? (const char*)g.Bt + (size_t)nxt.pn * tstep : cB;
        for (int t = 0; t < nt; t += 2) {
            const bool last = (t == nt - 2);
            const char* a1 = cA + (size_t)(t + 1) * kstep;
            const char* a2 = last ? nA : cA + (size_t)(t + 2) * kstep; const char* b2 = last ? nB : cB + (size_t)(t + 2) * kstep;
            const char* a3 = a2 + kstep; const char* b3 = b2 + kstep;
            if (last && has_next) S.a_ready(nxt);
            if constexpr (SP2) {
            PG8_LDB(B0, 0, 0); PG8_LDB(B1, 0, 1); PG8_SCHED; PG8_LDA(At, 0, 0); PG8_STAGE(PG8_SA(1, 1), a1 + hstep, voffA);
            PG8_WAIT_V(8); PG8_WAIT_L(0); PG8_BAR; PG8_MMA(0, 0, At, B0); PG8_MMA(0, 1, At, B1); PG8_BAR; PG8_SCHED;
            PG8_LDA(At, 0, 1); PG8_STAGE(PG8_SB(0, 0), b2, voffB); PG8_STAGE(PG8_SB(0, 1), b2 + hstep, voffB); PG8_STAGE(PG8_SA(0, 0), a2, voffA);
            PG8_WAIT_V(8); PG8_WAIT_L(0); PG8_BAR; PG8_MMA(1, 0, At, B0); PG8_MMA(1, 1, At, B1); PG8_BAR; PG8_SCHED;
            PG8_LDB(B0, 1, 0); PG8_LDB(B1, 1, 1); PG8_SCHED; PG8_LDA(At, 1, 0); PG8_STAGE(PG8_SA(0, 1), a2 + hstep, voffA);
            PG8_WAIT_V(8); PG8_WAIT_L(0); PG8_BAR; PG8_MMA(0, 0, At, B0); PG8_MMA(0, 1, At, B1); PG8_BAR; PG8_SCHED;
            PG8_LDA(At, 1, 1); PG8_STAGE(PG8_SB(1, 0), b3, voffB); PG8_STAGE(PG8_SB(1, 1), b3 + hstep, voffB); PG8_STAGE(PG8_SA(1, 0), a3, voffA);
            PG8_WAIT_V(8); PG8_WAIT_L(0); PG8_BAR; PG8_MMA(1, 0, At, B0); PG8_MMA(1, 1, At, B1); PG8_BAR; PG8_SCHED;
            } else {
            PG8_LDB(B0, 0, 0); PG8_SCHED; PG8_LDA(At, 0, 0); PG8_STAGE(PG8_SA(1, 1), a1 + hstep, voffA);
            PG8_WAIT_L(8); PG8_BAR; PG8_WAIT_L(0); PG8_MMA(0, 0, At, B0); PG8_BAR; PG8_SCHED;
            PG8_LDB(B1, 0, 1); PG8_STAGE(PG8_SB(0, 0), b2, voffB);
            PG8_BAR; PG8_WAIT_L(0); PG8_MMA(0, 1, At, B1); PG8_BAR;
            PG8_LDA(At, 0, 1); PG8_STAGE(PG8_SA(0, 0), a2, voffA);
            PG8_BAR; PG8_WAIT_L(0); PG8_MMA(1, 0, At, B0); PG8_BAR; PG8_SCHED;
            PG8_STAGE(PG8_SB(0, 1), b2 + hstep, voffB);
            PG8_WAIT_V(6); PG8_BAR; PG8_MMA(1, 1, At, B1); PG8_BAR;
            PG8_LDB(B0, 1, 0); PG8_SCHED; PG8_LDA(At, 1, 0); PG8_STAGE(PG8_SA(0, 1), a2 + hstep, voffA);
            PG8_WAIT_L(8); PG8_BAR; PG8_WAIT_L(0); PG8_MMA(0, 0, At, B0); PG8_BAR; PG8_SCHED;
            PG8_LDB(B1, 1, 1); PG8_STAGE(PG8_SB(1, 0), b3, voffB);
            PG8_BAR; PG8_WAIT_L(0); PG8_MMA(0, 1, At, B1); PG8_BAR;
            PG8_LDA(At, 1, 1); PG8_STAGE(PG8_SA(1, 0), a3, voffA);
            PG8_BAR; PG8_WAIT_L(0); PG8_MMA(1, 0, At, B0); PG8_BAR; PG8_SCHED;
            PG8_STAGE(PG8_SB(1, 1), b3 + hstep, voffB);
            PG8_WAIT_V(6); PG8_BAR; PG8_MMA(1, 1, At, B1); PG8_BAR;
            }
        }
        if constexpr (ALIGN_EPI) { if (wr == 0) PG8_BAR; }
        if constexpr (!Epi::AFTER_DRAIN) { E(acc, cur, wr, wc, fr, fq); S.done(cur); }
        if (!has_next) break;
#pragma unroll
        for (int a = 0; a < 2; ++a)
#pragma unroll
            for (int b = 0; b < 2; ++b)
#pragma unroll
                for (int m = 0; m < 4; ++m)
#pragma unroll
                    for (int n = 0; n < 2; ++n) acc[a][b][m][n] = (f32x4){0.f, 0.f, 0.f, 0.f};
        cur = nxt; cA = nA; cB = nB; ++ui;
        if constexpr (ALIGN_EPI) { if (wr == 1) PG8_BAR; }
    }
    PG8_WAIT_V(0);
    if constexpr (!ALIGN_EPI) { if (wr == 0) PG8_BAR; }
    PG8_BAR;
#undef PG8_SA
#undef PG8_SB
#undef PG8_STAGE
#undef PG8_LDA
#undef PG8_LDB
#undef PG8_MMA
#undef PG8_WAIT_V
#undef PG8_WAIT_L
#undef PG8_BAR
#undef PG8_SCHED
}
}

#define XB_TMO      128
#define XB_XCNT(j)  (256  + 64 * (j))
#define XB_XSUB(j)  (1280 + 64 * (j))
#define XB_XGEN(j)  (2304 + 64 * (j))
#define XB_TOP      3328
#define XB_TOPGEN   3392
#define XCD_BAR_WORDS 3456
#define XB_SPIN_CAP (1u << 18)
__device__ __forceinline__ unsigned xb_ld(unsigned* p)              { return __hip_atomic_load(p, __ATOMIC_RELAXED, __HIP_MEMORY_SCOPE_AGENT); }
__device__ __forceinline__ unsigned xb_add(unsigned* p, unsigned v) { return __hip_atomic_fetch_add(p, v, __ATOMIC_RELAXED, __HIP_MEMORY_SCOPE_AGENT); }
__device__ __forceinline__ unsigned xb_xcc_id() { return (unsigned)__builtin_amdgcn_s_getreg((3 << 11) | 20) & 0xFu; }
#define XB_SPIN(cond, bar) do { unsigned _sp = 0; while (cond) { __builtin_amdgcn_s_sleep(1); \
    if ((++_sp & 255u) == 0u) { if (xb_ld(&(bar)[XB_TMO])) break; if (_sp > XB_SPIN_CAP) { atomicAdd(&(bar)[XB_TMO], 1u); break; } } } } while (0)
struct XcdBarrier { unsigned* bar; unsigned x; volatile LAS unsigned* st; };
__device__ __forceinline__ XcdBarrier xcd_barrier_post(unsigned* bar, volatile LAS unsigned* st) {
    XcdBarrier b; b.bar = bar; b.x = xb_xcc_id(); b.st = st;
    if (threadIdx.x == 0) (void)xb_add(&bar[XB_XCNT(b.x)], 1u);
    return b;
}
__device__ __forceinline__ void xcd_barrier_complete(unsigned* bar, unsigned x, unsigned& nloc, unsigned& nx) {
    const unsigned G = gridDim.x * gridDim.y * gridDim.z;
    unsigned sum, cnt, mine, sp = 0u;
    for (;;) {
        sum = 0u; cnt = 0u; mine = 0u;
#pragma unroll
        for (unsigned j = 0; j < 16; ++j) { const unsigned c = xb_ld(&bar[XB_XCNT(j)]); sum += c; cnt += (c > 0u) ? 1u : 0u; mine = (j == x) ? c : mine; }
        if (sum == G) break;
        __builtin_amdgcn_s_sleep(1);
        if ((++sp & 255u) == 0u) { if (xb_ld(&bar[XB_TMO])) break; if (sp > XB_SPIN_CAP) { atomicAdd(&bar[XB_TMO], 1u); break; } }
    }
    nloc = mine > 0u ? mine : 1u; nx = cnt > 0u ? cnt : 1u;
}
__device__ __forceinline__ void xcd_barrier(const XcdBarrier& b) {
    asm volatile("s_waitcnt vmcnt(0)" ::: "memory");
    __syncthreads();
    if (threadIdx.x == 0) {
        unsigned* bar = b.bar;
        __builtin_amdgcn_s_waitcnt(0);
        unsigned nloc = b.st[0], nx = b.st[1];
        if (nloc == 0u) { xcd_barrier_complete(bar, b.x, nloc, nx); b.st[0] = nloc; b.st[1] = nx; }
        const unsigned old = xb_add(&bar[XB_XSUB(b.x)], 1u);
        const unsigned gen = old / nloc;
        if (old + 1u == (gen + 1u) * nloc) {
            __builtin_amdgcn_fence(__ATOMIC_RELEASE, "agent");
            asm volatile("s_waitcnt vmcnt(0)" ::: "memory");
            const unsigned og = xb_add(&bar[XB_TOP], 1u);
            const unsigned tg = og / nx;
            if (og + 1u == (tg + 1u) * nx) xb_add(&bar[XB_TOPGEN], 1u);
            else XB_SPIN(xb_ld(&bar[XB_TOPGEN]) == tg, bar);
            __builtin_amdgcn_fence(__ATOMIC_ACQUIRE, "agent");
            xb_add(&bar[XB_XGEN(b.x)], 1u);
            asm volatile("s_waitcnt vmcnt(0)" ::: "memory");
        } else {
            XB_SPIN(xb_ld(&bar[XB_XGEN(b.x)]) == gen, bar);
            __builtin_amdgcn_fence(__ATOMIC_ACQUIRE, "agent");
            asm volatile("s_waitcnt vmcnt(0)" ::: "memory");
        }
    }
    __syncthreads();
}

constexpr int NWAVES = 8;
constexpr int RING_OFF = 0, RING_BYTES = 131072;
constexpr int LDSCTL_OFF = RING_BYTES, MISC_OFF = LDSCTL_OFF + 320;
constexpr int LDS_BYTES = 147456;

struct Frame {
    LAS unsigned char* lds; volatile LAS unsigned* MISC; unsigned* ctl;
    int tid, lane, wave, vcu, G;
    const float* const* in; float* out; unsigned char* ws;
};
enum { I_X = 0, I_RELB, I_NFFN1, I_F1G, I_F1U, I_F1D, I_NMIX, I_WIN, I_MIXRKV, I_MIXWAG, I_WLA, I_WLB, I_W0, I_ALA, I_ALB, I_A0, I_GLA, I_GLB, I_KK, I_KA, I_RKP, I_LNW, I_LNB,
       I_PA, I_PB, I_WOUT, I_NFFN2, I_F2G, I_F2U, I_F2D, I_NFIN };

__device__ __forceinline__ float wave_sum(float v) {
#pragma unroll
    for (int o = 1; o < 64; o <<= 1) v += __shfl_xor(v, o);
    return v;
}

__device__ __forceinline__ void tr_item(const float* W, int ldw, int c0, bf16* WT, int K, int drow0, int k0, const float* g, const float* mix, int mode, LAS float* scr, int lane) {
#pragma unroll 8
    for (int i = 0; i < 32; ++i) { const int kk = 2 * i + (lane >> 5), k = k0 + kk; float s = g ? g[k] : 1.0f; if (mode == 1) s *= (1.0f - mix[k]); else if (mode == 2) s *= mix[k];
        scr[kk * 33 + (lane & 31)] = W[(size_t)k * ldw + c0 + (lane & 31)] * s; }
    LDS_WAIT(); asm volatile("" ::: "memory");
    const int c = lane & 7;
#pragma unroll
    for (int j = 0; j < 4; ++j) { const int n = (lane >> 3) + 8 * j; const LAS float* s = scr + (8 * c) * 33 + n;
        u32x4 o; o.x = pk2(s[0 * 33], s[1 * 33]); o.y = pk2(s[2 * 33], s[3 * 33]); o.z = pk2(s[4 * 33], s[5 * 33]); o.w = pk2(s[6 * 33], s[7 * 33]);
        *(u32x4*)(WT + (size_t)(drow0 + n) * K + k0 + 8 * c) = o; }
    LDS_WAIT(); asm volatile("" ::: "memory");
}
__device__ __forceinline__ void gu_item(const float* Wg, const float* Wu, const float* g, bf16* WT, int r, LAS float* scr, int lane) {
    const int kb = r / 176, nb = r % 176, pn = nb >> 3, bj = (nb >> 2) & 1, o = nb & 3;
    tr_item(bj ? Wu : Wg, FF, 128 * pn + 32 * o, WT, D, 32 * nb, 64 * kb, g, nullptr, 0, scr, lane);
}
__device__ __forceinline__ void p0_prologue(Frame& F) {
    LAS float* scr = (LAS float*)(F.lds + RING_OFF + F.wave * 16384);
    const int gw = F.vcu * NWAVES + F.wave, NGW = F.G * NWAVES;
    unsigned char* ws = F.ws;
    constexpr int J0 = 16 * 176, J1 = 44 * 32, J2 = 16 * 96, J3 = 16 * 18, J4 = 16 * 64, J5 = 8 * 32, J6 = 8 * 32, J7 = 16 * 32, J8 = J0, J9 = J1;
    constexpr int NITEMS = J0 + J1 + J2 + J3 + J4 + J5 + J6 + J7 + J8 + J9;
    for (int it = gw; it < NITEMS; it += NGW) {
        int r = it;
        if (r < J0) { gu_item(F.in[I_F1G], F.in[I_F1U], F.in[I_NFFN1], (bf16*)(ws + WS_WGU1), r, scr, F.lane); continue; } r -= J0;
        if (r < J1) { const int kb = r / 32, nb = r % 32; tr_item(F.in[I_F1D], D, 32 * nb, (bf16*)(ws + WS_WD1), FF, 32 * nb, 64 * kb, nullptr, nullptr, 0, scr, F.lane); continue; } r -= J1;
        if (r < J2) { const int kb = r / 96, nb = r % 96; tr_item(F.in[I_WIN], 5120, 32 * nb, (bf16*)(ws + WS_WIN), D, 32 * nb, 64 * kb, F.in[I_NMIX], nullptr, 0, scr, F.lane); continue; } r -= J2;
        if (r < J3) { const int kb = r / 18, nb = r % 18, md = nb < 9 ? 1 : 2, n9 = nb % 9;
            const float* W; int ldw, c0; const float* mix;
            if (n9 < 2) { W = F.in[I_WLA]; ldw = 64; c0 = 32 * n9; mix = F.in[I_MIXWAG]; }
            else if (n9 < 4) { W = F.in[I_ALA]; ldw = 64; c0 = 32 * (n9 - 2); mix = F.in[I_MIXWAG] + D; }
            else { W = F.in[I_GLA]; ldw = 160; c0 = 32 * (n9 - 4); mix = F.in[I_MIXWAG] + 2 * D; }
            tr_item(W, ldw, c0, (bf16*)(ws + WS_WIN), D, 3072 + 32 * nb, 64 * kb, F.in[I_NMIX], mix, md, scr, F.lane); continue; } r -= J3;
        if (r < J4) { const int kb = r / 64, nb = r % 64; tr_item(F.in[I_WIN], 5120, 3072 + 32 * nb, (bf16*)(ws + WS_WG), D, 32 * nb, 64 * kb, F.in[I_NMIX], nullptr, 0, scr, F.lane); continue; } r -= J4;
        if (r < J5) { const int kb = r / 32, nb = r % 32; tr_item(F.in[I_PA], D, 32 * nb, (bf16*)(ws + WS_WA), 512, 32 * nb, 64 * kb, nullptr, nullptr, 0, scr, F.lane); continue; } r -= J5;
        if (r < J6) { const int kb = r / 32, nb = r % 32; tr_item(F.in[I_PB], D, 32 * nb, (bf16*)(ws + WS_WB), 512, 32 * nb, 64 * kb, nullptr, nullptr, 0, scr, F.lane); continue; } r -= J6;
        if (r < J7) { const int kb = r / 32, nb = r % 32; tr_item(F.in[I_WOUT], D, 32 * nb, (bf16*)(ws + WS_WOUT), D, 32 * nb, 64 * kb, nullptr, nullptr, 0, scr, F.lane); continue; } r -= J7;
        if (r < J8) { gu_item(F.in[I_F2G], F.in[I_F2U], F.in[I_NFFN2], (bf16*)(ws + WS_WGU2), r, scr, F.lane); continue; } r -= J8;
        { const int kb = r / 32, nb = r % 32; tr_item(F.in[I_F2D], D, 32 * nb, (bf16*)(ws + WS_WD2), FF, 32 * nb, 64 * kb, nullptr, nullptr, 0, scr, F.lane); }
    }
    const int gt = F.vcu * 512 + F.tid, NGT = F.G * 512;
    { u32x4* z = (u32x4*)(ws + WS_WIN + (size_t)3648 * D * 2); for (int i = gt; i < 192 * D * 2 / 16; i += NGT) z[i] = (u32x4){0u, 0u, 0u, 0u}; }
    { bf16* lw = (bf16*)(ws + WS_LBW); bf16* la = (bf16*)(ws + WS_LBA); bf16* lg = (bf16*)(ws + WS_LBG);
      for (int i = gt; i < 512 * 64; i += NGT) { const int n = i >> 6, k = i & 63; lw[i] = (bf16)f2bf(F.in[I_WLB][k * 512 + n]); la[i] = (bf16)f2bf(F.in[I_ALB][k * 512 + n]); }
      for (int i = gt; i < 512 * 160; i += NGT) { const int n = i / 160, k = i % 160; lg[i] = (bf16)f2bf(F.in[I_GLB][k * 512 + n]); } }
    { const float* x = F.in[I_X]; bf16* xb = (bf16*)(ws + WS_XB); float* ssq = (float*)(ws + OFF_SSQ1);
      for (int m = gw; m < M; m += NGW) {
          const f32x4* xr = (const f32x4*)(x + (size_t)m * D) + F.lane; f32x4 v[4]; float s = 0.f;
#pragma unroll
          for (int j = 0; j < 4; ++j) { v[j] = xr[64 * j]; s += (v[j].x * v[j].x + v[j].y * v[j].y) + (v[j].z * v[j].z + v[j].w * v[j].w); }
          s = wave_sum(s); if (F.lane == 0) ssq[m] = s;
          unsigned long long* o8 = (unsigned long long*)(xb + (size_t)m * D) + F.lane;
#pragma unroll
          for (int j = 0; j < 4; ++j) o8[64 * j] = (unsigned long long)pk2(v[j].x, v[j].y) | ((unsigned long long)pk2(v[j].z, v[j].w) << 32);
      } }
}

__device__ __forceinline__ int t5_bucket(int n) {
    if (n < 16) return n < 0 ? 0 : n;
    int b = 16;
    b += (n >= 21); b += (n >= 27); b += (n >= 35); b += (n >= 46); b += (n >= 59); b += (n >= 77); b += (n >= 99); b += (n >= 128);
    b += (n >= 166); b += (n >= 216); b += (n >= 280); b += (n >= 363); b += (n >= 470); b += (n >= 609); b += (n >= 790);
    return b;
}

namespace attn_body {
typedef unsigned short bf16;
using bf16x8=__attribute__((ext_vector_type(8)))short;
using s16x4=__attribute__((ext_vector_type(4)))short;
using f32x16=__attribute__((ext_vector_type(16)))float;
using u32x4=__attribute__((ext_vector_type(4)))unsigned;
constexpr int BATCH=4,NHEAD=8,SEQ=4096,D=64,DM=NHEAD*D;
constexpr int NW=8,QBLK=32,QB=QBLK*NW,KVBLK=64,NQB=SEQ/QB;
constexpr int ATTN_PITCH=DM, ATTN_UNIT_ROWS=QB;
__device__ __forceinline__ int crow(int r,int hi){return (r&3)+8*(r>>2)+4*hi;}
#define SBAR() __builtin_amdgcn_sched_barrier(0)
typedef __attribute__((address_space(3))) float* lds_fptr;
typedef float f32x4_t __attribute__((ext_vector_type(4)));
__device__ __forceinline__ void cmask(f32x16&p0,f32x16&p1,int jb,int qrel,int hi){
  const float NEG=-INFINITY; int kb=64*jb+4*hi;
  #pragma unroll
  for(int r=0;r<16;++r){int kv=kb+(r&3)+8*(r>>2); if(kv>qrel)p0[r]=NEG; if(kv+32>qrel)p1[r]=NEG;}
}

constexpr int NSLOT=3, SLOTB=8192;
constexpr int LDS_K=0, LDS_V=NSLOT*SLOTB, LDS_WS=2*NSLOT*SLOTB, LDS_OST=LDS_WS+NW*64*4, LDS_RT=LDS_OST+NW*4096,LDS_KM=LDS_RT+1152*4,LDS_BYTES=LDS_KM+15*64*4;
constexpr float C2=0.125f*1.4426950408889634f, L2E=1.4426950408889634f;
__device__ __forceinline__ void glds16(const void*gsrc,unsigned lds_dst){unsigned keep;
  asm volatile("s_mov_b32 %0, m0\n\ts_mov_b32 m0, %2\n\ts_nop 0\n\tglobal_load_lds_dwordx4 %1, off\n\ts_mov_b32 m0, %0":"=&s"(keep):"v"(gsrc),"s"(lds_dst):"memory");}
__device__ __forceinline__ float max3f(float a,float b,float c){float r;asm("v_max3_f32 %0, %1, %2, %3":"=v"(r):"v"(a),"v"(b),"v"(c));return r;}
__device__ __forceinline__ float max2f(float a,float b){float r;asm("v_max_f32_e32 %0, %1, %2":"=v"(r):"v"(a),"v"(b));return r;}
__device__ __forceinline__ float fadd_s(float a,float b){float r;asm("v_add_f32_e32 %0, %1, %2":"=v"(r):"v"(a),"v"(b));return r;}
__device__ __forceinline__ float fsub_s(float a,float b){float r;asm("v_sub_f32_e32 %0, %1, %2":"=v"(r):"v"(a),"v"(b));return r;}
typedef float f32x2_t __attribute__((ext_vector_type(2))); typedef __bf16 bf16x2_t __attribute__((ext_vector_type(2)));
__device__ __forceinline__ unsigned cvtpk_s(float lo,float hi){f32x2_t v={lo,hi};bf16x2_t b=__builtin_convertvector(v,bf16x2_t);return __builtin_bit_cast(unsigned,b);}
#define WAIT_BAR(N) asm volatile("s_waitcnt vmcnt(" #N ") lgkmcnt(0)\n\ts_barrier":::"memory")

__device__ __forceinline__ void qkt(f32x16&p0,f32x16&p1,const char*Kslot,const bf16x8*qr,const f32x16&negm,int r32,int hi){
  const char*kb=Kslot+hi*1024+r32*16;
  #pragma unroll
  for(int d0=0;d0<4;++d0){
    const bf16x8 b0=*reinterpret_cast<const bf16x8*>(kb+d0*2048);
    const bf16x8 b1=*reinterpret_cast<const bf16x8*>(kb+d0*2048+512);
    if(d0==0){p0=__builtin_amdgcn_mfma_f32_32x32x16_bf16(b0,qr[0],negm,0,0,0);p1=__builtin_amdgcn_mfma_f32_32x32x16_bf16(b1,qr[0],negm,0,0,0);}
    else{p0=__builtin_amdgcn_mfma_f32_32x32x16_bf16(b0,qr[d0],p0,0,0,0);p1=__builtin_amdgcn_mfma_f32_32x32x16_bf16(b1,qr[d0],p1,0,0,0);}}
}
typedef __attribute__((address_space(3))) const char* lds_cptr;
typedef short v4i16_t __attribute__((ext_vector_type(4)));
__device__ __forceinline__ void kload8(bf16x8*kf,lds_cptr kp){
  kf[0]=*(const __attribute__((address_space(3))) bf16x8*)(kp);      kf[1]=*(const __attribute__((address_space(3))) bf16x8*)(kp+512);
  kf[2]=*(const __attribute__((address_space(3))) bf16x8*)(kp+2048); kf[3]=*(const __attribute__((address_space(3))) bf16x8*)(kp+2560);
  kf[4]=*(const __attribute__((address_space(3))) bf16x8*)(kp+4096); kf[5]=*(const __attribute__((address_space(3))) bf16x8*)(kp+4608);
  kf[6]=*(const __attribute__((address_space(3))) bf16x8*)(kp+6144); kf[7]=*(const __attribute__((address_space(3))) bf16x8*)(kp+6656);
}
__device__ __forceinline__ void kload2(bf16x8*kf,lds_cptr kp,int j){ kf[2*j]=*(const __attribute__((address_space(3))) bf16x8*)(kp+j*2048); kf[2*j+1]=*(const __attribute__((address_space(3))) bf16x8*)(kp+j*2048+512); }
__device__ __forceinline__ s16x4 vtr(lds_cptr p){ return __builtin_bit_cast(s16x4,__builtin_amdgcn_ds_read_tr16_b64_v4i16((__attribute__((address_space(3))) v4i16_t*)p)); }
__device__ __forceinline__ float rowmax(const f32x16&p0,const f32x16&p1){
  float a=max3f(p0[0],p0[1],p1[0]),b=max3f(p0[2],p0[3],p1[1]);a=max3f(a,p1[2],p1[3]);
  #pragma unroll
  for(int r=4;r<16;r+=4){a=max3f(a,p0[r],p0[r+1]);b=max3f(b,p0[r+2],p0[r+3]);a=max3f(a,p1[r],p1[r+1]);b=max3f(b,p1[r+2],p1[r+3]);}
  const float m=max2f(a,b);
  auto rr=__builtin_amdgcn_permlane32_swap(__float_as_uint(m),__float_as_uint(m),false,false);
  return max2f(__uint_as_float(rr[0]),__uint_as_float(rr[1]));
}
__device__ __forceinline__ void pv(f32x16*o,int vb,bf16x8 pa0,bf16x8 pa1,bf16x8 pa2,bf16x8 pa3){
  #pragma unroll
  for(int d0=0;d0<2;++d0){s16x4 lo[4],hi[4];
    #pragma unroll
    for(int ks=0;ks<4;++ks){
      asm volatile("ds_read_b64_tr_b16 %0,%1 offset:%c2":"=&v"(lo[ks]):"v"(vb),"i"(d0*4096+ks*1024):"memory");
      asm volatile("ds_read_b64_tr_b16 %0,%1 offset:%c2":"=&v"(hi[ks]):"v"(vb),"i"(d0*4096+ks*1024+512):"memory");}
    asm volatile("s_waitcnt lgkmcnt(0)":::"memory");SBAR();
    #define PK(k) (bf16x8){lo[k][0],lo[k][1],lo[k][2],lo[k][3],hi[k][0],hi[k][1],hi[k][2],hi[k][3]}
    o[d0]=__builtin_amdgcn_mfma_f32_32x32x16_bf16(pa0,PK(0),o[d0],0,0,0);
    o[d0]=__builtin_amdgcn_mfma_f32_32x32x16_bf16(pa1,PK(1),o[d0],0,0,0);
    o[d0]=__builtin_amdgcn_mfma_f32_32x32x16_bf16(pa2,PK(2),o[d0],0,0,0);
    o[d0]=__builtin_amdgcn_mfma_f32_32x32x16_bf16(pa3,PK(3),o[d0],0,0,0);
    #undef PK
  }
}

#ifndef ATTN_STORE16
#define ATTN_STORE16(p,v) (*(u32x4*)(p)=(v))
#endif
template<int THRL> __device__ __forceinline__ void attn_unit(int b,int h,int qb,const bf16*Q,const bf16*__restrict__ K,const bf16*__restrict__ V,bf16*O,char*shm,const float*__restrict__ kmsum,const float*__restrict__ relb){
  int tid_=threadIdx.x; asm volatile("":"+v"(tid_));
  const int tid=tid_,lane=tid&63,r32=lane&31,hi=lane>>5; const int wid=__builtin_amdgcn_readfirstlane(tid>>6);
  const long rowbase=(long)b*SEQ; const int q0=qb*QB;
  const bf16*Qw=Q+(rowbase+q0+wid*QBLK)*DM+h*D;
  const bf16*Kh=K+rowbase*DM+h*D,*Vh=V+rowbase*DM+h*D;
  const unsigned lds0=(unsigned)(uintptr_t)shm;
  float*wsf=(float*)(shm+LDS_WS)+wid*64;
  const bf16*ksrc=Kh+(long)lane*DM+wid*8;
  const bf16*vsrc=Vh+(long)(16*(wid&3)+(lane>>2))*DM+(wid>>2)*32+(lane&3)*8;
  const unsigned kdst=lds0+LDS_K+wid*1024, vdst=lds0+LDS_V+wid*1024;
  #define DMA_K(t,slot) glds16(ksrc+(long)PHYS(t)*KVBLK*DM,(unsigned)__builtin_amdgcn_readfirstlane(kdst+(slot)))
  #define DMA_V(t,slot) glds16(vsrc+(long)PHYS(t)*KVBLK*DM,(unsigned)__builtin_amdgcn_readfirstlane(vdst+(slot)))
  const int vb0=(int)(lds0+LDS_V)+((lane>>4)&1)*32+(lane&3)*8+(4*hi+((lane&15)>>2))*64;
  const char*Kbase=shm+LDS_K; bf16x8 kf[8];
  const lds_cptr shm3=(lds_cptr)shm; const lds_cptr kp0=shm3+LDS_K+hi*1024+r32*16; const lds_cptr vp0=shm3+LDS_V+((lane>>4)&1)*32+(lane&3)*8+(4*hi+((lane&15)>>2))*64;
  const int NT=(q0+QB)/KVBLK;
  const lds_fptr rt3=(lds_fptr)(shm+LDS_RT); const lds_fptr km3=(lds_fptr)(shm+LDS_KM);
  { for(int j=tid;j<1152;j+=512){ const int d=895-j; float v=0.f; if(d>=0&&d<790)v=(relb[t5_bucket(d)*NHEAD+h]-relb[31*NHEAD+h])*L2E; rt3[j]=v; }
    for(int i=tid;i<qb*64;i+=512)km3[i]=kmsum[i];
    asm volatile("s_waitcnt vmcnt(0) lgkmcnt(0)\n\ts_barrier":::"memory"); }
  unsigned selmask=0u; bool selcur=true;
  if(qb>0){
    bf16x8 qg[4]; { const bf16*Qg=Q+(rowbase+q0+wid*QBLK+(lane&31))*DM+h*D+(lane>>5)*8;
      #pragma unroll
      for(int d0=0;d0<4;++d0)qg[d0]=*reinterpret_cast<const bf16x8*>(Qg+d0*16); }
    float qf[32];
    #pragma unroll
    for(int d0=0;d0<4;++d0){
      #pragma unroll
      for(int j=0;j<8;++j)qf[8*d0+j]=__builtin_bit_cast(float,(unsigned)(unsigned short)qg[d0][j]<<16);}
    float g0=-INFINITY,g1=-INFINITY,g2=-INFINITY;int s0=-1,s1=-1,s2=-1;
    for(int n=0;n<qb;++n){ const lds_fptr kr=km3+n*64+8*(lane>>5); float acc=0.f;
      #pragma unroll
      for(int d0=0;d0<4;++d0){ const f32x4_t a=*(const __attribute__((address_space(3))) f32x4_t*)(kr+16*d0), c=*(const __attribute__((address_space(3))) f32x4_t*)(kr+16*d0+4);
        acc+=(qf[8*d0]*a[0]+qf[8*d0+1]*a[1])+(qf[8*d0+2]*a[2]+qf[8*d0+3]*a[3])+(qf[8*d0+4]*c[0]+qf[8*d0+5]*c[1])+(qf[8*d0+6]*c[2]+qf[8*d0+7]*c[3]); }
      acc+=__shfl_xor(acc,32);
      if(acc>g0){g2=g1;s2=s1;g1=g0;s1=s0;g0=acc;s0=n;} else if(acc>g1){g2=g1;s2=s1;g1=acc;s1=n;} else if(acc>g2){g2=acc;s2=n;} }
    if(s0>=0)selmask|=1u<<s0; if(s1>=0)selmask|=1u<<s1; if(s2>=0)selmask|=1u<<s2; }
  #define PHYS(t) (((t)<4)?(NT-4+(t)):((t)-4))
  DMA_K(0,0);DMA_V(0,0);DMA_K(1,SLOTB);
  bf16x8 qr[4];
  #pragma unroll
  for(int d0=0;d0<4;++d0)qr[d0]=*reinterpret_cast<const bf16x8*>(&Qw[(long)r32*DM+d0*16+hi*8]);
  float mhat=0.f,l_reg=0.f;f32x16 o[2];o[0]=f32x16{};o[1]=f32x16{};const f32x16 zero16=f32x16{};
  const int qrel=wid*QBLK+r32;
  #define BIASADD(P0,P1,kt0) do{ const lds_fptr rp_=rt3+(895-(q0+qrel)+(kt0)+4*hi); \
    _Pragma("unroll") for(int g_=0;g_<4;++g_){ SBAR(); \
      const float b0_=rp_[8*g_],b1_=rp_[8*g_+1],b2_=rp_[8*g_+2],b3_=rp_[8*g_+3],c0_=rp_[8*g_+32],c1_=rp_[8*g_+33],c2_=rp_[8*g_+34],c3_=rp_[8*g_+35]; \
      P0[4*g_]+=b0_;P0[4*g_+1]+=b1_;P0[4*g_+2]+=b2_;P0[4*g_+3]+=b3_;P1[4*g_]+=c0_;P1[4*g_+1]+=c1_;P1[4*g_+2]+=c2_;P1[4*g_+3]+=c3_; } SBAR(); }while(0)
  #define CMASK(P0,P1,t) do{ const int t_=(t); { const float nm_=selcur?-mhat:-1e30f; _Pragma("unroll") for(int r=0;r<16;++r){P0[r]+=nm_;P1[r]+=nm_;} } \
    if(t_<4){ BIASADD(P0,P1,q0+64*t_); cmask(P0,P1,t_,qrel,hi); } \
    else{ const int kt0_=64*(t_-4); if(q0+wid*QBLK-(kt0_+63)<790){ BIASADD(P0,P1,kt0_); } } }while(0)
  #define SELUPD(tn) do{ const int tn_=(tn); if(tn_>=4&&(tn_&3)==0){ selcur=((selmask>>((tn_-4)>>2))&1u)!=0u; } }while(0)
  bool resc=false;
  #define START(P0,P1) do{ const float rm=rowmax(P0,P1); resc=false; \
    { const float dl=rm; mhat=fadd_s(mhat,dl); \
      _Pragma("unroll") for(int r=0;r<16;++r){P0[r]=fsub_s(P0[r],dl);P1[r]=fsub_s(P1[r],dl);} \
      } \
    _Pragma("unroll") for(int r=0;r<16;++r)P0[r]=__builtin_amdgcn_exp2f(P0[r]); }while(0)
  #define RESC() do{ if(resc){ asm volatile("s_waitcnt lgkmcnt(0)":::"memory"); \
      _Pragma("unroll") for(int d_=0;d_<2;++d_) _Pragma("unroll") for(int r=0;r<16;++r)o[d_][r]*=wsf[crow(r,hi)]; } }while(0)
  f32x16 pA0,pA1,pB0,pB1;
  int sl_prev=0,sl_cur=0,sl_next=SLOTB;
  #define ROT() do{sl_prev=sl_cur;sl_cur=sl_next;sl_next=(sl_next==(NSLOT-1)*SLOTB)?0:sl_next+SLOTB;}while(0)
  DMA_K(2,2*SLOTB);
  WAIT_BAR(3);
  qkt(pA0,pA1,Kbase,qr,zero16,r32,hi);asm volatile("s_nop 15\n\ts_nop 7":"+v"(pA0),"+v"(pA1));CMASK(pA0,pA1,0);
  START(pA0,pA1);
  _Pragma("unroll") for(int r=0;r<16;++r)pA1[r]=__builtin_amdgcn_exp2f(pA1[r]);
  WAIT_BAR(0);
  DMA_K(3,0);DMA_V(1,SLOTB);
  ROT();
  kload8(kf,kp0+sl_cur);
  WAIT_BAR(2);
  s16x4 vlo[8],vhi[8]; u32x4 pw0,pw1,pw2,pw3;
  #define PKW(P,B) cvtpk_s(P[B],P[B+1])
  #define PAF(k) __builtin_bit_cast(bf16x8,pw##k)
  #define VFR(i) (bf16x8){vlo[i][0],vlo[i][1],vlo[i][2],vlo[i][3],vhi[i][0],vhi[i][1],vhi[i][2],vhi[i][3]}
  #define PIN(x) asm volatile("":"+v"(x))
  #define MX3(a,b,c) __builtin_fmaxf(__builtin_fmaxf((a),(b)),(c))
  #define GAPA(MF,A0,A1,A2,A3,W0,W1,PW) do{ MF; sacc+=A0; sacc+=A1; sacc+=A2; sacc+=A3; PIN(sacc); W0; W1; PIN(PW); SBAR(); }while(0)
  #define EX(v) __builtin_amdgcn_exp2f(v)
  #define GAPB(MF,X,B) do{ MF; X[B]=EX(X[B]); X[B+1]=EX(X[B+1]); X[B+2]=EX(X[B+2]); X[B+3]=EX(X[B+3]); PIN(X); SBAR(); }while(0)
  #define VRD(i) do{ vlo[i]=vtr(vp_+(((i)>>2)*4096+((i)&3)*1024)); vhi[i]=vtr(vp_+(((i)>>2)*4096+((i)&3)*1024+512)); }while(0)
  #define KRD(G,j) do{ if(G){ kload2(kf,kp0+sl_next,j); SBAR(); } }while(0)
  #define STEP(C0,C1,P0,P1,t,GK,GV,GL) do{ SBAR(); \
    const lds_cptr vp_=vp0+sl_prev; \
    VRD(0); SBAR(); float sacc=(P0[0]+P0[1]); \
    GAPA(C0=__builtin_amdgcn_mfma_f32_32x32x16_bf16(kf[0],qr[0],zero16,0,0,0), P0[2],P0[3],P0[4],P0[5],     pw0[0]=PKW(P0,0), pw0[1]=PKW(P0,2), pw0); \
    VRD(4); SBAR(); GAPA(C1=__builtin_amdgcn_mfma_f32_32x32x16_bf16(kf[1],qr[0],zero16,0,0,0), P0[6],P0[7],P0[8],P0[9],     pw0[2]=PKW(P0,4), pw0[3]=PKW(P0,6), pw0); \
    VRD(1); SBAR(); GAPA(C0=__builtin_amdgcn_mfma_f32_32x32x16_bf16(kf[2],qr[1],C0,0,0,0),   P0[10],P0[11],P0[12],P0[13], pw1[0]=PKW(P0,8), pw1[1]=PKW(P0,10), pw1); \
    VRD(5); SBAR(); GAPA(C1=__builtin_amdgcn_mfma_f32_32x32x16_bf16(kf[3],qr[1],C1,0,0,0),   P0[14],P0[15],P1[0],P1[1],   pw1[2]=PKW(P0,12),pw1[3]=PKW(P0,14), pw1); \
    VRD(2); SBAR(); GAPA(C0=__builtin_amdgcn_mfma_f32_32x32x16_bf16(kf[4],qr[2],C0,0,0,0),   P1[2],P1[3],P1[4],P1[5],     pw2[0]=PKW(P1,0), pw2[1]=PKW(P1,2), pw2); \
    VRD(6); SBAR(); GAPA(C1=__builtin_amdgcn_mfma_f32_32x32x16_bf16(kf[5],qr[2],C1,0,0,0),   P1[6],P1[7],P1[8],P1[9],     pw2[2]=PKW(P1,4), pw2[3]=PKW(P1,6), pw2); \
    VRD(3); SBAR(); GAPA(C0=__builtin_amdgcn_mfma_f32_32x32x16_bf16(kf[6],qr[3],C0,0,0,0),   P1[10],P1[11],P1[12],P1[13], pw3[0]=PKW(P1,8), pw3[1]=PKW(P1,10), pw3); \
    VRD(7); SBAR(); GAPA(C1=__builtin_amdgcn_mfma_f32_32x32x16_bf16(kf[7],qr[3],C1,0,0,0),   P1[14],P1[15],0.f,0.f,       pw3[2]=PKW(P1,12),pw3[3]=PKW(P1,14), pw3); \
    l_reg+=sacc; \
    if(GK){DMA_K((t)+3,sl_cur);} if(GV){DMA_V((t)+1,sl_next);} \
    CMASK(C0,C1,t); \
    { float a=MX3(C0[0],C0[1],C1[0]),b=MX3(C0[2],C0[3],C1[1]); a=MX3(a,C1[2],C1[3]); \
      _Pragma("unroll") for(int r=4;r<16;r+=4){a=MX3(a,C0[r],C0[r+1]);b=MX3(b,C0[r+2],C0[r+3]);a=MX3(a,C1[r],C1[r+1]);b=MX3(b,C1[r+2],C1[r+3]);} \
      float rm=__builtin_fmaxf(a,b); { auto rr=__builtin_amdgcn_permlane32_swap(__float_as_uint(rm),__float_as_uint(rm),false,false); rm=__builtin_fmaxf(__uint_as_float(rr[0]),__uint_as_float(rr[1])); } \
      resc=false; \
      if(__builtin_expect(__any(rm>(float)THRL),0)){ const float dl=__builtin_fmaxf(rm,0.f); mhat+=dl; \
        _Pragma("unroll") for(int r=0;r<16;++r){C0[r]-=dl;C1[r]-=dl;} \
        const float f=__builtin_amdgcn_exp2f(-dl); l_reg*=f; if(hi==0)wsf[r32]=f; resc=true; } } \
    SBAR(); \
    GAPB(o[0]=__builtin_amdgcn_mfma_f32_32x32x16_bf16(PAF(0),VFR(0),o[0],0,0,0), C0,0); \
    GAPB(o[1]=__builtin_amdgcn_mfma_f32_32x32x16_bf16(PAF(0),VFR(4),o[1],0,0,0), C0,4); \
    KRD(GL,0); GAPB(o[0]=__builtin_amdgcn_mfma_f32_32x32x16_bf16(PAF(1),VFR(1),o[0],0,0,0), C0,8); \
    KRD(GL,1); GAPB(o[1]=__builtin_amdgcn_mfma_f32_32x32x16_bf16(PAF(1),VFR(5),o[1],0,0,0), C0,12); \
    KRD(GL,2); GAPB(o[0]=__builtin_amdgcn_mfma_f32_32x32x16_bf16(PAF(2),VFR(2),o[0],0,0,0), C1,0); \
    KRD(GL,3); GAPB(o[1]=__builtin_amdgcn_mfma_f32_32x32x16_bf16(PAF(2),VFR(6),o[1],0,0,0), C1,4); \
    GAPB(o[0]=__builtin_amdgcn_mfma_f32_32x32x16_bf16(PAF(3),VFR(3),o[0],0,0,0), C1,8); \
    GAPB(o[1]=__builtin_amdgcn_mfma_f32_32x32x16_bf16(PAF(3),VFR(7),o[1],0,0,0), C1,12); \
    }while(0)
  int t=1;
  for(;t+5<NT;t+=2){
    STEP(pB0,pB1,pA0,pA1,t,true,true,true);     WAIT_BAR(2); RESC(); ROT(); SELUPD(t+1);
    STEP(pA0,pA1,pB0,pB1,t+1,true,true,true);   WAIT_BAR(2); RESC(); ROT(); SELUPD(t+2);
  }
  #define ENDW(tt) do{ if((tt)+3<NT){WAIT_BAR(2);} else if((tt)+2<NT){WAIT_BAR(1);} else {WAIT_BAR(0);} }while(0)
  for(;t+1<NT;t+=2){
    STEP(pB0,pB1,pA0,pA1,t,(t+3<NT),(t+1<NT),(t+1<NT));       ENDW(t);   RESC(); ROT(); SELUPD(t+1);
    STEP(pA0,pA1,pB0,pB1,t+1,(t+4<NT),(t+2<NT),(t+2<NT));     ENDW(t+1); RESC(); ROT(); SELUPD(t+2);
  }
  STEP(pB0,pB1,pA0,pA1,NT-1,false,false,false); RESC();
  { float sacc=pB0[0]+pB0[1]; _Pragma("unroll") for(int r=2;r<16;++r)sacc+=pB0[r]; _Pragma("unroll") for(int r=0;r<16;++r)sacc+=pB1[r]; l_reg+=sacc;
    pw0=(u32x4){PKW(pB0,0),PKW(pB0,2),PKW(pB0,4),PKW(pB0,6)};pw1=(u32x4){PKW(pB0,8),PKW(pB0,10),PKW(pB0,12),PKW(pB0,14)};pw2=(u32x4){PKW(pB1,0),PKW(pB1,2),PKW(pB1,4),PKW(pB1,6)};pw3=(u32x4){PKW(pB1,8),PKW(pB1,10),PKW(pB1,12),PKW(pB1,14)};
    SBAR(); pv(o,vb0+sl_cur,PAF(0),PAF(1),PAF(2),PAF(3)); }
  #undef PKW
  #undef PAF
  #undef VFR
  #undef PIN
  #undef MX3
  #undef GAPA
  #undef GAPB
  #undef EX
  #undef VRD
  #undef KRD
  #undef STEP
  #undef ENDW
  {auto rr=__builtin_amdgcn_permlane32_swap(__float_as_uint(l_reg),__float_as_uint(l_reg),false,false);l_reg=__uint_as_float(rr[0])+__uint_as_float(rr[1]);}
  if(hi==0)wsf[32+r32]=l_reg;asm volatile("s_waitcnt lgkmcnt(0)":::"memory");
  float rli[16];
  #pragma unroll
  for(int r=0;r<16;++r)rli[r]=__builtin_amdgcn_rcpf(wsf[32+crow(r,hi)]);
  bf16*Ow=O+(rowbase+q0+wid*QBLK)*DM+h*D;
  { bf16*stg=(bf16*)(shm+LDS_OST)+wid*2048;
    #pragma unroll
    for(int r=0;r<16;++r){const int orow=crow(r,hi);
      #pragma unroll
      for(int d0=0;d0<2;++d0)stg[orow*64+d0*32+r32]=(bf16)f2bf(o[d0][r]*rli[r]);}
    asm volatile("s_waitcnt lgkmcnt(0)":::"memory");
    #pragma unroll
    for(int i=0;i<4;++i){const int row=i*8+(lane>>3),ch=lane&7; const u32x4 v=*(const u32x4*)(stg+row*64+ch*8); ATTN_STORE16(Ow+(long)row*DM+ch*8,v);} }
  asm volatile("s_waitcnt lgkmcnt(0)\n\ts_barrier":::"memory");
  #undef DMA_K
  #undef DMA_V
  #undef CMASK
  #undef BIASADD
  #undef SELUPD
  #undef PHYS
  #undef START
  #undef RESC
  #undef ROT
}
constexpr int ATTN_LDS_BYTES=LDS_BYTES;
struct AttnTensors { const bf16* Q; const bf16* K; const bf16* V; bf16* O; const float* kmsum; const float* relb; };
struct AttnUnit { int bh; int qb; };
struct StaticOrder {
  int vcu;
  __device__ __forceinline__ explicit StaticOrder(int grid,int block):vcu((block%8)*(grid/8)+block/8){}
  __device__ __forceinline__ bool next(int i,AttnUnit&u)const{ if(i>=2)return false; const int s=vcu&7; u.bh=vcu>>3; u.qb=(i==0)?15-s:s; return true; }
  __device__ __forceinline__ void a_ready(const AttnUnit&)const{}
  __device__ __forceinline__ void done(const AttnUnit&)const{}
};
template<class Sched,int THRL=8> __device__ __forceinline__ void attn_phase(char*lds,const AttnTensors&T,const Sched&S){
  AttnUnit u;
  for(int i=0;S.next(i,u);++i){ S.a_ready(u); attn_unit<THRL>(u.bh/NHEAD,u.bh%NHEAD,u.qb,T.Q,T.K,T.V,T.O,lds,T.kmsum+(size_t)u.bh*16*64,T.relb); S.done(u); }
}
#undef SBAR
#undef WAIT_BAR
}

__device__ __forceinline__ void attn_simple(Frame& F) {
    LAS float* tab = (LAS float*)(F.lds + RING_OFF);
    const float* relb = F.in[I_RELB];
    for (int i = F.tid; i < 8 * 800; i += 512) { const int h = i / 800, d = i % 800; tab[i] = relb[t5_bucket(d) * NH + h] * LOG2E; }
    __syncthreads();
    const bf16* Q = (const bf16*)(F.ws + WS_Q); const bf16* K = (const bf16*)(F.ws + WS_K); const bf16* V = (const bf16*)(F.ws + WS_V); bf16* O = (bf16*)(F.ws + WS_Q);
    const float* kmean = (const float*)(F.ws + OFF_KMEAN);
    const int wv = blockIdx.x * NWAVES + F.wave;
    const int bh = wv >> 6, b = bh >> 3, h = bh & 7, q = (wv & 63) * 64 + F.lane, blk = q >> 8;
    const LAS float* tb = tab + h * 800;
    const size_t rowq = (size_t)(b * SEQ + q) * 512 + h * 64;
    float qf[64];
#pragma unroll
    for (int c = 0; c < 8; ++c) { const u32x4 w = *(const u32x4*)(Q + rowq + c * 8);
        qf[c * 8 + 0] = bflo(w.x); qf[c * 8 + 1] = bfhi(w.x); qf[c * 8 + 2] = bflo(w.y); qf[c * 8 + 3] = bfhi(w.y); qf[c * 8 + 4] = bflo(w.z); qf[c * 8 + 5] = bfhi(w.z); qf[c * 8 + 6] = bflo(w.w); qf[c * 8 + 7] = bfhi(w.w); }
    float g0 = -INFINITY, g1 = -INFINITY, g2 = -INFINITY; int s0 = -1, s1 = -1, s2 = -1;
    for (int n = 0; n < blk; ++n) {
        const float* km = kmean + ((size_t)bh * 16 + n) * 64; float gsum = 0.f;
#pragma unroll
        for (int d = 0; d < 64; ++d) gsum += qf[d] * km[d];
        if (gsum > g0) { g2 = g1; s2 = s1; g1 = g0; s1 = s0; g0 = gsum; s0 = n; }
        else if (gsum > g1) { g2 = g1; s2 = s1; g1 = gsum; s1 = n; }
        else if (gsum > g2) { g2 = gsum; s2 = n; }
    }
    float o[64];
#pragma unroll
    for (int d = 0; d < 64; ++d) o[d] = 0.f;
    float mx = -1e30f, l = 0.f;
    for (int pass = 0; pass < 4; ++pass) {
        const int jb = pass == 0 ? s0 : pass == 1 ? s1 : pass == 2 ? s2 : blk;
        const bool act = jb >= 0;
        const int jblk = act ? jb : 0;
        const int nkeys = (pass == 3) ? 256 : 256;
        if (pass < 3 && blk <= pass) continue;
        for (int kk = 0; kk < nkeys; ++kk) {
            const int kpos = jblk * 256 + kk;
            const size_t rowk = (size_t)(b * SEQ + kpos) * 512 + h * 64;
            float s = 0.f;
#pragma unroll
            for (int c = 0; c < 8; ++c) { const u32x4 w = *(const u32x4*)(K + rowk + c * 8);
                s += qf[c * 8 + 0] * bflo(w.x) + qf[c * 8 + 1] * bfhi(w.x) + qf[c * 8 + 2] * bflo(w.y) + qf[c * 8 + 3] * bfhi(w.y) + qf[c * 8 + 4] * bflo(w.z) + qf[c * 8 + 5] * bfhi(w.z) + qf[c * 8 + 6] * bflo(w.w) + qf[c * 8 + 7] * bfhi(w.w); }
            const int dist = q - kpos;
            const bool valid = act && dist >= 0;
            const int dcl = dist < 0 ? 0 : (dist > 799 ? 799 : dist);
            s += tb[dcl];
            if (!valid) s = -1e30f;
            const float mn = fmaxf(mx, s);
            const float f = fast_exp2(mx - mn), p = valid ? fast_exp2(s - mn) : 0.f;
            l = l * f + p; mx = mn;
#pragma unroll
            for (int c = 0; c < 8; ++c) { const u32x4 w = *(const u32x4*)(V + rowk + c * 8);
                o[c * 8 + 0] = o[c * 8 + 0] * f + p * bflo(w.x); o[c * 8 + 1] = o[c * 8 + 1] * f + p * bfhi(w.x); o[c * 8 + 2] = o[c * 8 + 2] * f + p * bflo(w.y); o[c * 8 + 3] = o[c * 8 + 3] * f + p * bfhi(w.y);
                o[c * 8 + 4] = o[c * 8 + 4] * f + p * bflo(w.z); o[c * 8 + 5] = o[c * 8 + 5] * f + p * bfhi(w.z); o[c * 8 + 6] = o[c * 8 + 6] * f + p * bflo(w.w); o[c * 8 + 7] = o[c * 8 + 7] * f + p * bfhi(w.w); }
        }
    }
    const float il = 1.0f / l;
#pragma unroll
    for (int c = 0; c < 8; ++c) { u32x4 w; w.x = pk2(o[c * 8 + 0] * il, o[c * 8 + 1] * il); w.y = pk2(o[c * 8 + 2] * il, o[c * 8 + 3] * il); w.z = pk2(o[c * 8 + 4] * il, o[c * 8 + 5] * il); w.w = pk2(o[c * 8 + 6] * il, o[c * 8 + 7] * il);
        *(u32x4*)(O + rowq + c * 8) = w; }
}

__device__ __forceinline__ void mix_phase(Frame& F) {
    unsigned char* ws = F.ws;
    const bf16* Z = (const bf16*)(ws + WS_Z);
    bf16* R = (bf16*)(ws + WS_R); bf16* KR = (bf16*)(ws + WS_KR); bf16* VR = (bf16*)(ws + WS_VR);
    bf16* KKo = (bf16*)(ws + WS_KK); bf16* BBo = (bf16*)(ws + WS_BB); float* WD = (float*)(ws + WS_WDEC); bf16* GB = (bf16*)(ws + WS_GB); float* RK = (float*)(ws + WS_RK);
    const bf16* bnd = (const bf16*)(ws + WS_BND);
    const bf16* LBW = (const bf16*)(ws + WS_LBW); const bf16* LBA = (const bf16*)(ws + WS_LBA); const bf16* LBG = (const bf16*)(ws + WS_LBG);
    const float* mixrkv = F.in[I_MIXRKV]; const float* w0 = F.in[I_W0]; const float* a0 = F.in[I_A0]; const float* k_k = F.in[I_KK]; const float* k_a = F.in[I_KA]; const float* r_k = F.in[I_RKP];
    const int lane = F.lane, n = lane & 15, q4 = lane >> 4;
    LAS float* stash = (LAS float*)(F.lds + RING_OFF) + F.wave * 2560;
    LAS float* keep = stash + 384;
    for (int item = blockIdx.x; item < 256; item += F.G) {
        const int pm = item >> 2, hp = item & 3;
        const int R0 = pm * 256 + F.wave * 32;
        if (q4 == 0) {
#pragma unroll
            for (int hh = 0; hh < 2; ++hh)
#pragma unroll
                for (int c = 0; c < 4; ++c) {
                    const int ch = (2 * hp + hh) * 64 + 16 * c + n; float vr = 0.f, vk = 0.f, vv = 0.f;
                    if ((R0 & (SEQ - 1)) != 0) {
                        if (F.wave == 0) { const bf16* bp = bnd + (size_t)(pm - 1) * 1536; vr = bf2f(bp[ch]); vk = bf2f(bp[512 + ch]); vv = bf2f(bp[1024 + ch]); }
                        else { const size_t o = (size_t)(R0 - 1) * 512 + ch; vr = bf2f(R[o]); vk = bf2f(KR[o]); vv = bf2f(VR[o]); }
                    }
                    stash[((hh * 4 + c) * 3 + 0) * 16 + n] = vr; stash[((hh * 4 + c) * 3 + 1) * 16 + n] = vk; stash[((hh * 4 + c) * 3 + 2) * 16 + n] = vv;
                }
        }
        asm volatile("s_waitcnt vmcnt(0) lgkmcnt(0)" ::: "memory"); __syncthreads();
#pragma unroll 1
        for (int g = 1; g >= 0; --g) {
            const int t0 = R0 + 16 * g;
            bf16x8 Af[9];
            {
                const int t = t0 + n; const bool first = (t & (SEQ - 1)) == 0;
#pragma unroll
                for (int s = 0; s < 9; ++s) {
                    const u32x4 z1 = *(const u32x4*)(Z + (size_t)t * ZP + 32 * s + 8 * q4);
                    u32x4 z2 = (u32x4){0u, 0u, 0u, 0u}; if (!first) z2 = *(const u32x4*)(Z + (size_t)(t - 1) * ZP + 288 + 32 * s + 8 * q4);
                    float hv[8] = { bflo(z1.x) + bflo(z2.x), bfhi(z1.x) + bfhi(z2.x), bflo(z1.y) + bflo(z2.y), bfhi(z1.y) + bfhi(z2.y), bflo(z1.z) + bflo(z2.z), bfhi(z1.z) + bfhi(z2.z), bflo(z1.w) + bflo(z2.w), bfhi(z1.w) + bfhi(z2.w) };
#pragma unroll
                    for (int i = 0; i < 8; ++i) { if (s < 2) { const float e = fast_exp2(hv[i] * (2.0f * LOG2E)); hv[i] = 1.0f - 2.0f * fast_rcp(e + 1.0f); } else if (s >= 4) hv[i] = sigmoidf_(hv[i]); }
                    u32x4 p; p.x = pk2(hv[0], hv[1]); p.y = pk2(hv[2], hv[3]); p.z = pk2(hv[4], hv[5]); p.w = pk2(hv[6], hv[7]);
                    Af[s] = __builtin_bit_cast(bf16x8, p);
                }
            }
#pragma unroll 1
            for (int hh = 0; hh < 2; ++hh) {
                const int hd = 2 * hp + hh;
                float n2[4] = {0.f, 0.f, 0.f, 0.f}, rks[4] = {0.f, 0.f, 0.f, 0.f};
#pragma unroll 1
                for (int c = 0; c < 4; ++c) {
                    const int ch = hd * 64 + 16 * c + n;
                    float oR[5], oK[5], oV[5];
                    if (q4 == 0 && g == 0) { oR[0] = stash[((hh * 4 + c) * 3 + 0) * 16 + n]; oK[0] = stash[((hh * 4 + c) * 3 + 1) * 16 + n]; oV[0] = stash[((hh * 4 + c) * 3 + 2) * 16 + n]; }
                    else { const size_t o = (size_t)(t0 + 4 * q4 - 1) * 512 + ch; oR[0] = bf2f(R[o]); oK[0] = bf2f(KR[o]); oV[0] = bf2f(VR[o]); }
#pragma unroll
                    for (int i = 0; i < 4; ++i) { const size_t o = (size_t)(t0 + 4 * q4 + i) * 512 + ch; oR[i + 1] = bf2f(R[o]); oK[i + 1] = bf2f(KR[o]); oV[i + 1] = bf2f(VR[o]); }
                    asm volatile("s_waitcnt vmcnt(0) lgkmcnt(0)" ::: "memory");
                    f32x4 aw = (f32x4){0.f, 0.f, 0.f, 0.f}, aa = aw, ag = aw;
#pragma unroll
                    for (int s = 0; s < 2; ++s) { const bf16x8 b = *(const bf16x8*)(LBW + (size_t)ch * 64 + 32 * s + 8 * q4); aw = __builtin_amdgcn_mfma_f32_16x16x32_bf16(Af[s], b, aw, 0, 0, 0); }
#pragma unroll
                    for (int s = 0; s < 2; ++s) { const bf16x8 b = *(const bf16x8*)(LBA + (size_t)ch * 64 + 32 * s + 8 * q4); aa = __builtin_amdgcn_mfma_f32_16x16x32_bf16(Af[2 + s], b, aa, 0, 0, 0); }
#pragma unroll
                    for (int s = 0; s < 5; ++s) { const bf16x8 b = *(const bf16x8*)(LBG + (size_t)ch * 160 + 32 * s + 8 * q4); ag = __builtin_amdgcn_mfma_f32_16x16x32_bf16(Af[4 + s], b, ag, 0, 0, 0); }
                    const float mr = mixrkv[ch], mk = mixrkv[512 + ch], mv = mixrkv[1024 + ch], w0c = w0[ch], a0c = a0[ch], kkc = k_k[ch], kac = k_a[ch], rkc = r_k[ch];
#pragma unroll
                    for (int i = 0; i < 4; ++i) {
                        const size_t o = (size_t)(t0 + 4 * q4 + i) * 512 + ch;
                        const float cr = oR[i + 1], ck = oK[i + 1], cv = oV[i + 1];
                        const float r_ = cr + (oR[i] - cr) * mr, k_ = ck + (oK[i] - ck) * mk, v_ = cv + (oV[i] - cv) * mv;
                        const float sg = sigmoidf_(w0c + aw[i]);
                        const float dec = fast_exp2(-0.6065306597126334f * LOG2E * sg);
                        const float a_ = sigmoidf_(a0c + aa[i]);
                        const float kr_ = k_ * kkc; n2[i] += kr_ * kr_;
                        const float kt_ = k_ * (1.0f + (a_ - 1.0f) * kac);
                        rks[i] += r_ * kt_ * rkc;
                        keep[((c * 4 + i) * 2 + 0) * 64 + lane] = kr_; keep[((c * 4 + i) * 2 + 1) * 64 + lane] = a_;
                        R[o] = (bf16)f2bf(r_); KR[o] = (bf16)f2bf(kt_); VR[o] = (bf16)f2bf(v_); WD[o] = dec; GB[o] = (bf16)f2bf(ag[i]);
                    }
                }
#pragma unroll
                for (int i = 0; i < 4; ++i) {
                    float a = n2[i], b = rks[i];
                    a += __shfl_xor(a, 1); a += __shfl_xor(a, 2); a += __shfl_xor(a, 4); a += __shfl_xor(a, 8);
                    b += __shfl_xor(b, 1); b += __shfl_xor(b, 2); b += __shfl_xor(b, 4); b += __shfl_xor(b, 8);
                    n2[i] = 1.0f / fmaxf(sqrtf(a), 1e-12f); rks[i] = b;
                }
                LDS_WAIT();
#pragma unroll 1
                for (int c = 0; c < 4; ++c) {
                    const int ch = hd * 64 + 16 * c + n;
#pragma unroll
                    for (int i = 0; i < 4; ++i) {
                        const size_t o = (size_t)(t0 + 4 * q4 + i) * 512 + ch;
                        const float kk_ = keep[((c * 4 + i) * 2 + 0) * 64 + lane] * n2[i], a_ = keep[((c * 4 + i) * 2 + 1) * 64 + lane];
                        KKo[o] = (bf16)f2bf(kk_); BBo[o] = (bf16)f2bf(kk_ * a_);
                    }
                }
                LDS_WAIT();
                if (n == 0) {
#pragma unroll
                    for (int i = 0; i < 4; ++i) RK[(size_t)(t0 + 4 * q4 + i) * 8 + hd] = rks[i];
                }
            }
        }
        __syncthreads();
    }
}

__device__ __forceinline__ float dpp_sum16(float x) {
    x += __builtin_bit_cast(float, __builtin_amdgcn_update_dpp(0, __builtin_bit_cast(int, x), 0xB1, 0xf, 0xf, true));
    x += __builtin_bit_cast(float, __builtin_amdgcn_update_dpp(0, __builtin_bit_cast(int, x), 0x4E, 0xf, 0xf, true));
    x += __builtin_bit_cast(float, __builtin_amdgcn_update_dpp(0, __builtin_bit_cast(int, x), 0x141, 0xf, 0xf, true));
    x += __builtin_bit_cast(float, __builtin_amdgcn_update_dpp(0, __builtin_bit_cast(int, x), 0x140, 0xf, 0xf, true));
    return x;
}
struct ScanBlk { u32x2 r[4], k[4], kk[4], bb[4]; f32x4 w[4]; unsigned v[4]; };
__device__ __forceinline__ void scan_phase(Frame& F) {
    if (F.wave >= 2) return;
    unsigned char* ws = F.ws;
    const bf16* R = (const bf16*)(ws + WS_R); const bf16* KR = (const bf16*)(ws + WS_KR); const bf16* VR = (const bf16*)(ws + WS_VR);
    const bf16* KK = (const bf16*)(ws + WS_KK); const bf16* BB = (const bf16*)(ws + WS_BB); const float* WD = (const float*)(ws + WS_WDEC);
    bf16* Y = (bf16*)(ws + WS_YRAW);
    for (int task = blockIdx.x * 2 + F.wave; task < 512; task += F.G * 2) {
        const int bh = task >> 4, rg = task & 15, b = bh >> 3, h = bh & 7;
        const int j = F.lane & 15, rr = F.lane >> 4, vi = 4 * rg + rr;
        const size_t base = (size_t)b * SEQ * 512 + h * 64;
        const size_t o4 = base + 4 * j, ov = base + vi;
        float s0 = 0.f, s1 = 0.f, s2 = 0.f, s3 = 0.f, ysel = 0.f;
        ScanBlk cur, nxt;
#define SCAN_LOAD(B, T0) do { _Pragma("unroll") for (int u_ = 0; u_ < 4; ++u_) { const size_t rw_ = (size_t)((T0) + u_) * 512; \
            B.r[u_] = *(const u32x2*)(R + o4 + rw_); B.k[u_] = *(const u32x2*)(KR + o4 + rw_); B.kk[u_] = *(const u32x2*)(KK + o4 + rw_); B.bb[u_] = *(const u32x2*)(BB + o4 + rw_); \
            B.w[u_] = *(const f32x4*)(WD + o4 + rw_); B.v[u_] = VR[ov + rw_]; } } while (0)
        SCAN_LOAD(cur, 0);
        for (int t0 = 0; t0 < SEQ; t0 += 4) {
            const int tn = (t0 + 4 < SEQ) ? t0 + 4 : t0;
            SCAN_LOAD(nxt, tn);
#pragma unroll
            for (int u = 0; u < 4; ++u) {
                const float kk0 = bflo(cur.kk[u].x), kk1 = bfhi(cur.kk[u].x), kk2 = bflo(cur.kk[u].y), kk3 = bfhi(cur.kk[u].y);
                float sa = (s0 * kk0 + s1 * kk1) + (s2 * kk2 + s3 * kk3);
                sa = dpp_sum16(sa);
                const float v_ = __builtin_bit_cast(float, cur.v[u] << 16);
                const float b0 = bflo(cur.bb[u].x), b1 = bfhi(cur.bb[u].x), b2 = bflo(cur.bb[u].y), b3 = bfhi(cur.bb[u].y);
                const float k0 = bflo(cur.k[u].x), k1 = bfhi(cur.k[u].x), k2 = bflo(cur.k[u].y), k3 = bfhi(cur.k[u].y);
                s0 = s0 * cur.w[u][0] + (v_ * k0 - sa * b0); s1 = s1 * cur.w[u][1] + (v_ * k1 - sa * b1); s2 = s2 * cur.w[u][2] + (v_ * k2 - sa * b2); s3 = s3 * cur.w[u][3] + (v_ * k3 - sa * b3);
                const float r0 = bflo(cur.r[u].x), r1 = bfhi(cur.r[u].x), r2 = bflo(cur.r[u].y), r3 = bfhi(cur.r[u].y);
                float y = (s0 * r0 + s1 * r1) + (s2 * r2 + s3 * r3);
                y = dpp_sum16(y);
                if (((t0 + u) & 15) == j) ysel = y;
            }
            if ((t0 & 15) == 12) Y[ov + (size_t)(t0 - 12 + j) * 512] = (bf16)f2bf(ysel);
            cur = nxt;
        }
#undef SCAN_LOAD
    }
}

__device__ __forceinline__ void e1_phase(Frame& F) {
    unsigned char* ws = F.ws;
    const bf16* Y = (const bf16*)(ws + WS_YRAW); const bf16* VR = (const bf16*)(ws + WS_VR); const bf16* GB = (const bf16*)(ws + WS_GB); const float* RK = (const float*)(ws + WS_RK);
    bf16* YB = (bf16*)(ws + WS_YB);
    const float* lnw = F.in[I_LNW]; const float* lnb = F.in[I_LNB];
    const int gw = F.vcu * NWAVES + F.wave, NGW = F.G * NWAVES, c0 = F.lane * 8;
    float lw[8], lb[8];
#pragma unroll
    for (int i = 0; i < 8; ++i) { lw[i] = lnw[c0 + i]; lb[i] = lnb[c0 + i]; }
    for (int m = gw; m < M; m += NGW) {
        const size_t o = (size_t)m * 512 + c0;
        const u32x4 yw = *(const u32x4*)(Y + o), vw = *(const u32x4*)(VR + o), gw_ = *(const u32x4*)(GB + o);
        const float rk = RK[(size_t)m * 8 + (F.lane >> 3)];
        float y[8] = { bflo(yw.x), bfhi(yw.x), bflo(yw.y), bfhi(yw.y), bflo(yw.z), bfhi(yw.z), bflo(yw.w), bfhi(yw.w) };
        const float v[8] = { bflo(vw.x), bfhi(vw.x), bflo(vw.y), bfhi(vw.y), bflo(vw.z), bfhi(vw.z), bflo(vw.w), bfhi(vw.w) };
        const float g[8] = { bflo(gw_.x), bfhi(gw_.x), bflo(gw_.y), bfhi(gw_.y), bflo(gw_.z), bfhi(gw_.z), bflo(gw_.w), bfhi(gw_.w) };
        float s = 0.f;
#pragma unroll
        for (int i = 0; i < 8; ++i) s += y[i];
        s += __shfl_xor(s, 1); s += __shfl_xor(s, 2); s += __shfl_xor(s, 4);
        const float mu = s * (1.0f / 64.0f); float q = 0.f;
#pragma unroll
        for (int i = 0; i < 8; ++i) { y[i] -= mu; q += y[i] * y[i]; }
        q += __shfl_xor(q, 1); q += __shfl_xor(q, 2); q += __shfl_xor(q, 4);
        const float rstd = 1.0f / sqrtf(q * (1.0f / 64.0f) + 64.0f * 1e-5f);
        float ov[8];
#pragma unroll
        for (int i = 0; i < 8; ++i) ov[i] = (y[i] * rstd * lw[i] + lb[i] + rk * v[i]) * g[i];
        u32x4 w; w.x = pk2(ov[0], ov[1]); w.y = pk2(ov[2], ov[3]); w.z = pk2(ov[4], ov[5]); w.w = pk2(ov[6], ov[7]);
        *(u32x4*)(YB + o) = w;
    }
}

__device__ __forceinline__ void fin_phase(Frame& F) {
    const f32x4* gf = (const f32x4*)F.in[I_NFIN] + F.lane;
    const int gw = F.vcu * NWAVES + F.wave, NGW = F.G * NWAVES;
    f32x4 gg[4];
#pragma unroll
    for (int j = 0; j < 4; ++j) gg[j] = gf[64 * j];
    for (int m = gw; m < M; m += NGW) {
        f32x4* xr = (f32x4*)(F.out + (size_t)m * D) + F.lane; f32x4 v[4]; float s = 0.f;
#pragma unroll
        for (int j = 0; j < 4; ++j) { v[j] = xr[64 * j]; s += (v[j].x * v[j].x + v[j].y * v[j].y) + (v[j].z * v[j].z + v[j].w * v[j].w); }
        s = wave_sum(s);
        const float rs = 1.0f / sqrtf(s * (1.0f / D) + RMS_EPS);
#pragma unroll
        for (int j = 0; j < 4; ++j) xr[64 * j] = v[j] * rs * gg[j];
    }
}


#ifdef DBG_OUT
__device__ __forceinline__ void dbg_phase(Frame& F) {
    const int gw = F.vcu * NWAVES + F.wave, NGW = F.G * NWAVES;
    for (int m = gw; m < M; m += NGW) {
        float* o = F.out + (size_t)m * D;
        for (int c = F.lane; c < D; c += 64) {
            bf16 v;
            if (DBG_OUT == 1) v = ((const bf16*)(F.ws + WS_MRG))[(size_t)m * D + c];
            else if (DBG_OUT == 2) v = ((const bf16*)(F.ws + WS_SGA))[(size_t)m * D + c];
            else if (DBG_OUT == 3) v = c < 512 ? ((const bf16*)(F.ws + WS_Q))[(size_t)m * 512 + c] : ((const bf16*)(F.ws + WS_K))[(size_t)m * 512 + c - 512];
            else if (DBG_OUT == 4) v = c < 512 ? ((const bf16*)(F.ws + WS_V))[(size_t)m * 512 + c] : ((const bf16*)(F.ws + WS_R))[(size_t)m * 512 + c - 512];
            else if (DBG_OUT == 5) v = c < 512 ? ((const bf16*)(F.ws + WS_KR))[(size_t)m * 512 + c] : ((const bf16*)(F.ws + WS_VR))[(size_t)m * 512 + c - 512];
            else if (DBG_OUT == 6) v = c < 768 ? ((const bf16*)(F.ws + WS_Z))[(size_t)m * ZP + c] : (bf16)0;
            else if (DBG_OUT == 7) v = ((const bf16*)(F.ws + WS_SGB))[(size_t)m * D + c];
            else if (DBG_OUT == 9) v = ((const bf16*)(F.ws + WS_WG))[(size_t)(m & 2047) * D + c];
            else v = ((const bf16*)(F.ws + WS_XB))[(size_t)m * D + c];
            o[c] = bf2f(v);
        }
    }
}
#endif
struct Args { const float* in[31]; float* out; unsigned char* ws; int ph_lo, ph_hi; };
constexpr int N_PHASES = 14;

#ifndef MK_N_LAUNCHES
#define MK_N_LAUNCHES 1
#endif

__global__ void __launch_bounds__(NWAVES * 64, 2) mk_fwd(Args args) {
    extern __shared__ __attribute__((aligned(16))) unsigned char lds[];
    Frame F;
    F.lds = (LAS unsigned char*)lds; F.MISC = (volatile LAS unsigned*)(F.lds + MISC_OFF);
    F.tid = threadIdx.x; F.lane = F.tid & 63; F.wave = __builtin_amdgcn_readfirstlane(F.tid >> 6);
    F.G = gridDim.x; { const int bx = blockIdx.x; F.vcu = (F.G % 8 == 0) ? (bx % 8) * (F.G / 8) + bx / 8 : bx; }
    F.in = args.in;
    F.out = args.out; F.ws = args.ws; F.ctl = (unsigned*)(args.ws + WS_CTL);
    unsigned char* ws = args.ws;
    for (int u = F.tid; u < (LDS_BYTES - LDSCTL_OFF) / 4; u += NWAVES * 64) ((LAS unsigned*)(F.lds + LDSCTL_OFF))[u] = 0u;
    __syncthreads();
    XcdBarrier bar; bar.bar = F.ctl + CW_BAR; bar.x = 0; bar.st = nullptr;
    if (MK_N_LAUNCHES == 1) bar = xcd_barrier_post(F.ctl + CW_BAR, F.MISC + 8);
    const int lo = args.ph_lo, hi = args.ph_hi;
#ifndef PH_MASK
#define PH_MASK 0xFFFFFFFFu
#endif
#define IN(k) (((PH_MASK >> (k)) & 1u) && lo <= (k) && (k) < hi)
#define SEAM(k) do { if (IN(k) && IN((k) + 1)) xcd_barrier(bar); } while (0)
    float* ssq1 = (float*)(ws + OFF_SSQ1); float* ssq2 = (float*)(ws + WS_SSQ2); float* ssq3 = (float*)(ws + WS_SSQ3);
#ifdef SKIP_MID
    ssq3 = ssq2;
#endif
    bf16* XB = (bf16*)(ws + WS_XB); bf16* ACT = (bf16*)(ws + WS_ACT);
    const int bx = (int)blockIdx.x;

    if (IN(0)) { p0_prologue(F); } SEAM(0);
    if (IN(1)) { pg8::Gemm g{XB, (const bf16*)(ws + WS_WGU1), M, N_GU, D}; pg8::StaticOrder S; S.init(M, N_GU, F.G, bx);
        pg8::EpiSwiGLU<1> E{ACT, FF, ssq1}; pg8::gemm_phase<pg8::EpiSwiGLU<1>, pg8::StaticOrder, true, true>(F.lds + RING_OFF, g, S, E); } SEAM(1);
    if (IN(2)) { pg8::Gemm g{ACT, (const bf16*)(ws + WS_WD1), M, D, FF}; pg8::StaticOrder S; S.init(M, D, F.G, bx);
        pg8::EpiResid E{F.in[I_X], F.out, XB, ssq2, 0.5f}; pg8::gemm_phase<pg8::EpiResid, pg8::StaticOrder, true, true>(F.lds + RING_OFF, g, S, E); } SEAM(2);
    if (IN(3)) { pg8::Gemm g{XB, (const bf16*)(ws + WS_WIN), M, N_IN, D}; pg8::StaticOrder S; S.init(M, N_IN, F.G, bx);
        pg8::EpiProj E{(bf16*)(ws + WS_Q), (bf16*)(ws + WS_Z), ssq2, (float*)(ws + OFF_KMEAN), (bf16*)(ws + WS_BND)};
        pg8::gemm_phase<pg8::EpiProj, pg8::StaticOrder, true, true>(F.lds + RING_OFF, g, S, E); } SEAM(3);
#ifdef ATT_SIMPLE
    if (IN(4)) { attn_simple(F); } SEAM(4);
#else
    if (IN(4)) { const attn_body::AttnTensors AT{(const bf16*)(ws + WS_Q), (const bf16*)(ws + WS_K), (const bf16*)(ws + WS_V), (bf16*)(ws + WS_Q), (const float*)(ws + OFF_KMEAN), F.in[I_RELB]};
        const attn_body::StaticOrder S((int)F.G, bx); attn_body::attn_phase<attn_body::StaticOrder>((char*)lds + RING_OFF, AT, S); } SEAM(4);
#endif
    if (IN(5)) { mix_phase(F); } SEAM(5);
    if (IN(6)) { scan_phase(F); } SEAM(6);
    if (IN(7)) { e1_phase(F);
        pg8::Gemm g{XB, (const bf16*)(ws + WS_WG), M, N_GATE, D}; pg8::StaticOrder S; S.init(M, N_GATE, F.G, bx);
        pg8::EpiGate<0> E{(bf16*)(ws + WS_SGA), nullptr, (bf16*)(ws + WS_SGB), ssq2}; pg8::gemm_phase<pg8::EpiGate<0>, pg8::StaticOrder, true, true>(F.lds + RING_OFF, g, S, E); } SEAM(7);
    if (IN(8)) { pg8::Gemm g{(const bf16*)(ws + WS_Q), (const bf16*)(ws + WS_WA), M, D, 512}; pg8::StaticOrder S; S.init(M, D, F.G, bx);
        pg8::EpiGate<1> E{(bf16*)(ws + WS_MRG), (const bf16*)(ws + WS_SGA), nullptr, nullptr}; pg8::gemm_phase<pg8::EpiGate<1>, pg8::StaticOrder, true, true>(F.lds + RING_OFF, g, S, E); } SEAM(8);
    if (IN(9)) { pg8::Gemm g{(const bf16*)(ws + WS_YB), (const bf16*)(ws + WS_WB), M, D, 512}; pg8::StaticOrder S; S.init(M, D, F.G, bx);
        pg8::EpiGate<2> E{(bf16*)(ws + WS_MRG), (const bf16*)(ws + WS_SGB), nullptr, nullptr}; pg8::gemm_phase<pg8::EpiGate<2>, pg8::StaticOrder, true, true>(F.lds + RING_OFF, g, S, E); } SEAM(9);
    if (IN(10)) { pg8::Gemm g{(const bf16*)(ws + WS_MRG), (const bf16*)(ws + WS_WOUT), M, D, D}; pg8::StaticOrder S; S.init(M, D, F.G, bx);
        pg8::EpiResid E{F.out, F.out, XB, ssq3, 1.0f}; pg8::gemm_phase<pg8::EpiResid, pg8::StaticOrder, true, true>(F.lds + RING_OFF, g, S, E); } SEAM(10);
    if (IN(11)) { pg8::Gemm g{XB, (const bf16*)(ws + WS_WGU2), M, N_GU, D}; pg8::StaticOrder S; S.init(M, N_GU, F.G, bx);
        pg8::EpiSwiGLU<16> E{ACT, FF, ssq3}; pg8::gemm_phase<pg8::EpiSwiGLU<16>, pg8::StaticOrder, true, true>(F.lds + RING_OFF, g, S, E); } SEAM(11);
    if (IN(12)) { pg8::Gemm g{ACT, (const bf16*)(ws + WS_WD2), M, D, FF}; pg8::StaticOrder S; S.init(M, D, F.G, bx);
        pg8::EpiResid E{F.out, F.out, nullptr, nullptr, 0.5f}; pg8::gemm_phase<pg8::EpiResid, pg8::StaticOrder, true, true>(F.lds + RING_OFF, g, S, E); } SEAM(12);
#ifdef DBG_OUT
    if (IN(13)) { dbg_phase(F); }
#else
    if (IN(13)) { fin_phase(F); }
#endif
#undef IN
#undef SEAM
}

extern "C" void kernel_launch(void* const* d_in, const int* in_sizes, int n_in, void* d_out, int out_size, void* d_ws, size_t ws_size, hipStream_t stream) {
    static int grid = 0;
    if (grid == 0) {
        if (n_in != 31 || out_size != M * D || ws_size < WS_END) { fprintf(stderr, "kernel_launch: unexpected shapes: n_in %d out %d ws %zu\n", n_in, out_size, ws_size); grid = -1; return; }
        int dev = 0, cus = 0;
        if (hipGetDevice(&dev) != hipSuccess || hipDeviceGetAttribute(&cus, hipDeviceAttributeMultiprocessorCount, dev) != hipSuccess) { grid = -1; return; }
        if (hipFuncSetAttribute((const void*)mk_fwd, hipFuncAttributeMaxDynamicSharedMemorySize, LDS_BYTES) != hipSuccess) { fprintf(stderr, "kernel_launch: hipFuncSetAttribute failed\n"); grid = -1; return; }
        int per_cu = 0;
        if (hipOccupancyMaxActiveBlocksPerMultiprocessor(&per_cu, (const void*)mk_fwd, NWAVES * 64, LDS_BYTES) != hipSuccess || per_cu < 1) fprintf(stderr, "kernel_launch: occupancy query says %d\n", per_cu);
        (void)hipGetLastError();
        grid = cus;
    }
    if (grid < 0) return;
    (void)hipMemsetAsync((char*)d_ws + WS_CTL, 0, CTL_ZERO_BYTES, stream);
    Args a{};
    for (int i = 0; i < 31; ++i) a.in[i] = (const float*)d_in[i];
    a.out = (float*)d_out; a.ws = (unsigned char*)d_ws;
#if MK_N_LAUNCHES == 1
    a.ph_lo = 0; a.ph_hi = N_PHASES;
    hipLaunchKernelGGL(mk_fwd, dim3(grid), dim3(NWAVES * 64), LDS_BYTES, stream, a);
#else
    for (int p = 0; p < N_PHASES; ++p) { a.ph_lo = p; a.ph_hi = p + 1; hipLaunchKernelGGL(mk_fwd, dim3(grid), dim3(NWAVES * 64), LDS_BYTES, stream, a); }
#endif
}
```

```cpp
#include <hip/hip_runtime.h>
#include <cstdio>
#include <cstdint>

#define LAS __attribute__((address_space(3)))
#define GAS __attribute__((address_space(1)))
typedef unsigned short bf16;
typedef short bf16x8 __attribute__((ext_vector_type(8)));
typedef float f32x4 __attribute__((ext_vector_type(4)));
typedef float f32x2 __attribute__((ext_vector_type(2)));
typedef unsigned u32x4 __attribute__((ext_vector_type(4)));
typedef unsigned u32x2 __attribute__((ext_vector_type(2)));

constexpr int M = 16384, D = 1024, FF = 2816, SEQ = 4096, NBATCH = 4, NH = 8, HD = 64, WR = 512;
constexpr int N_GU = 2 * FF;
constexpr int N_IN = 3840;
constexpr int N_GATE = 2048;
constexpr int ZP = 768;
constexpr float RMS_EPS = 1e-6f;
constexpr float LOG2E = 1.4426950408889634f;
constexpr float C2 = 0.125f * LOG2E;

constexpr size_t MiB = 1u << 20;
constexpr size_t WS_CTL = 0, CTL_ZERO_BYTES = 1 * MiB;
constexpr int CW_TMO = 0, CW_BAR = 4096;
constexpr size_t OFF_SSQ1 = 65536, OFF_SSQ2 = 131072, OFF_SSQ3 = 196608, OFF_SSQ4 = 262144, OFF_KMEAN = 327680;
constexpr size_t WS_RK = 1 * MiB;
constexpr size_t WS_BND = 1 * MiB + 512 * 1024;
constexpr size_t WS_WGU1 = 2 * MiB, WS_WD1 = 13 * MiB, WS_WIN = 18 * MiB + 512 * 1024, WS_WG = 26 * MiB, WS_WA = 30 * MiB, WS_WB = 31 * MiB,
                 WS_WOUT = 32 * MiB, WS_WGU2 = 34 * MiB, WS_WD2 = 45 * MiB, WS_LBW = 50 * MiB + 512 * 1024, WS_LBA = WS_LBW + 65536, WS_LBG = WS_LBA + 65536;
constexpr size_t WS_XB = 51 * MiB;
constexpr size_t WS_ACT = 83 * MiB;
constexpr size_t WS_Q = 83 * MiB, WS_K = 99 * MiB, WS_V = 115 * MiB, WS_R = 131 * MiB, WS_KR = 147 * MiB, WS_VR = 163 * MiB;
constexpr size_t WS_Z = 179 * MiB;
constexpr size_t WS_WDEC = 203 * MiB;
constexpr size_t WS_GB = 235 * MiB;
constexpr size_t WS_KK = WS_K, WS_BB = WS_V;
constexpr size_t WS_YRAW = WS_Z;
constexpr size_t WS_YB = WS_R;
constexpr size_t WS_SGA = 99 * MiB, WS_SGB = 203 * MiB;
constexpr size_t WS_MRG = 147 * MiB;
constexpr size_t WS_AQ = 2 * MiB;
constexpr size_t WS_BKQ = 99 * MiB;
constexpr size_t WS_RQ = 203 * MiB;
constexpr size_t WS_PC = 227 * MiB;
constexpr size_t WS_SSQ2 = 251 * MiB, WS_SSQ3 = 252 * MiB, WS_SSQ4 = 253 * MiB;
constexpr size_t WS_END = 256 * MiB;

__device__ __forceinline__ unsigned f2bf(float f) { unsigned u = __builtin_bit_cast(unsigned, f); return (u + 0x7fffu + ((u >> 16) & 1u)) >> 16; }
__device__ __forceinline__ unsigned pk2(float lo, float hi) { return f2bf(lo) | (f2bf(hi) << 16); }
__device__ __forceinline__ float bflo(unsigned w) { return __builtin_bit_cast(float, w << 16); }
__device__ __forceinline__ float bfhi(unsigned w) { return __builtin_bit_cast(float, w & 0xffff0000u); }
__device__ __forceinline__ float bf2f(bf16 h) { return __builtin_bit_cast(float, (unsigned)h << 16); }
__device__ __forceinline__ float fast_exp2(float x) { return __builtin_amdgcn_exp2f(x); }
__device__ __forceinline__ float fast_rcp(float x) { return __builtin_amdgcn_rcpf(x); }
__device__ __forceinline__ float sigmoidf_(float x) { return fast_rcp(1.0f + fast_exp2(-x * LOG2E)); }
#define LDS_WAIT() asm volatile("s_waitcnt lgkmcnt(0)" ::: "memory")
#define VM_WAIT() asm volatile("s_waitcnt vmcnt(0)" ::: "memory")

namespace pg8 {
#define PG8_LAS __attribute__((address_space(3)))
typedef unsigned short bf16_t;
constexpr int BM = 256, BK = 64, HALF = 128, HTB = HALF * BK * 2, STAGE_BYTES = 8 * HTB, NXCD = 8, WGM = 8;
__host__ __device__ __forceinline__ int lds_byte(int r, int c) { const int st = (r >> 4) * 2 + (c >> 5), rr = r & 15, cc = c & 31, ob = rr * 64 + cc * 2; return st * 1024 + (ob ^ (((ob >> 9) & 1) << 5)); }
__host__ __device__ __forceinline__ void stage_rc(int b, int& R, int& C) { const int st = b / 1024, sb = b % 1024, swz = sb ^ (((sb >> 9) & 1) << 5); R = (st >> 1) * 16 + swz / 64; C = (st & 1) * 32 + (swz % 64) / 2; }
__host__ __device__ __forceinline__ int perm32(int rho) { const int n = rho >> 4, i = rho & 15; return 8 * (i >> 2) + 4 * n + (i & 3); }
struct Unit { int pm, pn; };
struct Gemm { const bf16_t* A; const bf16_t* Bt; int M, N, K; };
struct StaticOrder {
    int nM, nN, nwg, G, c;
    __host__ __device__ void init(int M_, int N_, int G_, int c_) { nM = M_ / BM; nN = N_ / BM; nwg = nM * nN; G = G_; c = c_; }
    __host__ __device__ bool next(int i, Unit& u) const {
        const long L = (long)i * G + c; if (L >= nwg) return false;
        int wgid = (int)L; { const int q = nwg / NXCD, r = nwg % NXCD, xcd = wgid % NXCD, off = wgid / NXCD; wgid = (xcd < r ? xcd * (q + 1) : r * (q + 1) + (xcd - r) * q) + off; }
        const int nig = WGM * nN, gid = wgid / nig, fm = gid * WGM, gsz = (nM - fm) < WGM ? (nM - fm) : WGM;
        u.pm = fm + ((wgid % nig) % gsz); u.pn = (wgid % nig) / gsz; return true;
    }
    __device__ __forceinline__ void a_ready(const Unit&) const {}
    __device__ __forceinline__ void done(const Unit&) const {}
};
typedef __bf16 bf16x2_t __attribute__((ext_vector_type(2)));
__device__ __forceinline__ unsigned cvt_pk_bf16(float lo, float hi) { const f32x2 v = {lo, hi}; const bf16x2_t b = __builtin_convertvector(v, bf16x2_t); return __builtin_bit_cast(unsigned, b); }


template <int NP> __device__ __forceinline__ float row_ssq(const float* p, int row) {
    if (NP == 1) return p[row];
    const f32x4* q = (const f32x4*)(p + (size_t)row * 16); const f32x4 a = q[0], b = q[1], c = q[2], d = q[3];
    return (((a[0] + a[1]) + (a[2] + a[3])) + ((b[0] + b[1]) + (b[2] + b[3]))) + (((c[0] + c[1]) + (c[2] + c[3])) + ((d[0] + d[1]) + (d[2] + d[3])));
}
template <int NP> struct EpiSwiGLU {
    static constexpr bool PERM = true, AFTER_DRAIN = false;
    bf16_t* O; int ldc; const float* ssq;
    __device__ __forceinline__ void operator()(const f32x4 (&acc)[2][2][4][2], const Unit& u, int wr, int wc, int fr, int fq) const {
        const int row0 = u.pm * BM + wr * 64 + fr, col0 = u.pn * 128 + wc * 32 + 8 * fq;
#pragma unroll
        for (int ai = 0; ai < 2; ++ai)
#pragma unroll
            for (int m = 0; m < 4; ++m) {
                const int row = row0 + ai * HALF + m * 16;
                const float rs = 1.0f / sqrtf(row_ssq<NP>(ssq, row) * (1.0f / D) + RMS_EPS);
                float o[8];
#pragma unroll
                for (int n = 0; n < 2; ++n)
#pragma unroll
                    for (int i = 0; i < 4; ++i) { const float g = acc[ai][0][m][n][i] * rs, up = acc[ai][1][m][n][i] * rs; o[n * 4 + i] = g * sigmoidf_(g) * up; }
                u32x4 w; w.x = cvt_pk_bf16(o[0], o[1]); w.y = cvt_pk_bf16(o[2], o[3]); w.z = cvt_pk_bf16(o[4], o[5]); w.w = cvt_pk_bf16(o[6], o[7]);
                *(u32x4*)(O + (size_t)row * ldc + col0) = w;
            }
    }
};
struct EpiResid {
    static constexpr bool PERM = false, AFTER_DRAIN = false;
    const float* xin; float* xout; bf16_t* xb; float* ssq; float alpha;
    __device__ __forceinline__ void operator()(const f32x4 (&acc)[2][2][4][2], const Unit& u, int wr, int wc, int fr, int fq) const {
        const int row0 = u.pm * BM + wr * 64 + fr, col0 = u.pn * BM + wc * 32 + 4 * fq;
#pragma unroll
        for (int ai = 0; ai < 2; ++ai)
#pragma unroll
            for (int m = 0; m < 4; ++m) {
                const int row = row0 + ai * HALF + m * 16; const size_t off = (size_t)row * D + col0; float s = 0.f;
#pragma unroll
                for (int bj = 0; bj < 2; ++bj)
#pragma unroll
                    for (int n = 0; n < 2; ++n) {
                        const f32x4 v = *(const f32x4*)(xin + off + bj * HALF + n * 16) + acc[ai][bj][m][n] * alpha;
                        *(f32x4*)(xout + off + bj * HALF + n * 16) = v;
                        s += (v[0] * v[0] + v[1] * v[1]) + (v[2] * v[2] + v[3] * v[3]);
                        if (xb) { u32x2 w; w.x = cvt_pk_bf16(v[0], v[1]); w.y = cvt_pk_bf16(v[2], v[3]); *(u32x2*)(xb + off + bj * HALF + n * 16) = w; }
                    }
                s += __shfl_xor(s, 16); s += __shfl_xor(s, 32);
                if (fq == 0 && ssq) ssq[(size_t)row * 16 + u.pn * 4 + wc] = s;
                asm volatile("" ::: "memory");
            }
    }
};
struct EpiProj {
    static constexpr bool PERM = true, AFTER_DRAIN = false;
    bf16_t* arr0; bf16_t* zbuf; const float* ssq; float* kmean; bf16_t* bnd;
    __device__ __forceinline__ void operator()(const f32x4 (&acc)[2][2][4][2], const Unit& u, int wr, int wc, int fr, int fq) const {
        const int pn = u.pn; const int row0 = u.pm * BM + wr * 64 + fr;
        bf16_t* dst; int pitch, colt;
        if (pn < 12) { dst = arr0 + (size_t)(pn >> 1) * ((size_t)M * 512); pitch = 512; colt = (pn & 1) * 256; } else { dst = zbuf; pitch = ZP; colt = (pn - 12) * 256; }
        const float sc = (pn < 2) ? C2 : 1.0f; const int col0 = colt + wc * 32 + 8 * fq;
        const bool is_k = (pn == 2 || pn == 3), is_rkv = (pn >= 6 && pn < 12);
        float cs[2][8];
#pragma unroll
        for (int bj = 0; bj < 2; ++bj)
#pragma unroll
            for (int i = 0; i < 8; ++i) cs[bj][i] = 0.f;
#pragma unroll
        for (int ai = 0; ai < 2; ++ai)
#pragma unroll
            for (int m = 0; m < 4; ++m) {
                const int row = row0 + ai * HALF + m * 16;
                const float rs = sc / sqrtf(row_ssq<16>(ssq, row) * (1.0f / D) + RMS_EPS);
#pragma unroll
                for (int bj = 0; bj < 2; ++bj) {
                    float o[8];
#pragma unroll
                    for (int n = 0; n < 2; ++n)
#pragma unroll
                        for (int i = 0; i < 4; ++i) { o[n * 4 + i] = acc[ai][bj][m][n][i] * rs; cs[bj][n * 4 + i] += o[n * 4 + i]; }
                    u32x4 w; w.x = cvt_pk_bf16(o[0], o[1]); w.y = cvt_pk_bf16(o[2], o[3]); w.z = cvt_pk_bf16(o[4], o[5]); w.w = cvt_pk_bf16(o[6], o[7]);
                    *(u32x4*)(dst + (size_t)row * pitch + col0 + bj * HALF) = w;
                    if (is_rkv && ai == 1 && m == 3 && wr == 1 && fr == 15) *(u32x4*)(bnd + (size_t)u.pm * 1536 + (pn - 6) * 256 + wc * 32 + 8 * fq + bj * HALF) = w;
                }
            }
        if (is_k) {
#pragma unroll
            for (int bj = 0; bj < 2; ++bj)
#pragma unroll
                for (int i = 0; i < 8; ++i) { float v = cs[bj][i]; v += __shfl_xor(v, 1); v += __shfl_xor(v, 2); v += __shfl_xor(v, 4); v += __shfl_xor(v, 8);
                    if (fr == 0) { const int col = (pn - 2) * 256 + bj * HALF + wc * 32 + 8 * fq + i; atomicAdd(kmean + ((size_t)((u.pm >> 4) * NH + (col >> 6)) * 16 + (u.pm & 15)) * 64 + (col & 63), v); } }
        }
    }
};
template <int MODE> struct EpiGate {
    static constexpr bool PERM = true, AFTER_DRAIN = false;
    bf16_t* out; const bf16_t* gate; bf16_t* out2; const float* ssq;
    __device__ __forceinline__ void operator()(const f32x4 (&acc)[2][2][4][2], const Unit& u, int wr, int wc, int fr, int fq) const {
        const int row0 = u.pm * BM + wr * 64 + fr; int pn = u.pn; bf16_t* dst = out;
        if (MODE == 0 && pn >= 4) { pn -= 4; dst = out2; }
        const int col0 = pn * BM + wc * 32 + 8 * fq;
#pragma unroll
        for (int ai = 0; ai < 2; ++ai)
#pragma unroll
            for (int m = 0; m < 4; ++m) {
                const int row = row0 + ai * HALF + m * 16;
                float rs = 1.0f; if (MODE == 0) rs = 1.0f / sqrtf(row_ssq<16>(ssq, row) * (1.0f / D) + RMS_EPS);
#pragma unroll
                for (int bj = 0; bj < 2; ++bj) {
                    const size_t off = (size_t)row * D + col0 + bj * HALF; float o[8];
#pragma unroll
                    for (int n = 0; n < 2; ++n)
#pragma unroll
                        for (int i = 0; i < 4; ++i) o[n * 4 + i] = acc[ai][bj][m][n][i];
                    if (MODE == 0) {
#pragma unroll
                        for (int i = 0; i < 8; ++i) o[i] = sigmoidf_(o[i] * rs);
                    } else {
                        const u32x4 g = *(const u32x4*)(gate + off);
                        o[0] *= bflo(g.x); o[1] *= bfhi(g.x); o[2] *= bflo(g.y); o[3] *= bfhi(g.y); o[4] *= bflo(g.z); o[5] *= bfhi(g.z); o[6] *= bflo(g.w); o[7] *= bfhi(g.w);
                        if (MODE == 2) { const u32x4 p = *(const u32x4*)(dst + off);
                            o[0] += bflo(p.x); o[1] += bfhi(p.x); o[2] += bflo(p.y); o[3] += bfhi(p.y); o[4] += bflo(p.z); o[5] += bfhi(p.z); o[6] += bflo(p.w); o[7] += bfhi(p.w); }
                    }
                    u32x4 w; w.x = cvt_pk_bf16(o[0], o[1]); w.y = cvt_pk_bf16(o[2], o[3]); w.z = cvt_pk_bf16(o[4], o[5]); w.w = cvt_pk_bf16(o[6], o[7]);
                    *(u32x4*)(dst + off) = w;
                }
            }
    }
};

template <class Epi, class Sched, bool ALIGN_EPI = false, bool SP2 = false>
__device__ __forceinline__ void gemm_phase(PG8_LAS unsigned char* lds, const Gemm g, const Sched& S, const Epi& E) {
    const int tid = threadIdx.x, wid = __builtin_amdgcn_readfirstlane(tid >> 6), lane = tid & 63, wr = wid >> 2, wc = wid & 3, fr = lane & 15, fq = lane >> 4;
    const int K = g.K, nt = K / BK;
    unsigned voffA[2], voffB[2];
#pragma unroll
    for (int i = 0; i < 2; ++i) { int R, C; stage_rc(tid * 16 + i * 8192, R, C); const int Rb = Epi::PERM ? ((R & ~31) + perm32(R & 31)) : R;
        voffA[i] = (unsigned)(R * K + C) * 2u; voffB[i] = (unsigned)(Rb * K + C) * 2u; }
    const size_t kstep = (size_t)(BK * 2);
    const size_t hstep = (size_t)HALF * K * 2;
    const size_t tstep = 2 * hstep;
    const unsigned ldsw = (unsigned)wid * 1024u;
    const int aoff = lds_byte(wr * 64 + fr, fq * 8), boff = lds_byte(wc * 32 + fr, fq * 8);
#define PG8_SA(b, h) (((b) * 2 + (h)) * HTB)
#define PG8_SB(b, h) ((4 + (b) * 2 + (h)) * HTB)
#define PG8_STAGE(bufoff, gbase, voff) do { _Pragma("unroll") for (int _i = 0; _i < 2; ++_i) \
        __builtin_amdgcn_global_load_lds((const unsigned*)((const char*)(gbase) + (voff)[_i]), (PG8_LAS unsigned*)(lds + (bufoff) + ldsw + _i * 8192), 16, 0, 0); } while (0)
#define PG8_LDA(dst, b, h) do { _Pragma("unroll") for (int m = 0; m < 4; ++m) _Pragma("unroll") for (int k = 0; k < 2; ++k) dst[m][k] = *(const PG8_LAS bf16x8*)(lds + PG8_SA(b, h) + aoff + m * 2048 + k * 1024); } while (0)
#define PG8_LDB(dst, b, h) do { _Pragma("unroll") for (int n = 0; n < 2; ++n) _Pragma("unroll") for (int k = 0; k < 2; ++k) dst[n][k] = *(const PG8_LAS bf16x8*)(lds + PG8_SB(b, h) + boff + n * 2048 + k * 1024); } while (0)
#define PG8_MMA(ai, bj, At, Bt) do { __builtin_amdgcn_s_setprio(1); _Pragma("unroll") for (int m = 0; m < 4; ++m) _Pragma("unroll") for (int n = 0; n < 2; ++n) _Pragma("unroll") for (int k = 0; k < 2; ++k) \
        acc[ai][bj][m][n] = __builtin_amdgcn_mfma_f32_16x16x32_bf16(Bt[n][k], At[m][k], acc[ai][bj][m][n], 0, 0, 0); __builtin_amdgcn_s_setprio(0); } while (0)
#define PG8_WAIT_V(n) asm volatile("s_waitcnt vmcnt(" #n ")" ::: "memory")
#define PG8_WAIT_L(n) asm volatile("s_waitcnt lgkmcnt(" #n ")" ::: "memory")
#define PG8_BAR __builtin_amdgcn_s_barrier()
#define PG8_SCHED __builtin_amdgcn_sched_barrier(0)
    Unit cur, nxt; int ui = 0;
    if (!S.next(0, cur)) return;
    f32x4 acc[2][2][4][2];
#pragma unroll
    for (int a = 0; a < 2; ++a)
#pragma unroll
        for (int b = 0; b < 2; ++b)
#pragma unroll
            for (int m = 0; m < 4; ++m)
#pragma unroll
                for (int n = 0; n < 2; ++n) acc[a][b][m][n] = (f32x4){0.f, 0.f, 0.f, 0.f};
    bf16x8 At[4][2], B0[2][2], B1[2][2];
    const char* cA = (const char*)g.A + (size_t)cur.pm * tstep; const char* cB = (const char*)g.Bt + (size_t)cur.pn * tstep;
    S.a_ready(cur);
    if constexpr (SP2) {
        PG8_STAGE(PG8_SB(0, 0), cB, voffB); PG8_STAGE(PG8_SB(0, 1), cB + hstep, voffB); PG8_STAGE(PG8_SA(0, 0), cA, voffA); PG8_STAGE(PG8_SA(0, 1), cA + hstep, voffA);
        if (wr == 1) PG8_BAR;
        PG8_WAIT_V(2); PG8_BAR;
        PG8_STAGE(PG8_SB(1, 0), cB + kstep, voffB); PG8_STAGE(PG8_SA(1, 0), cA + kstep, voffA); PG8_STAGE(PG8_SB(1, 1), cB + hstep + kstep, voffB);
        PG8_WAIT_V(6); PG8_BAR;
    } else {
        PG8_STAGE(PG8_SB(0, 0), cB, voffB); PG8_STAGE(PG8_SA(0, 0), cA, voffA); PG8_STAGE(PG8_SB(0, 1), cB + hstep, voffB); PG8_STAGE(PG8_SA(0, 1), cA + hstep, voffA);
        if (wr == 1) PG8_BAR;
        PG8_WAIT_V(4); PG8_BAR;
        PG8_STAGE(PG8_SB(1, 0), cB + kstep, voffB); PG8_STAGE(PG8_SA(1, 0), cA + kstep, voffA); PG8_STAGE(PG8_SB(1, 1), cB + hstep + kstep, voffB);
        PG8_WAIT_V(6); PG8_BAR;
    }
    for (;;) {
        const bool has_next = S.next(ui + 1, nxt);
        const char* nA = has_next ? (const char*)g.A + (size_t)nxt.pm * tstep : cA; const char* nB = has_next ? (const char*)g.Bt + (size_t)nxt.pn * tstep : cB;
        for (int t = 0; t < nt; t += 2) {
            const bool last = (t == nt - 2);
            const char* a1 = cA + (size_t)(t + 1) * kstep;
            const char* a2 = last ? nA : cA + (size_t)(t + 2) * kstep; const char* b2 = last ? nB : cB + (size_t)(t + 2) * kstep;
            const char* a3 = a2 + kstep; const char* b3 = b2 + kstep;
            if (last && has_next) S.a_ready(nxt);
            if constexpr (SP2) {
            PG8_LDB(B0, 0, 0); PG8_LDB(B1, 0, 1); PG8_SCHED; PG8_LDA(At, 0, 0); PG8_STAGE(PG8_SA(1, 1), a1 + hstep, voffA);
            PG8_WAIT_V(8); PG8_WAIT_L(0); PG8_BAR; PG8_MMA(0, 0, At, B0); PG8_MMA(0, 1, At, B1); PG8_BAR; PG8_SCHED;
            PG8_LDA(At, 0, 1); PG8_STAGE(PG8_SB(0, 0), b2, voffB); PG8_STAGE(PG8_SB(0, 1), b2 + hstep, voffB); PG8_STAGE(PG8_SA(0, 0), a2, voffA);
            PG8_WAIT_V(8); PG8_WAIT_L(0); PG8_BAR; PG8_MMA(1, 0, At, B0); PG8_MMA(1, 1, At, B1); PG8_BAR; PG8_SCHED;
            PG8_LDB(B0, 1, 0); PG8_LDB(B1, 1, 1); PG8_SCHED; PG8_LDA(At, 1, 0); PG8_STAGE(PG8_SA(0, 1), a2 + hstep, voffA);
            PG8_WAIT_V(8); PG8_WAIT_L(0); PG8_BAR; PG8_MMA(0, 0, At, B0); PG8_MMA(0, 1, At, B1); PG8_BAR; PG8_SCHED;
            PG8_LDA(At, 1, 1); PG8_STAGE(PG8_SB(1, 0), b3, voffB); PG8_STAGE(PG8_SB(1, 1), b3 + hstep, voffB); PG8_STAGE(PG8_SA(1, 0), a3, voffA);
            PG8_WAIT_V(8); PG8_WAIT_L(0); PG8_BAR; PG8_MMA(1, 0, At, B0); PG8_MMA(1, 1, At, B1); PG8_BAR; PG8_SCHED;
            } else {
            PG8_LDB(B0, 0, 0); PG8_SCHED; PG8_LDA(At, 0, 0); PG8_STAGE(PG8_SA(1, 1), a1 + hstep, voffA);
            PG8_WAIT_L(8); PG8_BAR; PG8_WAIT_L(0); PG8_MMA(0, 0, At, B0); PG8_BAR; PG8_SCHED;
            PG8_LDB(B1, 0, 1); PG8_STAGE(PG8_SB(0, 0), b2, voffB);
            PG8_BAR; PG8_WAIT_L(0); PG8_MMA(0, 1, At, B1); PG8_BAR;
            PG8_LDA(At, 0, 1); PG8_STAGE(PG8_SA(0, 0), a2, voffA);
            PG8_BAR; PG8_WAIT_L(0); PG8_MMA(1, 0, At, B0); PG8_BAR; PG8_SCHED;
            PG8_STAGE(PG8_SB(0, 1), b2 + hstep, voffB);
            PG8_WAIT_V(6); PG8_BAR; PG8_MMA(1, 1, At, B1); PG8_BAR;
            PG8_LDB(B0, 1, 0); PG8_SCHED; PG8_LDA(At, 1, 0); PG8_STAGE(PG8_SA(0, 1), a2 + hstep, voffA);
            PG8_WAIT_L(8); PG8_BAR; PG8_WAIT_L(0); PG8_MMA(0, 0, At, B0); PG8_BAR; PG8_SCHED;
            PG8_LDB(B1, 1, 1); PG8_STAGE(PG8_SB(1, 0), b3, voffB);
            PG8_BAR; PG8_WAIT_L(0); PG8_MMA(0, 1, At, B1); PG8_BAR;
            PG8_LDA(At, 1, 1); PG8_STAGE(PG8_SA(1, 0), a3, voffA);
            PG8_BAR; PG8_WAIT_L(0); PG8_MMA(1, 0, At, B0); PG8_BAR; PG8_SCHED;
            PG8_STAGE(PG8_SB(1, 1), b3 + hstep, voffB);
            PG8_WAIT_V(6); PG8_BAR; PG8_MMA(1, 1, At, B1); PG8_BAR;
            }
        }
        if constexpr (ALIGN_EPI) { if (wr == 0) PG8_BAR; }
        if constexpr (!Epi::AFTER_DRAIN) { E(acc, cur, wr, wc, fr, fq); S.done(cur); }
        if (!has_next) break;
#pragma unroll
        for (int a = 0; a < 2; ++a)
#pragma unroll
            for (int b = 0; b < 2; ++b)
#pragma unroll
                for (int m = 0; m < 4; ++m)
#pragma unroll
                    for (int n = 0; n < 2; ++n) acc[a][b][m][n] = (f32x4){0.f, 0.f, 0.f, 0.f};
        cur = nxt; cA = nA; cB = nB; ++ui;
        if constexpr (ALIGN_EPI) { if (wr == 1) PG8_BAR; }
    }
    PG8_WAIT_V(0);
    if constexpr (!ALIGN_EPI) { if (wr == 0) PG8_BAR; }
    PG8_BAR;
#undef PG8_SA
#undef PG8_SB
#undef PG8_STAGE
#undef PG8_LDA
#undef PG8_LDB
#undef PG8_MMA
#undef PG8_WAIT_V
#undef PG8_WAIT_L
#undef PG8_BAR
#undef PG8_SCHED
}
}

#define XB_TMO      128
#define XB_XCNT(j)  (256  + 64 * (j))
#define XB_XSUB(j)  (1280 + 64 * (j))
#define XB_XGEN(j)  (2304 + 64 * (j))
#define XB_TOP      3328
#define XB_TOPGEN   3392
#define XCD_BAR_WORDS 3456
#define XB_SPIN_CAP (1u << 18)
__device__ __forceinline__ unsigned xb_ld(unsigned* p)              { return __hip_atomic_load(p, __ATOMIC_RELAXED, __HIP_MEMORY_SCOPE_AGENT); }
__device__ __forceinline__ unsigned xb_add(unsigned* p, unsigned v) { return __hip_atomic_fetch_add(p, v, __ATOMIC_RELAXED, __HIP_MEMORY_SCOPE_AGENT); }
__device__ __forceinline__ unsigned xb_xcc_id() { return (unsigned)__builtin_amdgcn_s_getreg((3 << 11) | 20) & 0xFu; }
#define XB_SPIN(cond, bar) do { unsigned _sp = 0; while (cond) { __builtin_amdgcn_s_sleep(1); \
    if ((++_sp & 255u) == 0u) { if (xb_ld(&(bar)[XB_TMO])) break; if (_sp > XB_SPIN_CAP) { atomicAdd(&(bar)[XB_TMO], 1u); break; } } } } while (0)
struct XcdBarrier { unsigned* bar; unsigned x; volatile LAS unsigned* st; };
__device__ __forceinline__ XcdBarrier xcd_barrier_post(unsigned* bar, volatile LAS unsigned* st) {
    XcdBarrier b; b.bar = bar; b.x = xb_xcc_id(); b.st = st;
    if (threadIdx.x == 0) (void)xb_add(&bar[XB_XCNT(b.x)], 1u);
    return b;
}
__device__ __forceinline__ void xcd_barrier_complete(unsigned* bar, unsigned x, unsigned& nloc, unsigned& nx) {
    const unsigned G = gridDim.x * gridDim.y * gridDim.z;
    unsigned sum, cnt, mine, sp = 0u;
    for (;;) {
        sum = 0u; cnt = 0u; mine = 0u;
#pragma unroll
        for (unsigned j = 0; j < 16; ++j) { const unsigned c = xb_ld(&bar[XB_XCNT(j)]); sum += c; cnt += (c > 0u) ? 1u : 0u; mine = (j == x) ? c : mine; }
        if (sum == G) break;
        __builtin_amdgcn_s_sleep(1);
        if ((++sp & 255u) == 0u) { if (xb_ld(&bar[XB_TMO])) break; if (sp > XB_SPIN_CAP) { atomicAdd(&bar[XB_TMO], 1u); break; } }
    }
    nloc = mine > 0u ? mine : 1u; nx = cnt > 0u ? cnt : 1u;
}
__device__ __forceinline__ void xcd_barrier(const XcdBarrier& b) {
    asm volatile("s_waitcnt vmcnt(0)" ::: "memory");
    __syncthreads();
    if (threadIdx.x == 0) {
        unsigned* bar = b.bar;
        __builtin_amdgcn_s_waitcnt(0);
        unsigned nloc = b.st[0], nx = b.st[1];
        if (nloc == 0u) { xcd_barrier_complete(bar, b.x, nloc, nx); b.st[0] = nloc; b.st[1] = nx; }
        const unsigned old = xb_add(&bar[XB_XSUB(b.x)], 1u);
        const unsigned gen = old / nloc;
        if (old + 1u == (gen + 1u) * nloc) {
            __builtin_amdgcn_fence(__ATOMIC_RELEASE, "agent");
            asm volatile("s_waitcnt vmcnt(0)" ::: "memory");
            const unsigned og = xb_add(&bar[XB_TOP], 1u);
            const unsigned tg = og / nx;
            if (og + 1u == (tg + 1u) * nx) xb_add(&bar[XB_TOPGEN], 1u);
            else XB_SPIN(xb_ld(&bar[XB_TOPGEN]) == tg, bar);
            __builtin_amdgcn_fence(__ATOMIC_ACQUIRE, "agent");
            xb_add(&bar[XB_XGEN(b.x)], 1u);
            asm volatile("s_waitcnt vmcnt(0)" ::: "memory");
        } else {
            XB_SPIN(xb_ld(&bar[XB_XGEN(b.x)]) == gen, bar);
            __builtin_amdgcn_fence(__ATOMIC_ACQUIRE, "agent");
            asm volatile("s_waitcnt vmcnt(0)" ::: "memory");
        }
    }
    __syncthreads();
}

constexpr int NWAVES = 8;
constexpr int RING_OFF = 0, RING_BYTES = 131072;
constexpr int LDSCTL_OFF = RING_BYTES, MISC_OFF = LDSCTL_OFF + 320;
constexpr int LDS_BYTES = 147456;

struct Frame {
    LAS unsigned char* lds; volatile LAS unsigned* MISC; unsigned* ctl;
    int tid, lane, wave, vcu, G;
    const float* const* in; float* out; unsigned char* ws;
};
enum { I_X = 0, I_RELB, I_NFFN1, I_F1G, I_F1U, I_F1D, I_NMIX, I_WIN, I_MIXRKV, I_MIXWAG, I_WLA, I_WLB, I_W0, I_ALA, I_ALB, I_A0, I_GLA, I_GLB, I_KK, I_KA, I_RKP, I_LNW, I_LNB,
       I_PA, I_PB, I_WOUT, I_NFFN2, I_F2G, I_F2U, I_F2D, I_NFIN };

__device__ __forceinline__ float wave_sum(float v) {
#pragma unroll
    for (int o = 1; o < 64; o <<= 1) v += __shfl_xor(v, o);
    return v;
}

__device__ __forceinline__ void tr_item(const float* W, int ldw, int c0, bf16* WT, int K, int drow0, int k0, const float* g, const float* mix, int mode, LAS float* scr, int lane) {
#pragma unroll 8
    for (int i = 0; i < 32; ++i) { const int kk = 2 * i + (lane >> 5), k = k0 + kk; float s = g ? g[k] : 1.0f; if (mode == 1) s *= (1.0f - mix[k]); else if (mode == 2) s *= mix[k];
        scr[kk * 33 + (lane & 31)] = W[(size_t)k * ldw + c0 + (lane & 31)] * s; }
    LDS_WAIT(); asm volatile("" ::: "memory");
    const int c = lane & 7;
#pragma unroll
    for (int j = 0; j < 4; ++j) { const int n = (lane >> 3) + 8 * j; const LAS float* s = scr + (8 * c) * 33 + n;
        u32x4 o; o.x = pk2(s[0 * 33], s[1 * 33]); o.y = pk2(s[2 * 33], s[3 * 33]); o.z = pk2(s[4 * 33], s[5 * 33]); o.w = pk2(s[6 * 33], s[7 * 33]);
        *(u32x4*)(WT + (size_t)(drow0 + n) * K + k0 + 8 * c) = o; }
    LDS_WAIT(); asm volatile("" ::: "memory");
}
__device__ __forceinline__ void gu_item(const float* Wg, const float* Wu, const float* g, bf16* WT, int r, LAS float* scr, int lane) {
    const int kb = r / 176, nb = r % 176, pn = nb >> 3, bj = (nb >> 2) & 1, o = nb & 3;
    tr_item(bj ? Wu : Wg, FF, 128 * pn + 32 * o, WT, D, 32 * nb, 64 * kb, g, nullptr, 0, scr, lane);
}
__device__ __forceinline__ void p0_prologue(Frame& F) {
    LAS float* scr = (LAS float*)(F.lds + RING_OFF + F.wave * 16384);
    const int gw = F.vcu * NWAVES + F.wave, NGW = F.G * NWAVES;
    unsigned char* ws = F.ws;
    constexpr int J0 = 16 * 176, J1 = 44 * 32, J2 = 16 * 96, J3 = 16 * 18, J4 = 16 * 64, J5 = 8 * 32, J6 = 8 * 32, J7 = 16 * 32, J8 = J0, J9 = J1;
    constexpr int NITEMS = J0 + J1 + J2 + J3 + J4 + J5 + J6 + J7 + J8 + J9;
    for (int it = gw; it < NITEMS; it += NGW) {
        int r = it;
        if (r < J0) { gu_item(F.in[I_F1G], F.in[I_F1U], F.in[I_NFFN1], (bf16*)(ws + WS_WGU1), r, scr, F.lane); continue; } r -= J0;
        if (r < J1) { const int kb = r / 32, nb = r % 32; tr_item(F.in[I_F1D], D, 32 * nb, (bf16*)(ws + WS_WD1), FF, 32 * nb, 64 * kb, nullptr, nullptr, 0, scr, F.lane); continue; } r -= J1;
        if (r < J2) { const int kb = r / 96, nb = r % 96; tr_item(F.in[I_WIN], 5120, 32 * nb, (bf16*)(ws + WS_WIN), D, 32 * nb, 64 * kb, F.in[I_NMIX], nullptr, 0, scr, F.lane); continue; } r -= J2;
        if (r < J3) { const int kb = r / 18, nb = r % 18, md = nb < 9 ? 1 : 2, n9 = nb % 9;
            const float* W; int ldw, c0; const float* mix;
            if (n9 < 2) { W = F.in[I_WLA]; ldw = 64; c0 = 32 * n9; mix = F.in[I_MIXWAG]; }
            else if (n9 < 4) { W = F.in[I_ALA]; ldw = 64; c0 = 32 * (n9 - 2); mix = F.in[I_MIXWAG] + D; }
            else { W = F.in[I_GLA]; ldw = 160; c0 = 32 * (n9 - 4); mix = F.in[I_MIXWAG] + 2 * D; }
            tr_item(W, ldw, c0, (bf16*)(ws + WS_WIN), D, 3072 + 32 * nb, 64 * kb, F.in[I_NMIX], mix, md, scr, F.lane); continue; } r -= J3;
        if (r < J4) { const int kb = r / 64, nb = r % 64; tr_item(F.in[I_WIN], 5120, 3072 + 32 * nb, (bf16*)(ws + WS_WG), D, 32 * nb, 64 * kb, F.in[I_NMIX], nullptr, 0, scr, F.lane); continue; } r -= J4;
        if (r < J5) { const int kb = r / 32, nb = r % 32; tr_item(F.in[I_PA], D, 32 * nb, (bf16*)(ws + WS_WA), 512, 32 * nb, 64 * kb, nullptr, nullptr, 0, scr, F.lane); continue; } r -= J5;
        if (r < J6) { const int kb = r / 32, nb = r % 32; tr_item(F.in[I_PB], D, 32 * nb, (bf16*)(ws + WS_WB), 512, 32 * nb, 64 * kb, nullptr, nullptr, 0, scr, F.lane); continue; } r -= J6;
        if (r < J7) { const int kb = r / 32, nb = r % 32; tr_item(F.in[I_WOUT], D, 32 * nb, (bf16*)(ws + WS_WOUT), D, 32 * nb, 64 * kb, nullptr, nullptr, 0, scr, F.lane); continue; } r -= J7;
        if (r < J8) { gu_item(F.in[I_F2G], F.in[I_F2U], F.in[I_NFFN2], (bf16*)(ws + WS_WGU2), r, scr, F.lane); continue; } r -= J8;
        { const int kb = r / 32, nb = r % 32; tr_item(F.in[I_F2D], D, 32 * nb, (bf16*)(ws + WS_WD2), FF, 32 * nb, 64 * kb, nullptr, nullptr, 0, scr, F.lane); }
    }
    const int gt = F.vcu * 512 + F.tid, NGT = F.G * 512;
    { u32x4* z = (u32x4*)(ws + WS_WIN + (size_t)3648 * D * 2); for (int i = gt; i < 192 * D * 2 / 16; i += NGT) z[i] = (u32x4){0u, 0u, 0u, 0u}; }
    { bf16* lw = (bf16*)(ws + WS_LBW); bf16* la = (bf16*)(ws + WS_LBA); bf16* lg = (bf16*)(ws + WS_LBG);
      for (int i = gt; i < 512 * 64; i += NGT) { const int n = i >> 6, k = i & 63; lw[i] = (bf16)f2bf(F.in[I_WLB][k * 512 + n]); la[i] = (bf16)f2bf(F.in[I_ALB][k * 512 + n]); }
      for (int i = gt; i < 512 * 160; i += NGT) { const int n = i / 160, k = i % 160; lg[i] = (bf16)f2bf(F.in[I_GLB][k * 512 + n]); } }
    { const float* x = F.in[I_X]; bf16* xb = (bf16*)(ws + WS_XB); float* ssq = (float*)(ws + OFF_SSQ1);
      for (int m = gw; m < M; m += NGW) {
          const f32x4* xr = (const f32x4*)(x + (size_t)m * D) + F.lane; f32x4 v[4]; float s = 0.f;
#pragma unroll
          for (int j = 0; j < 4; ++j) { v[j] = xr[64 * j]; s += (v[j].x * v[j].x + v[j].y * v[j].y) + (v[j].z * v[j].z + v[j].w * v[j].w); }
          s = wave_sum(s); if (F.lane == 0) ssq[m] = s;
          unsigned long long* o8 = (unsigned long long*)(xb + (size_t)m * D) + F.lane;
#pragma unroll
          for (int j = 0; j < 4; ++j) o8[64 * j] = (unsigned long long)pk2(v[j].x, v[j].y) | ((unsigned long long)pk2(v[j].z, v[j].w) << 32);
      } }
}

__device__ __forceinline__ int t5_bucket(int n) {
    if (n < 16) return n < 0 ? 0 : n;
    int b = 16;
    b += (n >= 21); b += (n >= 27); b += (n >= 35); b += (n >= 46); b += (n >= 59); b += (n >= 77); b += (n >= 99); b += (n >= 128);
    b += (n >= 166); b += (n >= 216); b += (n >= 280); b += (n >= 363); b += (n >= 470); b += (n >= 609); b += (n >= 790);
    return b;
}

namespace attn_body {
typedef unsigned short bf16;
using bf16x8=__attribute__((ext_vector_type(8)))short;
using s16x4=__attribute__((ext_vector_type(4)))short;
using f32x16=__attribute__((ext_vector_type(16)))float;
using u32x4=__attribute__((ext_vector_type(4)))unsigned;
constexpr int BATCH=4,NHEAD=8,SEQ=4096,D=64,DM=NHEAD*D;
constexpr int NW=8,QBLK=32,QB=QBLK*NW,KVBLK=64,NQB=SEQ/QB;
constexpr int ATTN_PITCH=DM, ATTN_UNIT_ROWS=QB;
__device__ __forceinline__ int crow(int r,int hi){return (r&3)+8*(r>>2)+4*hi;}
#define SBAR() __builtin_amdgcn_sched_barrier(0)
typedef __attribute__((address_space(3))) float* lds_fptr;
typedef float f32x4_t __attribute__((ext_vector_type(4)));
__device__ __forceinline__ void cmask(f32x16&p0,f32x16&p1,int jb,int qrel,int hi){
  const float NEG=-INFINITY; int kb=64*jb+4*hi;
  #pragma unroll
  for(int r=0;r<16;++r){int kv=kb+(r&3)+8*(r>>2); if(kv>qrel)p0[r]=NEG; if(kv+32>qrel)p1[r]=NEG;}
}

constexpr int NSLOT=3, SLOTB=8192;
constexpr int LDS_K=0, LDS_V=NSLOT*SLOTB, LDS_WS=2*NSLOT*SLOTB, LDS_OST=LDS_WS+NW*64*4, LDS_RT=LDS_OST+NW*4096,LDS_KM=LDS_RT+1152*4,LDS_BYTES=LDS_KM+15*64*4;
constexpr float C2=0.125f*1.4426950408889634f, L2E=1.4426950408889634f;
__device__ __forceinline__ void glds16(const void*gsrc,unsigned lds_dst){unsigned keep;
  asm volatile("s_mov_b32 %0, m0\n\ts_mov_b32 m0, %2\n\ts_nop 0\n\tglobal_load_lds_dwordx4 %1, off\n\ts_mov_b32 m0, %0":"=&s"(keep):"v"(gsrc),"s"(lds_dst):"memory");}
__device__ __forceinline__ float max3f(float a,float b,float c){float r;asm("v_max3_f32 %0, %1, %2, %3":"=v"(r):"v"(a),"v"(b),"v"(c));return r;}
__device__ __forceinline__ float max2f(float a,float b){float r;asm("v_max_f32_e32 %0, %1, %2":"=v"(r):"v"(a),"v"(b));return r;}
__device__ __forceinline__ float fadd_s(float a,float b){float r;asm("v_add_f32_e32 %0, %1, %2":"=v"(r):"v"(a),"v"(b));return r;}
__device__ __forceinline__ float fsub_s(float a,float b){float r;asm("v_sub_f32_e32 %0, %1, %2":"=v"(r):"v"(a),"v"(b));return r;}
typedef float f32x2_t __attribute__((ext_vector_type(2))); typedef __bf16 bf16x2_t __attribute__((ext_vector_type(2)));
__device__ __forceinline__ unsigned cvtpk_s(float lo,float hi){f32x2_t v={lo,hi};bf16x2_t b=__builtin_convertvector(v,bf16x2_t);return __builtin_bit_cast(unsigned,b);}
#define WAIT_BAR(N) asm volatile("s_waitcnt vmcnt(" #N ") lgkmcnt(0)\n\ts_barrier":::"memory")

__device__ __forceinline__ void qkt(f32x16&p0,f32x16&p1,const char*Kslot,const bf16x8*qr,const f32x16&negm,int r32,int hi){
  const char*kb=Kslot+hi*1024+r32*16;
  #pragma unroll
  for(int d0=0;d0<4;++d0){
    const bf16x8 b0=*reinterpret_cast<const bf16x8*>(kb+d0*2048);
    const bf16x8 b1=*reinterpret_cast<const bf16x8*>(kb+d0*2048+512);
    if(d0==0){p0=__builtin_amdgcn_mfma_f32_32x32x16_bf16(b0,qr[0],negm,0,0,0);p1=__builtin_amdgcn_mfma_f32_32x32x16_bf16(b1,qr[0],negm,0,0,0);}
    else{p0=__builtin_amdgcn_mfma_f32_32x32x16_bf16(b0,qr[d0],p0,0,0,0);p1=__builtin_amdgcn_mfma_f32_32x32x16_bf16(b1,qr[d0],p1,0,0,0);}}
}
typedef __attribute__((address_space(3))) const char* lds_cptr;
typedef short v4i16_t __attribute__((ext_vector_type(4)));
__device__ __forceinline__ void kload8(bf16x8*kf,lds_cptr kp){
  kf[0]=*(const __attribute__((address_space(3))) bf16x8*)(kp);      kf[1]=*(const __attribute__((address_space(3))) bf16x8*)(kp+512);
  kf[2]=*(const __attribute__((address_space(3))) bf16x8*)(kp+2048); kf[3]=*(const __attribute__((address_space(3))) bf16x8*)(kp+2560);
  kf[4]=*(const __attribute__((address_space(3))) bf16x8*)(kp+4096); kf[5]=*(const __attribute__((address_space(3))) bf16x8*)(kp+4608);
  kf[6]=*(const __attribute__((address_space(3))) bf16x8*)(kp+6144); kf[7]=*(const __attribute__((address_space(3))) bf16x8*)(kp+6656);
}
__device__ __forceinline__ void kload2(bf16x8*kf,lds_cptr kp,int j){ kf[2*j]=*(const __attribute__((address_space(3))) bf16x8*)(kp+j*2048); kf[2*j+1]=*(const __attribute__((address_space(3))) bf16x8*)(kp+j*2048+512); }
__device__ __forceinline__ s16x4 vtr(lds_cptr p){ return __builtin_bit_cast(s16x4,__builtin_amdgcn_ds_read_tr16_b64_v4i16((__attribute__((address_space(3))) v4i16_t*)p)); }
__device__ __forceinline__ float rowmax(const f32x16&p0,const f32x16&p1){
  float a=max3f(p0[0],p0[1],p1[0]),b=max3f(p0[2],p0[3],p1[1]);a=max3f(a,p1[2],p1[3]);
  #pragma unroll
  for(int r=4;r<16;r+=4){a=max3f(a,p0[r],p0[r+1]);b=max3f(b,p0[r+2],p0[r+3]);a=max3f(a,p1[r],p1[r+1]);b=max3f(b,p1[r+2],p1[r+3]);}
  const float m=max2f(a,b);
  auto rr=__builtin_amdgcn_permlane32_swap(__float_as_uint(m),__float_as_uint(m),false,false);
  return max2f(__uint_as_float(rr[0]),__uint_as_float(rr[1]));
}
__device__ __forceinline__ void pv(f32x16*o,int vb,bf16x8 pa0,bf16x8 pa1,bf16x8 pa2,bf16x8 pa3){
  #pragma unroll
  for(int d0=0;d0<2;++d0){s16x4 lo[4],hi[4];
    #pragma unroll
    for(int ks=0;ks<4;++ks){
      asm volatile("ds_read_b64_tr_b16 %0,%1 offset:%c2":"=&v"(lo[ks]):"v"(vb),"i"(d0*4096+ks*1024):"memory");
      asm volatile("ds_read_b64_tr_b16 %0,%1 offset:%c2":"=&v"(hi[ks]):"v"(vb),"i"(d0*4096+ks*1024+512):"memory");}
    asm volatile("s_waitcnt lgkmcnt(0)":::"memory");SBAR();
    #define PK(k) (bf16x8){lo[k][0],lo[k][1],lo[k][2],lo[k][3],hi[k][0],hi[k][1],hi[k][2],hi[k][3]}
    o[d0]=__builtin_amdgcn_mfma_f32_32x32x16_bf16(pa0,PK(0),o[d0],0,0,0);
    o[d0]=__builtin_amdgcn_mfma_f32_32x32x16_bf16(pa1,PK(1),o[d0],0,0,0);
    o[d0]=__builtin_amdgcn_mfma_f32_32x32x16_bf16(pa2,PK(2),o[d0],0,0,0);
    o[d0]=__builtin_amdgcn_mfma_f32_32x32x16_bf16(pa3,PK(3),o[d0],0,0,0);
    #undef PK
  }
}

#ifndef ATTN_STORE16
#define ATTN_STORE16(p,v) (*(u32x4*)(p)=(v))
#endif
template<int THRL> __device__ __forceinline__ void attn_unit(int b,int h,int qb,const bf16*Q,const bf16*__restrict__ K,const bf16*__restrict__ V,bf16*O,char*shm,const float*__restrict__ kmsum,const float*__restrict__ relb){
  int tid_=threadIdx.x; asm volatile("":"+v"(tid_));
  const int tid=tid_,lane=tid&63,r32=lane&31,hi=lane>>5; const int wid=__builtin_amdgcn_readfirstlane(tid>>6);
  const long rowbase=(long)b*SEQ; const int q0=qb*QB;
  const bf16*Qw=Q+(rowbase+q0+wid*QBLK)*DM+h*D;
  const bf16*Kh=K+rowbase*DM+h*D,*Vh=V+rowbase*DM+h*D;
  const unsigned lds0=(unsigned)(uintptr_t)shm;
  float*wsf=(float*)(shm+LDS_WS)+wid*64;
  const bf16*ksrc=Kh+(long)lane*DM+wid*8;
  const bf16*vsrc=Vh+(long)(16*(wid&3)+(lane>>2))*DM+(wid>>2)*32+(lane&3)*8;
  const unsigned kdst=lds0+LDS_K+wid*1024, vdst=lds0+LDS_V+wid*1024;
  #define DMA_K(t,slot) glds16(ksrc+(long)PHYS(t)*KVBLK*DM,(unsigned)__builtin_amdgcn_readfirstlane(kdst+(slot)))
  #define DMA_V(t,slot) glds16(vsrc+(long)PHYS(t)*KVBLK*DM,(unsigned)__builtin_amdgcn_readfirstlane(vdst+(slot)))
  const int vb0=(int)(lds0+LDS_V)+((lane>>4)&1)*32+(lane&3)*8+(4*hi+((lane&15)>>2))*64;
  const char*Kbase=shm+LDS_K; bf16x8 kf[8];
  const lds_cptr shm3=(lds_cptr)shm; const lds_cptr kp0=shm3+LDS_K+hi*1024+r32*16; const lds_cptr vp0=shm3+LDS_V+((lane>>4)&1)*32+(lane&3)*8+(4*hi+((lane&15)>>2))*64;
  const int NT=(q0+QB)/KVBLK;
  const lds_fptr rt3=(lds_fptr)(shm+LDS_RT); const lds_fptr km3=(lds_fptr)(shm+LDS_KM);
  { for(int j=tid;j<1152;j+=512){ const int d=895-j; float v=0.f; if(d>=0&&d<790)v=(relb[t5_bucket(d)*NHEAD+h]-relb[31*NHEAD+h])*L2E; rt3[j]=v; }
    for(int i=tid;i<qb*64;i+=512)km3[i]=kmsum[i];
    asm volatile("s_waitcnt vmcnt(0) lgkmcnt(0)\n\ts_barrier":::"memory"); }
  unsigned selmask=0u; bool selcur=true;
  if(qb>0){
    bf16x8 qg[4]; { const bf16*Qg=Q+(rowbase+q0+wid*QBLK+(lane&31))*DM+h*D+(lane>>5)*8;
      #pragma unroll
      for(int d0=0;d0<4;++d0)qg[d0]=*reinterpret_cast<const bf16x8*>(Qg+d0*16); }
    float qf[32];
    #pragma unroll
    for(int d0=0;d0<4;++d0){
      #pragma unroll
      for(int j=0;j<8;++j)qf[8*d0+j]=__builtin_bit_cast(float,(unsigned)(unsigned short)qg[d0][j]<<16);}
    float g0=-INFINITY,g1=-INFINITY,g2=-INFINITY;int s0=-1,s1=-1,s2=-1;
    for(int n=0;n<qb;++n){ const lds_fptr kr=km3+n*64+8*(lane>>5); float acc=0.f;
      #pragma unroll
      for(int d0=0;d0<4;++d0){ const f32x4_t a=*(const __attribute__((address_space(3))) f32x4_t*)(kr+16*d0), c=*(const __attribute__((address_space(3))) f32x4_t*)(kr+16*d0+4);
        acc+=(qf[8*d0]*a[0]+qf[8*d0+1]*a[1])+(qf[8*d0+2]*a[2]+qf[8*d0+3]*a[3])+(qf[8*d0+4]*c[0]+qf[8*d0+5]*c[1])+(qf[8*d0+6]*c[2]+qf[8*d0+7]*c[3]); }
      acc+=__shfl_xor(acc,32);
      if(acc>g0){g2=g1;s2=s1;g1=g0;s1=s0;g0=acc;s0=n;} else if(acc>g1){g2=g1;s2=s1;g1=acc;s1=n;} else if(acc>g2){g2=acc;s2=n;} }
    if(s0>=0)selmask|=1u<<s0; if(s1>=0)selmask|=1u<<s1; if(s2>=0)selmask|=1u<<s2; }
  #define PHYS(t) (((t)<4)?(NT-4+(t)):((t)-4))
  DMA_K(0,0);DMA_V(0,0);DMA_K(1,SLOTB);
  bf16x8 qr[4];
  #pragma unroll
  for(int d0=0;d0<4;++d0)qr[d0]=*reinterpret_cast<const bf16x8*>(&Qw[(long)r32*DM+d0*16+hi*8]);
  float mhat=0.f,l_reg=0.f;f32x16 o[2];o[0]=f32x16{};o[1]=f32x16{};const f32x16 zero16=f32x16{};
  const int qrel=wid*QBLK+r32;
  #define BIASADD(P0,P1,kt0) do{ const lds_fptr rp_=rt3+(895-(q0+qrel)+(kt0)+4*hi); \
    _Pragma("unroll") for(int g_=0;g_<4;++g_){ SBAR(); \
      const float b0_=rp_[8*g_],b1_=rp_[8*g_+1],b2_=rp_[8*g_+2],b3_=rp_[8*g_+3],c0_=rp_[8*g_+32],c1_=rp_[8*g_+33],c2_=rp_[8*g_+34],c3_=rp_[8*g_+35]; \
      P0[4*g_]+=b0_;P0[4*g_+1]+=b1_;P0[4*g_+2]+=b2_;P0[4*g_+3]+=b3_;P1[4*g_]+=c0_;P1[4*g_+1]+=c1_;P1[4*g_+2]+=c2_;P1[4*g_+3]+=c3_; } SBAR(); }while(0)
  #define CMASK(P0,P1,t) do{ const int t_=(t); { const float nm_=selcur?-mhat:-1e30f; _Pragma("unroll") for(int r=0;r<16;++r){P0[r]+=nm_;P1[r]+=nm_;} } \
    if(t_<4){ BIASADD(P0,P1,q0+64*t_); cmask(P0,P1,t_,qrel,hi); } \
    else{ const int kt0_=64*(t_-4); if(q0+wid*QBLK-(kt0_+63)<790){ BIASADD(P0,P1,kt0_); } } }while(0)
  #define SELUPD(tn) do{ const int tn_=(tn); if(tn_>=4&&(tn_&3)==0){ selcur=((selmask>>((tn_-4)>>2))&1u)!=0u; } }while(0)
  bool resc=false;
  #define START(P0,P1) do{ const float rm=rowmax(P0,P1); resc=false; \
    { const float dl=rm; mhat=fadd_s(mhat,dl); \
      _Pragma("unroll") for(int r=0;r<16;++r){P0[r]=fsub_s(P0[r],dl);P1[r]=fsub_s(P1[r],dl);} \
      } \
    _Pragma("unroll") for(int r=0;r<16;++r)P0[r]=__builtin_amdgcn_exp2f(P0[r]); }while(0)
  #define RESC() do{ if(resc){ asm volatile("s_waitcnt lgkmcnt(0)":::"memory"); \
      _Pragma("unroll") for(int d_=0;d_<2;++d_) _Pragma("unroll") for(int r=0;r<16;++r)o[d_][r]*=wsf[crow(r,hi)]; } }while(0)
  f32x16 pA0,pA1,pB0,pB1;
  int sl_prev=0,sl_cur=0,sl_next=SLOTB;
  #define ROT() do{sl_prev=sl_cur;sl_cur=sl_next;sl_next=(sl_next==(NSLOT-1)*SLOTB)?0:sl_next+SLOTB;}while(0)
  DMA_K(2,2*SLOTB);
  WAIT_BAR(3);
  qkt(pA0,pA1,Kbase,qr,zero16,r32,hi);asm volatile("s_nop 15\n\ts_nop 7":"+v"(pA0),"+v"(pA1));CMASK(pA0,pA1,0);
  START(pA0,pA1);
  _Pragma("unroll") for(int r=0;r<16;++r)pA1[r]=__builtin_amdgcn_exp2f(pA1[r]);
  WAIT_BAR(0);
  DMA_K(3,0);DMA_V(1,SLOTB);
  ROT();
  kload8(kf,kp0+sl_cur);
  WAIT_BAR(2);
  s16x4 vlo[8],vhi[8]; u32x4 pw0,pw1,pw2,pw3;
  #define PKW(P,B) cvtpk_s(P[B],P[B+1])
  #define PAF(k) __builtin_bit_cast(bf16x8,pw##k)
  #define VFR(i) (bf16x8){vlo[i][0],vlo[i][1],vlo[i][2],vlo[i][3],vhi[i][0],vhi[i][1],vhi[i][2],vhi[i][3]}
  #define PIN(x) asm volatile("":"+v"(x))
  #define MX3(a,b,c) __builtin_fmaxf(__builtin_fmaxf((a),(b)),(c))
  #define GAPA(MF,A0,A1,A2,A3,W0,W1,PW) do{ MF; sacc+=A0; sacc+=A1; sacc+=A2; sacc+=A3; PIN(sacc); W0; W1; PIN(PW); SBAR(); }while(0)
  #define EX(v) __builtin_amdgcn_exp2f(v)
  #define GAPB(MF,X,B) do{ MF; X[B]=EX(X[B]); X[B+1]=EX(X[B+1]); X[B+2]=EX(X[B+2]); X[B+3]=EX(X[B+3]); PIN(X); SBAR(); }while(0)
  #define VRD(i) do{ vlo[i]=vtr(vp_+(((i)>>2)*4096+((i)&3)*1024)); vhi[i]=vtr(vp_+(((i)>>2)*4096+((i)&3)*1024+512)); }while(0)
  #define KRD(G,j) do{ if(G){ kload2(kf,kp0+sl_next,j); SBAR(); } }while(0)
  #define STEP(C0,C1,P0,P1,t,GK,GV,GL) do{ SBAR(); \
    const lds_cptr vp_=vp0+sl_prev; \
    VRD(0); SBAR(); float sacc=(P0[0]+P0[1]); \
    GAPA(C0=__builtin_amdgcn_mfma_f32_32x32x16_bf16(kf[0],qr[0],zero16,0,0,0), P0[2],P0[3],P0[4],P0[5],     pw0[0]=PKW(P0,0), pw0[1]=PKW(P0,2), pw0); \
    VRD(4); SBAR(); GAPA(C1=__builtin_amdgcn_mfma_f32_32x32x16_bf16(kf[1],qr[0],zero16,0,0,0), P0[6],P0[7],P0[8],P0[9],     pw0[2]=PKW(P0,4), pw0[3]=PKW(P0,6), pw0); \
    VRD(1); SBAR(); GAPA(C0=__builtin_amdgcn_mfma_f32_32x32x16_bf16(kf[2],qr[1],C0,0,0,0),   P0[10],P0[11],P0[12],P0[13], pw1[0]=PKW(P0,8), pw1[1]=PKW(P0,10), pw1); \
    VRD(5); SBAR(); GAPA(C1=__builtin_amdgcn_mfma_f32_32x32x16_bf16(kf[3],qr[1],C1,0,0,0),   P0[14],P0[15],P1[0],P1[1],   pw1[2]=PKW(P0,12),pw1[3]=PKW(P0,14), pw1); \
    VRD(2); SBAR(); GAPA(C0=__builtin_amdgcn_mfma_f32_32x32x16_bf16(kf[4],qr[2],C0,0,0,0),   P1[2],P1[3],P1[4],P1[5],     pw2[0]=PKW(P1,0), pw2[1]=PKW(P1,2), pw2); \
    VRD(6); SBAR(); GAPA(C1=__builtin_amdgcn_mfma_f32_32x32x16_bf16(kf[5],qr[2],C1,0,0,0),   P1[6],P1[7],P1[8],P1[9],     pw2[2]=PKW(P1,4), pw2[3]=PKW(P1,6), pw2); \
    VRD(3); SBAR(); GAPA(C0=__builtin_amdgcn_mfma_f32_32x32x16_bf16(kf[6],qr[3],C0,0,0,0),   P1[10],P1[11],P1[12],P1[13], pw3[0]=PKW(P1,8), pw3[1]=PKW(P1,10), pw3); \
    VRD(7); SBAR(); GAPA(C1=__builtin_amdgcn_mfma_f32_32x32x16_bf16(kf[7],qr[3],C1,0,0,0),   P1[14],P1[15],0.f,0.f,       pw3[2]=PKW(P1,12),pw3[3]=PKW(P1,14), pw3); \
    l_reg+=sacc; \
    if(GK){DMA_K((t)+3,sl_cur);} if(GV){DMA_V((t)+1,sl_next);} \
    CMASK(C0,C1,t); \
    { float a=MX3(C0[0],C0[1],C1[0]),b=MX3(C0[2],C0[3],C1[1]); a=MX3(a,C1[2],C1[3]); \
      _Pragma("unroll") for(int r=4;r<16;r+=4){a=MX3(a,C0[r],C0[r+1]);b=MX3(b,C0[r+2],C0[r+3]);a=MX3(a,C1[r],C1[r+1]);b=MX3(b,C1[r+2],C1[r+3]);} \
      float rm=__builtin_fmaxf(a,b); { auto rr=__builtin_amdgcn_permlane32_swap(__float_as_uint(rm),__float_as_uint(rm),false,false); rm=__builtin_fmaxf(__uint_as_float(rr[0]),__uint_as_float(rr[1])); } \
      resc=false; \
      if(__builtin_expect(__any(rm>(float)THRL),0)){ const float dl=__builtin_fmaxf(rm,0.f); mhat+=dl; \
        _Pragma("unroll") for(int r=0;r<16;++r){C0[r]-=dl;C1[r]-=dl;} \
        const float f=__builtin_amdgcn_exp2f(-dl); l_reg*=f; if(hi==0)wsf[r32]=f; resc=true; } } \
    SBAR(); \
    GAPB(o[0]=__builtin_amdgcn_mfma_f32_32x32x16_bf16(PAF(0),VFR(0),o[0],0,0,0), C0,0); \
    GAPB(o[1]=__builtin_amdgcn_mfma_f32_32x32x16_bf16(PAF(0),VFR(4),o[1],0,0,0), C0,4); \
    KRD(GL,0); GAPB(o[0]=__builtin_amdgcn_mfma_f32_32x32x16_bf16(PAF(1),VFR(1),o[0],0,0,0), C0,8); \
    KRD(GL,1); GAPB(o[1]=__builtin_amdgcn_mfma_f32_32x32x16_bf16(PAF(1),VFR(5),o[1],0,0,0), C0,12); \
    KRD(GL,2); GAPB(o[0]=__builtin_amdgcn_mfma_f32_32x32x16_bf16(PAF(2),VFR(2),o[0],0,0,0), C1,0); \
    KRD(GL,3); GAPB(o[1]=__builtin_amdgcn_mfma_f32_32x32x16_bf16(PAF(2),VFR(6),o[1],0,0,0), C1,4); \
    GAPB(o[0]=__builtin_amdgcn_mfma_f32_32x32x16_bf16(PAF(3),VFR(3),o[0],0,0,0), C1,8); \
    GAPB(o[1]=__builtin_amdgcn_mfma_f32_32x32x16_bf16(PAF(3),VFR(7),o[1],0,0,0), C1,12); \
    }while(0)
  int t=1;
  for(;t+5<NT;t+=2){
    STEP(pB0,pB1,pA0,pA1,t,true,true,true);     WAIT_BAR(2); RESC(); ROT(); SELUPD(t+1);
    STEP(pA0,pA1,pB0,pB1,t+1,true,true,true);   WAIT_BAR(2); RESC(); ROT(); SELUPD(t+2);
  }
  #define ENDW(tt) do{ if((tt)+3<NT){WAIT_BAR(2);} else if((tt)+2<NT){WAIT_BAR(1);} else {WAIT_BAR(0);} }while(0)
  for(;t+1<NT;t+=2){
    STEP(pB0,pB1,pA0,pA1,t,(t+3<NT),(t+1<NT),(t+1<NT));       ENDW(t);   RESC(); ROT(); SELUPD(t+1);
    STEP(pA0,pA1,pB0,pB1,t+1,(t+4<NT),(t+2<NT),(t+2<NT));     ENDW(t+1); RESC(); ROT(); SELUPD(t+2);
  }
  STEP(pB0,pB1,pA0,pA1,NT-1,false,false,false); RESC();
  { float sacc=pB0[0]+pB0[1]; _Pragma("unroll") for(int r=2;r<16;++r)sacc+=pB0[r]; _Pragma("unroll") for(int r=0;r<16;++r)sacc+=pB1[r]; l_reg+=sacc;
    pw0=(u32x4){PKW(pB0,0),PKW(pB0,2),PKW(pB0,4),PKW(pB0,6)};pw1=(u32x4){PKW(pB0,8),PKW(pB0,10),PKW(pB0,12),PKW(pB0,14)};pw2=(u32x4){PKW(pB1,0),PKW(pB1,2),PKW(pB1,4),PKW(pB1,6)};pw3=(u32x4){PKW(pB1,8),PKW(pB1,10),PKW(pB1,12),PKW(pB1,14)};
    SBAR(); pv(o,vb0+sl_cur,PAF(0),PAF(1),PAF(2),PAF(3)); }
  #undef PKW
  #undef PAF
  #undef VFR
  #undef PIN
  #undef MX3
  #undef GAPA
  #undef GAPB
  #undef EX
  #undef VRD
  #undef KRD
  #undef STEP
  #undef ENDW
  {auto rr=__builtin_amdgcn_permlane32_swap(__float_as_uint(l_reg),__float_as_uint(l_reg),false,false);l_reg=__uint_as_float(rr[0])+__uint_as_float(rr[1]);}
  if(hi==0)wsf[32+r32]=l_reg;asm volatile("s_waitcnt lgkmcnt(0)":::"memory");
  float rli[16];
  #pragma unroll
  for(int r=0;r<16;++r)rli[r]=__builtin_amdgcn_rcpf(wsf[32+crow(r,hi)]);
  bf16*Ow=O+(rowbase+q0+wid*QBLK)*DM+h*D;
  { bf16*stg=(bf16*)(shm+LDS_OST)+wid*2048;
    #pragma unroll
    for(int r=0;r<16;++r){const int orow=crow(r,hi);
      #pragma unroll
      for(int d0=0;d0<2;++d0)stg[orow*64+d0*32+r32]=(bf16)f2bf(o[d0][r]*rli[r]);}
    asm volatile("s_waitcnt lgkmcnt(0)":::"memory");
    #pragma unroll
    for(int i=0;i<4;++i){const int row=i*8+(lane>>3),ch=lane&7; const u32x4 v=*(const u32x4*)(stg+row*64+ch*8); ATTN_STORE16(Ow+(long)row*DM+ch*8,v);} }
  asm volatile("s_waitcnt lgkmcnt(0)\n\ts_barrier":::"memory");
  #undef DMA_K
  #undef DMA_V
  #undef CMASK
  #undef BIASADD
  #undef SELUPD
  #undef PHYS
  #undef START
  #undef RESC
  #undef ROT
}
constexpr int ATTN_LDS_BYTES=LDS_BYTES;
struct AttnTensors { const bf16* Q; const bf16* K; const bf16* V; bf16* O; const float* kmsum; const float* relb; };
struct AttnUnit { int bh; int qb; };
struct StaticOrder {
  int vcu;
  __device__ __forceinline__ explicit StaticOrder(int grid,int block):vcu((block%8)*(grid/8)+block/8){}
  __device__ __forceinline__ bool next(int i,AttnUnit&u)const{ if(i>=2)return false; const int s=vcu&7; u.bh=vcu>>3; u.qb=(i==0)?15-s:s; return true; }
  __device__ __forceinline__ void a_ready(const AttnUnit&)const{}
  __device__ __forceinline__ void done(const AttnUnit&)const{}
};
template<class Sched,int THRL=8> __device__ __forceinline__ void attn_phase(char*lds,const AttnTensors&T,const Sched&S){
  AttnUnit u;
  for(int i=0;S.next(i,u);++i){ S.a_ready(u); attn_unit<THRL>(u.bh/NHEAD,u.bh%NHEAD,u.qb,T.Q,T.K,T.V,T.O,lds,T.kmsum+(size_t)u.bh*16*64,T.relb); S.done(u); }
}
#undef SBAR
#undef WAIT_BAR
}

__device__ __forceinline__ void attn_simple(Frame& F) {
    LAS float* tab = (LAS float*)(F.lds + RING_OFF);
    const float* relb = F.in[I_RELB];
    for (int i = F.tid; i < 8 * 800; i += 512) { const int h = i / 800, d = i % 800; tab[i] = relb[t5_bucket(d) * NH + h] * LOG2E; }
    __syncthreads();
    const bf16* Q = (const bf16*)(F.ws + WS_Q); const bf16* K = (const bf16*)(F.ws + WS_K); const bf16* V = (const bf16*)(F.ws + WS_V); bf16* O = (bf16*)(F.ws + WS_Q);
    const float* kmean = (const float*)(F.ws + OFF_KMEAN);
    const int wv = blockIdx.x * NWAVES + F.wave;
    const int bh = wv >> 6, b = bh >> 3, h = bh & 7, q = (wv & 63) * 64 + F.lane, blk = q >> 8;
    const LAS float* tb = tab + h * 800;
    const size_t rowq = (size_t)(b * SEQ + q) * 512 + h * 64;
    float qf[64];
#pragma unroll
    for (int c = 0; c < 8; ++c) { const u32x4 w = *(const u32x4*)(Q + rowq + c * 8);
        qf[c * 8 + 0] = bflo(w.x); qf[c * 8 + 1] = bfhi(w.x); qf[c * 8 + 2] = bflo(w.y); qf[c * 8 + 3] = bfhi(w.y); qf[c * 8 + 4] = bflo(w.z); qf[c * 8 + 5] = bfhi(w.z); qf[c * 8 + 6] = bflo(w.w); qf[c * 8 + 7] = bfhi(w.w); }
    float g0 = -INFINITY, g1 = -INFINITY, g2 = -INFINITY; int s0 = -1, s1 = -1, s2 = -1;
    for (int n = 0; n < blk; ++n) {
        const float* km = kmean + ((size_t)bh * 16 + n) * 64; float gsum = 0.f;
#pragma unroll
        for (int d = 0; d < 64; ++d) gsum += qf[d] * km[d];
        if (gsum > g0) { g2 = g1; s2 = s1; g1 = g0; s1 = s0; g0 = gsum; s0 = n; }
        else if (gsum > g1) { g2 = g1; s2 = s1; g1 = gsum; s1 = n; }
        else if (gsum > g2) { g2 = gsum; s2 = n; }
    }
    float o[64];
#pragma unroll
    for (int d = 0; d < 64; ++d) o[d] = 0.f;
    float mx = -1e30f, l = 0.f;
    for (int pass = 0; pass < 4; ++pass) {
        const int jb = pass == 0 ? s0 : pass == 1 ? s1 : pass == 2 ? s2 : blk;
        const bool act = jb >= 0;
        const int jblk = act ? jb : 0;
        const int nkeys = (pass == 3) ? 256 : 256;
        if (pass < 3 && blk <= pass) continue;
        for (int kk = 0; kk < nkeys; ++kk) {
            const int kpos = jblk * 256 + kk;
            const size_t rowk = (size_t)(b * SEQ + kpos) * 512 + h * 64;
            float s = 0.f;
#pragma unroll
            for (int c = 0; c < 8; ++c) { const u32x4 w = *(const u32x4*)(K + rowk + c * 8);
                s += qf[c * 8 + 0] * bflo(w.x) + qf[c * 8 + 1] * bfhi(w.x) + qf[c * 8 + 2] * bflo(w.y) + qf[c * 8 + 3] * bfhi(w.y) + qf[c * 8 + 4] * bflo(w.z) + qf[c * 8 + 5] * bfhi(w.z) + qf[c * 8 + 6] * bflo(w.w) + qf[c * 8 + 7] * bfhi(w.w); }
            const int dist = q - kpos;
            const bool valid = act && dist >= 0;
            const int dcl = dist < 0 ? 0 : (dist > 799 ? 799 : dist);
            s += tb[dcl];
            if (!valid) s = -1e30f;
            const float mn = fmaxf(mx, s);
            const float f = fast_exp2(mx - mn), p = valid ? fast_exp2(s - mn) : 0.f;
            l = l * f + p; mx = mn;
#pragma unroll
            for (int c = 0; c < 8; ++c) { const u32x4 w = *(const u32x4*)(V + rowk + c * 8);
                o[c * 8 + 0] = o[c * 8 + 0] * f + p * bflo(w.x); o[c * 8 + 1] = o[c * 8 + 1] * f + p * bfhi(w.x); o[c * 8 + 2] = o[c * 8 + 2] * f + p * bflo(w.y); o[c * 8 + 3] = o[c * 8 + 3] * f + p * bfhi(w.y);
                o[c * 8 + 4] = o[c * 8 + 4] * f + p * bflo(w.z); o[c * 8 + 5] = o[c * 8 + 5] * f + p * bfhi(w.z); o[c * 8 + 6] = o[c * 8 + 6] * f + p * bflo(w.w); o[c * 8 + 7] = o[c * 8 + 7] * f + p * bfhi(w.w); }
        }
    }
    const float il = 1.0f / l;
#pragma unroll
    for (int c = 0; c < 8; ++c) { u32x4 w; w.x = pk2(o[c * 8 + 0] * il, o[c * 8 + 1] * il); w.y = pk2(o[c * 8 + 2] * il, o[c * 8 + 3] * il); w.z = pk2(o[c * 8 + 4] * il, o[c * 8 + 5] * il); w.w = pk2(o[c * 8 + 6] * il, o[c * 8 + 7] * il);
        *(u32x4*)(O + rowq + c * 8) = w; }
}

__device__ __forceinline__ void mix_phase(Frame& F) {
    unsigned char* ws = F.ws;
    const bf16* Z = (const bf16*)(ws + WS_Z);
    bf16* R = (bf16*)(ws + WS_R); bf16* KR = (bf16*)(ws + WS_KR); bf16* VR = (bf16*)(ws + WS_VR);
    bf16* KKo = (bf16*)(ws + WS_KK); bf16* BBo = (bf16*)(ws + WS_BB); float* WD = (float*)(ws + WS_WDEC); bf16* GB = (bf16*)(ws + WS_GB); float* RK = (float*)(ws + WS_RK);
    const bf16* bnd = (const bf16*)(ws + WS_BND);
    const bf16* LBW = (const bf16*)(ws + WS_LBW); const bf16* LBA = (const bf16*)(ws + WS_LBA); const bf16* LBG = (const bf16*)(ws + WS_LBG);
    const float* mixrkv = F.in[I_MIXRKV]; const float* w0 = F.in[I_W0]; const float* a0 = F.in[I_A0]; const float* k_k = F.in[I_KK]; const float* k_a = F.in[I_KA]; const float* r_k = F.in[I_RKP];
    const int lane = F.lane, n = lane & 15, q4 = lane >> 4;
    LAS float* stash = (LAS float*)(F.lds + RING_OFF) + F.wave * 2560;
    LAS float* keep = stash + 384;
    for (int item = blockIdx.x; item < 256; item += F.G) {
        const int pm = item >> 2, hp = item & 3;
        const int R0 = pm * 256 + F.wave * 32;
        if (q4 == 0) {
#pragma unroll
            for (int hh = 0; hh < 2; ++hh)
#pragma unroll
                for (int c = 0; c < 4; ++c) {
                    const int ch = (2 * hp + hh) * 64 + 16 * c + n; float vr = 0.f, vk = 0.f, vv = 0.f;
                    if ((R0 & (SEQ - 1)) != 0) {
                        if (F.wave == 0) { const bf16* bp = bnd + (size_t)(pm - 1) * 1536; vr = bf2f(bp[ch]); vk = bf2f(bp[512 + ch]); vv = bf2f(bp[1024 + ch]); }
                        else { const size_t o = (size_t)(R0 - 1) * 512 + ch; vr = bf2f(R[o]); vk = bf2f(KR[o]); vv = bf2f(VR[o]); }
                    }
                    stash[((hh * 4 + c) * 3 + 0) * 16 + n] = vr; stash[((hh * 4 + c) * 3 + 1) * 16 + n] = vk; stash[((hh * 4 + c) * 3 + 2) * 16 + n] = vv;
                }
        }
        asm volatile("s_waitcnt vmcnt(0) lgkmcnt(0)" ::: "memory"); __syncthreads();
#pragma unroll 1
        for (int g = 1; g >= 0; --g) {
            const int t0 = R0 + 16 * g;
            bf16x8 Af[9];
            {
                const int t = t0 + n; const bool first = (t & (SEQ - 1)) == 0;
#pragma unroll
                for (int s = 0; s < 9; ++s) {
                    const u32x4 z1 = *(const u32x4*)(Z + (size_t)t * ZP + 32 * s + 8 * q4);
                    u32x4 z2 = (u32x4){0u, 0u, 0u, 0u}; if (!first) z2 = *(const u32x4*)(Z + (size_t)(t - 1) * ZP + 288 + 32 * s + 8 * q4);
                    float hv[8] = { bflo(z1.x) + bflo(z2.x), bfhi(z1.x) + bfhi(z2.x), bflo(z1.y) + bflo(z2.y), bfhi(z1.y) + bfhi(z2.y), bflo(z1.z) + bflo(z2.z), bfhi(z1.z) + bfhi(z2.z), bflo(z1.w) + bflo(z2.w), bfhi(z1.w) + bfhi(z2.w) };
#pragma unroll
                    for (int i = 0; i < 8; ++i) { if (s < 2) { const float e = fast_exp2(hv[i] * (2.0f * LOG2E)); hv[i] = 1.0f - 2.0f * fast_rcp(e + 1.0f); } else if (s >= 4) hv[i] = sigmoidf_(hv[i]); }
                    u32x4 p; p.x = pk2(hv[0], hv[1]); p.y = pk2(hv[2], hv[3]); p.z = pk2(hv[4], hv[5]); p.w = pk2(hv[6], hv[7]);
                    Af[s] = __builtin_bit_cast(bf16x8, p);
                }
            }
#pragma unroll 1
            for (int hh = 0; hh < 2; ++hh) {
                const int hd = 2 * hp + hh;
                float n2[4] = {0.f, 0.f, 0.f, 0.f}, rks[4] = {0.f, 0.f, 0.f, 0.f};
#pragma unroll 1
                for (int c = 0; c < 4; ++c) {
                    const int ch = hd * 64 + 16 * c + n;
                    float oR[5], oK[5], oV[5];
                    if (q4 == 0 && g == 0) { oR[0] = stash[((hh * 4 + c) * 3 + 0) * 16 + n]; oK[0] = stash[((hh * 4 + c) * 3 + 1) * 16 + n]; oV[0] = stash[((hh * 4 + c) * 3 + 2) * 16 + n]; }
                    else { const size_t o = (size_t)(t0 + 4 * q4 - 1) * 512 + ch; oR[0] = bf2f(R[o]); oK[0] = bf2f(KR[o]); oV[0] = bf2f(VR[o]); }
#pragma unroll
                    for (int i = 0; i < 4; ++i) { const size_t o = (size_t)(t0 + 4 * q4 + i) * 512 + ch; oR[i + 1] = bf2f(R[o]); oK[i + 1] = bf2f(KR[o]); oV[i + 1] = bf2f(VR[o]); }
                    asm volatile("s_waitcnt vmcnt(0) lgkmcnt(0)" ::: "memory");
                    f32x4 aw = (f32x4){0.f, 0.f, 0.f, 0.f}, aa = aw, ag = aw;
#pragma unroll
                    for (int s = 0; s < 2; ++s) { const bf16x8 b = *(const bf16x8*)(LBW + (size_t)ch * 64 + 32 * s + 8 * q4); aw = __builtin_amdgcn_mfma_f32_16x16x32_bf16(Af[s], b, aw, 0, 0, 0); }
#pragma unroll
                    for (int s = 0; s < 2; ++s) { const bf16x8 b = *(const bf16x8*)(LBA + (size_t)ch * 64 + 32 * s + 8 * q4); aa = __builtin_amdgcn_mfma_f32_16x16x32_bf16(Af[2 + s], b, aa, 0, 0, 0); }
#pragma unroll
                    for (int s = 0; s < 5; ++s) { const bf16x8 b = *(const bf16x8*)(LBG + (size_t)ch * 160 + 32 * s + 8 * q4); ag = __builtin_amdgcn_mfma_f32_16x16x32_bf16(Af[4 + s], b, ag, 0, 0, 0); }
                    const float mr = mixrkv[ch], mk = mixrkv[512 + ch], mv = mixrkv[1024 + ch], w0c = w0[ch], a0c = a0[ch], kkc = k_k[ch], kac = k_a[ch], rkc = r_k[ch];
#pragma unroll
                    for (int i = 0; i < 4; ++i) {
                        const size_t o = (size_t)(t0 + 4 * q4 + i) * 512 + ch;
                        const float cr = oR[i + 1], ck = oK[i + 1], cv = oV[i + 1];
                        const float r_ = cr + (oR[i] - cr) * mr, k_ = ck + (oK[i] - ck) * mk, v_ = cv + (oV[i] - cv) * mv;
                        const float sg = sigmoidf_(w0c + aw[i]);
                        const float dec = fast_exp2(-0.6065306597126334f * LOG2E * sg);
                        const float a_ = sigmoidf_(a0c + aa[i]);
                        const float kr_ = k_ * kkc; n2[i] += kr_ * kr_;
                        const float kt_ = k_ * (1.0f + (a_ - 1.0f) * kac);
                        rks[i] += r_ * kt_ * rkc;
                        keep[((c * 4 + i) * 2 + 0) * 64 + lane] = kr_; keep[((c * 4 + i) * 2 + 1) * 64 + lane] = a_;
                        R[o] = (bf16)f2bf(r_); KR[o] = (bf16)f2bf(kt_); VR[o] = (bf16)f2bf(v_); WD[o] = dec; GB[o] = (bf16)f2bf(ag[i]);
                    }
                }
#pragma unroll
                for (int i = 0; i < 4; ++i) {
                    float a = n2[i], b = rks[i];
                    a += __shfl_xor(a, 1); a += __shfl_xor(a, 2); a += __shfl_xor(a, 4); a += __shfl_xor(a, 8);
                    b += __shfl_xor(b, 1); b += __shfl_xor(b, 2); b += __shfl_xor(b, 4); b += __shfl_xor(b, 8);
                    n2[i] = 1.0f / fmaxf(sqrtf(a), 1e-12f); rks[i] = b;
                }
                LDS_WAIT();
#pragma unroll 1
                for (int c = 0; c < 4; ++c) {
                    const int ch = hd * 64 + 16 * c + n;
#pragma unroll
                    for (int i = 0; i < 4; ++i) {
                        const size_t o = (size_t)(t0 + 4 * q4 + i) * 512 + ch;
                        const float kk_ = keep[((c * 4 + i) * 2 + 0) * 64 + lane] * n2[i], a_ = keep[((c * 4 + i) * 2 + 1) * 64 + lane];
                        KKo[o] = (bf16)f2bf(kk_); BBo[o] = (bf16)f2bf(kk_ * a_);
                    }
                }
                LDS_WAIT();
                if (n == 0) {
#pragma unroll
                    for (int i = 0; i < 4; ++i) RK[(size_t)(t0 + 4 * q4 + i) * 8 + hd] = rks[i];
                }
            }
        }
        __syncthreads();
    }
}


typedef float f32x4v __attribute__((ext_vector_type(4)));
#define MF4(a, b, c) __builtin_amdgcn_mfma_f32_16x16x4f32((a), (b), (c), 0, 0, 0)

__device__ __forceinline__ void mixc_phase(Frame& F) {
    unsigned char* ws = F.ws;
    const bf16* Z = (const bf16*)(ws + WS_Z);
    const bf16* R = (const bf16*)(ws + WS_R); const bf16* KR = (const bf16*)(ws + WS_KR); bf16* VR = (bf16*)(ws + WS_VR);
    bf16* GB = (bf16*)(ws + WS_GB); float* RK = (float*)(ws + WS_RK);
    const bf16* bnd = (const bf16*)(ws + WS_BND);
    const bf16* LBW = (const bf16*)(ws + WS_LBW); const bf16* LBA = (const bf16*)(ws + WS_LBA); const bf16* LBG = (const bf16*)(ws + WS_LBG);
    const float* mixrkv = F.in[I_MIXRKV]; const float* w0 = F.in[I_W0]; const float* a0 = F.in[I_A0]; const float* k_k = F.in[I_KK]; const float* k_a = F.in[I_KA]; const float* r_k = F.in[I_RKP];
    const int lane0 = F.lane;
    LAS float* xb = (LAS float*)(F.lds + RING_OFF + F.wave * 16384);
    LAS float* tt = xb; LAS float* rb = xb + 320; LAS float* stash = xb + 3 * 1088;
    LAS unsigned short* sa = (LAS unsigned short*)xb;
    for (int item = blockIdx.x; item < 256; item += F.G) {
        const int pm = item >> 2, hp = item & 3;
        const int R0 = pm * 256 + F.wave * 32;
        { int lane = lane0; asm volatile("" : "+v"(lane)); const int n = lane & 15, q4 = lane >> 4;
        if (q4 == 0) {
#pragma unroll
            for (int hh = 0; hh < 2; ++hh)
#pragma unroll
                for (int c = 0; c < 4; ++c) {
                    const int ch = (2 * hp + hh) * 64 + 16 * c + n; float vr = 0.f, vk = 0.f, vv = 0.f;
                    if ((R0 & (SEQ - 1)) != 0) {
                        if (F.wave == 0) { const bf16* bp = bnd + (size_t)(pm - 1) * 1536; vr = bf2f(bp[ch]); vk = bf2f(bp[512 + ch]); vv = bf2f(bp[1024 + ch]); }
                        else { const size_t o = (size_t)(R0 - 1) * 512 + ch; vr = bf2f(R[o]); vk = bf2f(KR[o]); vv = bf2f(VR[o]); }
                    }
                    stash[((hh * 4 + c) * 3 + 0) * 16 + n] = vr; stash[((hh * 4 + c) * 3 + 1) * 16 + n] = vk; stash[((hh * 4 + c) * 3 + 2) * 16 + n] = vv;
                }
        }
        }
        asm volatile("s_waitcnt vmcnt(0) lgkmcnt(0)" ::: "memory"); __syncthreads();
#pragma unroll 1
        for (int g = 1; g >= 0; --g) {
            const int t0 = R0 + 16 * g;
#pragma unroll 1
            for (int hh = 0; hh < 2; ++hh) {
                const int hd = 2 * hp + hh;
                int lane = lane0; asm volatile("" : "+v"(lane));
                const int n = lane & 15, q4 = lane >> 4;
                bf16x8 Af[9];
                {
                    const int t = t0 + n; const bool first = (t & (SEQ - 1)) == 0;
#pragma unroll
                    for (int s = 0; s < 9; ++s) {
                        const u32x4 z1 = *(const u32x4*)(Z + (size_t)t * ZP + 32 * s + 8 * q4);
                        u32x4 z2 = (u32x4){0u, 0u, 0u, 0u}; if (!first) z2 = *(const u32x4*)(Z + (size_t)(t - 1) * ZP + 288 + 32 * s + 8 * q4);
                        float hv[8] = { bflo(z1.x) + bflo(z2.x), bfhi(z1.x) + bfhi(z2.x), bflo(z1.y) + bflo(z2.y), bfhi(z1.y) + bfhi(z2.y), bflo(z1.z) + bflo(z2.z), bfhi(z1.z) + bfhi(z2.z), bflo(z1.w) + bflo(z2.w), bfhi(z1.w) + bfhi(z2.w) };
#pragma unroll
                        for (int i = 0; i < 8; ++i) { if (s < 2) { const float e = fast_exp2(hv[i] * (2.0f * LOG2E)); hv[i] = 1.0f - 2.0f * fast_rcp(e + 1.0f); } else if (s >= 4) hv[i] = sigmoidf_(hv[i]); }
                        u32x4 p; p.x = pk2(hv[0], hv[1]); p.y = pk2(hv[2], hv[3]); p.z = pk2(hv[4], hv[5]); p.w = pk2(hv[6], hv[7]);
                        Af[s] = __builtin_bit_cast(bf16x8, p);
                    }
                }
                const int cid = ((t0 >> 12) * NH + hd) * 256 + ((t0 & (SEQ - 1)) >> 4);
                float At[4][4], Rt[4][4], Bh[4][4], Kh[4][4], pC[4];
                float n2[4] = {0.f, 0.f, 0.f, 0.f}, rks[4] = {0.f, 0.f, 0.f, 0.f};
#pragma unroll
                for (int c = 0; c < 4; ++c) {
                    const int ch = hd * 64 + 16 * c + n;
                    float oR[5], oK[5], oV[5];
                    if (q4 == 0 && g == 0) { oR[0] = stash[((hh * 4 + c) * 3 + 0) * 16 + n]; oK[0] = stash[((hh * 4 + c) * 3 + 1) * 16 + n]; oV[0] = stash[((hh * 4 + c) * 3 + 2) * 16 + n]; }
                    else { const size_t o = (size_t)(t0 + 4 * q4 - 1) * 512 + ch; oR[0] = bf2f(R[o]); oK[0] = bf2f(KR[o]); oV[0] = bf2f(VR[o]); }
#pragma unroll
                    for (int i = 0; i < 4; ++i) { const size_t o = (size_t)(t0 + 4 * q4 + i) * 512 + ch; oR[i + 1] = bf2f(R[o]); oK[i + 1] = bf2f(KR[o]); oV[i + 1] = bf2f(VR[o]); }
                    asm volatile("s_waitcnt vmcnt(0) lgkmcnt(0)" ::: "memory");
                    f32x4 aw = (f32x4){0.f, 0.f, 0.f, 0.f}, aa = aw, ag = aw;
#pragma unroll
                    for (int s = 0; s < 2; ++s) { const bf16x8 b = *(const bf16x8*)(LBW + (size_t)ch * 64 + 32 * s + 8 * q4); aw = __builtin_amdgcn_mfma_f32_16x16x32_bf16(Af[s], b, aw, 0, 0, 0); }
#pragma unroll
                    for (int s = 0; s < 2; ++s) { const bf16x8 b = *(const bf16x8*)(LBA + (size_t)ch * 64 + 32 * s + 8 * q4); aa = __builtin_amdgcn_mfma_f32_16x16x32_bf16(Af[2 + s], b, aa, 0, 0, 0); }
#pragma unroll
                    for (int s = 0; s < 5; ++s) { const bf16x8 b = *(const bf16x8*)(LBG + (size_t)ch * 160 + 32 * s + 8 * q4); ag = __builtin_amdgcn_mfma_f32_16x16x32_bf16(Af[4 + s], b, ag, 0, 0, 0); }
                    const float mr = mixrkv[ch], mk = mixrkv[512 + ch], mv = mixrkv[1024 + ch], w0c = w0[ch], a0c = a0[ch], kkc = k_k[ch], kac = k_a[ch], rkc = r_k[ch];
                    float wt[4], kr[4], as[4], kt[4], rr[4];
#pragma unroll
                    for (int i = 0; i < 4; ++i) {
                        const size_t o = (size_t)(t0 + 4 * q4 + i) * 512 + ch;
                        const float cr = oR[i + 1], ck = oK[i + 1], cv = oV[i + 1];
                        const float r_ = cr + (oR[i] - cr) * mr, k_ = ck + (oK[i] - ck) * mk, v_ = cv + (oV[i] - cv) * mv;
                        const float sg = sigmoidf_(w0c + aw[i]);
                        wt[i] = fast_exp2(-0.6065306597126334f * LOG2E * sg);
                        const float a_ = sigmoidf_(a0c + aa[i]);
                        const float kr_ = k_ * kkc; n2[i] += kr_ * kr_;
                        const float kt_ = k_ * (1.0f + (a_ - 1.0f) * kac);
                        rks[i] += r_ * kt_ * rkc;
                        kr[i] = kr_; as[i] = a_; kt[i] = kt_; rr[i] = r_;
                        VR[o] = (bf16)f2bf(v_); GB[o] = (bf16)f2bf(ag[i]);
                    }
                    {
                        const float p0 = wt[0], p1 = p0 * wt[1], p2 = p1 * wt[2], p3 = p2 * wt[3];
                        const float t1 = __shfl(p3, (lane + 48) & 63), t2 = __shfl(p3, (lane + 32) & 63), t3 = __shfl(p3, (lane + 16) & 63);
                        float E = 1.0f; if (q4 >= 1) E *= t1; if (q4 >= 2) E *= t2; if (q4 >= 3) E *= t3;
                        const float pm[4] = {E, p0 * E, p1 * E, p2 * E}; const float pp[4] = {p0 * E, p1 * E, p2 * E, p3 * E};
                        const float pc_ = __shfl(pp[3], 48 + n); pC[c] = pc_;
#pragma unroll
                        for (int i = 0; i < 4; ++i) {
                            const float ip = 1.0f / pp[i];
                            At[c][i] = kr[i] * pm[i]; Rt[c][i] = rr[i] * pp[i]; Bh[c][i] = kr[i] * as[i] * ip;
                            const float ktt = kt[i] * ip; Kh[c][i] = ktt * pc_;
                            xb[2 * 1088 + (4 * q4 + i) * 68 + 16 * c + n] = ktt;
                        }
                    }
                    asm volatile("" ::: "memory");
                }
#pragma unroll
                for (int i = 0; i < 4; ++i) {
                    float a = n2[i], b = rks[i];
                    a += __shfl_xor(a, 1); a += __shfl_xor(a, 2); a += __shfl_xor(a, 4); a += __shfl_xor(a, 8);
                    b += __shfl_xor(b, 1); b += __shfl_xor(b, 2); b += __shfl_xor(b, 4); b += __shfl_xor(b, 8);
                    n2[i] = 1.0f / fmaxf(sqrtf(a), 1e-12f); rks[i] = b;
                }
                if (n == 0) {
#pragma unroll
                    for (int i = 0; i < 4; ++i) RK[(size_t)(t0 + 4 * q4 + i) * 8 + hd] = rks[i];
                }
#pragma unroll
                for (int c = 0; c < 4; ++c)
#pragma unroll
                    for (int i = 0; i < 4; ++i) {
                        At[c][i] = -At[c][i] * n2[i]; const float bt = Bh[c][i] * n2[i]; Bh[c][i] = bt * pC[c];
                        xb[0 * 1088 + (4 * q4 + i) * 68 + 16 * c + n] = At[c][i]; xb[1 * 1088 + (4 * q4 + i) * 68 + 16 * c + n] = bt;
                    }
                { bf16* bkq = (bf16*)(ws + WS_BKQ) + (size_t)cid * 2048;
#pragma unroll
                  for (int c = 0; c < 4; ++c) { u32x4 w_; w_.x = pk2(Bh[c][0], Bh[c][1]); w_.y = pk2(Bh[c][2], Bh[c][3]); w_.z = pk2(Kh[c][0], Kh[c][1]); w_.w = pk2(Kh[c][2], Kh[c][3]);
                      *(u32x4*)(bkq + ((c * 16 + n) * 4 + q4) * 8) = w_; }
                  if (q4 == 0) { float* pc = (float*)(ws + WS_PC) + (size_t)cid * 64;
#pragma unroll
                      for (int c = 0; c < 4; ++c) pc[16 * c + n] = pC[c]; } }
                LDS_WAIT();
                f32x4v Aab = (f32x4v){0.f, 0.f, 0.f, 0.f}, Aak = Aab, Arb = Aab, Ark = Aab;
                {
                    f32x4v fa[4], fb[4], fk[4];
#pragma unroll
                    for (int s4 = 0; s4 < 4; ++s4) { fa[s4] = *(const LAS f32x4v*)(xb + 0 * 1088 + n * 68 + 16 * q4 + 4 * s4); fb[s4] = *(const LAS f32x4v*)(xb + 1 * 1088 + n * 68 + 16 * q4 + 4 * s4); fk[s4] = *(const LAS f32x4v*)(xb + 2 * 1088 + n * 68 + 16 * q4 + 4 * s4); }
#pragma unroll
                    for (int s4 = 0; s4 < 4; ++s4)
#pragma unroll
                        for (int e = 0; e < 4; ++e) { Aab = MF4(fa[s4][e], fb[s4][e], Aab); Aak = MF4(fa[s4][e], fk[s4][e], Aak); }
                    LDS_WAIT();
#pragma unroll
                    for (int c = 0; c < 4; ++c)
#pragma unroll
                        for (int i = 0; i < 4; ++i) xb[0 * 1088 + (4 * q4 + i) * 68 + 16 * c + n] = Rt[c][i];
                    LDS_WAIT();
#pragma unroll
                    for (int s4 = 0; s4 < 4; ++s4) fa[s4] = *(const LAS f32x4v*)(xb + 0 * 1088 + n * 68 + 16 * q4 + 4 * s4);
#pragma unroll
                    for (int s4 = 0; s4 < 4; ++s4)
#pragma unroll
                        for (int e = 0; e < 4; ++e) { Arb = MF4(fa[s4][e], fb[s4][e], Arb); Ark = MF4(fa[s4][e], fk[s4][e], Ark); }
                }
#pragma unroll
                for (int e = 0; e < 4; ++e) { const int tau = 4 * q4 + e; if (!(tau > n)) { Aab[e] = 0.f; Aak[e] = 0.f; } if (!(tau >= n)) { Arb[e] = 0.f; Ark[e] = 0.f; } }
                LDS_WAIT();
#pragma unroll
                for (int e = 0; e < 4; ++e) { tt[(4 * q4 + e) * 20 + n] = Aab[e]; rb[(4 * q4 + e) * 20 + n] = Arb[e]; }
                LDS_WAIT();
                f32x4v Tf, RBf;
                {
                    float Tc[16];
#pragma unroll
                    for (int tau = 0; tau < 16; ++tau) {
                        float acc = (tau == n) ? 1.0f : 0.0f;
#pragma unroll
                        for (int j4 = 0; j4 < (tau + 3) / 4; ++j4) { const f32x4v arow = *(const LAS f32x4v*)(tt + tau * 20 + 4 * j4);
#pragma unroll
                            for (int e = 0; e < 4; ++e) if (4 * j4 + e < tau) acc += arow[e] * Tc[4 * j4 + e]; }
                        Tc[tau] = acc;
                    }
                    RBf = *(const LAS f32x4v*)(rb + n * 20 + 4 * q4);
                    LDS_WAIT();
                    if (q4 == 0) {
#pragma unroll
                        for (int tau = 0; tau < 16; ++tau) tt[tau * 20 + n] = Tc[tau];
                    }
                    LDS_WAIT();
                    Tf = *(const LAS f32x4v*)(tt + n * 20 + 4 * q4);
                    LDS_WAIT();
                }
                f32x4v Ap[4], Rp[4], M1 = (f32x4v){0.f, 0.f, 0.f, 0.f}, M2 = Ark;
#pragma unroll
                for (int c = 0; c < 4; ++c) { f32x4v acc = (f32x4v){0.f, 0.f, 0.f, 0.f};
#pragma unroll
                    for (int s_ = 0; s_ < 4; ++s_) acc = MF4(Tf[s_], At[c][s_], acc);
                    Ap[c] = acc; }
#pragma unroll
                for (int s_ = 0; s_ < 4; ++s_) M1 = MF4(Tf[s_], Aak[s_], M1);
#pragma unroll
                for (int c = 0; c < 4; ++c) { f32x4v acc = (f32x4v){Rt[c][0], Rt[c][1], Rt[c][2], Rt[c][3]};
#pragma unroll
                    for (int s_ = 0; s_ < 4; ++s_) acc = MF4(RBf[s_], Ap[c][s_], acc);
                    Rp[c] = acc; }
#pragma unroll
                for (int s_ = 0; s_ < 4; ++s_) M2 = MF4(RBf[s_], M1[s_], M2);
#pragma unroll
                for (int pass = 0; pass < 2; ++pass) {
#pragma unroll
                    for (int c = 0; c < 4; ++c)
#pragma unroll
                        for (int i = 0; i < 4; ++i) { const float v_ = pass == 0 ? Ap[c][i] : Rp[c][i];
                            sa[(((c >> 1) * 4 + (n >> 2)) * 16 + 4 * q4 + i) * 8 + 4 * (c & 1) + (n & 3)] = (unsigned short)f2bf(v_); }
#pragma unroll
                    for (int e = 0; e < 4; ++e) { const float v_ = pass == 0 ? M1[e] : M2[e];
                        sa[((2 * 4 + (n >> 2)) * 16 + 4 * q4 + e) * 8 + (n & 3)] = (unsigned short)f2bf(v_); }
                    *(LAS u32x2*)(sa + ((2 * 4 + q4) * 16 + n) * 8 + 4) = (u32x2){0u, 0u};
                    LDS_WAIT();
                    bf16* dst = (bf16*)(ws + (pass == 0 ? WS_AQ : WS_RQ)) + (size_t)cid * 1536;
#pragma unroll
                    for (int s_ = 0; s_ < 3; ++s_) { const u32x4 w_ = *(const LAS u32x4*)(sa + (s_ * 64 + lane) * 8); *(u32x4*)(dst + (s_ * 64 + lane) * 8) = w_; }
                    LDS_WAIT();
                }
            }
        }
        __syncthreads();
    }
}

__device__ __forceinline__ void scan2_phase(Frame& F) {
    if (blockIdx.x >= 32 || F.wave >= 4) return;
    unsigned char* ws = F.ws;
    const int bh = blockIdx.x, wv = F.wave, lane = F.lane, col = lane & 15, q = lane >> 4;
    const int b = bh >> 3, h = bh & 7;
    const bf16* AQ = (const bf16*)(ws + WS_AQ) + (size_t)bh * 256 * 1536; const bf16* RQ = (const bf16*)(ws + WS_RQ) + (size_t)bh * 256 * 1536;
    const bf16* BKQ = (const bf16*)(ws + WS_BKQ) + (size_t)bh * 256 * 2048; const float* PC = (const float*)(ws + WS_PC) + (size_t)bh * 256 * 64;
    const bf16* VR = (const bf16*)(ws + WS_VR) + (size_t)b * SEQ * 512 + h * 64 + 16 * wv + col;
    bf16* Y = (bf16*)(ws + WS_YRAW) + (size_t)b * SEQ * 512 + h * 64 + 16 * wv + col;
    f32x4 st[4];
#pragma unroll
    for (int i = 0; i < 4; ++i) st[i] = (f32x4){0.f, 0.f, 0.f, 0.f};
    struct Ld { bf16x8 aq[3], rq[3], bk[4]; f32x4 pc[4]; unsigned short v[4]; };
    Ld cur, nxt;
#define SC_LOAD(L, ci) do { const int ci_ = (ci); \
        _Pragma("unroll") for (int s_ = 0; s_ < 3; ++s_) { L.aq[s_] = *(const bf16x8*)(AQ + (size_t)ci_ * 1536 + (s_ * 64 + lane) * 8); L.rq[s_] = *(const bf16x8*)(RQ + (size_t)ci_ * 1536 + (s_ * 64 + lane) * 8); } \
        _Pragma("unroll") for (int i_ = 0; i_ < 4; ++i_) { L.bk[i_] = *(const bf16x8*)(BKQ + (size_t)ci_ * 2048 + ((i_ * 16 + col) * 4 + q) * 8); L.pc[i_] = *(const f32x4*)(PC + (size_t)ci_ * 64 + 16 * i_ + 4 * q); \
            L.v[i_] = VR[(size_t)(ci_ * 16 + 4 * q + i_) * 512]; } } while (0)
    SC_LOAD(cur, 0);
    for (int ci = 0; ci < 256; ++ci) {
        SC_LOAD(nxt, ci + 1 < 256 ? ci + 1 : ci);
        bf16x8 sb[2];
#pragma unroll
        for (int s_ = 0; s_ < 2; ++s_) { u32x4 w_; w_.x = pg8::cvt_pk_bf16(st[2 * s_][0], st[2 * s_][1]); w_.y = pg8::cvt_pk_bf16(st[2 * s_][2], st[2 * s_][3]); w_.z = pg8::cvt_pk_bf16(st[2 * s_ + 1][0], st[2 * s_ + 1][1]); w_.w = pg8::cvt_pk_bf16(st[2 * s_ + 1][2], st[2 * s_ + 1][3]);
            sb[s_] = __builtin_bit_cast(bf16x8, w_); }
        const unsigned v01 = (unsigned)cur.v[0] | ((unsigned)cur.v[1] << 16), v23 = (unsigned)cur.v[2] | ((unsigned)cur.v[3] << 16);
        const bf16x8 vf = __builtin_bit_cast(bf16x8, ((u32x4){v01, v23, v01, v23}));
        f32x4 U = (f32x4){0.f, 0.f, 0.f, 0.f}, Yv = U;
        U = __builtin_amdgcn_mfma_f32_16x16x32_bf16(cur.aq[0], sb[0], U, 0, 0, 0); U = __builtin_amdgcn_mfma_f32_16x16x32_bf16(cur.aq[1], sb[1], U, 0, 0, 0); U = __builtin_amdgcn_mfma_f32_16x16x32_bf16(cur.aq[2], vf, U, 0, 0, 0);
        Yv = __builtin_amdgcn_mfma_f32_16x16x32_bf16(cur.rq[0], sb[0], Yv, 0, 0, 0); Yv = __builtin_amdgcn_mfma_f32_16x16x32_bf16(cur.rq[1], sb[1], Yv, 0, 0, 0); Yv = __builtin_amdgcn_mfma_f32_16x16x32_bf16(cur.rq[2], vf, Yv, 0, 0, 0);
        const bf16x8 uf = __builtin_bit_cast(bf16x8, ((u32x4){pg8::cvt_pk_bf16(U[0], U[1]), pg8::cvt_pk_bf16(U[2], U[3]), v01, v23}));
#pragma unroll
        for (int i = 0; i < 4; ++i) st[i] = __builtin_amdgcn_mfma_f32_16x16x32_bf16(cur.bk[i], uf, st[i] * cur.pc[i], 0, 0, 0);
#pragma unroll
        for (int e = 0; e < 4; ++e) Y[(size_t)(ci * 16 + 4 * q + e) * 512] = (bf16)f2bf(Yv[e]);
        cur = nxt;
    }
#undef SC_LOAD
}

__device__ __forceinline__ float dpp_sum16(float x) {
    x += __builtin_bit_cast(float, __builtin_amdgcn_update_dpp(0, __builtin_bit_cast(int, x), 0xB1, 0xf, 0xf, true));
    x += __builtin_bit_cast(float, __builtin_amdgcn_update_dpp(0, __builtin_bit_cast(int, x), 0x4E, 0xf, 0xf, true));
    x += __builtin_bit_cast(float, __builtin_amdgcn_update_dpp(0, __builtin_bit_cast(int, x), 0x141, 0xf, 0xf, true));
    x += __builtin_bit_cast(float, __builtin_amdgcn_update_dpp(0, __builtin_bit_cast(int, x), 0x140, 0xf, 0xf, true));
    return x;
}
struct ScanBlk { u32x2 r[4], k[4], kk[4], bb[4]; f32x4 w[4]; unsigned v[4]; };
__device__ __forceinline__ void scan_phase(Frame& F) {
    if (F.wave >= 2) return;
    unsigned char* ws = F.ws;
    const bf16* R = (const bf16*)(ws + WS_R); const bf16* KR = (const bf16*)(ws + WS_KR); const bf16* VR = (const bf16*)(ws + WS_VR);
    const bf16* KK = (const bf16*)(ws + WS_KK); const bf16* BB = (const bf16*)(ws + WS_BB); const float* WD = (const float*)(ws + WS_WDEC);
    bf16* Y = (bf16*)(ws + WS_YRAW);
    for (int task = blockIdx.x * 2 + F.wave; task < 512; task += F.G * 2) {
        const int bh = task >> 4, rg = task & 15, b = bh >> 3, h = bh & 7;
        const int j = F.lane & 15, rr = F.lane >> 4, vi = 4 * rg + rr;
        const size_t base = (size_t)b * SEQ * 512 + h * 64;
        const size_t o4 = base + 4 * j, ov = base + vi;
        float s0 = 0.f, s1 = 0.f, s2 = 0.f, s3 = 0.f, ysel = 0.f;
        ScanBlk cur, nxt;
#define SCAN_LOAD(B, T0) do { _Pragma("unroll") for (int u_ = 0; u_ < 4; ++u_) { const size_t rw_ = (size_t)((T0) + u_) * 512; \
            B.r[u_] = *(const u32x2*)(R + o4 + rw_); B.k[u_] = *(const u32x2*)(KR + o4 + rw_); B.kk[u_] = *(const u32x2*)(KK + o4 + rw_); B.bb[u_] = *(const u32x2*)(BB + o4 + rw_); \
            B.w[u_] = *(const f32x4*)(WD + o4 + rw_); B.v[u_] = VR[ov + rw_]; } } while (0)
        SCAN_LOAD(cur, 0);
        for (int t0 = 0; t0 < SEQ; t0 += 4) {
            const int tn = (t0 + 4 < SEQ) ? t0 + 4 : t0;
            SCAN_LOAD(nxt, tn);
#pragma unroll
            for (int u = 0; u < 4; ++u) {
                const float kk0 = bflo(cur.kk[u].x), kk1 = bfhi(cur.kk[u].x), kk2 = bflo(cur.kk[u].y), kk3 = bfhi(cur.kk[u].y);
                float sa = (s0 * kk0 + s1 * kk1) + (s2 * kk2 + s3 * kk3);
                sa = dpp_sum16(sa);
                const float v_ = __builtin_bit_cast(float, cur.v[u] << 16);
                const float b0 = bflo(cur.bb[u].x), b1 = bfhi(cur.bb[u].x), b2 = bflo(cur.bb[u].y), b3 = bfhi(cur.bb[u].y);
                const float k0 = bflo(cur.k[u].x), k1 = bfhi(cur.k[u].x), k2 = bflo(cur.k[u].y), k3 = bfhi(cur.k[u].y);
                s0 = s0 * cur.w[u][0] + (v_ * k0 - sa * b0); s1 = s1 * cur.w[u][1] + (v_ * k1 - sa * b1); s2 = s2 * cur.w[u][2] + (v_ * k2 - sa * b2); s3 = s3 * cur.w[u][3] + (v_ * k3 - sa * b3);
                const float r0 = bflo(cur.r[u].x), r1 = bfhi(cur.r[u].x), r2 = bflo(cur.r[u].y), r3 = bfhi(cur.r[u].y);
                float y = (s0 * r0 + s1 * r1) + (s2 * r2 + s3 * r3);
                y = dpp_sum16(y);
                if (((t0 + u) & 15) == j) ysel = y;
            }
            if ((t0 & 15) == 12) Y[ov + (size_t)(t0 - 12 + j) * 512] = (bf16)f2bf(ysel);
            cur = nxt;
        }
#undef SCAN_LOAD
    }
}

__device__ __forceinline__ void e1_phase(Frame& F) {
    unsigned char* ws = F.ws;
    const bf16* Y = (const bf16*)(ws + WS_YRAW); const bf16* VR = (const bf16*)(ws + WS_VR); const bf16* GB = (const bf16*)(ws + WS_GB); const float* RK = (const float*)(ws + WS_RK);
    bf16* YB = (bf16*)(ws + WS_YB);
    const float* lnw = F.in[I_LNW]; const float* lnb = F.in[I_LNB];
    const int gw = F.vcu * NWAVES + F.wave, NGW = F.G * NWAVES, c0 = F.lane * 8;
    float lw[8], lb[8];
#pragma unroll
    for (int i = 0; i < 8; ++i) { lw[i] = lnw[c0 + i]; lb[i] = lnb[c0 + i]; }
    for (int m = gw; m < M; m += NGW) {
        const size_t o = (size_t)m * 512 + c0;
        const u32x4 yw = *(const u32x4*)(Y + o), vw = *(const u32x4*)(VR + o), gw_ = *(const u32x4*)(GB + o);
        const float rk = RK[(size_t)m * 8 + (F.lane >> 3)];
        float y[8] = { bflo(yw.x), bfhi(yw.x), bflo(yw.y), bfhi(yw.y), bflo(yw.z), bfhi(yw.z), bflo(yw.w), bfhi(yw.w) };
        const float v[8] = { bflo(vw.x), bfhi(vw.x), bflo(vw.y), bfhi(vw.y), bflo(vw.z), bfhi(vw.z), bflo(vw.w), bfhi(vw.w) };
        const float g[8] = { bflo(gw_.x), bfhi(gw_.x), bflo(gw_.y), bfhi(gw_.y), bflo(gw_.z), bfhi(gw_.z), bflo(gw_.w), bfhi(gw_.w) };
        float s = 0.f;
#pragma unroll
        for (int i = 0; i < 8; ++i) s += y[i];
        s += __shfl_xor(s, 1); s += __shfl_xor(s, 2); s += __shfl_xor(s, 4);
        const float mu = s * (1.0f / 64.0f); float q = 0.f;
#pragma unroll
        for (int i = 0; i < 8; ++i) { y[i] -= mu; q += y[i] * y[i]; }
        q += __shfl_xor(q, 1); q += __shfl_xor(q, 2); q += __shfl_xor(q, 4);
        const float rstd = 1.0f / sqrtf(q * (1.0f / 64.0f) + 64.0f * 1e-5f);
        float ov[8];
#pragma unroll
        for (int i = 0; i < 8; ++i) ov[i] = (y[i] * rstd * lw[i] + lb[i] + rk * v[i]) * g[i];
        u32x4 w; w.x = pk2(ov[0], ov[1]); w.y = pk2(ov[2], ov[3]); w.z = pk2(ov[4], ov[5]); w.w = pk2(ov[6], ov[7]);
        *(u32x4*)(YB + o) = w;
    }
}

__device__ __forceinline__ void fin_phase(Frame& F) {
    const f32x4* gf = (const f32x4*)F.in[I_NFIN] + F.lane;
    const int gw = F.vcu * NWAVES + F.wave, NGW = F.G * NWAVES;
    f32x4 gg[4];
#pragma unroll
    for (int j = 0; j < 4; ++j) gg[j] = gf[64 * j];
    for (int m = gw; m < M; m += NGW) {
        f32x4* xr = (f32x4*)(F.out + (size_t)m * D) + F.lane; f32x4 v[4]; float s = 0.f;
#pragma unroll
        for (int j = 0; j < 4; ++j) { v[j] = xr[64 * j]; s += (v[j].x * v[j].x + v[j].y * v[j].y) + (v[j].z * v[j].z + v[j].w * v[j].w); }
        s = wave_sum(s);
        const float rs = 1.0f / sqrtf(s * (1.0f / D) + RMS_EPS);
#pragma unroll
        for (int j = 0; j < 4; ++j) xr[64 * j] = v[j] * rs * gg[j];
    }
}


#ifdef DBG_OUT
__device__ __forceinline__ void dbg_phase(Frame& F) {
    const int gw = F.vcu * NWAVES + F.wave, NGW = F.G * NWAVES;
    for (int m = gw; m < M; m += NGW) {
        float* o = F.out + (size_t)m * D;
        for (int c = F.lane; c < D; c += 64) {
            bf16 v;
            if (DBG_OUT == 1) v = ((const bf16*)(F.ws + WS_MRG))[(size_t)m * D + c];
            else if (DBG_OUT == 2) v = ((const bf16*)(F.ws + WS_SGA))[(size_t)m * D + c];
            else if (DBG_OUT == 3) v = c < 512 ? ((const bf16*)(F.ws + WS_Q))[(size_t)m * 512 + c] : ((const bf16*)(F.ws + WS_K))[(size_t)m * 512 + c - 512];
            else if (DBG_OUT == 4) v = c < 512 ? ((const bf16*)(F.ws + WS_V))[(size_t)m * 512 + c] : ((const bf16*)(F.ws + WS_R))[(size_t)m * 512 + c - 512];
            else if (DBG_OUT == 5) v = c < 512 ? ((const bf16*)(F.ws + WS_KR))[(size_t)m * 512 + c] : ((const bf16*)(F.ws + WS_VR))[(size_t)m * 512 + c - 512];
            else if (DBG_OUT == 6) v = c < 768 ? ((const bf16*)(F.ws + WS_Z))[(size_t)m * ZP + c] : (bf16)0;
            else if (DBG_OUT == 7) v = ((const bf16*)(F.ws + WS_SGB))[(size_t)m * D + c];
            else if (DBG_OUT == 9) v = ((const bf16*)(F.ws + WS_WG))[(size_t)(m & 2047) * D + c];
            else v = ((const bf16*)(F.ws + WS_XB))[(size_t)m * D + c];
            o[c] = bf2f(v);
        }
    }
}
#endif
struct Args { const float* in[31]; float* out; unsigned char* ws; int ph_lo, ph_hi; };
constexpr int N_PHASES = 14;

#ifndef MK_N_LAUNCHES
#define MK_N_LAUNCHES 1
#endif

__global__ void __launch_bounds__(NWAVES * 64, 2) mk_fwd(Args args) {
    extern __shared__ __attribute__((aligned(16))) unsigned char lds[];
    Frame F;
    F.lds = (LAS unsigned char*)lds; F.MISC = (volatile LAS unsigned*)(F.lds + MISC_OFF);
    F.tid = threadIdx.x; F.lane = F.tid & 63; F.wave = __builtin_amdgcn_readfirstlane(F.tid >> 6);
    F.G = gridDim.x; { const int bx = blockIdx.x; F.vcu = (F.G % 8 == 0) ? (bx % 8) * (F.G / 8) + bx / 8 : bx; }
    F.in = args.in;
    F.out = args.out; F.ws = args.ws; F.ctl = (unsigned*)(args.ws + WS_CTL);
    unsigned char* ws = args.ws;
    for (int u = F.tid; u < (LDS_BYTES - LDSCTL_OFF) / 4; u += NWAVES * 64) ((LAS unsigned*)(F.lds + LDSCTL_OFF))[u] = 0u;
    __syncthreads();
    XcdBarrier bar; bar.bar = F.ctl + CW_BAR; bar.x = 0; bar.st = nullptr;
    if (MK_N_LAUNCHES == 1) bar = xcd_barrier_post(F.ctl + CW_BAR, F.MISC + 8);
    const int lo = args.ph_lo, hi = args.ph_hi;
#ifndef PH_MASK
#define PH_MASK 0xFFFFFFFFu
#endif
#define IN(k) (((PH_MASK >> (k)) & 1u) && lo <= (k) && (k) < hi)
#define SEAM(k) do { if (IN(k) && IN((k) + 1)) xcd_barrier(bar); } while (0)
    float* ssq1 = (float*)(ws + OFF_SSQ1); float* ssq2 = (float*)(ws + WS_SSQ2); float* ssq3 = (float*)(ws + WS_SSQ3);
#ifdef SKIP_MID
    ssq3 = ssq2;
#endif
    bf16* XB = (bf16*)(ws + WS_XB); bf16* ACT = (bf16*)(ws + WS_ACT);
    const int bx = (int)blockIdx.x;

    if (IN(0)) { p0_prologue(F); } SEAM(0);
    if (IN(1)) { pg8::Gemm g{XB, (const bf16*)(ws + WS_WGU1), M, N_GU, D}; pg8::StaticOrder S; S.init(M, N_GU, F.G, bx);
        pg8::EpiSwiGLU<1> E{ACT, FF, ssq1}; pg8::gemm_phase<pg8::EpiSwiGLU<1>, pg8::StaticOrder, true, true>(F.lds + RING_OFF, g, S, E); } SEAM(1);
    if (IN(2)) { pg8::Gemm g{ACT, (const bf16*)(ws + WS_WD1), M, D, FF}; pg8::StaticOrder S; S.init(M, D, F.G, bx);
        pg8::EpiResid E{F.in[I_X], F.out, XB, ssq2, 0.5f}; pg8::gemm_phase<pg8::EpiResid, pg8::StaticOrder, true, true>(F.lds + RING_OFF, g, S, E); } SEAM(2);
    if (IN(3)) { pg8::Gemm g{XB, (const bf16*)(ws + WS_WIN), M, N_IN, D}; pg8::StaticOrder S; S.init(M, N_IN, F.G, bx);
        pg8::EpiProj E{(bf16*)(ws + WS_Q), (bf16*)(ws + WS_Z), ssq2, (float*)(ws + OFF_KMEAN), (bf16*)(ws + WS_BND)};
        pg8::gemm_phase<pg8::EpiProj, pg8::StaticOrder, true, true>(F.lds + RING_OFF, g, S, E); } SEAM(3);
#ifdef ATT_SIMPLE
    if (IN(4)) { attn_simple(F); } SEAM(4);
#else
    if (IN(4)) { const attn_body::AttnTensors AT{(const bf16*)(ws + WS_Q), (const bf16*)(ws + WS_K), (const bf16*)(ws + WS_V), (bf16*)(ws + WS_Q), (const float*)(ws + OFF_KMEAN), F.in[I_RELB]};
        const attn_body::StaticOrder S((int)F.G, bx); attn_body::attn_phase<attn_body::StaticOrder>((char*)lds + RING_OFF, AT, S); } SEAM(4);
#endif
#ifdef SCAN_DIRECT
    if (IN(5)) { mix_phase(F); } SEAM(5);
    if (IN(6)) { scan_phase(F); } SEAM(6);
#else
    if (IN(5)) { mixc_phase(F); } SEAM(5);
    if (IN(6)) { scan2_phase(F); } SEAM(6);
#endif
    if (IN(7)) { e1_phase(F);
        pg8::Gemm g{XB, (const bf16*)(ws + WS_WG), M, N_GATE, D}; pg8::StaticOrder S; S.init(M, N_GATE, F.G, bx);
        pg8::EpiGate<0> E{(bf16*)(ws + WS_SGA), nullptr, (bf16*)(ws + WS_SGB), ssq2}; pg8::gemm_phase<pg8::EpiGate<0>, pg8::StaticOrder, true, true>(F.lds + RING_OFF, g, S, E); } SEAM(7);
    if (IN(8)) { pg8::Gemm g{(const bf16*)(ws + WS_Q), (const bf16*)(ws + WS_WA), M, D, 512}; pg8::StaticOrder S; S.init(M, D, F.G, bx);
        pg8::EpiGate<1> E{(bf16*)(ws + WS_MRG), (const bf16*)(ws + WS_SGA), nullptr, nullptr}; pg8::gemm_phase<pg8::EpiGate<1>, pg8::StaticOrder, true, true>(F.lds + RING_OFF, g, S, E); } SEAM(8);
    if (IN(9)) { pg8::Gemm g{(const bf16*)(ws + WS_YB), (const bf16*)(ws + WS_WB), M, D, 512}; pg8::StaticOrder S; S.init(M, D, F.G, bx);
        pg8::EpiGate<2> E{(bf16*)(ws + WS_MRG), (const bf16*)(ws + WS_SGB), nullptr, nullptr}; pg8::gemm_phase<pg8::EpiGate<2>, pg8::StaticOrder, true, true>(F.lds + RING_OFF, g, S, E); } SEAM(9);
    if (IN(10)) { pg8::Gemm g{(const bf16*)(ws + WS_MRG), (const bf16*)(ws + WS_WOUT), M, D, D}; pg8::StaticOrder S; S.init(M, D, F.G, bx);
        pg8::EpiResid E{F.out, F.out, XB, ssq3, 1.0f}; pg8::gemm_phase<pg8::EpiResid, pg8::StaticOrder, true, true>(F.lds + RING_OFF, g, S, E); } SEAM(10);
    if (IN(11)) { pg8::Gemm g{XB, (const bf16*)(ws + WS_WGU2), M, N_GU, D}; pg8::StaticOrder S; S.init(M, N_GU, F.G, bx);
        pg8::EpiSwiGLU<16> E{ACT, FF, ssq3}; pg8::gemm_phase<pg8::EpiSwiGLU<16>, pg8::StaticOrder, true, true>(F.lds + RING_OFF, g, S, E); } SEAM(11);
    if (IN(12)) { pg8::Gemm g{ACT, (const bf16*)(ws + WS_WD2), M, D, FF}; pg8::StaticOrder S; S.init(M, D, F.G, bx);
        pg8::EpiResid E{F.out, F.out, nullptr, nullptr, 0.5f}; pg8::gemm_phase<pg8::EpiResid, pg8::StaticOrder, true, true>(F.lds + RING_OFF, g, S, E); } SEAM(12);
#ifdef DBG_OUT
    if (IN(13)) { dbg_phase(F); }
#else
    if (IN(13)) { fin_phase(F); }
#endif
#undef IN
#undef SEAM
}

extern "C" void kernel_launch(void* const* d_in, const int* in_sizes, int n_in, void* d_out, int out_size, void* d_ws, size_t ws_size, hipStream_t stream) {
    static int grid = 0;
    if (grid == 0) {
        if (n_in != 31 || out_size != M * D || ws_size < WS_END) { fprintf(stderr, "kernel_launch: unexpected shapes: n_in %d out %d ws %zu\n", n_in, out_size, ws_size); grid = -1; return; }
        int dev = 0, cus = 0;
        if (hipGetDevice(&dev) != hipSuccess || hipDeviceGetAttribute(&cus, hipDeviceAttributeMultiprocessorCount, dev) != hipSuccess) { grid = -1; return; }
        if (hipFuncSetAttribute((const void*)mk_fwd, hipFuncAttributeMaxDynamicSharedMemorySize, LDS_BYTES) != hipSuccess) { fprintf(stderr, "kernel_launch: hipFuncSetAttribute failed\n"); grid = -1; return; }
        int per_cu = 0;
        if (hipOccupancyMaxActiveBlocksPerMultiprocessor(&per_cu, (const void*)mk_fwd, NWAVES * 64, LDS_BYTES) != hipSuccess || per_cu < 1) fprintf(stderr, "kernel_launch: occupancy query says %d\n", per_cu);
        (void)hipGetLastError();
        grid = cus;
    }
    if (grid < 0) return;
    (void)hipMemsetAsync((char*)d_ws + WS_CTL, 0, CTL_ZERO_BYTES, stream);
    Args a{};
    for (int i = 0; i < 31; ++i) a.in[i] = (const float*)d_in[i];
    a.out = (float*)d_out; a.ws = (unsigned char*)d_ws;
#if MK_N_LAUNCHES == 1
    a.ph_lo = 0; a.ph_hi = N_PHASES;
    hipLaunchKernelGGL(mk_fwd, dim3(grid), dim3(NWAVES * 64), LDS_BYTES, stream, a);
#else
    for (int p = 0; p < N_PHASES; ++p) { a.ph_lo = p; a.ph_hi = p + 1; hipLaunchKernelGGL(mk_fwd, dim3(grid), dim3(NWAVES * 64), LDS_BYTES, stream, a); }
#endif
}
```

```cpp
#include <hip/hip_runtime.h>
#include <cstdio>
#include <cstdint>

#define LAS __attribute__((address_space(3)))
#define GAS __attribute__((address_space(1)))
typedef unsigned short bf16;
typedef short bf16x8 __attribute__((ext_vector_type(8)));
typedef float f32x4 __attribute__((ext_vector_type(4)));
typedef float f32x2 __attribute__((ext_vector_type(2)));
typedef unsigned u32x4 __attribute__((ext_vector_type(4)));
typedef unsigned u32x2 __attribute__((ext_vector_type(2)));

constexpr int M = 16384, D = 1024, FF = 2816, SEQ = 4096, NBATCH = 4, NH = 8, HD = 64, WR = 512;
constexpr int N_GU = 2 * FF;
constexpr int N_IN = 3840;
constexpr int N_GATE = 2048;
constexpr int ZP = 768;
constexpr float RMS_EPS = 1e-6f;
constexpr float LOG2E = 1.4426950408889634f;
constexpr float C2 = 0.125f * LOG2E;

constexpr size_t MiB = 1u << 20;
constexpr size_t WS_CTL = 0, CTL_ZERO_BYTES = 1 * MiB;
constexpr int CW_TMO = 0, CW_BAR = 4096;
constexpr size_t OFF_SSQ1 = 65536, OFF_SSQ2 = 131072, OFF_SSQ3 = 196608, OFF_SSQ4 = 262144, OFF_KMEAN = 327680;
constexpr size_t WS_RK = 1 * MiB;
constexpr size_t WS_BND = 1 * MiB + 512 * 1024;
constexpr size_t WS_WGU1 = 2 * MiB, WS_WD1 = 13 * MiB, WS_WIN = 18 * MiB + 512 * 1024, WS_WG = 26 * MiB, WS_WA = 30 * MiB, WS_WB = 31 * MiB,
                 WS_WOUT = 32 * MiB, WS_WGU2 = 34 * MiB, WS_WD2 = 45 * MiB, WS_LBW = 50 * MiB + 512 * 1024, WS_LBA = WS_LBW + 65536, WS_LBG = WS_LBA + 65536;
constexpr size_t WS_XB = 51 * MiB;
constexpr size_t WS_ACT = 83 * MiB;
constexpr size_t WS_Q = 83 * MiB, WS_K = 99 * MiB, WS_V = 115 * MiB, WS_R = 131 * MiB, WS_KR = 147 * MiB, WS_VR = 163 * MiB;
constexpr size_t WS_Z = 179 * MiB;
constexpr size_t WS_WDEC = 203 * MiB;
constexpr size_t WS_GB = 235 * MiB;
constexpr size_t WS_KK = WS_K, WS_BB = WS_V;
constexpr size_t WS_YRAW = WS_Z;
constexpr size_t WS_YB = WS_R;
constexpr size_t WS_SGA = 99 * MiB, WS_SGB = 203 * MiB;
constexpr size_t WS_MRG = 147 * MiB;
constexpr size_t WS_AQ = 2 * MiB;
constexpr size_t WS_BKQ = 99 * MiB;
constexpr size_t WS_RQ = 203 * MiB;
constexpr size_t WS_PC = 227 * MiB;
constexpr size_t WS_SSQ2 = 251 * MiB, WS_SSQ3 = 252 * MiB, WS_SSQ4 = 253 * MiB;
constexpr size_t WS_END = 256 * MiB;

__device__ __forceinline__ unsigned f2bf(float f) { unsigned u = __builtin_bit_cast(unsigned, f); return (u + 0x7fffu + ((u >> 16) & 1u)) >> 16; }
__device__ __forceinline__ unsigned pk2(float lo, float hi) { return f2bf(lo) | (f2bf(hi) << 16); }
__device__ __forceinline__ float bflo(unsigned w) { return __builtin_bit_cast(float, w << 16); }
__device__ __forceinline__ float bfhi(unsigned w) { return __builtin_bit_cast(float, w & 0xffff0000u); }
__device__ __forceinline__ float bf2f(bf16 h) { return __builtin_bit_cast(float, (unsigned)h << 16); }
__device__ __forceinline__ float fast_exp2(float x) { return __builtin_amdgcn_exp2f(x); }
__device__ __forceinline__ float fast_rcp(float x) { return __builtin_amdgcn_rcpf(x); }
__device__ __forceinline__ float sigmoidf_(float x) { return fast_rcp(1.0f + fast_exp2(-x * LOG2E)); }
#define LDS_WAIT() asm volatile("s_waitcnt lgkmcnt(0)" ::: "memory")
#define VM_WAIT() asm volatile("s_waitcnt vmcnt(0)" ::: "memory")

namespace pg8 {
#define PG8_LAS __attribute__((address_space(3)))
typedef unsigned short bf16_t;
constexpr int BM = 256, BK = 64, HALF = 128, HTB = HALF * BK * 2, STAGE_BYTES = 8 * HTB, NXCD = 8, WGM = 8;
__host__ __device__ __forceinline__ int lds_byte(int r, int c) { const int st = (r >> 4) * 2 + (c >> 5), rr = r & 15, cc = c & 31, ob = rr * 64 + cc * 2; return st * 1024 + (ob ^ (((ob >> 9) & 1) << 5)); }
__host__ __device__ __forceinline__ void stage_rc(int b, int& R, int& C) { const int st = b / 1024, sb = b % 1024, swz = sb ^ (((sb >> 9) & 1) << 5); R = (st >> 1) * 16 + swz / 64; C = (st & 1) * 32 + (swz % 64) / 2; }
__host__ __device__ __forceinline__ int perm32(int rho) { const int n = rho >> 4, i = rho & 15; return 8 * (i >> 2) + 4 * n + (i & 3); }
struct Unit { int pm, pn; };
struct Gemm { const bf16_t* A; const bf16_t* Bt; int M, N, K; };
struct StaticOrder {
    int nM, nN, nwg, G, c;
    __host__ __device__ void init(int M_, int N_, int G_, int c_) { nM = M_ / BM; nN = N_ / BM; nwg = nM * nN; G = G_; c = c_; }
    __host__ __device__ bool next(int i, Unit& u) const {
        const long L = (long)i * G + c; if (L >= nwg) return false;
        int wgid = (int)L; { const int q = nwg / NXCD, r = nwg % NXCD, xcd = wgid % NXCD, off = wgid / NXCD; wgid = (xcd < r ? xcd * (q + 1) : r * (q + 1) + (xcd - r) * q) + off; }
        const int nig = WGM * nN, gid = wgid / nig, fm = gid * WGM, gsz = (nM - fm) < WGM ? (nM - fm) : WGM;
        u.pm = fm + ((wgid % nig) % gsz); u.pn = (wgid % nig) / gsz; return true;
    }
    __device__ __forceinline__ void a_ready(const Unit&) const {}
    __device__ __forceinline__ void done(const Unit&) const {}
};
typedef __bf16 bf16x2_t __attribute__((ext_vector_type(2)));
__device__ __forceinline__ unsigned cvt_pk_bf16(float lo, float hi) { const f32x2 v = {lo, hi}; const bf16x2_t b = __builtin_convertvector(v, bf16x2_t); return __builtin_bit_cast(unsigned, b); }


template <int NP> __device__ __forceinline__ float row_ssq(const float* p, int row) {
    if (NP == 1) return p[row];
    const f32x4* q = (const f32x4*)(p + (size_t)row * 16); const f32x4 a = q[0], b = q[1], c = q[2], d = q[3];
    return (((a[0] + a[1]) + (a[2] + a[3])) + ((b[0] + b[1]) + (b[2] + b[3]))) + (((c[0] + c[1]) + (c[2] + c[3])) + ((d[0] + d[1]) + (d[2] + d[3])));
}
template <int NP> struct EpiSwiGLU {
    static constexpr bool PERM = true, AFTER_DRAIN = false;
    bf16_t* O; int ldc; const float* ssq;
    __device__ __forceinline__ void operator()(const f32x4 (&acc)[2][2][4][2], const Unit& u, int wr, int wc, int fr, int fq) const {
        const int row0 = u.pm * BM + wr * 64 + fr, col0 = u.pn * 128 + wc * 32 + 8 * fq;
#pragma unroll
        for (int ai = 0; ai < 2; ++ai)
#pragma unroll
            for (int m = 0; m < 4; ++m) {
                const int row = row0 + ai * HALF + m * 16;
                const float rs = 1.0f / sqrtf(row_ssq<NP>(ssq, row) * (1.0f / D) + RMS_EPS);
                float o[8];
#pragma unroll
                for (int n = 0; n < 2; ++n)
#pragma unroll
                    for (int i = 0; i < 4; ++i) { const float g = acc[ai][0][m][n][i] * rs, up = acc[ai][1][m][n][i] * rs; o[n * 4 + i] = g * sigmoidf_(g) * up; }
                u32x4 w; w.x = cvt_pk_bf16(o[0], o[1]); w.y = cvt_pk_bf16(o[2], o[3]); w.z = cvt_pk_bf16(o[4], o[5]); w.w = cvt_pk_bf16(o[6], o[7]);
                *(u32x4*)(O + (size_t)row * ldc + col0) = w;
            }
    }
};
struct EpiResid {
    static constexpr bool PERM = false, AFTER_DRAIN = false;
    const float* xin; float* xout; bf16_t* xb; float* ssq; float alpha;
    __device__ __forceinline__ void operator()(const f32x4 (&acc)[2][2][4][2], const Unit& u, int wr, int wc, int fr, int fq) const {
        const int row0 = u.pm * BM + wr * 64 + fr, col0 = u.pn * BM + wc * 32 + 4 * fq;
#pragma unroll
        for (int ai = 0; ai < 2; ++ai)
#pragma unroll
            for (int m = 0; m < 4; ++m) {
                const int row = row0 + ai * HALF + m * 16; const size_t off = (size_t)row * D + col0; float s = 0.f;
#pragma unroll
                for (int bj = 0; bj < 2; ++bj)
#pragma unroll
                    for (int n = 0; n < 2; ++n) {
                        const f32x4 v = *(const f32x4*)(xin + off + bj * HALF + n * 16) + acc[ai][bj][m][n] * alpha;
                        *(f32x4*)(xout + off + bj * HALF + n * 16) = v;
                        s += (v[0] * v[0] + v[1] * v[1]) + (v[2] * v[2] + v[3] * v[3]);
                        if (xb) { u32x2 w; w.x = cvt_pk_bf16(v[0], v[1]); w.y = cvt_pk_bf16(v[2], v[3]); *(u32x2*)(xb + off + bj * HALF + n * 16) = w; }
                    }
                s += __shfl_xor(s, 16); s += __shfl_xor(s, 32);
                if (fq == 0 && ssq) ssq[(size_t)row * 16 + u.pn * 4 + wc] = s;
                asm volatile("" ::: "memory");
            }
    }
};
struct EpiProj {
    static constexpr bool PERM = true, AFTER_DRAIN = false;
    bf16_t* arr0; bf16_t* zbuf; const float* ssq; float* kmean; bf16_t* bnd;
    __device__ __forceinline__ void operator()(const f32x4 (&acc)[2][2][4][2], const Unit& u, int wr, int wc, int fr, int fq) const {
        const int pn = u.pn; const int row0 = u.pm * BM + wr * 64 + fr;
        bf16_t* dst; int pitch, colt;
        if (pn < 12) { dst = arr0 + (size_t)(pn >> 1) * ((size_t)M * 512); pitch = 512; colt = (pn & 1) * 256; } else { dst = zbuf; pitch = ZP; colt = (pn - 12) * 256; }
        const float sc = (pn < 2) ? C2 : 1.0f; const int col0 = colt + wc * 32 + 8 * fq;
        const bool is_k = (pn == 2 || pn == 3), is_rkv = (pn >= 6 && pn < 12);
        float cs[2][8];
#pragma unroll
        for (int bj = 0; bj < 2; ++bj)
#pragma unroll
            for (int i = 0; i < 8; ++i) cs[bj][i] = 0.f;
#pragma unroll
        for (int ai = 0; ai < 2; ++ai)
#pragma unroll
            for (int m = 0; m < 4; ++m) {
                const int row = row0 + ai * HALF + m * 16;
                const float rs = sc / sqrtf(row_ssq<16>(ssq, row) * (1.0f / D) + RMS_EPS);
#pragma unroll
                for (int bj = 0; bj < 2; ++bj) {
                    float o[8];
#pragma unroll
                    for (int n = 0; n < 2; ++n)
#pragma unroll
                        for (int i = 0; i < 4; ++i) { o[n * 4 + i] = acc[ai][bj][m][n][i] * rs; cs[bj][n * 4 + i] += o[n * 4 + i]; }
                    u32x4 w; w.x = cvt_pk_bf16(o[0], o[1]); w.y = cvt_pk_bf16(o[2], o[3]); w.z = cvt_pk_bf16(o[4], o[5]); w.w = cvt_pk_bf16(o[6], o[7]);
                    *(u32x4*)(dst + (size_t)row * pitch + col0 + bj * HALF) = w;
                    if (is_rkv && ai == 1 && m == 3 && wr == 1 && fr == 15) *(u32x4*)(bnd + (size_t)u.pm * 1536 + (pn - 6) * 256 + wc * 32 + 8 * fq + bj * HALF) = w;
                }
            }
        if (is_k) {
#pragma unroll
            for (int bj = 0; bj < 2; ++bj)
#pragma unroll
                for (int i = 0; i < 8; ++i) { float v = cs[bj][i]; v += __shfl_xor(v, 1); v += __shfl_xor(v, 2); v += __shfl_xor(v, 4); v += __shfl_xor(v, 8);
                    if (fr == 0) { const int col = (pn - 2) * 256 + bj * HALF + wc * 32 + 8 * fq + i; atomicAdd(kmean + ((size_t)((u.pm >> 4) * NH + (col >> 6)) * 16 + (u.pm & 15)) * 64 + (col & 63), v); } }
        }
    }
};
template <int MODE> struct EpiGate {
    static constexpr bool PERM = true, AFTER_DRAIN = false;
    bf16_t* out; const bf16_t* gate; bf16_t* out2; const float* ssq;
    __device__ __forceinline__ void operator()(const f32x4 (&acc)[2][2][4][2], const Unit& u, int wr, int wc, int fr, int fq) const {
        const int row0 = u.pm * BM + wr * 64 + fr; int pn = u.pn; bf16_t* dst = out;
        if (MODE == 0 && pn >= 4) { pn -= 4; dst = out2; }
        const int col0 = pn * BM + wc * 32 + 8 * fq;
#pragma unroll
        for (int ai = 0; ai < 2; ++ai)
#pragma unroll
            for (int m = 0; m < 4; ++m) {
                const int row = row0 + ai * HALF + m * 16;
                float rs = 1.0f; if (MODE == 0) rs = 1.0f / sqrtf(row_ssq<16>(ssq, row) * (1.0f / D) + RMS_EPS);
#pragma unroll
                for (int bj = 0; bj < 2; ++bj) {
                    const size_t off = (size_t)row * D + col0 + bj * HALF; float o[8];
#pragma unroll
                    for (int n = 0; n < 2; ++n)
#pragma unroll
                        for (int i = 0; i < 4; ++i) o[n * 4 + i] = acc[ai][bj][m][n][i];
                    if (MODE == 0) {
#pragma unroll
                        for (int i = 0; i < 8; ++i) o[i] = sigmoidf_(o[i] * rs);
                    } else {
                        const u32x4 g = *(const u32x4*)(gate + off);
                        o[0] *= bflo(g.x); o[1] *= bfhi(g.x); o[2] *= bflo(g.y); o[3] *= bfhi(g.y); o[4] *= bflo(g.z); o[5] *= bfhi(g.z); o[6] *= bflo(g.w); o[7] *= bfhi(g.w);
                        if (MODE == 2) { const u32x4 p = *(const u32x4*)(dst + off);
                            o[0] += bflo(p.x); o[1] += bfhi(p.x); o[2] += bflo(p.y); o[3] += bfhi(p.y); o[4] += bflo(p.z); o[5] += bfhi(p.z); o[6] += bflo(p.w); o[7] += bfhi(p.w); }
                    }
                    u32x4 w; w.x = cvt_pk_bf16(o[0], o[1]); w.y = cvt_pk_bf16(o[2], o[3]); w.z = cvt_pk_bf16(o[4], o[5]); w.w = cvt_pk_bf16(o[6], o[7]);
                    *(u32x4*)(dst + off) = w;
                }
            }
    }
};

template <class Epi, class Sched, bool ALIGN_EPI = false, bool SP2 = false>
__device__ __forceinline__ void gemm_phase(PG8_LAS unsigned char* lds, const Gemm g, const Sched& S, const Epi& E) {
    const int tid = threadIdx.x, wid = __builtin_amdgcn_readfirstlane(tid >> 6), lane = tid & 63, wr = wid >> 2, wc = wid & 3, fr = lane & 15, fq = lane >> 4;
    const int K = g.K, nt = K / BK;
    unsigned voffA[2], voffB[2];
#pragma unroll
    for (int i = 0; i < 2; ++i) { int R, C; stage_rc(tid * 16 + i * 8192, R, C); const int Rb = Epi::PERM ? ((R & ~31) + perm32(R & 31)) : R;
        voffA[i] = (unsigned)(R * K + C) * 2u; voffB[i] = (unsigned)(Rb * K + C) * 2u; }
    const size_t kstep = (size_t)(BK * 2);
    const size_t hstep = (size_t)HALF * K * 2;
    const size_t tstep = 2 * hstep;
    const unsigned ldsw = (unsigned)wid * 1024u;
    const int aoff = lds_byte(wr * 64 + fr, fq * 8), boff = lds_byte(wc * 32 + fr, fq * 8);
#define PG8_SA(b, h) (((b) * 2 + (h)) * HTB)
#define PG8_SB(b, h) ((4 + (b) * 2 + (h)) * HTB)
#define PG8_STAGE(bufoff, gbase, voff) do { _Pragma("unroll") for (int _i = 0; _i < 2; ++_i) \
        __builtin_amdgcn_global_load_lds((const unsigned*)((const char*)(gbase) + (voff)[_i]), (PG8_LAS unsigned*)(lds + (bufoff) + ldsw + _i * 8192), 16, 0, 0); } while (0)
#define PG8_LDA(dst, b, h) do { _Pragma("unroll") for (int m = 0; m < 4; ++m) _Pragma("unroll") for (int k = 0; k < 2; ++k) dst[m][k] = *(const PG8_LAS bf16x8*)(lds + PG8_SA(b, h) + aoff + m * 2048 + k * 1024); } while (0)
#define PG8_LDB(dst, b, h) do { _Pragma("unroll") for (int n = 0; n < 2; ++n) _Pragma("unroll") for (int k = 0; k < 2; ++k) dst[n][k] = *(const PG8_LAS bf16x8*)(lds + PG8_SB(b, h) + boff + n * 2048 + k * 1024); } while (0)
#define PG8_MMA(ai, bj, At, Bt) do { __builtin_amdgcn_s_setprio(1); _Pragma("unroll") for (int m = 0; m < 4; ++m) _Pragma("unroll") for (int n = 0; n < 2; ++n) _Pragma("unroll") for (int k = 0; k < 2; ++k) \
        acc[ai][bj][m][n] = __builtin_amdgcn_mfma_f32_16x16x32_bf16(Bt[n][k], At[m][k], acc[ai][bj][m][n], 0, 0, 0); __builtin_amdgcn_s_setprio(0); } while (0)
#define PG8_WAIT_V(n) asm volatile("s_waitcnt vmcnt(" #n ")" ::: "memory")
#define PG8_WAIT_L(n) asm volatile("s_waitcnt lgkmcnt(" #n ")" ::: "memory")
#define PG8_BAR __builtin_amdgcn_s_barrier()
#define PG8_SCHED __builtin_amdgcn_sched_barrier(0)
    Unit cur, nxt; int ui = 0;
    if (!S.next(0, cur)) return;
    f32x4 acc[2][2][4][2];
#pragma unroll
    for (int a = 0; a < 2; ++a)
#pragma unroll
        for (int b = 0; b < 2; ++b)
#pragma unroll
            for (int m = 0; m < 4; ++m)
#pragma unroll
                for (int n = 0; n < 2; ++n) acc[a][b][m][n] = (f32x4){0.f, 0.f, 0.f, 0.f};
    bf16x8 At[4][2], B0[2][2], B1[2][2];
    const char* cA = (const char*)g.A + (size_t)cur.pm * tstep; const char* cB = (const char*)g.Bt + (size_t)cur.pn * tstep;
    S.a_ready(cur);
    if constexpr (SP2) {
        PG8_STAGE(PG8_SB(0, 0), cB, voffB); PG8_STAGE(PG8_SB(0, 1), cB + hstep, voffB); PG8_STAGE(PG8_SA(0, 0), cA, voffA); PG8_STAGE(PG8_SA(0, 1), cA + hstep, voffA);
        if (wr == 1) PG8_BAR;
        PG8_WAIT_V(2); PG8_BAR;
        PG8_STAGE(PG8_SB(1, 0), cB + kstep, voffB); PG8_STAGE(PG8_SA(1, 0), cA + kstep, voffA); PG8_STAGE(PG8_SB(1, 1), cB + hstep + kstep, voffB);
        PG8_WAIT_V(6); PG8_BAR;
    } else {
        PG8_STAGE(PG8_SB(0, 0), cB, voffB); PG8_STAGE(PG8_SA(0, 0), cA, voffA); PG8_STAGE(PG8_SB(0, 1), cB + hstep, voffB); PG8_STAGE(PG8_SA(0, 1), cA + hstep, voffA);
        if (wr == 1) PG8_BAR;
        PG8_WAIT_V(4); PG8_BAR;
        PG8_STAGE(PG8_SB(1, 0), cB + kstep, voffB); PG8_STAGE(PG8_SA(1, 0), cA + kstep, voffA); PG8_STAGE(PG8_SB(1, 1), cB + hstep + kstep, voffB);
        PG8_WAIT_V(6); PG8_BAR;
    }
    for (;;) {
        const bool has_next = S.next(ui + 1, nxt);
        const char* nA = has_next ? (const char*)g.A + (size_t)nxt.pm * tstep : cA; const char* nB = has_next ? (const char*)g.Bt + (size_t)nxt.pn * tstep : cB;
        for (int t = 0; t < nt; t += 2) {
            const bool last = (t == nt - 2);
            const char* a1 = cA + (size_t)(t + 1) * kstep;
            const char* a2 = last ? nA : cA + (size_t)(t + 2) * kstep; const char* b2 = last ? nB : cB + (size_t)(t + 2) * kstep;
            const char* a3 = a2 + kstep; const char* b3 = b2 + kstep;
            if (last && has_next) S.a_ready(nxt);
            if constexpr (SP2) {
            PG8_LDB(B0, 0, 0); PG8_LDB(B1, 0, 1); PG8_SCHED; PG8_LDA(At, 0, 0); PG8_STAGE(PG8_SA(1, 1), a1 + hstep, voffA);
            PG8_WAIT_V(8); PG8_WAIT_L(0); PG8_BAR; PG8_MMA(0, 0, At, B0); PG8_MMA(0, 1, At, B1); PG8_BAR; PG8_SCHED;
            PG8_LDA(At, 0, 1); PG8_STAGE(PG8_SB(0, 0), b2, voffB); PG8_STAGE(PG8_SB(0, 1), b2 + hstep, voffB); PG8_STAGE(PG8_SA(0, 0), a2, voffA);
            PG8_WAIT_V(8); PG8_WAIT_L(0); PG8_BAR; PG8_MMA(1, 0, At, B0); PG8_MMA(1, 1, At, B1); PG8_BAR; PG8_SCHED;
            PG8_LDB(B0, 1, 0); PG8_LDB(B1, 1, 1); PG8_SCHED; PG8_LDA(At, 1, 0); PG8_STAGE(PG8_SA(0, 1), a2 + hstep, voffA);
            PG8_WAIT_V(8); PG8_WAIT_L(0); PG8_BAR; PG8_MMA(0, 0, At, B0); PG8_MMA(0, 1, At, B1); PG8_BAR; PG8_SCHED;
            PG8_LDA(At, 1, 1); PG8_STAGE(PG8_SB(1, 0), b3, voffB); PG8_STAGE(PG8_SB(1, 1), b3 + hstep, voffB); PG8_STAGE(PG8_SA(1, 0), a3, voffA);
            PG8_WAIT_V(8); PG8_WAIT_L(0); PG8_BAR; PG8_MMA(1, 0, At, B0); PG8_MMA(1, 1, At, B1); PG8_BAR; PG8_SCHED;
            } else {
            PG8_LDB(B0, 0, 0); PG8_SCHED; PG8_LDA(At, 0, 0); PG8_STAGE(PG8_SA(1, 1), a1 + hstep, voffA);
            PG8_WAIT_L(8); PG8_BAR; PG8_WAIT_L(0); PG8_MMA(0, 0, At, B0); PG8_BAR; PG8_SCHED;
            PG8_LDB(B1, 0, 1); PG8_STAGE(PG8_SB(0, 0), b2, voffB);
            PG8_BAR; PG8_WAIT_L(0); PG8_MMA(0, 1, At, B1); PG8_BAR;
            PG8_LDA(At, 0, 1); PG8_STAGE(PG8_SA(0, 0), a2, voffA);
            PG8_BAR; PG8_WAIT_L(0); PG8_MMA(1, 0, At, B0); PG8_BAR; PG8_SCHED;
            PG8_STAGE(PG8_SB(0, 1), b2 + hstep, voffB);
            PG8_WAIT_V(6); PG8_BAR; PG8_MMA(1, 1, At, B1); PG8_BAR;
            PG8_LDB(B0, 1, 0); PG8_SCHED; PG8_LDA(At, 1, 0); PG8_STAGE(PG8_SA(0, 1), a2 + hstep, voffA);
            PG8_WAIT_L(8); PG8_BAR; PG8_WAIT_L(0); PG8_MMA(0, 0, At, B0); PG8_BAR; PG8_SCHED;
            PG8_LDB(B1, 1, 1); PG8_STAGE(PG8_SB(1, 0), b3, voffB);
            PG8_BAR; PG8_WAIT_L(0); PG8_MMA(0, 1, At, B1); PG8_BAR;
            PG8_LDA(At, 1, 1); PG8_STAGE(PG8_SA(1, 0), a3, voffA);
            PG8_BAR; PG8_WAIT_L(0); PG8_MMA(1, 0, At, B0); PG8_BAR; PG8_SCHED;
            PG8_STAGE(PG8_SB(1, 1), b3 + hstep, voffB);
            PG8_WAIT_V(6); PG8_BAR; PG8_MMA(1, 1, At, B1); PG8_BAR;
            }
        }
        if constexpr (ALIGN_EPI) { if (wr == 0) PG8_BAR; }
        if constexpr (!Epi::AFTER_DRAIN) { E(acc, cur, wr, wc, fr, fq); S.done(cur); }
        if (!has_next) break;
#pragma unroll
        for (int a = 0; a < 2; ++a)
#pragma unroll
            for (int b = 0; b < 2; ++b)
#pragma unroll
                for (int m = 0; m < 4; ++m)
#pragma unroll
                    for (int n = 0; n < 2; ++n) acc[a][b][m][n] = (f32x4){0.f, 0.f, 0.f, 0.f};
        cur = nxt; cA = nA; cB = nB; ++ui;
        if constexpr (ALIGN_EPI) { if (wr == 1) PG8_BAR; }
    }
    PG8_WAIT_V(0);
    if constexpr (!ALIGN_EPI) { if (wr == 0) PG8_BAR; }
    PG8_BAR;
#undef PG8_SA
#undef PG8_SB
#undef PG8_STAGE
#undef PG8_LDA
#undef PG8_LDB
#undef PG8_MMA
#undef PG8_WAIT_V
#undef PG8_WAIT_L
#undef PG8_BAR
#undef PG8_SCHED
}
}

#define XB_TMO      128
#define XB_XCNT(j)  (256  + 64 * (j))
#define XB_XSUB(j)  (1280 + 64 * (j))
#define XB_XGEN(j)  (2304 + 64 * (j))
#define XB_TOP      3328
#define XB_TOPGEN   3392
#define XCD_BAR_WORDS 3456
#define XB_SPIN_CAP (1u << 18)
__device__ __forceinline__ unsigned xb_ld(unsigned* p)              { return __hip_atomic_load(p, __ATOMIC_RELAXED, __HIP_MEMORY_SCOPE_AGENT); }
__device__ __forceinline__ unsigned xb_add(unsigned* p, unsigned v) { return __hip_atomic_fetch_add(p, v, __ATOMIC_RELAXED, __HIP_MEMORY_SCOPE_AGENT); }
__device__ __forceinline__ unsigned xb_xcc_id() { return (unsigned)__builtin_amdgcn_s_getreg((3 << 11) | 20) & 0xFu; }
#define XB_SPIN(cond, bar) do { unsigned _sp = 0; while (cond) { __builtin_amdgcn_s_sleep(1); \
    if ((++_sp & 255u) == 0u) { if (xb_ld(&(bar)[XB_TMO])) break; if (_sp > XB_SPIN_CAP) { atomicAdd(&(bar)[XB_TMO], 1u); break; } } } } while (0)
struct XcdBarrier { unsigned* bar; unsigned x; volatile LAS unsigned* st; };
__device__ __forceinline__ XcdBarrier xcd_barrier_post(unsigned* bar, volatile LAS unsigned* st) {
    XcdBarrier b; b.bar = bar; b.x = xb_xcc_id(); b.st = st;
    if (threadIdx.x == 0) (void)xb_add(&bar[XB_XCNT(b.x)], 1u);
    return b;
}
__device__ __forceinline__ void xcd_barrier_complete(unsigned* bar, unsigned x, unsigned& nloc, unsigned& nx) {
    const unsigned G = gridDim.x * gridDim.y * gridDim.z;
    unsigned sum, cnt, mine, sp = 0u;
    for (;;) {
        sum = 0u; cnt = 0u; mine = 0u;
#pragma unroll
        for (unsigned j = 0; j < 16; ++j) { const unsigned c = xb_ld(&bar[XB_XCNT(j)]); sum += c; cnt += (c > 0u) ? 1u : 0u; mine = (j == x) ? c : mine; }
        if (sum == G) break;
        __builtin_amdgcn_s_sleep(1);
        if ((++sp & 255u) == 0u) { if (xb_ld(&bar[XB_TMO])) break; if (sp > XB_SPIN_CAP) { atomicAdd(&bar[XB_TMO], 1u); break; } }
    }
    nloc = mine > 0u ? mine : 1u; nx = cnt > 0u ? cnt : 1u;
}
__device__ __forceinline__ void xcd_barrier(const XcdBarrier& b) {
    asm volatile("s_waitcnt vmcnt(0)" ::: "memory");
    __syncthreads();
    if (threadIdx.x == 0) {
        unsigned* bar = b.bar;
        __builtin_amdgcn_s_waitcnt(0);
        unsigned nloc = b.st[0], nx = b.st[1];
        if (nloc == 0u) { xcd_barrier_complete(bar, b.x, nloc, nx); b.st[0] = nloc; b.st[1] = nx; }
        const unsigned old = xb_add(&bar[XB_XSUB(b.x)], 1u);
        const unsigned gen = old / nloc;
        if (old + 1u == (gen + 1u) * nloc) {
            __builtin_amdgcn_fence(__ATOMIC_RELEASE, "agent");
            asm volatile("s_waitcnt vmcnt(0)" ::: "memory");
            const unsigned og = xb_add(&bar[XB_TOP], 1u);
            const unsigned tg = og / nx;
            if (og + 1u == (tg + 1u) * nx) xb_add(&bar[XB_TOPGEN], 1u);
            else XB_SPIN(xb_ld(&bar[XB_TOPGEN]) == tg, bar);
            __builtin_amdgcn_fence(__ATOMIC_ACQUIRE, "agent");
            xb_add(&bar[XB_XGEN(b.x)], 1u);
            asm volatile("s_waitcnt vmcnt(0)" ::: "memory");
        } else {
            XB_SPIN(xb_ld(&bar[XB_XGEN(b.x)]) == gen, bar);
            __builtin_amdgcn_fence(__ATOMIC_ACQUIRE, "agent");
            asm volatile("s_waitcnt vmcnt(0)" ::: "memory");
        }
    }
    __syncthreads();
}

constexpr int NWAVES = 8;
constexpr int RING_OFF = 0, RING_BYTES = 131072;
constexpr int LDSCTL_OFF = RING_BYTES, MISC_OFF = LDSCTL_OFF + 320;
constexpr int LDS_BYTES = 147456;

struct Frame {
    LAS unsigned char* lds; volatile LAS unsigned* MISC; unsigned* ctl;
    int tid, lane, wave, vcu, G;
    const float* const* in; float* out; unsigned char* ws;
};
enum { I_X = 0, I_RELB, I_NFFN1, I_F1G, I_F1U, I_F1D, I_NMIX, I_WIN, I_MIXRKV, I_MIXWAG, I_WLA, I_WLB, I_W0, I_ALA, I_ALB, I_A0, I_GLA, I_GLB, I_KK, I_KA, I_RKP, I_LNW, I_LNB,
       I_PA, I_PB, I_WOUT, I_NFFN2, I_F2G, I_F2U, I_F2D, I_NFIN };

__device__ __forceinline__ float wave_sum(float v) {
#pragma unroll
    for (int o = 1; o < 64; o <<= 1) v += __shfl_xor(v, o);
    return v;
}

__device__ __forceinline__ void tr_item(const float* W, int ldw, int c0, bf16* WT, int K, int drow0, int k0, const float* g, const float* mix, int mode, LAS float* scr, int lane) {
#pragma unroll 8
    for (int i = 0; i < 32; ++i) { const int kk = 2 * i + (lane >> 5), k = k0 + kk; float s = g ? g[k] : 1.0f; if (mode == 1) s *= (1.0f - mix[k]); else if (mode == 2) s *= mix[k];
        scr[kk * 33 + (lane & 31)] = W[(size_t)k * ldw + c0 + (lane & 31)] * s; }
    LDS_WAIT(); asm volatile("" ::: "memory");
    const int c = lane & 7;
#pragma unroll
    for (int j = 0; j < 4; ++j) { const int n = (lane >> 3) + 8 * j; const LAS float* s = scr + (8 * c) * 33 + n;
        u32x4 o; o.x = pk2(s[0 * 33], s[1 * 33]); o.y = pk2(s[2 * 33], s[3 * 33]); o.z = pk2(s[4 * 33], s[5 * 33]); o.w = pk2(s[6 * 33], s[7 * 33]);
        *(u32x4*)(WT + (size_t)(drow0 + n) * K + k0 + 8 * c) = o; }
    LDS_WAIT(); asm volatile("" ::: "memory");
}
__device__ __forceinline__ void gu_item(const float* Wg, const float* Wu, const float* g, bf16* WT, int r, LAS float* scr, int lane) {
    const int kb = r / 176, nb = r % 176, pn = nb >> 3, bj = (nb >> 2) & 1, o = nb & 3;
    tr_item(bj ? Wu : Wg, FF, 128 * pn + 32 * o, WT, D, 32 * nb, 64 * kb, g, nullptr, 0, scr, lane);
}
__device__ __forceinline__ void p0_prologue(Frame& F) {
    LAS float* scr = (LAS float*)(F.lds + RING_OFF + F.wave * 16384);
    const int gw = F.vcu * NWAVES + F.wave, NGW = F.G * NWAVES;
    unsigned char* ws = F.ws;
    constexpr int J0 = 16 * 176, J1 = 44 * 32, J2 = 16 * 96, J3 = 16 * 18, J4 = 16 * 64, J5 = 8 * 32, J6 = 8 * 32, J7 = 16 * 32, J8 = J0, J9 = J1;
    constexpr int NITEMS = J0 + J1 + J2 + J3 + J4 + J5 + J6 + J7 + J8 + J9;
    for (int it = gw; it < NITEMS; it += NGW) {
        int r = it;
        if (r < J0) { gu_item(F.in[I_F1G], F.in[I_F1U], F.in[I_NFFN1], (bf16*)(ws + WS_WGU1), r, scr, F.lane); continue; } r -= J0;
        if (r < J1) { const int kb = r / 32, nb = r % 32; tr_item(F.in[I_F1D], D, 32 * nb, (bf16*)(ws + WS_WD1), FF, 32 * nb, 64 * kb, nullptr, nullptr, 0, scr, F.lane); continue; } r -= J1;
        if (r < J2) { const int kb = r / 96, nb = r % 96; tr_item(F.in[I_WIN], 5120, 32 * nb, (bf16*)(ws + WS_WIN), D, 32 * nb, 64 * kb, F.in[I_NMIX], nullptr, 0, scr, F.lane); continue; } r -= J2;
        if (r < J3) { const int kb = r / 18, nb = r % 18, md = nb < 9 ? 1 : 2, n9 = nb % 9;
            const float* W; int ldw, c0; const float* mix;
            if (n9 < 2) { W = F.in[I_WLA]; ldw = 64; c0 = 32 * n9; mix = F.in[I_MIXWAG]; }
            else if (n9 < 4) { W = F.in[I_ALA]; ldw = 64; c0 = 32 * (n9 - 2); mix = F.in[I_MIXWAG] + D; }
            else { W = F.in[I_GLA]; ldw = 160; c0 = 32 * (n9 - 4); mix = F.in[I_MIXWAG] + 2 * D; }
            tr_item(W, ldw, c0, (bf16*)(ws + WS_WIN), D, 3072 + 32 * nb, 64 * kb, F.in[I_NMIX], mix, md, scr, F.lane); continue; } r -= J3;
        if (r < J4) { const int kb = r / 64, nb = r % 64; tr_item(F.in[I_WIN], 5120, 3072 + 32 * nb, (bf16*)(ws + WS_WG), D, 32 * nb, 64 * kb, F.in[I_NMIX], nullptr, 0, scr, F.lane); continue; } r -= J4;
        if (r < J5) { const int kb = r / 32, nb = r % 32; tr_item(F.in[I_PA], D, 32 * nb, (bf16*)(ws + WS_WA), 512, 32 * nb, 64 * kb, nullptr, nullptr, 0, scr, F.lane); continue; } r -= J5;
        if (r < J6) { const int kb = r / 32, nb = r % 32; tr_item(F.in[I_PB], D, 32 * nb, (bf16*)(ws + WS_WB), 512, 32 * nb, 64 * kb, nullptr, nullptr, 0, scr, F.lane); continue; } r -= J6;
        if (r < J7) { const int kb = r / 32, nb = r % 32; tr_item(F.in[I_WOUT], D, 32 * nb, (bf16*)(ws + WS_WOUT), D, 32 * nb, 64 * kb, nullptr, nullptr, 0, scr, F.lane); continue; } r -= J7;
        if (r < J8) { gu_item(F.in[I_F2G], F.in[I_F2U], F.in[I_NFFN2], (bf16*)(ws + WS_WGU2), r, scr, F.lane); continue; } r -= J8;
        { const int kb = r / 32, nb = r % 32; tr_item(F.in[I_F2D], D, 32 * nb, (bf16*)(ws + WS_WD2), FF, 32 * nb, 64 * kb, nullptr, nullptr, 0, scr, F.lane); }
    }
    const int gt = F.vcu * 512 + F.tid, NGT = F.G * 512;
    { u32x4* z = (u32x4*)(ws + WS_WIN + (size_t)3648 * D * 2); for (int i = gt; i < 192 * D * 2 / 16; i += NGT) z[i] = (u32x4){0u, 0u, 0u, 0u}; }
    { bf16* lw = (bf16*)(ws + WS_LBW); bf16* la = (bf16*)(ws + WS_LBA); bf16* lg = (bf16*)(ws + WS_LBG);
      for (int i = gt; i < 512 * 64; i += NGT) { const int n = i >> 6, k = i & 63; lw[i] = (bf16)f2bf(F.in[I_WLB][k * 512 + n]); la[i] = (bf16)f2bf(F.in[I_ALB][k * 512 + n]); }
      for (int i = gt; i < 512 * 160; i += NGT) { const int n = i / 160, k = i % 160; lg[i] = (bf16)f2bf(F.in[I_GLB][k * 512 + n]); } }
    { const float* x = F.in[I_X]; bf16* xb = (bf16*)(ws + WS_XB); float* ssq = (float*)(ws + OFF_SSQ1);
      for (int m = gw; m < M; m += NGW) {
          const f32x4* xr = (const f32x4*)(x + (size_t)m * D) + F.lane; f32x4 v[4]; float s = 0.f;
#pragma unroll
          for (int j = 0; j < 4; ++j) { v[j] = xr[64 * j]; s += (v[j].x * v[j].x + v[j].y * v[j].y) + (v[j].z * v[j].z + v[j].w * v[j].w); }
          s = wave_sum(s); if (F.lane == 0) ssq[m] = s;
          unsigned long long* o8 = (unsigned long long*)(xb + (size_t)m * D) + F.lane;
#pragma unroll
          for (int j = 0; j < 4; ++j) o8[64 * j] = (unsigned long long)pk2(v[j].x, v[j].y) | ((unsigned long long)pk2(v[j].z, v[j].w) << 32);
      } }
}

__device__ __forceinline__ int t5_bucket(int n) {
    if (n < 16) return n < 0 ? 0 : n;
    int b = 16;
    b += (n >= 21); b += (n >= 27); b += (n >= 35); b += (n >= 46); b += (n >= 59); b += (n >= 77); b += (n >= 99); b += (n >= 128);
    b += (n >= 166); b += (n >= 216); b += (n >= 280); b += (n >= 363); b += (n >= 470); b += (n >= 609); b += (n >= 790);
    return b;
}

namespace attn_body {
typedef unsigned short bf16;
using bf16x8=__attribute__((ext_vector_type(8)))short;
using s16x4=__attribute__((ext_vector_type(4)))short;
using f32x16=__attribute__((ext_vector_type(16)))float;
using u32x4=__attribute__((ext_vector_type(4)))unsigned;
constexpr int BATCH=4,NHEAD=8,SEQ=4096,D=64,DM=NHEAD*D;
constexpr int NW=8,QBLK=32,QB=QBLK*NW,KVBLK=64,NQB=SEQ/QB;
constexpr int ATTN_PITCH=DM, ATTN_UNIT_ROWS=QB;
__device__ __forceinline__ int crow(int r,int hi){return (r&3)+8*(r>>2)+4*hi;}
#define SBAR() __builtin_amdgcn_sched_barrier(0)
typedef __attribute__((address_space(3))) float* lds_fptr;
typedef float f32x4_t __attribute__((ext_vector_type(4)));
__device__ __forceinline__ void cmask(f32x16&p0,f32x16&p1,int jb,int qrel,int hi){
  const float NEG=-INFINITY; int kb=64*jb+4*hi;
  #pragma unroll
  for(int r=0;r<16;++r){int kv=kb+(r&3)+8*(r>>2); if(kv>qrel)p0[r]=NEG; if(kv+32>qrel)p1[r]=NEG;}
}

constexpr int NSLOT=3, SLOTB=8192;
constexpr int LDS_K=0, LDS_V=NSLOT*SLOTB, LDS_WS=2*NSLOT*SLOTB, LDS_OST=LDS_WS+NW*64*4, LDS_RT=LDS_OST+NW*4096,LDS_KM=LDS_RT+1152*4,LDS_BYTES=LDS_KM+15*64*4;
constexpr float C2=0.125f*1.4426950408889634f, L2E=1.4426950408889634f;
__device__ __forceinline__ void glds16(const void*gsrc,unsigned lds_dst){unsigned keep;
  asm volatile("s_mov_b32 %0, m0\n\ts_mov_b32 m0, %2\n\ts_nop 0\n\tglobal_load_lds_dwordx4 %1, off\n\ts_mov_b32 m0, %0":"=&s"(keep):"v"(gsrc),"s"(lds_dst):"memory");}
__device__ __forceinline__ float max3f(float a,float b,float c){float r;asm("v_max3_f32 %0, %1, %2, %3":"=v"(r):"v"(a),"v"(b),"v"(c));return r;}
__device__ __forceinline__ float max2f(float a,float b){float r;asm("v_max_f32_e32 %0, %1, %2":"=v"(r):"v"(a),"v"(b));return r;}
__device__ __forceinline__ float fadd_s(float a,float b){float r;asm("v_add_f32_e32 %0, %1, %2":"=v"(r):"v"(a),"v"(b));return r;}
__device__ __forceinline__ float fsub_s(float a,float b){float r;asm("v_sub_f32_e32 %0, %1, %2":"=v"(r):"v"(a),"v"(b));return r;}
typedef float f32x2_t __attribute__((ext_vector_type(2))); typedef __bf16 bf16x2_t __attribute__((ext_vector_type(2)));
__device__ __forceinline__ unsigned cvtpk_s(float lo,float hi){f32x2_t v={lo,hi};bf16x2_t b=__builtin_convertvector(v,bf16x2_t);return __builtin_bit_cast(unsigned,b);}
#define WAIT_BAR(N) asm volatile("s_waitcnt vmcnt(" #N ") lgkmcnt(0)\n\ts_barrier":::"memory")

__device__ __forceinline__ void qkt(f32x16&p0,f32x16&p1,const char*Kslot,const bf16x8*qr,const f32x16&negm,int r32,int hi){
  const char*kb=Kslot+hi*1024+r32*16;
  #pragma unroll
  for(int d0=0;d0<4;++d0){
    const bf16x8 b0=*reinterpret_cast<const bf16x8*>(kb+d0*2048);
    const bf16x8 b1=*reinterpret_cast<const bf16x8*>(kb+d0*2048+512);
    if(d0==0){p0=__builtin_amdgcn_mfma_f32_32x32x16_bf16(b0,qr[0],negm,0,0,0);p1=__builtin_amdgcn_mfma_f32_32x32x16_bf16(b1,qr[0],negm,0,0,0);}
    else{p0=__builtin_amdgcn_mfma_f32_32x32x16_bf16(b0,qr[d0],p0,0,0,0);p1=__builtin_amdgcn_mfma_f32_32x32x16_bf16(b1,qr[d0],p1,0,0,0);}}
}
typedef __attribute__((address_space(3))) const char* lds_cptr;
typedef short v4i16_t __attribute__((ext_vector_type(4)));
__device__ __forceinline__ void kload8(bf16x8*kf,lds_cptr kp){
  kf[0]=*(const __attribute__((address_space(3))) bf16x8*)(kp);      kf[1]=*(const __attribute__((address_space(3))) bf16x8*)(kp+512);
  kf[2]=*(const __attribute__((address_space(3))) bf16x8*)(kp+2048); kf[3]=*(const __attribute__((address_space(3))) bf16x8*)(kp+2560);
  kf[4]=*(const __attribute__((address_space(3))) bf16x8*)(kp+4096); kf[5]=*(const __attribute__((address_space(3))) bf16x8*)(kp+4608);
  kf[6]=*(const __attribute__((address_space(3))) bf16x8*)(kp+6144); kf[7]=*(const __attribute__((address_space(3))) bf16x8*)(kp+6656);
}
__device__ __forceinline__ void kload2(bf16x8*kf,lds_cptr kp,int j){ kf[2*j]=*(const __attribute__((address_space(3))) bf16x8*)(kp+j*2048); kf[2*j+1]=*(const __attribute__((address_space(3))) bf16x8*)(kp+j*2048+512); }
__device__ __forceinline__ s16x4 vtr(lds_cptr p){ return __builtin_bit_cast(s16x4,__builtin_amdgcn_ds_read_tr16_b64_v4i16((__attribute__((address_space(3))) v4i16_t*)p)); }
__device__ __forceinline__ float rowmax(const f32x16&p0,const f32x16&p1){
  float a=max3f(p0[0],p0[1],p1[0]),b=max3f(p0[2],p0[3],p1[1]);a=max3f(a,p1[2],p1[3]);
  #pragma unroll
  for(int r=4;r<16;r+=4){a=max3f(a,p0[r],p0[r+1]);b=max3f(b,p0[r+2],p0[r+3]);a=max3f(a,p1[r],p1[r+1]);b=max3f(b,p1[r+2],p1[r+3]);}
  const float m=max2f(a,b);
  auto rr=__builtin_amdgcn_permlane32_swap(__float_as_uint(m),__float_as_uint(m),false,false);
  return max2f(__uint_as_float(rr[0]),__uint_as_float(rr[1]));
}
__device__ __forceinline__ void pv(f32x16*o,int vb,bf16x8 pa0,bf16x8 pa1,bf16x8 pa2,bf16x8 pa3){
  #pragma unroll
  for(int d0=0;d0<2;++d0){s16x4 lo[4],hi[4];
    #pragma unroll
    for(int ks=0;ks<4;++ks){
      asm volatile("ds_read_b64_tr_b16 %0,%1 offset:%c2":"=&v"(lo[ks]):"v"(vb),"i"(d0*4096+ks*1024):"memory");
      asm volatile("ds_read_b64_tr_b16 %0,%1 offset:%c2":"=&v"(hi[ks]):"v"(vb),"i"(d0*4096+ks*1024+512):"memory");}
    asm volatile("s_waitcnt lgkmcnt(0)":::"memory");SBAR();
    #define PK(k) (bf16x8){lo[k][0],lo[k][1],lo[k][2],lo[k][3],hi[k][0],hi[k][1],hi[k][2],hi[k][3]}
    o[d0]=__builtin_amdgcn_mfma_f32_32x32x16_bf16(pa0,PK(0),o[d0],0,0,0);
    o[d0]=__builtin_amdgcn_mfma_f32_32x32x16_bf16(pa1,PK(1),o[d0],0,0,0);
    o[d0]=__builtin_amdgcn_mfma_f32_32x32x16_bf16(pa2,PK(2),o[d0],0,0,0);
    o[d0]=__builtin_amdgcn_mfma_f32_32x32x16_bf16(pa3,PK(3),o[d0],0,0,0);
    #undef PK
  }
}

#ifndef ATTN_STORE16
#define ATTN_STORE16(p,v) (*(u32x4*)(p)=(v))
#endif
template<int THRL> __device__ __forceinline__ void attn_unit(int b,int h,int qb,const bf16*Q,const bf16*__restrict__ K,const bf16*__restrict__ V,bf16*O,char*shm,const float*__restrict__ kmsum,const float*__restrict__ relb){
  int tid_=threadIdx.x; asm volatile("":"+v"(tid_));
  const int tid=tid_,lane=tid&63,r32=lane&31,hi=lane>>5; const int wid=__builtin_amdgcn_readfirstlane(tid>>6);
  const long rowbase=(long)b*SEQ; const int q0=qb*QB;
  const bf16*Qw=Q+(rowbase+q0+wid*QBLK)*DM+h*D;
  const bf16*Kh=K+rowbase*DM+h*D,*Vh=V+rowbase*DM+h*D;
  const unsigned lds0=(unsigned)(uintptr_t)shm;
  float*wsf=(float*)(shm+LDS_WS)+wid*64;
  const bf16*ksrc=Kh+(long)lane*DM+wid*8;
  const bf16*vsrc=Vh+(long)(16*(wid&3)+(lane>>2))*DM+(wid>>2)*32+(lane&3)*8;
  const unsigned kdst=lds0+LDS_K+wid*1024, vdst=lds0+LDS_V+wid*1024;
  #define DMA_K(t,slot) glds16(ksrc+(long)PHYS(t)*KVBLK*DM,(unsigned)__builtin_amdgcn_readfirstlane(kdst+(slot)))
  #define DMA_V(t,slot) glds16(vsrc+(long)PHYS(t)*KVBLK*DM,(unsigned)__builtin_amdgcn_readfirstlane(vdst+(slot)))
  const int vb0=(int)(lds0+LDS_V)+((lane>>4)&1)*32+(lane&3)*8+(4*hi+((lane&15)>>2))*64;
  const char*Kbase=shm+LDS_K; bf16x8 kf[8];
  const lds_cptr shm3=(lds_cptr)shm; const lds_cptr kp0=shm3+LDS_K+hi*1024+r32*16; const lds_cptr vp0=shm3+LDS_V+((lane>>4)&1)*32+(lane&3)*8+(4*hi+((lane&15)>>2))*64;
  const int NT=(q0+QB)/KVBLK;
  const lds_fptr rt3=(lds_fptr)(shm+LDS_RT); const lds_fptr km3=(lds_fptr)(shm+LDS_KM);
  { for(int j=tid;j<1152;j+=512){ const int d=895-j; float v=0.f; if(d>=0&&d<790)v=(relb[t5_bucket(d)*NHEAD+h]-relb[31*NHEAD+h])*L2E; rt3[j]=v; }
    for(int i=tid;i<qb*64;i+=512)km3[i]=kmsum[i];
    asm volatile("s_waitcnt vmcnt(0) lgkmcnt(0)\n\ts_barrier":::"memory"); }
  unsigned selmask=0u; bool selcur=true;
  if(qb>0){
    bf16x8 qg[4]; { const bf16*Qg=Q+(rowbase+q0+wid*QBLK+(lane&31))*DM+h*D+(lane>>5)*8;
      #pragma unroll
      for(int d0=0;d0<4;++d0)qg[d0]=*reinterpret_cast<const bf16x8*>(Qg+d0*16); }
    float qf[32];
    #pragma unroll
    for(int d0=0;d0<4;++d0){
      #pragma unroll
      for(int j=0;j<8;++j)qf[8*d0+j]=__builtin_bit_cast(float,(unsigned)(unsigned short)qg[d0][j]<<16);}
    float g0=-INFINITY,g1=-INFINITY,g2=-INFINITY;int s0=-1,s1=-1,s2=-1;
    for(int n=0;n<qb;++n){ const lds_fptr kr=km3+n*64+8*(lane>>5); float acc=0.f;
      #pragma unroll
      for(int d0=0;d0<4;++d0){ const f32x4_t a=*(const __attribute__((address_space(3))) f32x4_t*)(kr+16*d0), c=*(const __attribute__((address_space(3))) f32x4_t*)(kr+16*d0+4);
        acc+=(qf[8*d0]*a[0]+qf[8*d0+1]*a[1])+(qf[8*d0+2]*a[2]+qf[8*d0+3]*a[3])+(qf[8*d0+4]*c[0]+qf[8*d0+5]*c[1])+(qf[8*d0+6]*c[2]+qf[8*d0+7]*c[3]); }
      acc+=__shfl_xor(acc,32);
      if(acc>g0){g2=g1;s2=s1;g1=g0;s1=s0;g0=acc;s0=n;} else if(acc>g1){g2=g1;s2=s1;g1=acc;s1=n;} else if(acc>g2){g2=acc;s2=n;} }
    if(s0>=0)selmask|=1u<<s0; if(s1>=0)selmask|=1u<<s1; if(s2>=0)selmask|=1u<<s2; }
  #define PHYS(t) (((t)<4)?(NT-4+(t)):((t)-4))
  DMA_K(0,0);DMA_V(0,0);DMA_K(1,SLOTB);
  bf16x8 qr[4];
  #pragma unroll
  for(int d0=0;d0<4;++d0)qr[d0]=*reinterpret_cast<const bf16x8*>(&Qw[(long)r32*DM+d0*16+hi*8]);
  float mhat=0.f,l_reg=0.f;f32x16 o[2];o[0]=f32x16{};o[1]=f32x16{};const f32x16 zero16=f32x16{};
  const int qrel=wid*QBLK+r32;
  #define BIASADD(P0,P1,kt0) do{ const lds_fptr rp_=rt3+(895-(q0+qrel)+(kt0)+4*hi); \
    _Pragma("unroll") for(int g_=0;g_<4;++g_){ SBAR(); \
      const float b0_=rp_[8*g_],b1_=rp_[8*g_+1],b2_=rp_[8*g_+2],b3_=rp_[8*g_+3],c0_=rp_[8*g_+32],c1_=rp_[8*g_+33],c2_=rp_[8*g_+34],c3_=rp_[8*g_+35]; \
      P0[4*g_]+=b0_;P0[4*g_+1]+=b1_;P0[4*g_+2]+=b2_;P0[4*g_+3]+=b3_;P1[4*g_]+=c0_;P1[4*g_+1]+=c1_;P1[4*g_+2]+=c2_;P1[4*g_+3]+=c3_; } SBAR(); }while(0)
  #define CMASK(P0,P1,t) do{ const int t_=(t); { const float nm_=selcur?-mhat:-1e30f; _Pragma("unroll") for(int r=0;r<16;++r){P0[r]+=nm_;P1[r]+=nm_;} } \
    if(t_<4){ BIASADD(P0,P1,q0+64*t_); cmask(P0,P1,t_,qrel,hi); } \
    else{ const int kt0_=64*(t_-4); if(q0+wid*QBLK-(kt0_+63)<790){ BIASADD(P0,P1,kt0_); } } }while(0)
  #define SELUPD(tn) do{ const int tn_=(tn); if(tn_>=4&&(tn_&3)==0){ selcur=((selmask>>((tn_-4)>>2))&1u)!=0u; } }while(0)
  bool resc=false;
  #define START(P0,P1) do{ const float rm=rowmax(P0,P1); resc=false; \
    { const float dl=rm; mhat=fadd_s(mhat,dl); \
      _Pragma("unroll") for(int r=0;r<16;++r){P0[r]=fsub_s(P0[r],dl);P1[r]=fsub_s(P1[r],dl);} \
      } \
    _Pragma("unroll") for(int r=0;r<16;++r)P0[r]=__builtin_amdgcn_exp2f(P0[r]); }while(0)
  #define RESC() do{ if(resc){ asm volatile("s_waitcnt lgkmcnt(0)":::"memory"); \
      _Pragma("unroll") for(int d_=0;d_<2;++d_) _Pragma("unroll") for(int r=0;r<16;++r)o[d_][r]*=wsf[crow(r,hi)]; } }while(0)
  f32x16 pA0,pA1,pB0,pB1;
  int sl_prev=0,sl_cur=0,sl_next=SLOTB;
  #define ROT() do{sl_prev=sl_cur;sl_cur=sl_next;sl_next=(sl_next==(NSLOT-1)*SLOTB)?0:sl_next+SLOTB;}while(0)
  DMA_K(2,2*SLOTB);
  WAIT_BAR(3);
  qkt(pA0,pA1,Kbase,qr,zero16,r32,hi);asm volatile("s_nop 15\n\ts_nop 7":"+v"(pA0),"+v"(pA1));CMASK(pA0,pA1,0);
  START(pA0,pA1);
  _Pragma("unroll") for(int r=0;r<16;++r)pA1[r]=__builtin_amdgcn_exp2f(pA1[r]);
  WAIT_BAR(0);
  DMA_K(3,0);DMA_V(1,SLOTB);
  ROT();
  kload8(kf,kp0+sl_cur);
  WAIT_BAR(2);
  s16x4 vlo[8],vhi[8]; u32x4 pw0,pw1,pw2,pw3;
  #define PKW(P,B) cvtpk_s(P[B],P[B+1])
  #define PAF(k) __builtin_bit_cast(bf16x8,pw##k)
  #define VFR(i) (bf16x8){vlo[i][0],vlo[i][1],vlo[i][2],vlo[i][3],vhi[i][0],vhi[i][1],vhi[i][2],vhi[i][3]}
  #define PIN(x) asm volatile("":"+v"(x))
  #define MX3(a,b,c) __builtin_fmaxf(__builtin_fmaxf((a),(b)),(c))
  #define GAPA(MF,A0,A1,A2,A3,W0,W1,PW) do{ MF; sacc+=A0; sacc+=A1; sacc+=A2; sacc+=A3; PIN(sacc); W0; W1; PIN(PW); SBAR(); }while(0)
  #define EX(v) __builtin_amdgcn_exp2f(v)
  #define GAPB(MF,X,B) do{ MF; X[B]=EX(X[B]); X[B+1]=EX(X[B+1]); X[B+2]=EX(X[B+2]); X[B+3]=EX(X[B+3]); PIN(X); SBAR(); }while(0)
  #define VRD(i) do{ vlo[i]=vtr(vp_+(((i)>>2)*4096+((i)&3)*1024)); vhi[i]=vtr(vp_+(((i)>>2)*4096+((i)&3)*1024+512)); }while(0)
  #define KRD(G,j) do{ if(G){ kload2(kf,kp0+sl_next,j); SBAR(); } }while(0)
  #define STEP(C0,C1,P0,P1,t,GK,GV,GL) do{ SBAR(); \
    const lds_cptr vp_=vp0+sl_prev; \
    VRD(0); SBAR(); float sacc=(P0[0]+P0[1]); \
    GAPA(C0=__builtin_amdgcn_mfma_f32_32x32x16_bf16(kf[0],qr[0],zero16,0,0,0), P0[2],P0[3],P0[4],P0[5],     pw0[0]=PKW(P0,0), pw0[1]=PKW(P0,2), pw0); \
    VRD(4); SBAR(); GAPA(C1=__builtin_amdgcn_mfma_f32_32x32x16_bf16(kf[1],qr[0],zero16,0,0,0), P0[6],P0[7],P0[8],P0[9],     pw0[2]=PKW(P0,4), pw0[3]=PKW(P0,6), pw0); \
    VRD(1); SBAR(); GAPA(C0=__builtin_amdgcn_mfma_f32_32x32x16_bf16(kf[2],qr[1],C0,0,0,0),   P0[10],P0[11],P0[12],P0[13], pw1[0]=PKW(P0,8), pw1[1]=PKW(P0,10), pw1); \
    VRD(5); SBAR(); GAPA(C1=__builtin_amdgcn_mfma_f32_32x32x16_bf16(kf[3],qr[1],C1,0,0,0),   P0[14],P0[15],P1[0],P1[1],   pw1[2]=PKW(P0,12),pw1[3]=PKW(P0,14), pw1); \
    VRD(2); SBAR(); GAPA(C0=__builtin_amdgcn_mfma_f32_32x32x16_bf16(kf[4],qr[2],C0,0,0,0),   P1[2],P1[3],P1[4],P1[5],     pw2[0]=PKW(P1,0), pw2[1]=PKW(P1,2), pw2); \
    VRD(6); SBAR(); GAPA(C1=__builtin_amdgcn_mfma_f32_32x32x16_bf16(kf[5],qr[2],C1,0,0,0),   P1[6],P1[7],P1[8],P1[9],     pw2[2]=PKW(P1,4), pw2[3]=PKW(P1,6), pw2); \
    VRD(3); SBAR(); GAPA(C0=__builtin_amdgcn_mfma_f32_32x32x16_bf16(kf[6],qr[3],C0,0,0,0),   P1[10],P1[11],P1[12],P1[13], pw3[0]=PKW(P1,8), pw3[1]=PKW(P1,10), pw3); \
    VRD(7); SBAR(); GAPA(C1=__builtin_amdgcn_mfma_f32_32x32x16_bf16(kf[7],qr[3],C1,0,0,0),   P1[14],P1[15],0.f,0.f,       pw3[2]=PKW(P1,12),pw3[3]=PKW(P1,14), pw3); \
    l_reg+=sacc; \
    if(GK){DMA_K((t)+3,sl_cur);} if(GV){DMA_V((t)+1,sl_next);} \
    CMASK(C0,C1,t); \
    { float a=MX3(C0[0],C0[1],C1[0]),b=MX3(C0[2],C0[3],C1[1]); a=MX3(a,C1[2],C1[3]); \
      _Pragma("unroll") for(int r=4;r<16;r+=4){a=MX3(a,C0[r],C0[r+1]);b=MX3(b,C0[r+2],C0[r+3]);a=MX3(a,C1[r],C1[r+1]);b=MX3(b,C1[r+2],C1[r+3]);} \
      float rm=__builtin_fmaxf(a,b); { auto rr=__builtin_amdgcn_permlane32_swap(__float_as_uint(rm),__float_as_uint(rm),false,false); rm=__builtin_fmaxf(__uint_as_float(rr[0]),__uint_as_float(rr[1])); } \
      resc=false; \
      if(__builtin_expect(__any(rm>(float)THRL),0)){ const float dl=__builtin_fmaxf(rm,0.f); mhat+=dl; \
        _Pragma("unroll") for(int r=0;r<16;++r){C0[r]-=dl;C1[r]-=dl;} \
        const float f=__builtin_amdgcn_exp2f(-dl); l_reg*=f; if(hi==0)wsf[r32]=f; resc=true; } } \
    SBAR(); \
    GAPB(o[0]=__builtin_amdgcn_mfma_f32_32x32x16_bf16(PAF(0),VFR(0),o[0],0,0,0), C0,0); \
    GAPB(o[1]=__builtin_amdgcn_mfma_f32_32x32x16_bf16(PAF(0),VFR(4),o[1],0,0,0), C0,4); \
    KRD(GL,0); GAPB(o[0]=__builtin_amdgcn_mfma_f32_32x32x16_bf16(PAF(1),VFR(1),o[0],0,0,0), C0,8); \
    KRD(GL,1); GAPB(o[1]=__builtin_amdgcn_mfma_f32_32x32x16_bf16(PAF(1),VFR(5),o[1],0,0,0), C0,12); \
    KRD(GL,2); GAPB(o[0]=__builtin_amdgcn_mfma_f32_32x32x16_bf16(PAF(2),VFR(2),o[0],0,0,0), C1,0); \
    KRD(GL,3); GAPB(o[1]=__builtin_amdgcn_mfma_f32_32x32x16_bf16(PAF(2),VFR(6),o[1],0,0,0), C1,4); \
    GAPB(o[0]=__builtin_amdgcn_mfma_f32_32x32x16_bf16(PAF(3),VFR(3),o[0],0,0,0), C1,8); \
    GAPB(o[1]=__builtin_amdgcn_mfma_f32_32x32x16_bf16(PAF(3),VFR(7),o[1],0,0,0), C1,12); \
    }while(0)
  int t=1;
  for(;t+5<NT;t+=2){
    STEP(pB0,pB1,pA0,pA1,t,true,true,true);     WAIT_BAR(2); RESC(); ROT(); SELUPD(t+1);
    STEP(pA0,pA1,pB0,pB1,t+1,true,true,true);   WAIT_BAR(2); RESC(); ROT(); SELUPD(t+2);
  }
  #define ENDW(tt) do{ if((tt)+3<NT){WAIT_BAR(2);} else if((tt)+2<NT){WAIT_BAR(1);} else {WAIT_BAR(0);} }while(0)
  for(;t+1<NT;t+=2){
    STEP(pB0,pB1,pA0,pA1,t,(t+3<NT),(t+1<NT),(t+1<NT));       ENDW(t);   RESC(); ROT(); SELUPD(t+1);
    STEP(pA0,pA1,pB0,pB1,t+1,(t+4<NT),(t+2<NT),(t+2<NT));     ENDW(t+1); RESC(); ROT(); SELUPD(t+2);
  }
  STEP(pB0,pB1,pA0,pA1,NT-1,false,false,false); RESC();
  { float sacc=pB0[0]+pB0[1]; _Pragma("unroll") for(int r=2;r<16;++r)sacc+=pB0[r]; _Pragma("unroll") for(int r=0;r<16;++r)sacc+=pB1[r]; l_reg+=sacc;
    pw0=(u32x4){PKW(pB0,0),PKW(pB0,2),PKW(pB0,4),PKW(pB0,6)};pw1=(u32x4){PKW(pB0,8),PKW(pB0,10),PKW(pB0,12),PKW(pB0,14)};pw2=(u32x4){PKW(pB1,0),PKW(pB1,2),PKW(pB1,4),PKW(pB1,6)};pw3=(u32x4){PKW(pB1,8),PKW(pB1,10),PKW(pB1,12),PKW(pB1,14)};
    SBAR(); pv(o,vb0+sl_cur,PAF(0),PAF(1),PAF(2),PAF(3)); }
  #undef PKW
  #undef PAF
  #undef VFR
  #undef PIN
  #undef MX3
  #undef GAPA
  #undef GAPB
  #undef EX
  #undef VRD
  #undef KRD
  #undef STEP
  #undef ENDW
  {auto rr=__builtin_amdgcn_permlane32_swap(__float_as_uint(l_reg),__float_as_uint(l_reg),false,false);l_reg=__uint_as_float(rr[0])+__uint_as_float(rr[1]);}
  if(hi==0)wsf[32+r32]=l_reg;asm volatile("s_waitcnt lgkmcnt(0)":::"memory");
  float rli[16];
  #pragma unroll
  for(int r=0;r<16;++r)rli[r]=__builtin_amdgcn_rcpf(wsf[32+crow(r,hi)]);
  bf16*Ow=O+(rowbase+q0+wid*QBLK)*DM+h*D;
  { bf16*stg=(bf16*)(shm+LDS_OST)+wid*2048;
    #pragma unroll
    for(int r=0;r<16;++r){const int orow=crow(r,hi);
      #pragma unroll
      for(int d0=0;d0<2;++d0)stg[orow*64+d0*32+r32]=(bf16)f2bf(o[d0][r]*rli[r]);}
    asm volatile("s_waitcnt lgkmcnt(0)":::"memory");
    #pragma unroll
    for(int i=0;i<4;++i){const int row=i*8+(lane>>3),ch=lane&7; const u32x4 v=*(const u32x4*)(stg+row*64+ch*8); ATTN_STORE16(Ow+(long)row*DM+ch*8,v);} }
  asm volatile("s_waitcnt lgkmcnt(0)\n\ts_barrier":::"memory");
  #undef DMA_K
  #undef DMA_V
  #undef CMASK
  #undef BIASADD
  #undef SELUPD
  #undef PHYS
  #undef START
  #undef RESC
  #undef ROT
}
constexpr int ATTN_LDS_BYTES=LDS_BYTES;
struct AttnTensors { const bf16* Q; const bf16* K; const bf16* V; bf16* O; const float* kmsum; const float* relb; };
struct AttnUnit { int bh; int qb; };
struct StaticOrder {
  int vcu;
  __device__ __forceinline__ explicit StaticOrder(int grid,int block):vcu((block%8)*(grid/8)+block/8){}
  __device__ __forceinline__ bool next(int i,AttnUnit&u)const{ if(i>=2)return false; const int s=vcu&7; u.bh=vcu>>3; u.qb=(i==0)?15-s:s; return true; }
  __device__ __forceinline__ void a_ready(const AttnUnit&)const{}
  __device__ __forceinline__ void done(const AttnUnit&)const{}
};
template<class Sched,int THRL=8> __device__ __forceinline__ void attn_phase(char*lds,const AttnTensors&T,const Sched&S){
  AttnUnit u;
  for(int i=0;S.next(i,u);++i){ S.a_ready(u); attn_unit<THRL>(u.bh/NHEAD,u.bh%NHEAD,u.qb,T.Q,T.K,T.V,T.O,lds,T.kmsum+(size_t)u.bh*16*64,T.relb); S.done(u); }
}
#undef SBAR
#undef WAIT_BAR
}

__device__ __forceinline__ void attn_simple(Frame& F) {
    LAS float* tab = (LAS float*)(F.lds + RING_OFF);
    const float* relb = F.in[I_RELB];
    for (int i = F.tid; i < 8 * 800; i += 512) { const int h = i / 800, d = i % 800; tab[i] = relb[t5_bucket(d) * NH + h] * LOG2E; }
    __syncthreads();
    const bf16* Q = (const bf16*)(F.ws + WS_Q); const bf16* K = (const bf16*)(F.ws + WS_K); const bf16* V = (const bf16*)(F.ws + WS_V); bf16* O = (bf16*)(F.ws + WS_Q);
    const float* kmean = (const float*)(F.ws + OFF_KMEAN);
    const int wv = blockIdx.x * NWAVES + F.wave;
    const int bh = wv >> 6, b = bh >> 3, h = bh & 7, q = (wv & 63) * 64 + F.lane, blk = q >> 8;
    const LAS float* tb = tab + h * 800;
    const size_t rowq = (size_t)(b * SEQ + q) * 512 + h * 64;
    float qf[64];
#pragma unroll
    for (int c = 0; c < 8; ++c) { const u32x4 w = *(const u32x4*)(Q + rowq + c * 8);
        qf[c * 8 + 0] = bflo(w.x); qf[c * 8 + 1] = bfhi(w.x); qf[c * 8 + 2] = bflo(w.y); qf[c * 8 + 3] = bfhi(w.y); qf[c * 8 + 4] = bflo(w.z); qf[c * 8 + 5] = bfhi(w.z); qf[c * 8 + 6] = bflo(w.w); qf[c * 8 + 7] = bfhi(w.w); }
    float g0 = -INFINITY, g1 = -INFINITY, g2 = -INFINITY; int s0 = -1, s1 = -1, s2 = -1;
    for (int n = 0; n < blk; ++n) {
        const float* km = kmean + ((size_t)bh * 16 + n) * 64; float gsum = 0.f;
#pragma unroll
        for (int d = 0; d < 64; ++d) gsum += qf[d] * km[d];
        if (gsum > g0) { g2 = g1; s2 = s1; g1 = g0; s1 = s0; g0 = gsum; s0 = n; }
        else if (gsum > g1) { g2 = g1; s2 = s1; g1 = gsum; s1 = n; }
        else if (gsum > g2) { g2 = gsum; s2 = n; }
    }
    float o[64];
#pragma unroll
    for (int d = 0; d < 64; ++d) o[d] = 0.f;
    float mx = -1e30f, l = 0.f;
    for (int pass = 0; pass < 4; ++pass) {
        const int jb = pass == 0 ? s0 : pass == 1 ? s1 : pass == 2 ? s2 : blk;
        const bool act = jb >= 0;
        const int jblk = act ? jb : 0;
        const int nkeys = (pass == 3) ? 256 : 256;
        if (pass < 3 && blk <= pass) continue;
        for (int kk = 0; kk < nkeys; ++kk) {
            const int kpos = jblk * 256 + kk;
            const size_t rowk = (size_t)(b * SEQ + kpos) * 512 + h * 64;
            float s = 0.f;
#pragma unroll
            for (int c = 0; c < 8; ++c) { const u32x4 w = *(const u32x4*)(K + rowk + c * 8);
                s += qf[c * 8 + 0] * bflo(w.x) + qf[c * 8 + 1] * bfhi(w.x) + qf[c * 8 + 2] * bflo(w.y) + qf[c * 8 + 3] * bfhi(w.y) + qf[c * 8 + 4] * bflo(w.z) + qf[c * 8 + 5] * bfhi(w.z) + qf[c * 8 + 6] * bflo(w.w) + qf[c * 8 + 7] * bfhi(w.w); }
            const int dist = q - kpos;
            const bool valid = act && dist >= 0;
            const int dcl = dist < 0 ? 0 : (dist > 799 ? 799 : dist);
            s += tb[dcl];
            if (!valid) s = -1e30f;
            const float mn = fmaxf(mx, s);
            const float f = fast_exp2(mx - mn), p = valid ? fast_exp2(s - mn) : 0.f;
            l = l * f + p; mx = mn;
#pragma unroll
            for (int c = 0; c < 8; ++c) { const u32x4 w = *(const u32x4*)(V + rowk + c * 8);
                o[c * 8 + 0] = o[c * 8 + 0] * f + p * bflo(w.x); o[c * 8 + 1] = o[c * 8 + 1] * f + p * bfhi(w.x); o[c * 8 + 2] = o[c * 8 + 2] * f + p * bflo(w.y); o[c * 8 + 3] = o[c * 8 + 3] * f + p * bfhi(w.y);
                o[c * 8 + 4] = o[c * 8 + 4] * f + p * bflo(w.z); o[c * 8 + 5] = o[c * 8 + 5] * f + p * bfhi(w.z); o[c * 8 + 6] = o[c * 8 + 6] * f + p * bflo(w.w); o[c * 8 + 7] = o[c * 8 + 7] * f + p * bfhi(w.w); }
        }
    }
    const float il = 1.0f / l;
#pragma unroll
    for (int c = 0; c < 8; ++c) { u32x4 w; w.x = pk2(o[c * 8 + 0] * il, o[c * 8 + 1] * il); w.y = pk2(o[c * 8 + 2] * il, o[c * 8 + 3] * il); w.z = pk2(o[c * 8 + 4] * il, o[c * 8 + 5] * il); w.w = pk2(o[c * 8 + 6] * il, o[c * 8 + 7] * il);
        *(u32x4*)(O + rowq + c * 8) = w; }
}

__device__ __forceinline__ void mix_phase(Frame& F) {
    unsigned char* ws = F.ws;
    const bf16* Z = (const bf16*)(ws + WS_Z);
    bf16* R = (bf16*)(ws + WS_R); bf16* KR = (bf16*)(ws + WS_KR); bf16* VR = (bf16*)(ws + WS_VR);
    bf16* KKo = (bf16*)(ws + WS_KK); bf16* BBo = (bf16*)(ws + WS_BB); float* WD = (float*)(ws + WS_WDEC); bf16* GB = (bf16*)(ws + WS_GB); float* RK = (float*)(ws + WS_RK);
    const bf16* bnd = (const bf16*)(ws + WS_BND);
    const bf16* LBW = (const bf16*)(ws + WS_LBW); const bf16* LBA = (const bf16*)(ws + WS_LBA); const bf16* LBG = (const bf16*)(ws + WS_LBG);
    const float* mixrkv = F.in[I_MIXRKV]; const float* w0 = F.in[I_W0]; const float* a0 = F.in[I_A0]; const float* k_k = F.in[I_KK]; const float* k_a = F.in[I_KA]; const float* r_k = F.in[I_RKP];
    const int lane = F.lane, n = lane & 15, q4 = lane >> 4;
    LAS float* stash = (LAS float*)(F.lds + RING_OFF) + F.wave * 2560;
    LAS float* keep = stash + 384;
    for (int item = blockIdx.x; item < 256; item += F.G) {
        const int pm = item >> 2, hp = item & 3;
        const int R0 = pm * 256 + F.wave * 32;
        if (q4 == 0) {
#pragma unroll
            for (int hh = 0; hh < 2; ++hh)
#pragma unroll
                for (int c = 0; c < 4; ++c) {
                    const int ch = (2 * hp + hh) * 64 + 16 * c + n; float vr = 0.f, vk = 0.f, vv = 0.f;
                    if ((R0 & (SEQ - 1)) != 0) {
                        if (F.wave == 0) { const bf16* bp = bnd + (size_t)(pm - 1) * 1536; vr = bf2f(bp[ch]); vk = bf2f(bp[512 + ch]); vv = bf2f(bp[1024 + ch]); }
                        else { const size_t o = (size_t)(R0 - 1) * 512 + ch; vr = bf2f(R[o]); vk = bf2f(KR[o]); vv = bf2f(VR[o]); }
                    }
                    stash[((hh * 4 + c) * 3 + 0) * 16 + n] = vr; stash[((hh * 4 + c) * 3 + 1) * 16 + n] = vk; stash[((hh * 4 + c) * 3 + 2) * 16 + n] = vv;
                }
        }
        asm volatile("s_waitcnt vmcnt(0) lgkmcnt(0)" ::: "memory"); __syncthreads();
#pragma unroll 1
        for (int g = 1; g >= 0; --g) {
            const int t0 = R0 + 16 * g;
            bf16x8 Af[9];
            {
                const int t = t0 + n; const bool first = (t & (SEQ - 1)) == 0;
#pragma unroll
                for (int s = 0; s < 9; ++s) {
                    const u32x4 z1 = *(const u32x4*)(Z + (size_t)t * ZP + 32 * s + 8 * q4);
                    u32x4 z2 = (u32x4){0u, 0u, 0u, 0u}; if (!first) z2 = *(const u32x4*)(Z + (size_t)(t - 1) * ZP + 288 + 32 * s + 8 * q4);
                    float hv[8] = { bflo(z1.x) + bflo(z2.x), bfhi(z1.x) + bfhi(z2.x), bflo(z1.y) + bflo(z2.y), bfhi(z1.y) + bfhi(z2.y), bflo(z1.z) + bflo(z2.z), bfhi(z1.z) + bfhi(z2.z), bflo(z1.w) + bflo(z2.w), bfhi(z1.w) + bfhi(z2.w) };
#pragma unroll
                    for (int i = 0; i < 8; ++i) { if (s < 2) { const float e = fast_exp2(hv[i] * (2.0f * LOG2E)); hv[i] = 1.0f - 2.0f * fast_rcp(e + 1.0f); } else if (s >= 4) hv[i] = sigmoidf_(hv[i]); }
                    u32x4 p; p.x = pk2(hv[0], hv[1]); p.y = pk2(hv[2], hv[3]); p.z = pk2(hv[4], hv[5]); p.w = pk2(hv[6], hv[7]);
                    Af[s] = __builtin_bit_cast(bf16x8, p);
                }
            }
#pragma unroll 1
            for (int hh = 0; hh < 2; ++hh) {
                const int hd = 2 * hp + hh;
                float n2[4] = {0.f, 0.f, 0.f, 0.f}, rks[4] = {0.f, 0.f, 0.f, 0.f};
#pragma unroll 1
                for (int c = 0; c < 4; ++c) {
                    const int ch = hd * 64 + 16 * c + n;
                    float oR[5], oK[5], oV[5];
                    if (q4 == 0 && g == 0) { oR[0] = stash[((hh * 4 + c) * 3 + 0) * 16 + n]; oK[0] = stash[((hh * 4 + c) * 3 + 1) * 16 + n]; oV[0] = stash[((hh * 4 + c) * 3 + 2) * 16 + n]; }
                    else { const size_t o = (size_t)(t0 + 4 * q4 - 1) * 512 + ch; oR[0] = bf2f(R[o]); oK[0] = bf2f(KR[o]); oV[0] = bf2f(VR[o]); }
#pragma unroll
                    for (int i = 0; i < 4; ++i) { const size_t o = (size_t)(t0 + 4 * q4 + i) * 512 + ch; oR[i + 1] = bf2f(R[o]); oK[i + 1] = bf2f(KR[o]); oV[i + 1] = bf2f(VR[o]); }
                    asm volatile("s_waitcnt vmcnt(0) lgkmcnt(0)" ::: "memory");
                    f32x4 aw = (f32x4){0.f, 0.f, 0.f, 0.f}, aa = aw, ag = aw;
#pragma unroll
                    for (int s = 0; s < 2; ++s) { const bf16x8 b = *(const bf16x8*)(LBW + (size_t)ch * 64 + 32 * s + 8 * q4); aw = __builtin_amdgcn_mfma_f32_16x16x32_bf16(Af[s], b, aw, 0, 0, 0); }
#pragma unroll
                    for (int s = 0; s < 2; ++s) { const bf16x8 b = *(const bf16x8*)(LBA + (size_t)ch * 64 + 32 * s + 8 * q4); aa = __builtin_amdgcn_mfma_f32_16x16x32_bf16(Af[2 + s], b, aa, 0, 0, 0); }
#pragma unroll
                    for (int s = 0; s < 5; ++s) { const bf16x8 b = *(const bf16x8*)(LBG + (size_t)ch * 160 + 32 * s + 8 * q4); ag = __builtin_amdgcn_mfma_f32_16x16x32_bf16(Af[4 + s], b, ag, 0, 0, 0); }
                    const float mr = mixrkv[ch], mk = mixrkv[512 + ch], mv = mixrkv[1024 + ch], w0c = w0[ch], a0c = a0[ch], kkc = k_k[ch], kac = k_a[ch], rkc = r_k[ch];
#pragma unroll
                    for (int i = 0; i < 4; ++i) {
                        const size_t o = (size_t)(t0 + 4 * q4 + i) * 512 + ch;
                        const float cr = oR[i + 1], ck = oK[i + 1], cv = oV[i + 1];
                        const float r_ = cr + (oR[i] - cr) * mr, k_ = ck + (oK[i] - ck) * mk, v_ = cv + (oV[i] - cv) * mv;
                        const float sg = sigmoidf_(w0c + aw[i]);
                        const float dec = fast_exp2(-0.6065306597126334f * LOG2E * sg);
                        const float a_ = sigmoidf_(a0c + aa[i]);
                        const float kr_ = k_ * kkc; n2[i] += kr_ * kr_;
                        const float kt_ = k_ * (1.0f + (a_ - 1.0f) * kac);
                        rks[i] += r_ * kt_ * rkc;
                        keep[((c * 4 + i) * 2 + 0) * 64 + lane] = kr_; keep[((c * 4 + i) * 2 + 1) * 64 + lane] = a_;
                        R[o] = (bf16)f2bf(r_); KR[o] = (bf16)f2bf(kt_); VR[o] = (bf16)f2bf(v_); WD[o] = dec; GB[o] = (bf16)f2bf(ag[i]);
                    }
                }
#pragma unroll
                for (int i = 0; i < 4; ++i) {
                    float a = n2[i], b = rks[i];
                    a += __shfl_xor(a, 1); a += __shfl_xor(a, 2); a += __shfl_xor(a, 4); a += __shfl_xor(a, 8);
                    b += __shfl_xor(b, 1); b += __shfl_xor(b, 2); b += __shfl_xor(b, 4); b += __shfl_xor(b, 8);
                    n2[i] = 1.0f / fmaxf(sqrtf(a), 1e-12f); rks[i] = b;
                }
                LDS_WAIT();
#pragma unroll 1
                for (int c = 0; c < 4; ++c) {
                    const int ch = hd * 64 + 16 * c + n;
#pragma unroll
                    for (int i = 0; i < 4; ++i) {
                        const size_t o = (size_t)(t0 + 4 * q4 + i) * 512 + ch;
                        const float kk_ = keep[((c * 4 + i) * 2 + 0) * 64 + lane] * n2[i], a_ = keep[((c * 4 + i) * 2 + 1) * 64 + lane];
                        KKo[o] = (bf16)f2bf(kk_); BBo[o] = (bf16)f2bf(kk_ * a_);
                    }
                }
                LDS_WAIT();
                if (n == 0) {
#pragma unroll
                    for (int i = 0; i < 4; ++i) RK[(size_t)(t0 + 4 * q4 + i) * 8 + hd] = rks[i];
                }
            }
        }
        __syncthreads();
    }
}


typedef float f32x4v __attribute__((ext_vector_type(4)));
#define MF4(a, b, c) __builtin_amdgcn_mfma_f32_16x16x4f32((a), (b), (c), 0, 0, 0)

__device__ __forceinline__ void mixc_phase(Frame& F) {
    unsigned char* ws = F.ws;
    const bf16* Z = (const bf16*)(ws + WS_Z);
    const bf16* R = (const bf16*)(ws + WS_R); const bf16* KR = (const bf16*)(ws + WS_KR); bf16* VR = (bf16*)(ws + WS_VR);
    bf16* GB = (bf16*)(ws + WS_GB); float* RK = (float*)(ws + WS_RK);
    const bf16* bnd = (const bf16*)(ws + WS_BND);
    const bf16* LBW = (const bf16*)(ws + WS_LBW); const bf16* LBA = (const bf16*)(ws + WS_LBA); const bf16* LBG = (const bf16*)(ws + WS_LBG);
    const float* mixrkv = F.in[I_MIXRKV]; const float* w0 = F.in[I_W0]; const float* a0 = F.in[I_A0]; const float* k_k = F.in[I_KK]; const float* k_a = F.in[I_KA]; const float* r_k = F.in[I_RKP];
    const int lane0 = F.lane;
    LAS float* xb = (LAS float*)(F.lds + RING_OFF + F.wave * 16384);
    LAS float* tt = xb; LAS float* rb = xb + 320; LAS float* stash = xb + 3 * 1088;
    LAS unsigned short* sa = (LAS unsigned short*)xb;
    for (int item = blockIdx.x; item < 256; item += F.G) {
        const int pm = item >> 2, hp = item & 3;
        const int R0 = pm * 256 + F.wave * 32;
        { int lane = lane0; asm volatile("" : "+v"(lane)); const int n = lane & 15, q4 = lane >> 4;
        if (q4 == 0) {
#pragma unroll
            for (int hh = 0; hh < 2; ++hh)
#pragma unroll
                for (int c = 0; c < 4; ++c) {
                    const int ch = (2 * hp + hh) * 64 + 16 * c + n; float vr = 0.f, vk = 0.f, vv = 0.f;
                    if ((R0 & (SEQ - 1)) != 0) {
                        if (F.wave == 0) { const bf16* bp = bnd + (size_t)(pm - 1) * 1536; vr = bf2f(bp[ch]); vk = bf2f(bp[512 + ch]); vv = bf2f(bp[1024 + ch]); }
                        else { const size_t o = (size_t)(R0 - 1) * 512 + ch; vr = bf2f(R[o]); vk = bf2f(KR[o]); vv = bf2f(VR[o]); }
                    }
                    stash[((hh * 4 + c) * 3 + 0) * 16 + n] = vr; stash[((hh * 4 + c) * 3 + 1) * 16 + n] = vk; stash[((hh * 4 + c) * 3 + 2) * 16 + n] = vv;
                }
        }
        }
        asm volatile("s_waitcnt vmcnt(0) lgkmcnt(0)" ::: "memory"); __syncthreads();
#pragma unroll 1
        for (int g = 1; g >= 0; --g) {
            const int t0 = R0 + 16 * g;
#pragma unroll 1
            for (int hh = 0; hh < 2; ++hh) {
                const int hd = 2 * hp + hh;
                int lane = lane0; asm volatile("" : "+v"(lane));
                const int n = lane & 15, q4 = lane >> 4;
                bf16x8 Af[9];
                {
                    const int t = t0 + n; const bool first = (t & (SEQ - 1)) == 0;
#pragma unroll
                    for (int s = 0; s < 9; ++s) {
                        const u32x4 z1 = *(const u32x4*)(Z + (size_t)t * ZP + 32 * s + 8 * q4);
                        u32x4 z2 = (u32x4){0u, 0u, 0u, 0u}; if (!first) z2 = *(const u32x4*)(Z + (size_t)(t - 1) * ZP + 288 + 32 * s + 8 * q4);
                        float hv[8] = { bflo(z1.x) + bflo(z2.x), bfhi(z1.x) + bfhi(z2.x), bflo(z1.y) + bflo(z2.y), bfhi(z1.y) + bfhi(z2.y), bflo(z1.z) + bflo(z2.z), bfhi(z1.z) + bfhi(z2.z), bflo(z1.w) + bflo(z2.w), bfhi(z1.w) + bfhi(z2.w) };
#pragma unroll
                        for (int i = 0; i < 8; ++i) { if (s < 2) { const float e = fast_exp2(hv[i] * (2.0f * LOG2E)); hv[i] = 1.0f - 2.0f * fast_rcp(e + 1.0f); } else if (s >= 4) hv[i] = sigmoidf_(hv[i]); }
                        u32x4 p; p.x = pk2(hv[0], hv[1]); p.y = pk2(hv[2], hv[3]); p.z = pk2(hv[4], hv[5]); p.w = pk2(hv[6], hv[7]);
                        Af[s] = __builtin_bit_cast(bf16x8, p);
                    }
                }
                const int cid = ((t0 >> 12) * NH + hd) * 256 + ((t0 & (SEQ - 1)) >> 4);
                float At[4][4], Rt[4][4], Bh[4][4], Kh[4][4], pC[4];
                float n2[4] = {0.f, 0.f, 0.f, 0.f}, rks[4] = {0.f, 0.f, 0.f, 0.f};
#pragma unroll
                for (int c = 0; c < 4; ++c) {
                    const int ch = hd * 64 + 16 * c + n;
                    float oR[5], oK[5], oV[5];
                    if (q4 == 0 && g == 0) { oR[0] = stash[((hh * 4 + c) * 3 + 0) * 16 + n]; oK[0] = stash[((hh * 4 + c) * 3 + 1) * 16 + n]; oV[0] = stash[((hh * 4 + c) * 3 + 2) * 16 + n]; }
                    else { const size_t o = (size_t)(t0 + 4 * q4 - 1) * 512 + ch; oR[0] = bf2f(R[o]); oK[0] = bf2f(KR[o]); oV[0] = bf2f(VR[o]); }
#pragma unroll
                    for (int i = 0; i < 4; ++i) { const size_t o = (size_t)(t0 + 4 * q4 + i) * 512 + ch; oR[i + 1] = bf2f(R[o]); oK[i + 1] = bf2f(KR[o]); oV[i + 1] = bf2f(VR[o]); }
                    asm volatile("s_waitcnt vmcnt(0) lgkmcnt(0)" ::: "memory");
                    f32x4 aw = (f32x4){0.f, 0.f, 0.f, 0.f}, aa = aw, ag = aw;
#pragma unroll
                    for (int s = 0; s < 2; ++s) { const bf16x8 b = *(const bf16x8*)(LBW + (size_t)ch * 64 + 32 * s + 8 * q4); aw = __builtin_amdgcn_mfma_f32_16x16x32_bf16(Af[s], b, aw, 0, 0, 0); }
#pragma unroll
                    for (int s = 0; s < 2; ++s) { const bf16x8 b = *(const bf16x8*)(LBA + (size_t)ch * 64 + 32 * s + 8 * q4); aa = __builtin_amdgcn_mfma_f32_16x16x32_bf16(Af[2 + s], b, aa, 0, 0, 0); }
#pragma unroll
                    for (int s = 0; s < 5; ++s) { const bf16x8 b = *(const bf16x8*)(LBG + (size_t)ch * 160 + 32 * s + 8 * q4); ag = __builtin_amdgcn_mfma_f32_16x16x32_bf16(Af[4 + s], b, ag, 0, 0, 0); }
                    const float mr = mixrkv[ch], mk = mixrkv[512 + ch], mv = mixrkv[1024 + ch], w0c = w0[ch], a0c = a0[ch], kkc = k_k[ch], kac = k_a[ch], rkc = r_k[ch];
                    float wt[4], kr[4], as[4], kt[4], rr[4];
#pragma unroll
                    for (int i = 0; i < 4; ++i) {
                        const size_t o = (size_t)(t0 + 4 * q4 + i) * 512 + ch;
                        const float cr = oR[i + 1], ck = oK[i + 1], cv = oV[i + 1];
                        const float r_ = cr + (oR[i] - cr) * mr, k_ = ck + (oK[i] - ck) * mk, v_ = cv + (oV[i] - cv) * mv;
                        const float sg = sigmoidf_(w0c + aw[i]);
                        wt[i] = fast_exp2(-0.6065306597126334f * LOG2E * sg);
                        const float a_ = sigmoidf_(a0c + aa[i]);
                        const float kr_ = k_ * kkc; n2[i] += kr_ * kr_;
                        const float kt_ = k_ * (1.0f + (a_ - 1.0f) * kac);
                        rks[i] += r_ * kt_ * rkc;
                        kr[i] = kr_; as[i] = a_; kt[i] = kt_; rr[i] = r_;
                        VR[o] = (bf16)f2bf(v_); GB[o] = (bf16)f2bf(ag[i]);
                    }
                    {
                        const float p0 = wt[0], p1 = p0 * wt[1], p2 = p1 * wt[2], p3 = p2 * wt[3];
                        const float t1 = __shfl(p3, (lane + 48) & 63), t2 = __shfl(p3, (lane + 32) & 63), t3 = __shfl(p3, (lane + 16) & 63);
                        float E = 1.0f; if (q4 >= 1) E *= t1; if (q4 >= 2) E *= t2; if (q4 >= 3) E *= t3;
                        const float pm[4] = {E, p0 * E, p1 * E, p2 * E}; const float pp[4] = {p0 * E, p1 * E, p2 * E, p3 * E};
                        const float pc_ = __shfl(pp[3], 48 + n); pC[c] = pc_;
#pragma unroll
                        for (int i = 0; i < 4; ++i) {
                            const float ip = 1.0f / pp[i];
                            At[c][i] = kr[i] * pm[i]; Rt[c][i] = rr[i] * pp[i]; Bh[c][i] = kr[i] * as[i] * ip;
                            const float ktt = kt[i] * ip; Kh[c][i] = ktt * pc_;
                            xb[2 * 1088 + (4 * q4 + i) * 68 + 16 * c + n] = ktt;
                        }
                    }
                    asm volatile("" ::: "memory");
                }
#pragma unroll
                for (int i = 0; i < 4; ++i) {
                    float a = n2[i], b = rks[i];
                    a += __shfl_xor(a, 1); a += __shfl_xor(a, 2); a += __shfl_xor(a, 4); a += __shfl_xor(a, 8);
                    b += __shfl_xor(b, 1); b += __shfl_xor(b, 2); b += __shfl_xor(b, 4); b += __shfl_xor(b, 8);
                    n2[i] = 1.0f / fmaxf(sqrtf(a), 1e-12f); rks[i] = b;
                }
                if (n == 0) {
#pragma unroll
                    for (int i = 0; i < 4; ++i) RK[(size_t)(t0 + 4 * q4 + i) * 8 + hd] = rks[i];
                }
#pragma unroll
                for (int c = 0; c < 4; ++c)
#pragma unroll
                    for (int i = 0; i < 4; ++i) {
                        At[c][i] = -At[c][i] * n2[i]; const float bt = Bh[c][i] * n2[i]; Bh[c][i] = bt * pC[c];
                        xb[0 * 1088 + (4 * q4 + i) * 68 + 16 * c + n] = At[c][i]; xb[1 * 1088 + (4 * q4 + i) * 68 + 16 * c + n] = bt;
                    }
                { bf16* bkq = (bf16*)(ws + WS_BKQ) + (size_t)cid * 2048;
#pragma unroll
                  for (int c = 0; c < 4; ++c) { u32x4 w_; w_.x = pk2(Bh[c][0], Bh[c][1]); w_.y = pk2(Bh[c][2], Bh[c][3]); w_.z = pk2(Kh[c][0], Kh[c][1]); w_.w = pk2(Kh[c][2], Kh[c][3]);
                      *(u32x4*)(bkq + ((c * 16 + n) * 4 + q4) * 8) = w_; }
                  if (q4 == 0) { float* pc = (float*)(ws + WS_PC) + (size_t)cid * 64;
#pragma unroll
                      for (int c = 0; c < 4; ++c) pc[16 * c + n] = pC[c]; } }
                LDS_WAIT();
                f32x4v Aab = (f32x4v){0.f, 0.f, 0.f, 0.f}, Aak = Aab, Arb = Aab, Ark = Aab;
                {
                    f32x4v fa[4], fb[4], fk[4];
#pragma unroll
                    for (int s4 = 0; s4 < 4; ++s4) { fa[s4] = *(const LAS f32x4v*)(xb + 0 * 1088 + n * 68 + 16 * q4 + 4 * s4); fb[s4] = *(const LAS f32x4v*)(xb + 1 * 1088 + n * 68 + 16 * q4 + 4 * s4); fk[s4] = *(const LAS f32x4v*)(xb + 2 * 1088 + n * 68 + 16 * q4 + 4 * s4); }
#pragma unroll
                    for (int s4 = 0; s4 < 4; ++s4)
#pragma unroll
                        for (int e = 0; e < 4; ++e) { Aab = MF4(fa[s4][e], fb[s4][e], Aab); Aak = MF4(fa[s4][e], fk[s4][e], Aak); }
                    LDS_WAIT();
#pragma unroll
                    for (int c = 0; c < 4; ++c)
#pragma unroll
                        for (int i = 0; i < 4; ++i) xb[0 * 1088 + (4 * q4 + i) * 68 + 16 * c + n] = Rt[c][i];
                    LDS_WAIT();
#pragma unroll
                    for (int s4 = 0; s4 < 4; ++s4) fa[s4] = *(const LAS f32x4v*)(xb + 0 * 1088 + n * 68 + 16 * q4 + 4 * s4);
#pragma unroll
                    for (int s4 = 0; s4 < 4; ++s4)
#pragma unroll
                        for (int e = 0; e < 4; ++e) { Arb = MF4(fa[s4][e], fb[s4][e], Arb); Ark = MF4(fa[s4][e], fk[s4][e], Ark); }
                }
#pragma unroll
                for (int e = 0; e < 4; ++e) { const int tau = 4 * q4 + e; if (!(tau > n)) { Aab[e] = 0.f; Aak[e] = 0.f; } if (!(tau >= n)) { Arb[e] = 0.f; Ark[e] = 0.f; } }
                LDS_WAIT();
#pragma unroll
                for (int e = 0; e < 4; ++e) { tt[(4 * q4 + e) * 20 + n] = Aab[e]; rb[(4 * q4 + e) * 20 + n] = Arb[e]; }
                LDS_WAIT();
                f32x4v Tf, RBf;
                {
                    float Tc[16];
#pragma unroll
                    for (int tau = 0; tau < 16; ++tau) {
                        float acc = (tau == n) ? 1.0f : 0.0f;
#pragma unroll
                        for (int j4 = 0; j4 < (tau + 3) / 4; ++j4) { const f32x4v arow = *(const LAS f32x4v*)(tt + tau * 20 + 4 * j4);
#pragma unroll
                            for (int e = 0; e < 4; ++e) if (4 * j4 + e < tau) acc += arow[e] * Tc[4 * j4 + e]; }
                        Tc[tau] = acc;
                    }
                    RBf = *(const LAS f32x4v*)(rb + n * 20 + 4 * q4);
                    LDS_WAIT();
                    if (q4 == 0) {
#pragma unroll
                        for (int tau = 0; tau < 16; ++tau) tt[tau * 20 + n] = Tc[tau];
                    }
                    LDS_WAIT();
                    Tf = *(const LAS f32x4v*)(tt + n * 20 + 4 * q4);
                    LDS_WAIT();
                }
                f32x4v Ap[4], Rp[4], M1 = (f32x4v){0.f, 0.f, 0.f, 0.f}, M2 = Ark;
#pragma unroll
                for (int c = 0; c < 4; ++c) { f32x4v acc = (f32x4v){0.f, 0.f, 0.f, 0.f};
#pragma unroll
                    for (int s_ = 0; s_ < 4; ++s_) acc = MF4(Tf[s_], At[c][s_], acc);
                    Ap[c] = acc; }
#pragma unroll
                for (int s_ = 0; s_ < 4; ++s_) M1 = MF4(Tf[s_], Aak[s_], M1);
#pragma unroll
                for (int c = 0; c < 4; ++c) { f32x4v acc = (f32x4v){Rt[c][0], Rt[c][1], Rt[c][2], Rt[c][3]};
#pragma unroll
                    for (int s_ = 0; s_ < 4; ++s_) acc = MF4(RBf[s_], Ap[c][s_], acc);
                    Rp[c] = acc; }
#pragma unroll
                for (int s_ = 0; s_ < 4; ++s_) M2 = MF4(RBf[s_], M1[s_], M2);
#pragma unroll
                for (int pass = 0; pass < 2; ++pass) {
#pragma unroll
                    for (int c = 0; c < 4; ++c)
#pragma unroll
                        for (int i = 0; i < 4; ++i) { const float v_ = pass == 0 ? Ap[c][i] : Rp[c][i];
                            sa[(((c >> 1) * 4 + (n >> 2)) * 16 + 4 * q4 + i) * 8 + 4 * (c & 1) + (n & 3)] = (unsigned short)f2bf(v_); }
#pragma unroll
                    for (int e = 0; e < 4; ++e) { const float v_ = pass == 0 ? M1[e] : M2[e];
                        sa[((2 * 4 + (n >> 2)) * 16 + 4 * q4 + e) * 8 + (n & 3)] = (unsigned short)f2bf(v_); }
                    *(LAS u32x2*)(sa + ((2 * 4 + q4) * 16 + n) * 8 + 4) = (u32x2){0u, 0u};
                    LDS_WAIT();
                    bf16* dst = (bf16*)(ws + (pass == 0 ? WS_AQ : WS_RQ)) + (size_t)cid * 1536;
#pragma unroll
                    for (int s_ = 0; s_ < 3; ++s_) { const u32x4 w_ = *(const LAS u32x4*)(sa + (s_ * 64 + lane) * 8); *(u32x4*)(dst + (s_ * 64 + lane) * 8) = w_; }
                    LDS_WAIT();
                }
            }
        }
        __syncthreads();
    }
}

__device__ __forceinline__ void scan2_phase(Frame& F) {
    if (blockIdx.x >= 32 || F.wave >= 4) return;
    unsigned char* ws = F.ws;
    const int bh = blockIdx.x, wv = F.wave, lane = F.lane, col = lane & 15, q = lane >> 4;
    const int b = bh >> 3, h = bh & 7;
    const bf16* AQ = (const bf16*)(ws + WS_AQ) + (size_t)bh * 256 * 1536; const bf16* RQ = (const bf16*)(ws + WS_RQ) + (size_t)bh * 256 * 1536;
    const bf16* BKQ = (const bf16*)(ws + WS_BKQ) + (size_t)bh * 256 * 2048; const float* PC = (const float*)(ws + WS_PC) + (size_t)bh * 256 * 64;
    const bf16* VR = (const bf16*)(ws + WS_VR) + (size_t)b * SEQ * 512 + h * 64 + 16 * wv + col;
    bf16* Y = (bf16*)(ws + WS_YRAW) + (size_t)b * SEQ * 512 + h * 64 + 16 * wv + col;
    f32x4 st[4];
#pragma unroll
    for (int i = 0; i < 4; ++i) st[i] = (f32x4){0.f, 0.f, 0.f, 0.f};
    struct Ld { bf16x8 aq[3], rq[3], bk[4]; f32x4 pc[4]; unsigned short v[4]; };
    Ld cur, nxt;
#define SC_LOAD(L, ci) do { const int ci_ = (ci); \
        _Pragma("unroll") for (int s_ = 0; s_ < 3; ++s_) { L.aq[s_] = *(const bf16x8*)(AQ + (size_t)ci_ * 1536 + (s_ * 64 + lane) * 8); L.rq[s_] = *(const bf16x8*)(RQ + (size_t)ci_ * 1536 + (s_ * 64 + lane) * 8); } \
        _Pragma("unroll") for (int i_ = 0; i_ < 4; ++i_) { L.bk[i_] = *(const bf16x8*)(BKQ + (size_t)ci_ * 2048 + ((i_ * 16 + col) * 4 + q) * 8); L.pc[i_] = *(const f32x4*)(PC + (size_t)ci_ * 64 + 16 * i_ + 4 * q); \
            L.v[i_] = VR[(size_t)(ci_ * 16 + 4 * q + i_) * 512]; } } while (0)
    SC_LOAD(cur, 0);
    for (int ci = 0; ci < 256; ++ci) {
        SC_LOAD(nxt, ci + 1 < 256 ? ci + 1 : ci);
        bf16x8 sb[2];
#pragma unroll
        for (int s_ = 0; s_ < 2; ++s_) { u32x4 w_; w_.x = pg8::cvt_pk_bf16(st[2 * s_][0], st[2 * s_][1]); w_.y = pg8::cvt_pk_bf16(st[2 * s_][2], st[2 * s_][3]); w_.z = pg8::cvt_pk_bf16(st[2 * s_ + 1][0], st[2 * s_ + 1][1]); w_.w = pg8::cvt_pk_bf16(st[2 * s_ + 1][2], st[2 * s_ + 1][3]);
            sb[s_] = __builtin_bit_cast(bf16x8, w_); }
        const unsigned v01 = (unsigned)cur.v[0] | ((unsigned)cur.v[1] << 16), v23 = (unsigned)cur.v[2] | ((unsigned)cur.v[3] << 16);
        const bf16x8 vf = __builtin_bit_cast(bf16x8, ((u32x4){v01, v23, v01, v23}));
        f32x4 U = (f32x4){0.f, 0.f, 0.f, 0.f}, Yv = U;
        U = __builtin_amdgcn_mfma_f32_16x16x32_bf16(cur.aq[0], sb[0], U, 0, 0, 0); U = __builtin_amdgcn_mfma_f32_16x16x32_bf16(cur.aq[1], sb[1], U, 0, 0, 0); U = __builtin_amdgcn_mfma_f32_16x16x32_bf16(cur.aq[2], vf, U, 0, 0, 0);
        Yv = __builtin_amdgcn_mfma_f32_16x16x32_bf16(cur.rq[0], sb[0], Yv, 0, 0, 0); Yv = __builtin_amdgcn_mfma_f32_16x16x32_bf16(cur.rq[1], sb[1], Yv, 0, 0, 0); Yv = __builtin_amdgcn_mfma_f32_16x16x32_bf16(cur.rq[2], vf, Yv, 0, 0, 0);
        const bf16x8 uf = __builtin_bit_cast(bf16x8, ((u32x4){pg8::cvt_pk_bf16(U[0], U[1]), pg8::cvt_pk_bf16(U[2], U[3]), v01, v23}));
#pragma unroll
        for (int i = 0; i < 4; ++i) st[i] = __builtin_amdgcn_mfma_f32_16x16x32_bf16(cur.bk[i], uf, st[i] * cur.pc[i], 0, 0, 0);
#pragma unroll
        for (int e = 0; e < 4; ++e) Y[(size_t)(ci * 16 + 4 * q + e) * 512] = (bf16)f2bf(Yv[e]);
        cur = nxt;
    }
#undef SC_LOAD
}


__device__ __forceinline__ void scan3_phase(Frame& F) {
    if (blockIdx.x >= 32) return;
    constexpr int NS = 8, DA = 7, SLOT = 12544, O_AQ = 0, O_RQ = 3072, O_BK = 6144, O_PC = 10240, O_V = 10496;
    unsigned char* ws = F.ws;
    const int bh = blockIdx.x, lane = F.lane, b = bh >> 3, h = bh & 7;
    LAS unsigned char* ring = F.lds + RING_OFF;
    const char* AQ = (const char*)(ws + WS_AQ) + (size_t)bh * 256 * 3072; const char* RQ = (const char*)(ws + WS_RQ) + (size_t)bh * 256 * 3072;
    const char* BKQ = (const char*)(ws + WS_BKQ) + (size_t)bh * 256 * 4096; const char* PC = (const char*)(ws + WS_PC) + (size_t)bh * 256 * 256;
    const char* VRb = (const char*)(ws + WS_VR) + ((size_t)b * SEQ * 512 + h * 64) * 2;
#define SC_DMA(src, dstoff) __builtin_amdgcn_global_load_lds((const unsigned*)(src), (LAS unsigned*)(ring + (dstoff)), 16, 0, 0)
#define SC_WAITV(n) asm volatile("s_waitcnt vmcnt(" #n ")" ::: "memory")
    if (F.wave >= 4) {
        const int lw = F.wave - 4;
        if (lw == 0 || lw == 1) {
            const char* src = (lw == 0 ? AQ : RQ) + lane * 16; const int doff = (lw == 0 ? O_AQ : O_RQ);
#define SC_ISSUE(ci) do { const int cc_ = (ci) < 256 ? (ci) : 255; const int so_ = ((ci) & (NS - 1)) * SLOT + doff; const char* s_ = src + (size_t)cc_ * 3072; \
            SC_DMA(s_, so_); SC_DMA(s_ + 1024, so_ + 1024); SC_DMA(s_ + 2048, so_ + 2048); } while (0)
            for (int ci = 0; ci < DA; ++ci) SC_ISSUE(ci);
            SC_WAITV(18); __builtin_amdgcn_s_barrier();
            for (int ci = 0; ci < 256; ++ci) { SC_ISSUE(ci + DA); SC_WAITV(18); __builtin_amdgcn_s_barrier(); }
#undef SC_ISSUE
        } else if (lw == 2) {
            const char* src = BKQ + lane * 16;
#define SC_ISSUE(ci) do { const int cc_ = (ci) < 256 ? (ci) : 255; const int so_ = ((ci) & (NS - 1)) * SLOT + O_BK; const char* s_ = src + (size_t)cc_ * 4096; \
            SC_DMA(s_, so_); SC_DMA(s_ + 1024, so_ + 1024); SC_DMA(s_ + 2048, so_ + 2048); SC_DMA(s_ + 3072, so_ + 3072); } while (0)
            for (int ci = 0; ci < DA; ++ci) SC_ISSUE(ci);
            SC_WAITV(24); __builtin_amdgcn_s_barrier();
            for (int ci = 0; ci < 256; ++ci) { SC_ISSUE(ci + DA); SC_WAITV(24); __builtin_amdgcn_s_barrier(); }
#undef SC_ISSUE
        } else {
            const char* srcp = PC + (lane & 15) * 16; const char* srcv = VRb + (size_t)(lane >> 3) * 1024 + (lane & 7) * 16;
#define SC_ISSUE(ci) do { const int cc_ = (ci) < 256 ? (ci) : 255; const int so_ = ((ci) & (NS - 1)) * SLOT; \
            SC_DMA(srcp + (size_t)cc_ * 256, so_ + O_PC); SC_DMA(srcv + (size_t)cc_ * 16384, so_ + O_V); SC_DMA(srcv + (size_t)cc_ * 16384 + 8192, so_ + O_V + 1024); } while (0)
            for (int ci = 0; ci < DA; ++ci) SC_ISSUE(ci);
            SC_WAITV(18); __builtin_amdgcn_s_barrier();
            for (int ci = 0; ci < 256; ++ci) { SC_ISSUE(ci + DA); SC_WAITV(18); __builtin_amdgcn_s_barrier(); }
#undef SC_ISSUE
        }
    } else {
        const int wv = F.wave, col = lane & 15, q = lane >> 4;
        bf16* Y = (bf16*)(ws + WS_YRAW) + (size_t)b * SEQ * 512 + h * 64 + 16 * wv + col;
        f32x4 st[4];
#pragma unroll
        for (int i = 0; i < 4; ++i) st[i] = (f32x4){0.f, 0.f, 0.f, 0.f};
        __builtin_amdgcn_s_barrier();
        for (int ci = 0; ci < 256; ++ci) {
            const LAS unsigned char* sl = ring + (ci & (NS - 1)) * SLOT;
            bf16x8 aq[3], rq[3], bk[4]; f32x4 pc[4]; unsigned short vv[4];
#pragma unroll
            for (int s_ = 0; s_ < 3; ++s_) { aq[s_] = *(const LAS bf16x8*)(sl + O_AQ + (s_ * 64 + lane) * 16); rq[s_] = *(const LAS bf16x8*)(sl + O_RQ + (s_ * 64 + lane) * 16); }
#pragma unroll
            for (int i = 0; i < 4; ++i) { bk[i] = *(const LAS bf16x8*)(sl + O_BK + ((i * 16 + col) * 4 + q) * 16); pc[i] = *(const LAS f32x4*)(sl + O_PC + (16 * i + 4 * q) * 4);
                vv[i] = *(const LAS unsigned short*)(sl + O_V + (4 * q + i) * 128 + (16 * wv + col) * 2); }
            bf16x8 sb[2];
#pragma unroll
            for (int s_ = 0; s_ < 2; ++s_) { u32x4 w_; w_.x = pg8::cvt_pk_bf16(st[2 * s_][0], st[2 * s_][1]); w_.y = pg8::cvt_pk_bf16(st[2 * s_][2], st[2 * s_][3]); w_.z = pg8::cvt_pk_bf16(st[2 * s_ + 1][0], st[2 * s_ + 1][1]); w_.w = pg8::cvt_pk_bf16(st[2 * s_ + 1][2], st[2 * s_ + 1][3]);
                sb[s_] = __builtin_bit_cast(bf16x8, w_); }
            const unsigned v01 = (unsigned)vv[0] | ((unsigned)vv[1] << 16), v23 = (unsigned)vv[2] | ((unsigned)vv[3] << 16);
            const bf16x8 vf = __builtin_bit_cast(bf16x8, ((u32x4){v01, v23, v01, v23}));
            f32x4 U = (f32x4){0.f, 0.f, 0.f, 0.f}, Yv = U;
            U = __builtin_amdgcn_mfma_f32_16x16x32_bf16(aq[0], sb[0], U, 0, 0, 0); U = __builtin_amdgcn_mfma_f32_16x16x32_bf16(aq[1], sb[1], U, 0, 0, 0); U = __builtin_amdgcn_mfma_f32_16x16x32_bf16(aq[2], vf, U, 0, 0, 0);
            Yv = __builtin_amdgcn_mfma_f32_16x16x32_bf16(rq[0], sb[0], Yv, 0, 0, 0); Yv = __builtin_amdgcn_mfma_f32_16x16x32_bf16(rq[1], sb[1], Yv, 0, 0, 0); Yv = __builtin_amdgcn_mfma_f32_16x16x32_bf16(rq[2], vf, Yv, 0, 0, 0);
            const bf16x8 uf = __builtin_bit_cast(bf16x8, ((u32x4){pg8::cvt_pk_bf16(U[0], U[1]), pg8::cvt_pk_bf16(U[2], U[3]), v01, v23}));
#pragma unroll
            for (int i = 0; i < 4; ++i) st[i] = __builtin_amdgcn_mfma_f32_16x16x32_bf16(bk[i], uf, st[i] * pc[i], 0, 0, 0);
#pragma unroll
            for (int e = 0; e < 4; ++e) Y[(size_t)(ci * 16 + 4 * q + e) * 512] = (bf16)f2bf(Yv[e]);
            asm volatile("s_waitcnt lgkmcnt(0)" ::: "memory"); __builtin_amdgcn_s_barrier();
        }
    }
    asm volatile("s_waitcnt vmcnt(0)" ::: "memory");
#undef SC_DMA
#undef SC_WAITV
}

__device__ __forceinline__ float dpp_sum16(float x) {
    x += __builtin_bit_cast(float, __builtin_amdgcn_update_dpp(0, __builtin_bit_cast(int, x), 0xB1, 0xf, 0xf, true));
    x += __builtin_bit_cast(float, __builtin_amdgcn_update_dpp(0, __builtin_bit_cast(int, x), 0x4E, 0xf, 0xf, true));
    x += __builtin_bit_cast(float, __builtin_amdgcn_update_dpp(0, __builtin_bit_cast(int, x), 0x141, 0xf, 0xf, true));
    x += __builtin_bit_cast(float, __builtin_amdgcn_update_dpp(0, __builtin_bit_cast(int, x), 0x140, 0xf, 0xf, true));
    return x;
}
struct ScanBlk { u32x2 r[4], k[4], kk[4], bb[4]; f32x4 w[4]; unsigned v[4]; };
__device__ __forceinline__ void scan_phase(Frame& F) {
    if (F.wave >= 2) return;
    unsigned char* ws = F.ws;
    const bf16* R = (const bf16*)(ws + WS_R); const bf16* KR = (const bf16*)(ws + WS_KR); const bf16* VR = (const bf16*)(ws + WS_VR);
    const bf16* KK = (const bf16*)(ws + WS_KK); const bf16* BB = (const bf16*)(ws + WS_BB); const float* WD = (const float*)(ws + WS_WDEC);
    bf16* Y = (bf16*)(ws + WS_YRAW);
    for (int task = blockIdx.x * 2 + F.wave; task < 512; task += F.G * 2) {
        const int bh = task >> 4, rg = task & 15, b = bh >> 3, h = bh & 7;
        const int j = F.lane & 15, rr = F.lane >> 4, vi = 4 * rg + rr;
        const size_t base = (size_t)b * SEQ * 512 + h * 64;
        const size_t o4 = base + 4 * j, ov = base + vi;
        float s0 = 0.f, s1 = 0.f, s2 = 0.f, s3 = 0.f, ysel = 0.f;
        ScanBlk cur, nxt;
#define SCAN_LOAD(B, T0) do { _Pragma("unroll") for (int u_ = 0; u_ < 4; ++u_) { const size_t rw_ = (size_t)((T0) + u_) * 512; \
            B.r[u_] = *(const u32x2*)(R + o4 + rw_); B.k[u_] = *(const u32x2*)(KR + o4 + rw_); B.kk[u_] = *(const u32x2*)(KK + o4 + rw_); B.bb[u_] = *(const u32x2*)(BB + o4 + rw_); \
            B.w[u_] = *(const f32x4*)(WD + o4 + rw_); B.v[u_] = VR[ov + rw_]; } } while (0)
        SCAN_LOAD(cur, 0);
        for (int t0 = 0; t0 < SEQ; t0 += 4) {
            const int tn = (t0 + 4 < SEQ) ? t0 + 4 : t0;
            SCAN_LOAD(nxt, tn);
#pragma unroll
            for (int u = 0; u < 4; ++u) {
                const float kk0 = bflo(cur.kk[u].x), kk1 = bfhi(cur.kk[u].x), kk2 = bflo(cur.kk[u].y), kk3 = bfhi(cur.kk[u].y);
                float sa = (s0 * kk0 + s1 * kk1) + (s2 * kk2 + s3 * kk3);
                sa = dpp_sum16(sa);
                const float v_ = __builtin_bit_cast(float, cur.v[u] << 16);
                const float b0 = bflo(cur.bb[u].x), b1 = bfhi(cur.bb[u].x), b2 = bflo(cur.bb[u].y), b3 = bfhi(cur.bb[u].y);
                const float k0 = bflo(cur.k[u].x), k1 = bfhi(cur.k[u].x), k2 = bflo(cur.k[u].y), k3 = bfhi(cur.k[u].y);
                s0 = s0 * cur.w[u][0] + (v_ * k0 - sa * b0); s1 = s1 * cur.w[u][1] + (v_ * k1 - sa * b1); s2 = s2 * cur.w[u][2] + (v_ * k2 - sa * b2); s3 = s3 * cur.w[u][3] + (v_ * k3 - sa * b3);
                const float r0 = bflo(cur.r[u].x), r1 = bfhi(cur.r[u].x), r2 = bflo(cur.r[u].y), r3 = bfhi(cur.r[u].y);
                float y = (s0 * r0 + s1 * r1) + (s2 * r2 + s3 * r3);
                y = dpp_sum16(y);
                if (((t0 + u) & 15) == j) ysel = y;
            }
            if ((t0 & 15) == 12) Y[ov + (size_t)(t0 - 12 + j) * 512] = (bf16)f2bf(ysel);
            cur = nxt;
        }
#undef SCAN_LOAD
    }
}

__device__ __forceinline__ void e1_phase(Frame& F) {
    unsigned char* ws = F.ws;
    const bf16* Y = (const bf16*)(ws + WS_YRAW); const bf16* VR = (const bf16*)(ws + WS_VR); const bf16* GB = (const bf16*)(ws + WS_GB); const float* RK = (const float*)(ws + WS_RK);
    bf16* YB = (bf16*)(ws + WS_YB);
    const float* lnw = F.in[I_LNW]; const float* lnb = F.in[I_LNB];
    const int gw = F.vcu * NWAVES + F.wave, NGW = F.G * NWAVES, c0 = F.lane * 8;
    float lw[8], lb[8];
#pragma unroll
    for (int i = 0; i < 8; ++i) { lw[i] = lnw[c0 + i]; lb[i] = lnb[c0 + i]; }
    for (int m = gw; m < M; m += NGW) {
        const size_t o = (size_t)m * 512 + c0;
        const u32x4 yw = *(const u32x4*)(Y + o), vw = *(const u32x4*)(VR + o), gw_ = *(const u32x4*)(GB + o);
        const float rk = RK[(size_t)m * 8 + (F.lane >> 3)];
        float y[8] = { bflo(yw.x), bfhi(yw.x), bflo(yw.y), bfhi(yw.y), bflo(yw.z), bfhi(yw.z), bflo(yw.w), bfhi(yw.w) };
        const float v[8] = { bflo(vw.x), bfhi(vw.x), bflo(vw.y), bfhi(vw.y), bflo(vw.z), bfhi(vw.z), bflo(vw.w), bfhi(vw.w) };
        const float g[8] = { bflo(gw_.x), bfhi(gw_.x), bflo(gw_.y), bfhi(gw_.y), bflo(gw_.z), bfhi(gw_.z), bflo(gw_.w), bfhi(gw_.w) };
        float s = 0.f;
#pragma unroll
        for (int i = 0; i < 8; ++i) s += y[i];
        s += __shfl_xor(s, 1); s += __shfl_xor(s, 2); s += __shfl_xor(s, 4);
        const float mu = s * (1.0f / 64.0f); float q = 0.f;
#pragma unroll
        for (int i = 0; i < 8; ++i) { y[i] -= mu; q += y[i] * y[i]; }
        q += __shfl_xor(q, 1); q += __shfl_xor(q, 2); q += __shfl_xor(q, 4);
        const float rstd = 1.0f / sqrtf(q * (1.0f / 64.0f) + 64.0f * 1e-5f);
        float ov[8];
#pragma unroll
        for (int i = 0; i < 8; ++i) ov[i] = (y[i] * rstd * lw[i] + lb[i] + rk * v[i]) * g[i];
        u32x4 w; w.x = pk2(ov[0], ov[1]); w.y = pk2(ov[2], ov[3]); w.z = pk2(ov[4], ov[5]); w.w = pk2(ov[6], ov[7]);
        *(u32x4*)(YB + o) = w;
    }
}

__device__ __forceinline__ void fin_phase(Frame& F) {
    const f32x4* gf = (const f32x4*)F.in[I_NFIN] + F.lane;
    const int gw = F.vcu * NWAVES + F.wave, NGW = F.G * NWAVES;
    f32x4 gg[4];
#pragma unroll
    for (int j = 0; j < 4; ++j) gg[j] = gf[64 * j];
    for (int m = gw; m < M; m += NGW) {
        f32x4* xr = (f32x4*)(F.out + (size_t)m * D) + F.lane; f32x4 v[4]; float s = 0.f;
#pragma unroll
        for (int j = 0; j < 4; ++j) { v[j] = xr[64 * j]; s += (v[j].x * v[j].x + v[j].y * v[j].y) + (v[j].z * v[j].z + v[j].w * v[j].w); }
        s = wave_sum(s);
        const float rs = 1.0f / sqrtf(s * (1.0f / D) + RMS_EPS);
#pragma unroll
        for (int j = 0; j < 4; ++j) xr[64 * j] = v[j] * rs * gg[j];
    }
}


#ifdef DBG_OUT
__device__ __forceinline__ void dbg_phase(Frame& F) {
    const int gw = F.vcu * NWAVES + F.wave, NGW = F.G * NWAVES;
    for (int m = gw; m < M; m += NGW) {
        float* o = F.out + (size_t)m * D;
        for (int c = F.lane; c < D; c += 64) {
            bf16 v;
            if (DBG_OUT == 1) v = ((const bf16*)(F.ws + WS_MRG))[(size_t)m * D + c];
            else if (DBG_OUT == 2) v = ((const bf16*)(F.ws + WS_SGA))[(size_t)m * D + c];
            else if (DBG_OUT == 3) v = c < 512 ? ((const bf16*)(F.ws + WS_Q))[(size_t)m * 512 + c] : ((const bf16*)(F.ws + WS_K))[(size_t)m * 512 + c - 512];
            else if (DBG_OUT == 4) v = c < 512 ? ((const bf16*)(F.ws + WS_V))[(size_t)m * 512 + c] : ((const bf16*)(F.ws + WS_R))[(size_t)m * 512 + c - 512];
            else if (DBG_OUT == 5) v = c < 512 ? ((const bf16*)(F.ws + WS_KR))[(size_t)m * 512 + c] : ((const bf16*)(F.ws + WS_VR))[(size_t)m * 512 + c - 512];
            else if (DBG_OUT == 6) v = c < 768 ? ((const bf16*)(F.ws + WS_Z))[(size_t)m * ZP + c] : (bf16)0;
            else if (DBG_OUT == 7) v = ((const bf16*)(F.ws + WS_SGB))[(size_t)m * D + c];
            else if (DBG_OUT == 9) v = ((const bf16*)(F.ws + WS_WG))[(size_t)(m & 2047) * D + c];
            else v = ((const bf16*)(F.ws + WS_XB))[(size_t)m * D + c];
            o[c] = bf2f(v);
        }
    }
}
#endif
struct Args { const float* in[31]; float* out; unsigned char* ws; int ph_lo, ph_hi; };
constexpr int N_PHASES = 14;

#ifndef MK_N_LAUNCHES
#define MK_N_LAUNCHES 1
#endif

__global__ void __launch_bounds__(NWAVES * 64, 2) mk_fwd(Args args) {
    extern __shared__ __attribute__((aligned(16))) unsigned char lds[];
    Frame F;
    F.lds = (LAS unsigned char*)lds; F.MISC = (volatile LAS unsigned*)(F.lds + MISC_OFF);
    F.tid = threadIdx.x; F.lane = F.tid & 63; F.wave = __builtin_amdgcn_readfirstlane(F.tid >> 6);
    F.G = gridDim.x; { const int bx = blockIdx.x; F.vcu = (F.G % 8 == 0) ? (bx % 8) * (F.G / 8) + bx / 8 : bx; }
    F.in = args.in;
    F.out = args.out; F.ws = args.ws; F.ctl = (unsigned*)(args.ws + WS_CTL);
    unsigned char* ws = args.ws;
    for (int u = F.tid; u < (LDS_BYTES - LDSCTL_OFF) / 4; u += NWAVES * 64) ((LAS unsigned*)(F.lds + LDSCTL_OFF))[u] = 0u;
    __syncthreads();
    XcdBarrier bar; bar.bar = F.ctl + CW_BAR; bar.x = 0; bar.st = nullptr;
    if (MK_N_LAUNCHES == 1) bar = xcd_barrier_post(F.ctl + CW_BAR, F.MISC + 8);
    const int lo = args.ph_lo, hi = args.ph_hi;
#ifndef PH_MASK
#define PH_MASK 0xFFFFFFFFu
#endif
#define IN(k) (((PH_MASK >> (k)) & 1u) && lo <= (k) && (k) < hi)
#define SEAM(k) do { if (IN(k) && IN((k) + 1)) xcd_barrier(bar); } while (0)
    float* ssq1 = (float*)(ws + OFF_SSQ1); float* ssq2 = (float*)(ws + WS_SSQ2); float* ssq3 = (float*)(ws + WS_SSQ3);
#ifdef SKIP_MID
    ssq3 = ssq2;
#endif
    bf16* XB = (bf16*)(ws + WS_XB); bf16* ACT = (bf16*)(ws + WS_ACT);
    const int bx = (int)blockIdx.x;

    if (IN(0)) { p0_prologue(F); } SEAM(0);
    if (IN(1)) { pg8::Gemm g{XB, (const bf16*)(ws + WS_WGU1), M, N_GU, D}; pg8::StaticOrder S; S.init(M, N_GU, F.G, bx);
        pg8::EpiSwiGLU<1> E{ACT, FF, ssq1}; pg8::gemm_phase<pg8::EpiSwiGLU<1>, pg8::StaticOrder, true, true>(F.lds + RING_OFF, g, S, E); } SEAM(1);
    if (IN(2)) { pg8::Gemm g{ACT, (const bf16*)(ws + WS_WD1), M, D, FF}; pg8::StaticOrder S; S.init(M, D, F.G, bx);
        pg8::EpiResid E{F.in[I_X], F.out, XB, ssq2, 0.5f}; pg8::gemm_phase<pg8::EpiResid, pg8::StaticOrder, true, true>(F.lds + RING_OFF, g, S, E); } SEAM(2);
    if (IN(3)) { pg8::Gemm g{XB, (const bf16*)(ws + WS_WIN), M, N_IN, D}; pg8::StaticOrder S; S.init(M, N_IN, F.G, bx);
        pg8::EpiProj E{(bf16*)(ws + WS_Q), (bf16*)(ws + WS_Z), ssq2, (float*)(ws + OFF_KMEAN), (bf16*)(ws + WS_BND)};
        pg8::gemm_phase<pg8::EpiProj, pg8::StaticOrder, true, true>(F.lds + RING_OFF, g, S, E); } SEAM(3);
#ifdef ATT_SIMPLE
    if (IN(4)) { attn_simple(F); } SEAM(4);
#else
    if (IN(4)) { const attn_body::AttnTensors AT{(const bf16*)(ws + WS_Q), (const bf16*)(ws + WS_K), (const bf16*)(ws + WS_V), (bf16*)(ws + WS_Q), (const float*)(ws + OFF_KMEAN), F.in[I_RELB]};
        const attn_body::StaticOrder S((int)F.G, bx); attn_body::attn_phase<attn_body::StaticOrder>((char*)lds + RING_OFF, AT, S); } SEAM(4);
#endif
#ifdef SCAN_DIRECT
    if (IN(5)) { mix_phase(F); } SEAM(5);
    if (IN(6)) { scan_phase(F); } SEAM(6);
#else
    if (IN(5)) { mixc_phase(F); } SEAM(5);
    if (IN(6)) { scan3_phase(F); } SEAM(6);
#endif
    if (IN(7)) { e1_phase(F);
        pg8::Gemm g{XB, (const bf16*)(ws + WS_WG), M, N_GATE, D}; pg8::StaticOrder S; S.init(M, N_GATE, F.G, bx);
        pg8::EpiGate<0> E{(bf16*)(ws + WS_SGA), nullptr, (bf16*)(ws + WS_SGB), ssq2}; pg8::gemm_phase<pg8::EpiGate<0>, pg8::StaticOrder, true, true>(F.lds + RING_OFF, g, S, E); } SEAM(7);
    if (IN(8)) { pg8::Gemm g{(const bf16*)(ws + WS_Q), (const bf16*)(ws + WS_WA), M, D, 512}; pg8::StaticOrder S; S.init(M, D, F.G, bx);
        pg8::EpiGate<1> E{(bf16*)(ws + WS_MRG), (const bf16*)(ws + WS_SGA), nullptr, nullptr}; pg8::gemm_phase<pg8::EpiGate<1>, pg8::StaticOrder, true, true>(F.lds + RING_OFF, g, S, E); } SEAM(8);
    if (IN(9)) { pg8::Gemm g{(const bf16*)(ws + WS_YB), (const bf16*)(ws + WS_WB), M, D, 512}; pg8::StaticOrder S; S.init(M, D, F.G, bx);
        pg8::EpiGate<2> E{(bf16*)(ws + WS_MRG), (const bf16*)(ws + WS_SGB), nullptr, nullptr}; pg8::gemm_phase<pg8::EpiGate<2>, pg8::StaticOrder, true, true>(F.lds + RING_OFF, g, S, E); } SEAM(9);
    if (IN(10)) { pg8::Gemm g{(const bf16*)(ws + WS_MRG), (const bf16*)(ws + WS_WOUT), M, D, D}; pg8::StaticOrder S; S.init(M, D, F.G, bx);
        pg8::EpiResid E{F.out, F.out, XB, ssq3, 1.0f}; pg8::gemm_phase<pg8::EpiResid, pg8::StaticOrder, true, true>(F.lds + RING_OFF, g, S, E); } SEAM(10);
    if (IN(11)) { pg8::Gemm g{XB, (const bf16*)(ws + WS_WGU2), M, N_GU, D}; pg8::StaticOrder S; S.init(M, N_GU, F.G, bx);
        pg8::EpiSwiGLU<16> E{ACT, FF, ssq3}; pg8::gemm_phase<pg8::EpiSwiGLU<16>, pg8::StaticOrder, true, true>(F.lds + RING_OFF, g, S, E); } SEAM(11);
    if (IN(12)) { pg8::Gemm g{ACT, (const bf16*)(ws + WS_WD2), M, D, FF}; pg8::StaticOrder S; S.init(M, D, F.G, bx);
        pg8::EpiResid E{F.out, F.out, nullptr, nullptr, 0.5f}; pg8::gemm_phase<pg8::EpiResid, pg8::StaticOrder, true, true>(F.lds + RING_OFF, g, S, E); } SEAM(12);
#ifdef DBG_OUT
    if (IN(13)) { dbg_phase(F); }
#else
    if (IN(13)) { fin_phase(F); }
#endif
#undef IN
#undef SEAM
}

extern "C" void kernel_launch(void* const* d_in, const int* in_sizes, int n_in, void* d_out, int out_size, void* d_ws, size_t ws_size, hipStream_t stream) {
    static int grid = 0;
    if (grid == 0) {
        if (n_in != 31 || out_size != M * D || ws_size < WS_END) { fprintf(stderr, "kernel_launch: unexpected shapes: n_in %d out %d ws %zu\n", n_in, out_size, ws_size); grid = -1; return; }
        int dev = 0, cus = 0;
        if (hipGetDevice(&dev) != hipSuccess || hipDeviceGetAttribute(&cus, hipDeviceAttributeMultiprocessorCount, dev) != hipSuccess) { grid = -1; return; }
        if (hipFuncSetAttribute((const void*)mk_fwd, hipFuncAttributeMaxDynamicSharedMemorySize, LDS_BYTES) != hipSuccess) { fprintf(stderr, "kernel_launch: hipFuncSetAttribute failed\n"); grid = -1; return; }
        int per_cu = 0;
        if (hipOccupancyMaxActiveBlocksPerMultiprocessor(&per_cu, (const void*)mk_fwd, NWAVES * 64, LDS_BYTES) != hipSuccess || per_cu < 1) fprintf(stderr, "kernel_launch: occupancy query says %d\n", per_cu);
        (void)hipGetLastError();
        grid = cus;
    }
    if (grid < 0) return;
    (void)hipMemsetAsync((char*)d_ws + WS_CTL, 0, CTL_ZERO_BYTES, stream);
    Args a{};
    for (int i = 0; i < 31; ++i) a.in[i] = (const float*)d_in[i];
    a.out = (float*)d_out; a.ws = (unsigned char*)d_ws;
#if MK_N_LAUNCHES == 1
    a.ph_lo = 0; a.ph_hi = N_PHASES;
    hipLaunchKernelGGL(mk_fwd, dim3(grid), dim3(NWAVES * 64), LDS_BYTES, stream, a);
#else
    for (int p = 0; p < N_PHASES; ++p) { a.ph_lo = p; a.ph_hi = p + 1; hipLaunchKernelGGL(mk_fwd, dim3(grid), dim3(NWAVES * 64), LDS_BYTES, stream, a); }
#endif
}
```

```cpp
#include <hip/hip_runtime.h>
#include <cstdio>
#include <cstdint>

#define LAS __attribute__((address_space(3)))
#define GAS __attribute__((address_space(1)))
typedef unsigned short bf16;
typedef short bf16x8 __attribute__((ext_vector_type(8)));
typedef float f32x4 __attribute__((ext_vector_type(4)));
typedef float f32x2 __attribute__((ext_vector_type(2)));
typedef unsigned u32x4 __attribute__((ext_vector_type(4)));
typedef unsigned u32x2 __attribute__((ext_vector_type(2)));

constexpr int M = 16384, D = 1024, FF = 2816, SEQ = 4096, NBATCH = 4, NH = 8, HD = 64, WR = 512;
constexpr int N_GU = 2 * FF;
constexpr int N_IN = 3840;
constexpr int N_GATE = 2048;
constexpr int ZP = 768;
constexpr float RMS_EPS = 1e-6f;
constexpr float LOG2E = 1.4426950408889634f;
constexpr float C2 = 0.125f * LOG2E;

constexpr size_t MiB = 1u << 20;
constexpr size_t WS_CTL = 0, CTL_ZERO_BYTES = 1 * MiB;
constexpr int CW_TMO = 0, CW_BAR = 4096;
constexpr size_t OFF_SSQ1 = 65536, OFF_SSQ2 = 131072, OFF_SSQ3 = 196608, OFF_SSQ4 = 262144, OFF_KMEAN = 327680;
constexpr size_t WS_RK = 1 * MiB;
constexpr size_t WS_BND = 1 * MiB + 512 * 1024;
constexpr size_t WS_WGU1 = 2 * MiB, WS_WD1 = 13 * MiB, WS_WIN = 18 * MiB + 512 * 1024, WS_WG = 26 * MiB, WS_WA = 30 * MiB, WS_WB = 31 * MiB,
                 WS_WOUT = 32 * MiB, WS_WGU2 = 34 * MiB, WS_WD2 = 45 * MiB, WS_LBW = 50 * MiB + 512 * 1024, WS_LBA = WS_LBW + 65536, WS_LBG = WS_LBA + 65536;
constexpr size_t WS_XB = 51 * MiB;
constexpr size_t WS_ACT = 83 * MiB;
constexpr size_t WS_Q = 83 * MiB, WS_K = 99 * MiB, WS_V = 115 * MiB, WS_R = 131 * MiB, WS_KR = 147 * MiB, WS_VR = 163 * MiB;
constexpr size_t WS_Z = 179 * MiB;
constexpr size_t WS_WDEC = 203 * MiB;
constexpr size_t WS_GB = 235 * MiB;
constexpr size_t WS_KK = WS_K, WS_BB = WS_V;
constexpr size_t WS_YRAW = WS_Z;
constexpr size_t WS_YB = WS_GB;
constexpr size_t WS_SGA = 131 * MiB, WS_SGB = 203 * MiB;
constexpr size_t WS_MRG = WS_SGA;
constexpr size_t WS_AQ = 2 * MiB;
constexpr size_t WS_BKQ = 99 * MiB;
constexpr size_t WS_RQ = 203 * MiB;
constexpr size_t WS_PC = 227 * MiB;
constexpr size_t WS_SSQ2 = 251 * MiB, WS_SSQ3 = 252 * MiB, WS_SSQ4 = 253 * MiB;
constexpr size_t WS_END = 256 * MiB;

typedef __bf16 bf16x2_hw __attribute__((ext_vector_type(2)));
__device__ __forceinline__ unsigned pk2(float lo, float hi) { const f32x2 v = {lo, hi}; const bf16x2_hw b = __builtin_convertvector(v, bf16x2_hw); return __builtin_bit_cast(unsigned, b); }
__device__ __forceinline__ unsigned f2bf(float f) { return pk2(f, 0.0f) & 0xffffu; }
__device__ __forceinline__ float bflo(unsigned w) { return __builtin_bit_cast(float, w << 16); }
__device__ __forceinline__ float bfhi(unsigned w) { return __builtin_bit_cast(float, w & 0xffff0000u); }
__device__ __forceinline__ float bf2f(bf16 h) { return __builtin_bit_cast(float, (unsigned)h << 16); }
__device__ __forceinline__ float fast_exp2(float x) { return __builtin_amdgcn_exp2f(x); }
__device__ __forceinline__ float fast_rcp(float x) { return __builtin_amdgcn_rcpf(x); }
__device__ __forceinline__ float sigmoidf_(float x) { return fast_rcp(1.0f + fast_exp2(-x * LOG2E)); }
#define LDS_WAIT() asm volatile("s_waitcnt lgkmcnt(0)" ::: "memory")
#define VM_WAIT() asm volatile("s_waitcnt vmcnt(0)" ::: "memory")

namespace pg8 {
#define PG8_LAS __attribute__((address_space(3)))
typedef unsigned short bf16_t;
constexpr int BM = 256, BK = 64, HALF = 128, HTB = HALF * BK * 2, STAGE_BYTES = 8 * HTB, NXCD = 8, WGM = 8;
__host__ __device__ __forceinline__ int lds_byte(int r, int c) { const int st = (r >> 4) * 2 + (c >> 5), rr = r & 15, cc = c & 31, ob = rr * 64 + cc * 2; return st * 1024 + (ob ^ (((ob >> 9) & 1) << 5)); }
__host__ __device__ __forceinline__ void stage_rc(int b, int& R, int& C) { const int st = b / 1024, sb = b % 1024, swz = sb ^ (((sb >> 9) & 1) << 5); R = (st >> 1) * 16 + swz / 64; C = (st & 1) * 32 + (swz % 64) / 2; }
__host__ __device__ __forceinline__ int perm32(int rho) { const int n = rho >> 4, i = rho & 15; return 8 * (i >> 2) + 4 * n + (i & 3); }
struct Unit { int pm, pn; };
struct Gemm { const bf16_t* A; const bf16_t* Bt; int M, N, K; };
struct StaticOrder {
    int nM, nN, nwg, G, c;
    __host__ __device__ void init(int M_, int N_, int G_, int c_) { nM = M_ / BM; nN = N_ / BM; nwg = nM * nN; G = G_; c = c_; }
    __host__ __device__ bool next(int i, Unit& u) const {
        const long L = (long)i * G + c; if (L >= nwg) return false;
        int wgid = (int)L; { const int q = nwg / NXCD, r = nwg % NXCD, xcd = wgid % NXCD, off = wgid / NXCD; wgid = (xcd < r ? xcd * (q + 1) : r * (q + 1) + (xcd - r) * q) + off; }
        const int nig = WGM * nN, gid = wgid / nig, fm = gid * WGM, gsz = (nM - fm) < WGM ? (nM - fm) : WGM;
        u.pm = fm + ((wgid % nig) % gsz); u.pn = (wgid % nig) / gsz; return true;
    }
    __device__ __forceinline__ void a_ready(const Unit&) const {}
    __device__ __forceinline__ void done(const Unit&) const {}
};
typedef __bf16 bf16x2_t __attribute__((ext_vector_type(2)));
__device__ __forceinline__ unsigned cvt_pk_bf16(float lo, float hi) { const f32x2 v = {lo, hi}; const bf16x2_t b = __builtin_convertvector(v, bf16x2_t); return __builtin_bit_cast(unsigned, b); }


template <int NP> __device__ __forceinline__ float row_ssq(const float* p, int row) {
    if (NP == 1) return p[row];
    const f32x4* q = (const f32x4*)(p + (size_t)row * 16); const f32x4 a = q[0], b = q[1], c = q[2], d = q[3];
    return (((a[0] + a[1]) + (a[2] + a[3])) + ((b[0] + b[1]) + (b[2] + b[3]))) + (((c[0] + c[1]) + (c[2] + c[3])) + ((d[0] + d[1]) + (d[2] + d[3])));
}
template <int NP> struct EpiSwiGLU {
    static constexpr bool PERM = true, AFTER_DRAIN = false;
    bf16_t* O; int ldc; const float* ssq;
    __device__ __forceinline__ void operator()(const f32x4 (&acc)[2][2][4][2], const Unit& u, int wr, int wc, int fr, int fq) const {
        const int row0 = u.pm * BM + wr * 64 + fr, col0 = u.pn * 128 + wc * 32 + 8 * fq;
#pragma unroll
        for (int ai = 0; ai < 2; ++ai)
#pragma unroll
            for (int m = 0; m < 4; ++m) {
                const int row = row0 + ai * HALF + m * 16;
                const float rs = 1.0f / sqrtf(row_ssq<NP>(ssq, row) * (1.0f / D) + RMS_EPS);
                float o[8];
#pragma unroll
                for (int n = 0; n < 2; ++n)
#pragma unroll
                    for (int i = 0; i < 4; ++i) { const float g = acc[ai][0][m][n][i] * rs, up = acc[ai][1][m][n][i] * rs; o[n * 4 + i] = g * sigmoidf_(g) * up; }
                u32x4 w; w.x = cvt_pk_bf16(o[0], o[1]); w.y = cvt_pk_bf16(o[2], o[3]); w.z = cvt_pk_bf16(o[4], o[5]); w.w = cvt_pk_bf16(o[6], o[7]);
                *(u32x4*)(O + (size_t)row * ldc + col0) = w;
            }
    }
};
struct EpiResid {
    static constexpr bool PERM = false, AFTER_DRAIN = false;
    const float* xin; float* xout; bf16_t* xb; float* ssq; float alpha;
    __device__ __forceinline__ void operator()(const f32x4 (&acc)[2][2][4][2], const Unit& u, int wr, int wc, int fr, int fq) const {
        const int row0 = u.pm * BM + wr * 64 + fr, col0 = u.pn * BM + wc * 32 + 4 * fq;
#pragma unroll
        for (int ai = 0; ai < 2; ++ai)
#pragma unroll
            for (int m = 0; m < 4; ++m) {
                const int row = row0 + ai * HALF + m * 16; const size_t off = (size_t)row * D + col0; float s = 0.f;
#pragma unroll
                for (int bj = 0; bj < 2; ++bj)
#pragma unroll
                    for (int n = 0; n < 2; ++n) {
                        const f32x4 v = *(const f32x4*)(xin + off + bj * HALF + n * 16) + acc[ai][bj][m][n] * alpha;
                        *(f32x4*)(xout + off + bj * HALF + n * 16) = v;
                        s += (v[0] * v[0] + v[1] * v[1]) + (v[2] * v[2] + v[3] * v[3]);
                        if (xb) { u32x2 w; w.x = cvt_pk_bf16(v[0], v[1]); w.y = cvt_pk_bf16(v[2], v[3]); *(u32x2*)(xb + off + bj * HALF + n * 16) = w; }
                    }
                s += __shfl_xor(s, 16); s += __shfl_xor(s, 32);
                if (fq == 0 && ssq) ssq[(size_t)row * 16 + u.pn * 4 + wc] = s;
                asm volatile("" ::: "memory");
            }
    }
};
struct EpiProj {
    static constexpr bool PERM = true, AFTER_DRAIN = false;
    bf16_t* arr0; bf16_t* zbuf; const float* ssq; float* kmean; bf16_t* bnd;
    __device__ __forceinline__ void operator()(const f32x4 (&acc)[2][2][4][2], const Unit& u, int wr, int wc, int fr, int fq) const {
        const int pn = u.pn; const int row0 = u.pm * BM + wr * 64 + fr;
        bf16_t* dst; int pitch, colt;
        if (pn < 12) { dst = arr0 + (size_t)(pn >> 1) * ((size_t)M * 512); pitch = 512; colt = (pn & 1) * 256; } else { dst = zbuf; pitch = ZP; colt = (pn - 12) * 256; }
        const float sc = (pn < 2) ? C2 : 1.0f; const int col0 = colt + wc * 32 + 8 * fq;
        const bool is_k = (pn == 2 || pn == 3), is_rkv = (pn >= 6 && pn < 12);
        float cs[2][8];
#pragma unroll
        for (int bj = 0; bj < 2; ++bj)
#pragma unroll
            for (int i = 0; i < 8; ++i) cs[bj][i] = 0.f;
#pragma unroll
        for (int ai = 0; ai < 2; ++ai)
#pragma unroll
            for (int m = 0; m < 4; ++m) {
                const int row = row0 + ai * HALF + m * 16;
                const float rs = sc / sqrtf(row_ssq<16>(ssq, row) * (1.0f / D) + RMS_EPS);
#pragma unroll
                for (int bj = 0; bj < 2; ++bj) {
                    float o[8];
#pragma unroll
                    for (int n = 0; n < 2; ++n)
#pragma unroll
                        for (int i = 0; i < 4; ++i) { o[n * 4 + i] = acc[ai][bj][m][n][i] * rs; cs[bj][n * 4 + i] += o[n * 4 + i]; }
                    u32x4 w; w.x = cvt_pk_bf16(o[0], o[1]); w.y = cvt_pk_bf16(o[2], o[3]); w.z = cvt_pk_bf16(o[4], o[5]); w.w = cvt_pk_bf16(o[6], o[7]);
                    *(u32x4*)(dst + (size_t)row * pitch + col0 + bj * HALF) = w;
                    if (is_rkv && ai == 1 && m == 3 && wr == 1 && fr == 15) *(u32x4*)(bnd + (size_t)u.pm * 1536 + (pn - 6) * 256 + wc * 32 + 8 * fq + bj * HALF) = w;
                }
            }
        if (is_k) {
#pragma unroll
            for (int bj = 0; bj < 2; ++bj)
#pragma unroll
                for (int i = 0; i < 8; ++i) { float v = cs[bj][i]; v += __shfl_xor(v, 1); v += __shfl_xor(v, 2); v += __shfl_xor(v, 4); v += __shfl_xor(v, 8);
                    if (fr == 0) { const int col = (pn - 2) * 256 + bj * HALF + wc * 32 + 8 * fq + i; atomicAdd(kmean + ((size_t)((u.pm >> 4) * NH + (col >> 6)) * 16 + (u.pm & 15)) * 64 + (col & 63), v); } }
        }
    }
};
template <int MODE> struct EpiGate {
    static constexpr bool PERM = true, AFTER_DRAIN = false;
    bf16_t* out; const bf16_t* gate; bf16_t* out2; const float* ssq;
    __device__ __forceinline__ void operator()(const f32x4 (&acc)[2][2][4][2], const Unit& u, int wr, int wc, int fr, int fq) const {
        const int row0 = u.pm * BM + wr * 64 + fr; int pn = u.pn; bf16_t* dst = out;
        if (MODE == 0 && pn >= 4) { pn -= 4; dst = out2; }
        const int col0 = pn * BM + wc * 32 + 8 * fq;
#pragma unroll
        for (int ai = 0; ai < 2; ++ai)
#pragma unroll
            for (int m = 0; m < 4; ++m) {
                const int row = row0 + ai * HALF + m * 16;
                float rs = 1.0f; if (MODE == 0) rs = 1.0f / sqrtf(row_ssq<16>(ssq, row) * (1.0f / D) + RMS_EPS);
#pragma unroll
                for (int bj = 0; bj < 2; ++bj) {
                    const size_t off = (size_t)row * D + col0 + bj * HALF; float o[8];
#pragma unroll
                    for (int n = 0; n < 2; ++n)
#pragma unroll
                        for (int i = 0; i < 4; ++i) o[n * 4 + i] = acc[ai][bj][m][n][i];
                    if (MODE == 0) {
#pragma unroll
                        for (int i = 0; i < 8; ++i) o[i] = sigmoidf_(o[i] * rs);
                    } else {
                        const u32x4 g = *(const u32x4*)(gate + off);
                        o[0] *= bflo(g.x); o[1] *= bfhi(g.x); o[2] *= bflo(g.y); o[3] *= bfhi(g.y); o[4] *= bflo(g.z); o[5] *= bfhi(g.z); o[6] *= bflo(g.w); o[7] *= bfhi(g.w);
                        if (MODE == 2) { const u32x4 p = *(const u32x4*)(dst + off);
                            o[0] += bflo(p.x); o[1] += bfhi(p.x); o[2] += bflo(p.y); o[3] += bfhi(p.y); o[4] += bflo(p.z); o[5] += bfhi(p.z); o[6] += bflo(p.w); o[7] += bfhi(p.w); }
                    }
                    u32x4 w; w.x = cvt_pk_bf16(o[0], o[1]); w.y = cvt_pk_bf16(o[2], o[3]); w.z = cvt_pk_bf16(o[4], o[5]); w.w = cvt_pk_bf16(o[6], o[7]);
                    *(u32x4*)(dst + off) = w;
                }
            }
    }
};

template <class Epi, class Sched, bool ALIGN_EPI = false, bool SP2 = false>
__device__ __forceinline__ void gemm_phase(PG8_LAS unsigned char* lds, const Gemm g, const Sched& S, const Epi& E) {
    const int tid = threadIdx.x, wid = __builtin_amdgcn_readfirstlane(tid >> 6), lane = tid & 63, wr = wid >> 2, wc = wid & 3, fr = lane & 15, fq = lane >> 4;
    const int K = g.K, nt = K / BK;
    unsigned voffA[2], voffB[2];
#pragma unroll
    for (int i = 0; i < 2; ++i) { int R, C; stage_rc(tid * 16 + i * 8192, R, C); const int Rb = Epi::PERM ? ((R & ~31) + perm32(R & 31)) : R;
        voffA[i] = (unsigned)(R * K + C) * 2u; voffB[i] = (unsigned)(Rb * K + C) * 2u; }
    const size_t kstep = (size_t)(BK * 2);
    const size_t hstep = (size_t)HALF * K * 2;
    const size_t tstep = 2 * hstep;
    const unsigned ldsw = (unsigned)wid * 1024u;
    const int aoff = lds_byte(wr * 64 + fr, fq * 8), boff = lds_byte(wc * 32 + fr, fq * 8);
#define PG8_SA(b, h) (((b) * 2 + (h)) * HTB)
#define PG8_SB(b, h) ((4 + (b) * 2 + (h)) * HTB)
#define PG8_STAGE(bufoff, gbase, voff) do { _Pragma("unroll") for (int _i = 0; _i < 2; ++_i) \
        __builtin_amdgcn_global_load_lds((const unsigned*)((const char*)(gbase) + (voff)[_i]), (PG8_LAS unsigned*)(lds + (bufoff) + ldsw + _i * 8192), 16, 0, 0); } while (0)
#define PG8_LDA(dst, b, h) do { _Pragma("unroll") for (int m = 0; m < 4; ++m) _Pragma("unroll") for (int k = 0; k < 2; ++k) dst[m][k] = *(const PG8_LAS bf16x8*)(lds + PG8_SA(b, h) + aoff + m * 2048 + k * 1024); } while (0)
#define PG8_LDB(dst, b, h) do { _Pragma("unroll") for (int n = 0; n < 2; ++n) _Pragma("unroll") for (int k = 0; k < 2; ++k) dst[n][k] = *(const PG8_LAS bf16x8*)(lds + PG8_SB(b, h) + boff + n * 2048 + k * 1024); } while (0)
#define PG8_MMA(ai, bj, At, Bt) do { __builtin_amdgcn_s_setprio(1); _Pragma("unroll") for (int m = 0; m < 4; ++m) _Pragma("unroll") for (int n = 0; n < 2; ++n) _Pragma("unroll") for (int k = 0; k < 2; ++k) \
        acc[ai][bj][m][n] = __builtin_amdgcn_mfma_f32_16x16x32_bf16(Bt[n][k], At[m][k], acc[ai][bj][m][n], 0, 0, 0); __builtin_amdgcn_s_setprio(0); } while (0)
#define PG8_WAIT_V(n) asm volatile("s_waitcnt vmcnt(" #n ")" ::: "memory")
#define PG8_WAIT_L(n) asm volatile("s_waitcnt lgkmcnt(" #n ")" ::: "memory")
#define PG8_BAR __builtin_amdgcn_s_barrier()
#define PG8_SCHED __builtin_amdgcn_sched_barrier(0)
    Unit cur, nxt; int ui = 0;
    if (!S.next(0, cur)) return;
    f32x4 acc[2][2][4][2];
#pragma unroll
    for (int a = 0; a < 2; ++a)
#pragma unroll
        for (int b = 0; b < 2; ++b)
#pragma unroll
            for (int m = 0; m < 4; ++m)
#pragma unroll
                for (int n = 0; n < 2; ++n) acc[a][b][m][n] = (f32x4){0.f, 0.f, 0.f, 0.f};
    bf16x8 At[4][2], B0[2][2], B1[2][2];
    const char* cA = (const char*)g.A + (size_t)cur.pm * tstep; const char* cB = (const char*)g.Bt + (size_t)cur.pn * tstep;
    S.a_ready(cur);
    if constexpr (SP2) {
        PG8_STAGE(PG8_SB(0, 0), cB, voffB); PG8_STAGE(PG8_SB(0, 1), cB + hstep, voffB); PG8_STAGE(PG8_SA(0, 0), cA, voffA); PG8_STAGE(PG8_SA(0, 1), cA + hstep, voffA);
        if (wr == 1) PG8_BAR;
        PG8_WAIT_V(2); PG8_BAR;
        PG8_STAGE(PG8_SB(1, 0), cB + kstep, voffB); PG8_STAGE(PG8_SA(1, 0), cA + kstep, voffA); PG8_STAGE(PG8_SB(1, 1), cB + hstep + kstep, voffB);
        PG8_WAIT_V(6); PG8_BAR;
    } else {
        PG8_STAGE(PG8_SB(0, 0), cB, voffB); PG8_STAGE(PG8_SA(0, 0), cA, voffA); PG8_STAGE(PG8_SB(0, 1), cB + hstep, voffB); PG8_STAGE(PG8_SA(0, 1), cA + hstep, voffA);
        if (wr == 1) PG8_BAR;
        PG8_WAIT_V(4); PG8_BAR;
        PG8_STAGE(PG8_SB(1, 0), cB + kstep, voffB); PG8_STAGE(PG8_SA(1, 0), cA + kstep, voffA); PG8_STAGE(PG8_SB(1, 1), cB + hstep + kstep, voffB);
        PG8_WAIT_V(6); PG8_BAR;
    }
    for (;;) {
        const bool has_next = S.next(ui + 1, nxt);
        const char* nA = has_next ? (const char*)g.A + (size_t)nxt.pm * tstep : cA; const char* nB = has_next ? (const char*)g.Bt + (size_t)nxt.pn * tstep : cB;
        for (int t = 0; t < nt; t += 2) {
            const bool last = (t == nt - 2);
            const char* a1 = cA + (size_t)(t + 1) * kstep;
            const char* a2 = last ? nA : cA + (size_t)(t + 2) * kstep; const char* b2 = last ? nB : cB + (size_t)(t + 2) * kstep;
            const char* a3 = a2 + kstep; const char* b3 = b2 + kstep;
            if (last && has_next) S.a_ready(nxt);
            if constexpr (SP2) {
            PG8_LDB(B0, 0, 0); PG8_LDB(B1, 0, 1); PG8_SCHED; PG8_LDA(At, 0, 0); PG8_STAGE(PG8_SA(1, 1), a1 + hstep, voffA);
            PG8_WAIT_V(8); PG8_WAIT_L(0); PG8_BAR; PG8_MMA(0, 0, At, B0); PG8_MMA(0, 1, At, B1); PG8_BAR; PG8_SCHED;
            PG8_LDA(At, 0, 1); PG8_STAGE(PG8_SB(0, 0), b2, voffB); PG8_STAGE(PG8_SB(0, 1), b2 + hstep, voffB); PG8_STAGE(PG8_SA(0, 0), a2, voffA);
            PG8_WAIT_V(8); PG8_WAIT_L(0); PG8_BAR; PG8_MMA(1, 0, At, B0); PG8_MMA(1, 1, At, B1); PG8_BAR; PG8_SCHED;
            PG8_LDB(B0, 1, 0); PG8_LDB(B1, 1, 1); PG8_SCHED; PG8_LDA(At, 1, 0); PG8_STAGE(PG8_SA(0, 1), a2 + hstep, voffA);
            PG8_WAIT_V(8); PG8_WAIT_L(0); PG8_BAR; PG8_MMA(0, 0, At, B0); PG8_MMA(0, 1, At, B1); PG8_BAR; PG8_SCHED;
            PG8_LDA(At, 1, 1); PG8_STAGE(PG8_SB(1, 0), b3, voffB); PG8_STAGE(PG8_SB(1, 1), b3 + hstep, voffB); PG8_STAGE(PG8_SA(1, 0), a3, voffA);
            PG8_WAIT_V(8); PG8_WAIT_L(0); PG8_BAR; PG8_MMA(1, 0, At, B0); PG8_MMA(1, 1, At, B1); PG8_BAR; PG8_SCHED;
            } else {
            PG8_LDB(B0, 0, 0); PG8_SCHED; PG8_LDA(At, 0, 0); PG8_STAGE(PG8_SA(1, 1), a1 + hstep, voffA);
            PG8_WAIT_L(8); PG8_BAR; PG8_WAIT_L(0); PG8_MMA(0, 0, At, B0); PG8_BAR; PG8_SCHED;
            PG8_LDB(B1, 0, 1); PG8_STAGE(PG8_SB(0, 0), b2, voffB);
            PG8_BAR; PG8_WAIT_L(0); PG8_MMA(0, 1, At, B1); PG8_BAR;
            PG8_LDA(At, 0, 1); PG8_STAGE(PG8_SA(0, 0), a2, voffA);
            PG8_BAR; PG8_WAIT_L(0); PG8_MMA(1, 0, At, B0); PG8_BAR; PG8_SCHED;
            PG8_STAGE(PG8_SB(0, 1), b2 + hstep, voffB);
            PG8_WAIT_V(6); PG8_BAR; PG8_MMA(1, 1, At, B1); PG8_BAR;
            PG8_LDB(B0, 1, 0); PG8_SCHED; PG8_LDA(At, 1, 0); PG8_STAGE(PG8_SA(0, 1), a2 + hstep, voffA);
            PG8_WAIT_L(8); PG8_BAR; PG8_WAIT_L(0); PG8_MMA(0, 0, At, B0); PG8_BAR; PG8_SCHED;
            PG8_LDB(B1, 1, 1); PG8_STAGE(PG8_SB(1, 0), b3, voffB);
            PG8_BAR; PG8_WAIT_L(0); PG8_MMA(0, 1, At, B1); PG8_BAR;
            PG8_LDA(At, 1, 1); PG8_STAGE(PG8_SA(1, 0), a3, voffA);
            PG8_BAR; PG8_WAIT_L(0); PG8_MMA(1, 0, At, B0); PG8_BAR; PG8_SCHED;
            PG8_STAGE(PG8_SB(1, 1), b3 + hstep, voffB);
            PG8_WAIT_V(6); PG8_BAR; PG8_MMA(1, 1, At, B1); PG8_BAR;
            }
        }
        if constexpr (ALIGN_EPI) { if (wr == 0) PG8_BAR; }
        if constexpr (!Epi::AFTER_DRAIN) { E(acc, cur, wr, wc, fr, fq); S.done(cur); }
        if (!has_next) break;
#pragma unroll
        for (int a = 0; a < 2; ++a)
#pragma unroll
            for (int b = 0; b < 2; ++b)
#pragma unroll
                for (int m = 0; m < 4; ++m)
#pragma unroll
                    for (int n = 0; n < 2; ++n) acc[a][b][m][n] = (f32x4){0.f, 0.f, 0.f, 0.f};
        cur = nxt; cA = nA; cB = nB; ++ui;
        if constexpr (ALIGN_EPI) { if (wr == 1) PG8_BAR; }
    }
    PG8_WAIT_V(0);
    if constexpr (!ALIGN_EPI) { if (wr == 0) PG8_BAR; }
    PG8_BAR;
#undef PG8_SA
#undef PG8_SB
#undef PG8_STAGE
#undef PG8_LDA
#undef PG8_LDB
#undef PG8_MMA
#undef PG8_WAIT_V
#undef PG8_WAIT_L
#undef PG8_BAR
#undef PG8_SCHED
}
}

#define XB_TMO      128
#define XB_XCNT(j)  (256  + 64 * (j))
#define XB_XSUB(j)  (1280 + 64 * (j))
#define XB_XGEN(j)  (2304 + 64 * (j))
#define XB_TOP      3328
#define XB_TOPGEN   3392
#define XCD_BAR_WORDS 3456
#define XB_SPIN_CAP (1u << 18)
__device__ __forceinline__ unsigned xb_ld(unsigned* p)              { return __hip_atomic_load(p, __ATOMIC_RELAXED, __HIP_MEMORY_SCOPE_AGENT); }
__device__ __forceinline__ unsigned xb_add(unsigned* p, unsigned v) { return __hip_atomic_fetch_add(p, v, __ATOMIC_RELAXED, __HIP_MEMORY_SCOPE_AGENT); }
__device__ __forceinline__ unsigned xb_xcc_id() { return (unsigned)__builtin_amdgcn_s_getreg((3 << 11) | 20) & 0xFu; }
#define XB_SPIN(cond, bar) do { unsigned _sp = 0; while (cond) { __builtin_amdgcn_s_sleep(1); \
    if ((++_sp & 255u) == 0u) { if (xb_ld(&(bar)[XB_TMO])) break; if (_sp > XB_SPIN_CAP) { atomicAdd(&(bar)[XB_TMO], 1u); break; } } } } while (0)
struct XcdBarrier { unsigned* bar; unsigned x; volatile LAS unsigned* st; };
__device__ __forceinline__ XcdBarrier xcd_barrier_post(unsigned* bar, volatile LAS unsigned* st) {
    XcdBarrier b; b.bar = bar; b.x = xb_xcc_id(); b.st = st;
    if (threadIdx.x == 0) (void)xb_add(&bar[XB_XCNT(b.x)], 1u);
    return b;
}
__device__ __forceinline__ void xcd_barrier_complete(unsigned* bar, unsigned x, unsigned& nloc, unsigned& nx) {
    const unsigned G = gridDim.x * gridDim.y * gridDim.z;
    unsigned sum, cnt, mine, sp = 0u;
    for (;;) {
        sum = 0u; cnt = 0u; mine = 0u;
#pragma unroll
        for (unsigned j = 0; j < 16; ++j) { const unsigned c = xb_ld(&bar[XB_XCNT(j)]); sum += c; cnt += (c > 0u) ? 1u : 0u; mine = (j == x) ? c : mine; }
        if (sum == G) break;
        __builtin_amdgcn_s_sleep(1);
        if ((++sp & 255u) == 0u) { if (xb_ld(&bar[XB_TMO])) break; if (sp > XB_SPIN_CAP) { atomicAdd(&bar[XB_TMO], 1u); break; } }
    }
    nloc = mine > 0u ? mine : 1u; nx = cnt > 0u ? cnt : 1u;
}
__device__ __forceinline__ void xcd_barrier(const XcdBarrier& b) {
    asm volatile("s_waitcnt vmcnt(0)" ::: "memory");
    __syncthreads();
    if (threadIdx.x == 0) {
        unsigned* bar = b.bar;
        __builtin_amdgcn_s_waitcnt(0);
        unsigned nloc = b.st[0], nx = b.st[1];
        if (nloc == 0u) { xcd_barrier_complete(bar, b.x, nloc, nx); b.st[0] = nloc; b.st[1] = nx; }
        const unsigned old = xb_add(&bar[XB_XSUB(b.x)], 1u);
        const unsigned gen = old / nloc;
        if (old + 1u == (gen + 1u) * nloc) {
            __builtin_amdgcn_fence(__ATOMIC_RELEASE, "agent");
            asm volatile("s_waitcnt vmcnt(0)" ::: "memory");
            const unsigned og = xb_add(&bar[XB_TOP], 1u);
            const unsigned tg = og / nx;
            if (og + 1u == (tg + 1u) * nx) xb_add(&bar[XB_TOPGEN], 1u);
            else XB_SPIN(xb_ld(&bar[XB_TOPGEN]) == tg, bar);
            __builtin_amdgcn_fence(__ATOMIC_ACQUIRE, "agent");
            xb_add(&bar[XB_XGEN(b.x)], 1u);
            asm volatile("s_waitcnt vmcnt(0)" ::: "memory");
        } else {
            XB_SPIN(xb_ld(&bar[XB_XGEN(b.x)]) == gen, bar);
            __builtin_amdgcn_fence(__ATOMIC_ACQUIRE, "agent");
            asm volatile("s_waitcnt vmcnt(0)" ::: "memory");
        }
    }
    __syncthreads();
}

constexpr int NWAVES = 8;
constexpr int RING_OFF = 0, RING_BYTES = 131072;
constexpr int LDSCTL_OFF = RING_BYTES, MISC_OFF = LDSCTL_OFF + 320;
constexpr int LDS_BYTES = 147456;

struct Frame {
    LAS unsigned char* lds; volatile LAS unsigned* MISC; unsigned* ctl;
    int tid, lane, wave, vcu, G;
    const float* const* in; float* out; unsigned char* ws;
};
enum { I_X = 0, I_RELB, I_NFFN1, I_F1G, I_F1U, I_F1D, I_NMIX, I_WIN, I_MIXRKV, I_MIXWAG, I_WLA, I_WLB, I_W0, I_ALA, I_ALB, I_A0, I_GLA, I_GLB, I_KK, I_KA, I_RKP, I_LNW, I_LNB,
       I_PA, I_PB, I_WOUT, I_NFFN2, I_F2G, I_F2U, I_F2D, I_NFIN };

__device__ __forceinline__ float wave_sum(float v) {
#pragma unroll
    for (int o = 1; o < 64; o <<= 1) v += __shfl_xor(v, o);
    return v;
}

__device__ __forceinline__ void tr_item(const float* W, int ldw, int c0, bf16* WT, int K, int drow0, int k0, const float* g, const float* mix, int mode, LAS float* scr, int lane) {
#pragma unroll 8
    for (int i = 0; i < 32; ++i) { const int kk = 2 * i + (lane >> 5), k = k0 + kk; float s = g ? g[k] : 1.0f; if (mode == 1) s *= (1.0f - mix[k]); else if (mode == 2) s *= mix[k];
        scr[kk * 33 + (lane & 31)] = W[(size_t)k * ldw + c0 + (lane & 31)] * s; }
    LDS_WAIT(); asm volatile("" ::: "memory");
    const int c = lane & 7;
#pragma unroll
    for (int j = 0; j < 4; ++j) { const int n = (lane >> 3) + 8 * j; const LAS float* s = scr + (8 * c) * 33 + n;
        u32x4 o; o.x = pk2(s[0 * 33], s[1 * 33]); o.y = pk2(s[2 * 33], s[3 * 33]); o.z = pk2(s[4 * 33], s[5 * 33]); o.w = pk2(s[6 * 33], s[7 * 33]);
        *(u32x4*)(WT + (size_t)(drow0 + n) * K + k0 + 8 * c) = o; }
    LDS_WAIT(); asm volatile("" ::: "memory");
}
__device__ __forceinline__ void gu_item(const float* Wg, const float* Wu, const float* g, bf16* WT, int r, LAS float* scr, int lane) {
    const int kb = r / 176, nb = r % 176, pn = nb >> 3, bj = (nb >> 2) & 1, o = nb & 3;
    tr_item(bj ? Wu : Wg, FF, 128 * pn + 32 * o, WT, D, 32 * nb, 64 * kb, g, nullptr, 0, scr, lane);
}
constexpr int CJ0 = 16 * 176, CJ1 = 44 * 32, CJ2 = 16 * 96, CJ3 = 16 * 18, CJ4 = 16 * 64, CJ5 = 8 * 32, CJ6 = 8 * 32, CJ7 = 16 * 32, CJ8 = CJ0, CJ9 = CJ1;
constexpr int CV0 = CJ0, CV1 = CJ0 + CJ1 + CJ2 + CJ3 + CJ4 + CJ5 + CJ6 + CJ7, CV2 = CV1 + CJ8 + CJ9;
__device__ __forceinline__ void conv_item(Frame& F, int it, LAS float* scr) {
    unsigned char* ws = F.ws; int r = it;
    if (r < CJ0) { gu_item(F.in[I_F1G], F.in[I_F1U], F.in[I_NFFN1], (bf16*)(ws + WS_WGU1), r, scr, F.lane); return; } r -= CJ0;
    if (r < CJ1) { const int kb = r / 32, nb = r % 32; tr_item(F.in[I_F1D], D, 32 * nb, (bf16*)(ws + WS_WD1), FF, 32 * nb, 64 * kb, nullptr, nullptr, 0, scr, F.lane); return; } r -= CJ1;
    if (r < CJ2) { const int kb = r / 96, nb = r % 96; tr_item(F.in[I_WIN], 5120, 32 * nb, (bf16*)(ws + WS_WIN), D, 32 * nb, 64 * kb, F.in[I_NMIX], nullptr, 0, scr, F.lane); return; } r -= CJ2;
    if (r < CJ3) { const int kb = r / 18, nb = r % 18, md = nb < 9 ? 1 : 2, n9 = nb % 9;
        const float* W; int ldw, c0; const float* mix;
        if (n9 < 2) { W = F.in[I_WLA]; ldw = 64; c0 = 32 * n9; mix = F.in[I_MIXWAG]; }
        else if (n9 < 4) { W = F.in[I_ALA]; ldw = 64; c0 = 32 * (n9 - 2); mix = F.in[I_MIXWAG] + D; }
        else { W = F.in[I_GLA]; ldw = 160; c0 = 32 * (n9 - 4); mix = F.in[I_MIXWAG] + 2 * D; }
        tr_item(W, ldw, c0, (bf16*)(ws + WS_WIN), D, 3072 + 32 * nb, 64 * kb, F.in[I_NMIX], mix, md, scr, F.lane); return; } r -= CJ3;
    if (r < CJ4) { const int kb = r / 64, nb = r % 64; tr_item(F.in[I_WIN], 5120, 3072 + 32 * nb, (bf16*)(ws + WS_WG), D, 32 * nb, 64 * kb, F.in[I_NMIX], nullptr, 0, scr, F.lane); return; } r -= CJ4;
    if (r < CJ5) { const int kb = r / 32, nb = r % 32; tr_item(F.in[I_PA], D, 32 * nb, (bf16*)(ws + WS_WA), 512, 32 * nb, 64 * kb, nullptr, nullptr, 0, scr, F.lane); return; } r -= CJ5;
    if (r < CJ6) { const int kb = r / 32, nb = r % 32; tr_item(F.in[I_PB], D, 32 * nb, (bf16*)(ws + WS_WB), 512, 32 * nb, 64 * kb, nullptr, nullptr, 0, scr, F.lane); return; } r -= CJ6;
    if (r < CJ7) { const int kb = r / 32, nb = r % 32; tr_item(F.in[I_WOUT], D, 32 * nb, (bf16*)(ws + WS_WOUT), D, 32 * nb, 64 * kb, nullptr, nullptr, 0, scr, F.lane); return; } r -= CJ7;
    if (r < CJ8) { gu_item(F.in[I_F2G], F.in[I_F2U], F.in[I_NFFN2], (bf16*)(ws + WS_WGU2), r, scr, F.lane); return; } r -= CJ8;
    { const int kb = r / 32, nb = r % 32; tr_item(F.in[I_F2D], D, 32 * nb, (bf16*)(ws + WS_WD2), FF, 32 * nb, 64 * kb, nullptr, nullptr, 0, scr, F.lane); }
}
__device__ __forceinline__ void conv_range(Frame& F, int lo, int hi, int w, int nworkers) {
    LAS float* scr = (LAS float*)(F.lds + RING_OFF + F.wave * 16384);
    for (int it = lo + w; it < hi; it += nworkers) conv_item(F, it, scr);
}
__device__ __forceinline__ void p0_prologue(Frame& F) {
    const int gw = F.vcu * NWAVES + F.wave, NGW = F.G * NWAVES;
    unsigned char* ws = F.ws;
    conv_range(F, 0, CV0, gw, NGW);
    const int gt = F.vcu * 512 + F.tid, NGT = F.G * 512;
    { u32x4* z = (u32x4*)(ws + WS_WIN + (size_t)3648 * D * 2); for (int i = gt; i < 192 * D * 2 / 16; i += NGT) z[i] = (u32x4){0u, 0u, 0u, 0u}; }
    { bf16* lw = (bf16*)(ws + WS_LBW); bf16* la = (bf16*)(ws + WS_LBA); bf16* lg = (bf16*)(ws + WS_LBG);
      for (int i = gt; i < 512 * 64; i += NGT) { const int n = i >> 6, k = i & 63; lw[i] = (bf16)f2bf(F.in[I_WLB][k * 512 + n]); la[i] = (bf16)f2bf(F.in[I_ALB][k * 512 + n]); }
      for (int i = gt; i < 512 * 160; i += NGT) { const int n = i / 160, k = i % 160; lg[i] = (bf16)f2bf(F.in[I_GLB][k * 512 + n]); } }
    { const float* x = F.in[I_X]; bf16* xb = (bf16*)(ws + WS_XB); float* ssq = (float*)(ws + OFF_SSQ1);
      for (int m = gw; m < M; m += NGW) {
          const f32x4* xr = (const f32x4*)(x + (size_t)m * D) + F.lane; f32x4 v[4]; float s = 0.f;
#pragma unroll
          for (int j = 0; j < 4; ++j) { v[j] = xr[64 * j]; s += (v[j].x * v[j].x + v[j].y * v[j].y) + (v[j].z * v[j].z + v[j].w * v[j].w); }
          s = wave_sum(s); if (F.lane == 0) ssq[m] = s;
          unsigned long long* o8 = (unsigned long long*)(xb + (size_t)m * D) + F.lane;
#pragma unroll
          for (int j = 0; j < 4; ++j) o8[64 * j] = (unsigned long long)pk2(v[j].x, v[j].y) | ((unsigned long long)pk2(v[j].z, v[j].w) << 32);
      } }
}

__device__ __forceinline__ int t5_bucket(int n) {
    if (n < 16) return n < 0 ? 0 : n;
    int b = 16;
    b += (n >= 21); b += (n >= 27); b += (n >= 35); b += (n >= 46); b += (n >= 59); b += (n >= 77); b += (n >= 99); b += (n >= 128);
    b += (n >= 166); b += (n >= 216); b += (n >= 280); b += (n >= 363); b += (n >= 470); b += (n >= 609); b += (n >= 790);
    return b;
}

namespace attn_body {
typedef unsigned short bf16;
using bf16x8=__attribute__((ext_vector_type(8)))short;
using s16x4=__attribute__((ext_vector_type(4)))short;
using f32x16=__attribute__((ext_vector_type(16)))float;
using u32x4=__attribute__((ext_vector_type(4)))unsigned;
constexpr int BATCH=4,NHEAD=8,SEQ=4096,D=64,DM=NHEAD*D;
constexpr int NW=8,QBLK=32,QB=QBLK*NW,KVBLK=64,NQB=SEQ/QB;
constexpr int ATTN_PITCH=DM, ATTN_UNIT_ROWS=QB;
__device__ __forceinline__ int crow(int r,int hi){return (r&3)+8*(r>>2)+4*hi;}
#define SBAR() __builtin_amdgcn_sched_barrier(0)
typedef __attribute__((address_space(3))) float* lds_fptr;
typedef float f32x4_t __attribute__((ext_vector_type(4)));
__device__ __forceinline__ void cmask(f32x16&p0,f32x16&p1,int jb,int qrel,int hi){
  const float NEG=-INFINITY; int kb=64*jb+4*hi;
  #pragma unroll
  for(int r=0;r<16;++r){int kv=kb+(r&3)+8*(r>>2); if(kv>qrel)p0[r]=NEG; if(kv+32>qrel)p1[r]=NEG;}
}

constexpr int NSLOT=3, SLOTB=8192;
constexpr int LDS_K=0, LDS_V=NSLOT*SLOTB, LDS_WS=2*NSLOT*SLOTB, LDS_OST=LDS_WS+NW*64*4, LDS_RT=LDS_OST+NW*4096,LDS_KM=LDS_RT+1152*4,LDS_BYTES=LDS_KM+15*64*4;
constexpr float C2=0.125f*1.4426950408889634f, L2E=1.4426950408889634f;
__device__ __forceinline__ void glds16(const void*gsrc,unsigned lds_dst){unsigned keep;
  asm volatile("s_mov_b32 %0, m0\n\ts_mov_b32 m0, %2\n\ts_nop 0\n\tglobal_load_lds_dwordx4 %1, off\n\ts_mov_b32 m0, %0":"=&s"(keep):"v"(gsrc),"s"(lds_dst):"memory");}
__device__ __forceinline__ float max3f(float a,float b,float c){float r;asm("v_max3_f32 %0, %1, %2, %3":"=v"(r):"v"(a),"v"(b),"v"(c));return r;}
__device__ __forceinline__ float max2f(float a,float b){float r;asm("v_max_f32_e32 %0, %1, %2":"=v"(r):"v"(a),"v"(b));return r;}
__device__ __forceinline__ float fadd_s(float a,float b){float r;asm("v_add_f32_e32 %0, %1, %2":"=v"(r):"v"(a),"v"(b));return r;}
__device__ __forceinline__ float fsub_s(float a,float b){float r;asm("v_sub_f32_e32 %0, %1, %2":"=v"(r):"v"(a),"v"(b));return r;}
typedef float f32x2_t __attribute__((ext_vector_type(2))); typedef __bf16 bf16x2_t __attribute__((ext_vector_type(2)));
__device__ __forceinline__ unsigned cvtpk_s(float lo,float hi){f32x2_t v={lo,hi};bf16x2_t b=__builtin_convertvector(v,bf16x2_t);return __builtin_bit_cast(unsigned,b);}
#define WAIT_BAR(N) asm volatile("s_waitcnt vmcnt(" #N ") lgkmcnt(0)\n\ts_barrier":::"memory")

__device__ __forceinline__ void qkt(f32x16&p0,f32x16&p1,const char*Kslot,const bf16x8*qr,const f32x16&negm,int r32,int hi){
  const char*kb=Kslot+hi*1024+r32*16;
  #pragma unroll
  for(int d0=0;d0<4;++d0){
    const bf16x8 b0=*reinterpret_cast<const bf16x8*>(kb+d0*2048);
    const bf16x8 b1=*reinterpret_cast<const bf16x8*>(kb+d0*2048+512);
    if(d0==0){p0=__builtin_amdgcn_mfma_f32_32x32x16_bf16(b0,qr[0],negm,0,0,0);p1=__builtin_amdgcn_mfma_f32_32x32x16_bf16(b1,qr[0],negm,0,0,0);}
    else{p0=__builtin_amdgcn_mfma_f32_32x32x16_bf16(b0,qr[d0],p0,0,0,0);p1=__builtin_amdgcn_mfma_f32_32x32x16_bf16(b1,qr[d0],p1,0,0,0);}}
}
typedef __attribute__((address_space(3))) const char* lds_cptr;
typedef short v4i16_t __attribute__((ext_vector_type(4)));
__device__ __forceinline__ void kload8(bf16x8*kf,lds_cptr kp){
  kf[0]=*(const __attribute__((address_space(3))) bf16x8*)(kp);      kf[1]=*(const __attribute__((address_space(3))) bf16x8*)(kp+512);
  kf[2]=*(const __attribute__((address_space(3))) bf16x8*)(kp+2048); kf[3]=*(const __attribute__((address_space(3))) bf16x8*)(kp+2560);
  kf[4]=*(const __attribute__((address_space(3))) bf16x8*)(kp+4096); kf[5]=*(const __attribute__((address_space(3))) bf16x8*)(kp+4608);
  kf[6]=*(const __attribute__((address_space(3))) bf16x8*)(kp+6144); kf[7]=*(const __attribute__((address_space(3))) bf16x8*)(kp+6656);
}
__device__ __forceinline__ void kload2(bf16x8*kf,lds_cptr kp,int j){ kf[2*j]=*(const __attribute__((address_space(3))) bf16x8*)(kp+j*2048); kf[2*j+1]=*(const __attribute__((address_space(3))) bf16x8*)(kp+j*2048+512); }
__device__ __forceinline__ s16x4 vtr(lds_cptr p){ return __builtin_bit_cast(s16x4,__builtin_amdgcn_ds_read_tr16_b64_v4i16((__attribute__((address_space(3))) v4i16_t*)p)); }
__device__ __forceinline__ float rowmax(const f32x16&p0,const f32x16&p1){
  float a=max3f(p0[0],p0[1],p1[0]),b=max3f(p0[2],p0[3],p1[1]);a=max3f(a,p1[2],p1[3]);
  #pragma unroll
  for(int r=4;r<16;r+=4){a=max3f(a,p0[r],p0[r+1]);b=max3f(b,p0[r+2],p0[r+3]);a=max3f(a,p1[r],p1[r+1]);b=max3f(b,p1[r+2],p1[r+3]);}
  const float m=max2f(a,b);
  auto rr=__builtin_amdgcn_permlane32_swap(__float_as_uint(m),__float_as_uint(m),false,false);
  return max2f(__uint_as_float(rr[0]),__uint_as_float(rr[1]));
}
__device__ __forceinline__ void pv(f32x16*o,int vb,bf16x8 pa0,bf16x8 pa1,bf16x8 pa2,bf16x8 pa3){
  #pragma unroll
  for(int d0=0;d0<2;++d0){s16x4 lo[4],hi[4];
    #pragma unroll
    for(int ks=0;ks<4;++ks){
      asm volatile("ds_read_b64_tr_b16 %0,%1 offset:%c2":"=&v"(lo[ks]):"v"(vb),"i"(d0*4096+ks*1024):"memory");
      asm volatile("ds_read_b64_tr_b16 %0,%1 offset:%c2":"=&v"(hi[ks]):"v"(vb),"i"(d0*4096+ks*1024+512):"memory");}
    asm volatile("s_waitcnt lgkmcnt(0)":::"memory");SBAR();
    #define PK(k) (bf16x8){lo[k][0],lo[k][1],lo[k][2],lo[k][3],hi[k][0],hi[k][1],hi[k][2],hi[k][3]}
    o[d0]=__builtin_amdgcn_mfma_f32_32x32x16_bf16(pa0,PK(0),o[d0],0,0,0);
    o[d0]=__builtin_amdgcn_mfma_f32_32x32x16_bf16(pa1,PK(1),o[d0],0,0,0);
    o[d0]=__builtin_amdgcn_mfma_f32_32x32x16_bf16(pa2,PK(2),o[d0],0,0,0);
    o[d0]=__builtin_amdgcn_mfma_f32_32x32x16_bf16(pa3,PK(3),o[d0],0,0,0);
    #undef PK
  }
}

#ifndef ATTN_STORE16
#define ATTN_STORE16(p,v) (*(u32x4*)(p)=(v))
#endif
template<int THRL> __device__ __forceinline__ void attn_unit(int b,int h,int qb,const bf16*Q,const bf16*__restrict__ K,const bf16*__restrict__ V,bf16*O,char*shm,const float*__restrict__ kmsum,const float*__restrict__ relb){
  int tid_=threadIdx.x; asm volatile("":"+v"(tid_));
  const int tid=tid_,lane=tid&63,r32=lane&31,hi=lane>>5; const int wid=__builtin_amdgcn_readfirstlane(tid>>6);
  const long rowbase=(long)b*SEQ; const int q0=qb*QB;
  const bf16*Qw=Q+(rowbase+q0+wid*QBLK)*DM+h*D;
  const bf16*Kh=K+rowbase*DM+h*D,*Vh=V+rowbase*DM+h*D;
  const unsigned lds0=(unsigned)(uintptr_t)shm;
  float*wsf=(float*)(shm+LDS_WS)+wid*64;
  const bf16*ksrc=Kh+(long)lane*DM+wid*8;
  const bf16*vsrc=Vh+(long)(16*(wid&3)+(lane>>2))*DM+(wid>>2)*32+(lane&3)*8;
  const unsigned kdst=lds0+LDS_K+wid*1024, vdst=lds0+LDS_V+wid*1024;
  #define DMA_K(t,slot) glds16(ksrc+(long)PHYS(t)*KVBLK*DM,(unsigned)__builtin_amdgcn_readfirstlane(kdst+(slot)))
  #define DMA_V(t,slot) glds16(vsrc+(long)PHYS(t)*KVBLK*DM,(unsigned)__builtin_amdgcn_readfirstlane(vdst+(slot)))
  const int vb0=(int)(lds0+LDS_V)+((lane>>4)&1)*32+(lane&3)*8+(4*hi+((lane&15)>>2))*64;
  const char*Kbase=shm+LDS_K; bf16x8 kf[8];
  const lds_cptr shm3=(lds_cptr)shm; const lds_cptr kp0=shm3+LDS_K+hi*1024+r32*16; const lds_cptr vp0=shm3+LDS_V+((lane>>4)&1)*32+(lane&3)*8+(4*hi+((lane&15)>>2))*64;
  const int NT=(q0+QB)/KVBLK;
  const lds_fptr rt3=(lds_fptr)(shm+LDS_RT); const lds_fptr km3=(lds_fptr)(shm+LDS_KM);
  { for(int j=tid;j<1152;j+=512){ const int d=895-j; float v=0.f; if(d>=0&&d<790)v=(relb[t5_bucket(d)*NHEAD+h]-relb[31*NHEAD+h])*L2E; rt3[j]=v; }
    for(int i=tid;i<qb*64;i+=512)km3[i]=kmsum[i];
    asm volatile("s_waitcnt vmcnt(0) lgkmcnt(0)\n\ts_barrier":::"memory"); }
  unsigned selmask=0u; bool selcur=true;
  if(qb>0){
    bf16x8 qg[4]; { const bf16*Qg=Q+(rowbase+q0+wid*QBLK+(lane&31))*DM+h*D+(lane>>5)*8;
      #pragma unroll
      for(int d0=0;d0<4;++d0)qg[d0]=*reinterpret_cast<const bf16x8*>(Qg+d0*16); }
    float qf[32];
    #pragma unroll
    for(int d0=0;d0<4;++d0){
      #pragma unroll
      for(int j=0;j<8;++j)qf[8*d0+j]=__builtin_bit_cast(float,(unsigned)(unsigned short)qg[d0][j]<<16);}
    float g0=-INFINITY,g1=-INFINITY,g2=-INFINITY;int s0=-1,s1=-1,s2=-1;
    for(int n=0;n<qb;++n){ const lds_fptr kr=km3+n*64+8*(lane>>5); float acc=0.f;
      #pragma unroll
      for(int d0=0;d0<4;++d0){ const f32x4_t a=*(const __attribute__((address_space(3))) f32x4_t*)(kr+16*d0), c=*(const __attribute__((address_space(3))) f32x4_t*)(kr+16*d0+4);
        acc+=(qf[8*d0]*a[0]+qf[8*d0+1]*a[1])+(qf[8*d0+2]*a[2]+qf[8*d0+3]*a[3])+(qf[8*d0+4]*c[0]+qf[8*d0+5]*c[1])+(qf[8*d0+6]*c[2]+qf[8*d0+7]*c[3]); }
      acc+=__shfl_xor(acc,32);
      if(acc>g0){g2=g1;s2=s1;g1=g0;s1=s0;g0=acc;s0=n;} else if(acc>g1){g2=g1;s2=s1;g1=acc;s1=n;} else if(acc>g2){g2=acc;s2=n;} }
    if(s0>=0)selmask|=1u<<s0; if(s1>=0)selmask|=1u<<s1; if(s2>=0)selmask|=1u<<s2; }
  #define PHYS(t) (((t)<4)?(NT-4+(t)):((t)-4))
  DMA_K(0,0);DMA_V(0,0);DMA_K(1,SLOTB);
  bf16x8 qr[4];
  #pragma unroll
  for(int d0=0;d0<4;++d0)qr[d0]=*reinterpret_cast<const bf16x8*>(&Qw[(long)r32*DM+d0*16+hi*8]);
  float mhat=0.f,l_reg=0.f;f32x16 o[2];o[0]=f32x16{};o[1]=f32x16{};const f32x16 zero16=f32x16{};
  const int qrel=wid*QBLK+r32;
  #define BIASADD(P0,P1,kt0) do{ const lds_fptr rp_=rt3+(895-(q0+qrel)+(kt0)+4*hi); \
    _Pragma("unroll") for(int g_=0;g_<4;++g_){ SBAR(); \
      const float b0_=rp_[8*g_],b1_=rp_[8*g_+1],b2_=rp_[8*g_+2],b3_=rp_[8*g_+3],c0_=rp_[8*g_+32],c1_=rp_[8*g_+33],c2_=rp_[8*g_+34],c3_=rp_[8*g_+35]; \
      P0[4*g_]+=b0_;P0[4*g_+1]+=b1_;P0[4*g_+2]+=b2_;P0[4*g_+3]+=b3_;P1[4*g_]+=c0_;P1[4*g_+1]+=c1_;P1[4*g_+2]+=c2_;P1[4*g_+3]+=c3_; } SBAR(); }while(0)
  #define CMASK(P0,P1,t) do{ const int t_=(t); { const float nm_=selcur?-mhat:-1e30f; _Pragma("unroll") for(int r=0;r<16;++r){P0[r]+=nm_;P1[r]+=nm_;} } \
    if(t_<4){ BIASADD(P0,P1,q0+64*t_); cmask(P0,P1,t_,qrel,hi); } \
    else{ const int kt0_=64*(t_-4); if(q0+wid*QBLK-(kt0_+63)<790){ BIASADD(P0,P1,kt0_); } } }while(0)
  #define SELUPD(tn) do{ const int tn_=(tn); if(tn_>=4&&(tn_&3)==0){ selcur=((selmask>>((tn_-4)>>2))&1u)!=0u; } }while(0)
  bool resc=false;
  #define START(P0,P1) do{ const float rm=rowmax(P0,P1); resc=false; \
    { const float dl=rm; mhat=fadd_s(mhat,dl); \
      _Pragma("unroll") for(int r=0;r<16;++r){P0[r]=fsub_s(P0[r],dl);P1[r]=fsub_s(P1[r],dl);} \
      } \
    _Pragma("unroll") for(int r=0;r<16;++r)P0[r]=__builtin_amdgcn_exp2f(P0[r]); }while(0)
  #define RESC() do{ if(resc){ asm volatile("s_waitcnt lgkmcnt(0)":::"memory"); \
      _Pragma("unroll") for(int d_=0;d_<2;++d_) _Pragma("unroll") for(int r=0;r<16;++r)o[d_][r]*=wsf[crow(r,hi)]; } }while(0)
  f32x16 pA0,pA1,pB0,pB1;
  int sl_prev=0,sl_cur=0,sl_next=SLOTB;
  #define ROT() do{sl_prev=sl_cur;sl_cur=sl_next;sl_next=(sl_next==(NSLOT-1)*SLOTB)?0:sl_next+SLOTB;}while(0)
  DMA_K(2,2*SLOTB);
  WAIT_BAR(3);
  qkt(pA0,pA1,Kbase,qr,zero16,r32,hi);asm volatile("s_nop 15\n\ts_nop 7":"+v"(pA0),"+v"(pA1));CMASK(pA0,pA1,0);
  START(pA0,pA1);
  _Pragma("unroll") for(int r=0;r<16;++r)pA1[r]=__builtin_amdgcn_exp2f(pA1[r]);
  WAIT_BAR(0);
  DMA_K(3,0);DMA_V(1,SLOTB);
  ROT();
  kload8(kf,kp0+sl_cur);
  WAIT_BAR(2);
  s16x4 vlo[8],vhi[8]; u32x4 pw0,pw1,pw2,pw3;
  #define PKW(P,B) cvtpk_s(P[B],P[B+1])
  #define PAF(k) __builtin_bit_cast(bf16x8,pw##k)
  #define VFR(i) (bf16x8){vlo[i][0],vlo[i][1],vlo[i][2],vlo[i][3],vhi[i][0],vhi[i][1],vhi[i][2],vhi[i][3]}
  #define PIN(x) asm volatile("":"+v"(x))
  #define MX3(a,b,c) __builtin_fmaxf(__builtin_fmaxf((a),(b)),(c))
  #define GAPA(MF,A0,A1,A2,A3,W0,W1,PW) do{ MF; sacc+=A0; sacc+=A1; sacc+=A2; sacc+=A3; PIN(sacc); W0; W1; PIN(PW); SBAR(); }while(0)
  #define EX(v) __builtin_amdgcn_exp2f(v)
  #define GAPB(MF,X,B) do{ MF; X[B]=EX(X[B]); X[B+1]=EX(X[B+1]); X[B+2]=EX(X[B+2]); X[B+3]=EX(X[B+3]); PIN(X); SBAR(); }while(0)
  #define VRD(i) do{ vlo[i]=vtr(vp_+(((i)>>2)*4096+((i)&3)*1024)); vhi[i]=vtr(vp_+(((i)>>2)*4096+((i)&3)*1024+512)); }while(0)
  #define KRD(G,j) do{ if(G){ kload2(kf,kp0+sl_next,j); SBAR(); } }while(0)
  #define STEP(C0,C1,P0,P1,t,GK,GV,GL) do{ SBAR(); \
    const lds_cptr vp_=vp0+sl_prev; \
    VRD(0); SBAR(); float sacc=(P0[0]+P0[1]); \
    GAPA(C0=__builtin_amdgcn_mfma_f32_32x32x16_bf16(kf[0],qr[0],zero16,0,0,0), P0[2],P0[3],P0[4],P0[5],     pw0[0]=PKW(P0,0), pw0[1]=PKW(P0,2), pw0); \
    VRD(4); SBAR(); GAPA(C1=__builtin_amdgcn_mfma_f32_32x32x16_bf16(kf[1],qr[0],zero16,0,0,0), P0[6],P0[7],P0[8],P0[9],     pw0[2]=PKW(P0,4), pw0[3]=PKW(P0,6), pw0); \
    VRD(1); SBAR(); GAPA(C0=__builtin_amdgcn_mfma_f32_32x32x16_bf16(kf[2],qr[1],C0,0,0,0),   P0[10],P0[11],P0[12],P0[13], pw1[0]=PKW(P0,8), pw1[1]=PKW(P0,10), pw1); \
    VRD(5); SBAR(); GAPA(C1=__builtin_amdgcn_mfma_f32_32x32x16_bf16(kf[3],qr[1],C1,0,0,0),   P0[14],P0[15],P1[0],P1[1],   pw1[2]=PKW(P0,12),pw1[3]=PKW(P0,14), pw1); \
    VRD(2); SBAR(); GAPA(C0=__builtin_amdgcn_mfma_f32_32x32x16_bf16(kf[4],qr[2],C0,0,0,0),   P1[2],P1[3],P1[4],P1[5],     pw2[0]=PKW(P1,0), pw2[1]=PKW(P1,2), pw2); \
    VRD(6); SBAR(); GAPA(C1=__builtin_amdgcn_mfma_f32_32x32x16_bf16(kf[5],qr[2],C1,0,0,0),   P1[6],P1[7],P1[8],P1[9],     pw2[2]=PKW(P1,4), pw2[3]=PKW(P1,6), pw2); \
    VRD(3); SBAR(); GAPA(C0=__builtin_amdgcn_mfma_f32_32x32x16_bf16(kf[6],qr[3],C0,0,0,0),   P1[10],P1[11],P1[12],P1[13], pw3[0]=PKW(P1,8), pw3[1]=PKW(P1,10), pw3); \
    VRD(7); SBAR(); GAPA(C1=__builtin_amdgcn_mfma_f32_32x32x16_bf16(kf[7],qr[3],C1,0,0,0),   P1[14],P1[15],0.f,0.f,       pw3[2]=PKW(P1,12),pw3[3]=PKW(P1,14), pw3); \
    l_reg+=sacc; \
    if(GK){DMA_K((t)+3,sl_cur);} if(GV){DMA_V((t)+1,sl_next);} \
    CMASK(C0,C1,t); \
    { float a=MX3(C0[0],C0[1],C1[0]),b=MX3(C0[2],C0[3],C1[1]); a=MX3(a,C1[2],C1[3]); \
      _Pragma("unroll") for(int r=4;r<16;r+=4){a=MX3(a,C0[r],C0[r+1]);b=MX3(b,C0[r+2],C0[r+3]);a=MX3(a,C1[r],C1[r+1]);b=MX3(b,C1[r+2],C1[r+3]);} \
      float rm=__builtin_fmaxf(a,b); { auto rr=__builtin_amdgcn_permlane32_swap(__float_as_uint(rm),__float_as_uint(rm),false,false); rm=__builtin_fmaxf(__uint_as_float(rr[0]),__uint_as_float(rr[1])); } \
      resc=false; \
      if(__builtin_expect(__any(rm>(float)THRL),0)){ const float dl=__builtin_fmaxf(rm,0.f); mhat+=dl; \
        _Pragma("unroll") for(int r=0;r<16;++r){C0[r]-=dl;C1[r]-=dl;} \
        const float f=__builtin_amdgcn_exp2f(-dl); l_reg*=f; if(hi==0)wsf[r32]=f; resc=true; } } \
    SBAR(); \
    GAPB(o[0]=__builtin_amdgcn_mfma_f32_32x32x16_bf16(PAF(0),VFR(0),o[0],0,0,0), C0,0); \
    GAPB(o[1]=__builtin_amdgcn_mfma_f32_32x32x16_bf16(PAF(0),VFR(4),o[1],0,0,0), C0,4); \
    KRD(GL,0); GAPB(o[0]=__builtin_amdgcn_mfma_f32_32x32x16_bf16(PAF(1),VFR(1),o[0],0,0,0), C0,8); \
    KRD(GL,1); GAPB(o[1]=__builtin_amdgcn_mfma_f32_32x32x16_bf16(PAF(1),VFR(5),o[1],0,0,0), C0,12); \
    KRD(GL,2); GAPB(o[0]=__builtin_amdgcn_mfma_f32_32x32x16_bf16(PAF(2),VFR(2),o[0],0,0,0), C1,0); \
    KRD(GL,3); GAPB(o[1]=__builtin_amdgcn_mfma_f32_32x32x16_bf16(PAF(2),VFR(6),o[1],0,0,0), C1,4); \
    GAPB(o[0]=__builtin_amdgcn_mfma_f32_32x32x16_bf16(PAF(3),VFR(3),o[0],0,0,0), C1,8); \
    GAPB(o[1]=__builtin_amdgcn_mfma_f32_32x32x16_bf16(PAF(3),VFR(7),o[1],0,0,0), C1,12); \
    }while(0)
  int t=1;
  for(;t+5<NT;t+=2){
    STEP(pB0,pB1,pA0,pA1,t,true,true,true);     WAIT_BAR(2); RESC(); ROT(); SELUPD(t+1);
    STEP(pA0,pA1,pB0,pB1,t+1,true,true,true);   WAIT_BAR(2); RESC(); ROT(); SELUPD(t+2);
  }
  #define ENDW(tt) do{ if((tt)+3<NT){WAIT_BAR(2);} else if((tt)+2<NT){WAIT_BAR(1);} else {WAIT_BAR(0);} }while(0)
  for(;t+1<NT;t+=2){
    STEP(pB0,pB1,pA0,pA1,t,(t+3<NT),(t+1<NT),(t+1<NT));       ENDW(t);   RESC(); ROT(); SELUPD(t+1);
    STEP(pA0,pA1,pB0,pB1,t+1,(t+4<NT),(t+2<NT),(t+2<NT));     ENDW(t+1); RESC(); ROT(); SELUPD(t+2);
  }
  STEP(pB0,pB1,pA0,pA1,NT-1,false,false,false); RESC();
  { float sacc=pB0[0]+pB0[1]; _Pragma("unroll") for(int r=2;r<16;++r)sacc+=pB0[r]; _Pragma("unroll") for(int r=0;r<16;++r)sacc+=pB1[r]; l_reg+=sacc;
    pw0=(u32x4){PKW(pB0,0),PKW(pB0,2),PKW(pB0,4),PKW(pB0,6)};pw1=(u32x4){PKW(pB0,8),PKW(pB0,10),PKW(pB0,12),PKW(pB0,14)};pw2=(u32x4){PKW(pB1,0),PKW(pB1,2),PKW(pB1,4),PKW(pB1,6)};pw3=(u32x4){PKW(pB1,8),PKW(pB1,10),PKW(pB1,12),PKW(pB1,14)};
    SBAR(); pv(o,vb0+sl_cur,PAF(0),PAF(1),PAF(2),PAF(3)); }
  #undef PKW
  #undef PAF
  #undef VFR
  #undef PIN
  #undef MX3
  #undef GAPA
  #undef GAPB
  #undef EX
  #undef VRD
  #undef KRD
  #undef STEP
  #undef ENDW
  {auto rr=__builtin_amdgcn_permlane32_swap(__float_as_uint(l_reg),__float_as_uint(l_reg),false,false);l_reg=__uint_as_float(rr[0])+__uint_as_float(rr[1]);}
  if(hi==0)wsf[32+r32]=l_reg;asm volatile("s_waitcnt lgkmcnt(0)":::"memory");
  float rli[16];
  #pragma unroll
  for(int r=0;r<16;++r)rli[r]=__builtin_amdgcn_rcpf(wsf[32+crow(r,hi)]);
  bf16*Ow=O+(rowbase+q0+wid*QBLK)*DM+h*D;
  { bf16*stg=(bf16*)(shm+LDS_OST)+wid*2048;
    #pragma unroll
    for(int r=0;r<16;++r){const int orow=crow(r,hi);
      #pragma unroll
      for(int d0=0;d0<2;++d0)stg[orow*64+d0*32+r32]=(bf16)f2bf(o[d0][r]*rli[r]);}
    asm volatile("s_waitcnt lgkmcnt(0)":::"memory");
    #pragma unroll
    for(int i=0;i<4;++i){const int row=i*8+(lane>>3),ch=lane&7; const u32x4 v=*(const u32x4*)(stg+row*64+ch*8); ATTN_STORE16(Ow+(long)row*DM+ch*8,v);} }
  asm volatile("s_waitcnt lgkmcnt(0)\n\ts_barrier":::"memory");
  #undef DMA_K
  #undef DMA_V
  #undef CMASK
  #undef BIASADD
  #undef SELUPD
  #undef PHYS
  #undef START
  #undef RESC
  #undef ROT
}
constexpr int ATTN_LDS_BYTES=LDS_BYTES;
struct AttnTensors { const bf16* Q; const bf16* K; const bf16* V; bf16* O; const float* kmsum; const float* relb; };
struct AttnUnit { int bh; int qb; };
struct StaticOrder {
  int vcu;
  __device__ __forceinline__ explicit StaticOrder(int grid,int block):vcu((block%8)*(grid/8)+block/8){}
  __device__ __forceinline__ bool next(int i,AttnUnit&u)const{ if(i>=2)return false; const int s=vcu&7; u.bh=vcu>>3; u.qb=(i==0)?15-s:s; return true; }
  __device__ __forceinline__ void a_ready(const AttnUnit&)const{}
  __device__ __forceinline__ void done(const AttnUnit&)const{}
};
template<class Sched,int THRL=8> __device__ __forceinline__ void attn_phase(char*lds,const AttnTensors&T,const Sched&S){
  AttnUnit u;
  for(int i=0;S.next(i,u);++i){ S.a_ready(u); attn_unit<THRL>(u.bh/NHEAD,u.bh%NHEAD,u.qb,T.Q,T.K,T.V,T.O,lds,T.kmsum+(size_t)u.bh*16*64,T.relb); S.done(u); }
}
#undef SBAR
#undef WAIT_BAR
}

__device__ __forceinline__ void attn_simple(Frame& F) {
    LAS float* tab = (LAS float*)(F.lds + RING_OFF);
    const float* relb = F.in[I_RELB];
    for (int i = F.tid; i < 8 * 800; i += 512) { const int h = i / 800, d = i % 800; tab[i] = relb[t5_bucket(d) * NH + h] * LOG2E; }
    __syncthreads();
    const bf16* Q = (const bf16*)(F.ws + WS_Q); const bf16* K = (const bf16*)(F.ws + WS_K); const bf16* V = (const bf16*)(F.ws + WS_V); bf16* O = (bf16*)(F.ws + WS_Q);
    const float* kmean = (const float*)(F.ws + OFF_KMEAN);
    const int wv = blockIdx.x * NWAVES + F.wave;
    const int bh = wv >> 6, b = bh >> 3, h = bh & 7, q = (wv & 63) * 64 + F.lane, blk = q >> 8;
    const LAS float* tb = tab + h * 800;
    const size_t rowq = (size_t)(b * SEQ + q) * 512 + h * 64;
    float qf[64];
#pragma unroll
    for (int c = 0; c < 8; ++c) { const u32x4 w = *(const u32x4*)(Q + rowq + c * 8);
        qf[c * 8 + 0] = bflo(w.x); qf[c * 8 + 1] = bfhi(w.x); qf[c * 8 + 2] = bflo(w.y); qf[c * 8 + 3] = bfhi(w.y); qf[c * 8 + 4] = bflo(w.z); qf[c * 8 + 5] = bfhi(w.z); qf[c * 8 + 6] = bflo(w.w); qf[c * 8 + 7] = bfhi(w.w); }
    float g0 = -INFINITY, g1 = -INFINITY, g2 = -INFINITY; int s0 = -1, s1 = -1, s2 = -1;
    for (int n = 0; n < blk; ++n) {
        const float* km = kmean + ((size_t)bh * 16 + n) * 64; float gsum = 0.f;
#pragma unroll
        for (int d = 0; d < 64; ++d) gsum += qf[d] * km[d];
        if (gsum > g0) { g2 = g1; s2 = s1; g1 = g0; s1 = s0; g0 = gsum; s0 = n; }
        else if (gsum > g1) { g2 = g1; s2 = s1; g1 = gsum; s1 = n; }
        else if (gsum > g2) { g2 = gsum; s2 = n; }
    }
    float o[64];
#pragma unroll
    for (int d = 0; d < 64; ++d) o[d] = 0.f;
    float mx = -1e30f, l = 0.f;
    for (int pass = 0; pass < 4; ++pass) {
        const int jb = pass == 0 ? s0 : pass == 1 ? s1 : pass == 2 ? s2 : blk;
        const bool act = jb >= 0;
        const int jblk = act ? jb : 0;
        const int nkeys = (pass == 3) ? 256 : 256;
        if (pass < 3 && blk <= pass) continue;
        for (int kk = 0; kk < nkeys; ++kk) {
            const int kpos = jblk * 256 + kk;
            const size_t rowk = (size_t)(b * SEQ + kpos) * 512 + h * 64;
            float s = 0.f;
#pragma unroll
            for (int c = 0; c < 8; ++c) { const u32x4 w = *(const u32x4*)(K + rowk + c * 8);
                s += qf[c * 8 + 0] * bflo(w.x) + qf[c * 8 + 1] * bfhi(w.x) + qf[c * 8 + 2] * bflo(w.y) + qf[c * 8 + 3] * bfhi(w.y) + qf[c * 8 + 4] * bflo(w.z) + qf[c * 8 + 5] * bfhi(w.z) + qf[c * 8 + 6] * bflo(w.w) + qf[c * 8 + 7] * bfhi(w.w); }
            const int dist = q - kpos;
            const bool valid = act && dist >= 0;
            const int dcl = dist < 0 ? 0 : (dist > 799 ? 799 : dist);
            s += tb[dcl];
            if (!valid) s = -1e30f;
            const float mn = fmaxf(mx, s);
            const float f = fast_exp2(mx - mn), p = valid ? fast_exp2(s - mn) : 0.f;
            l = l * f + p; mx = mn;
#pragma unroll
            for (int c = 0; c < 8; ++c) { const u32x4 w = *(const u32x4*)(V + rowk + c * 8);
                o[c * 8 + 0] = o[c * 8 + 0] * f + p * bflo(w.x); o[c * 8 + 1] = o[c * 8 + 1] * f + p * bfhi(w.x); o[c * 8 + 2] = o[c * 8 + 2] * f + p * bflo(w.y); o[c * 8 + 3] = o[c * 8 + 3] * f + p * bfhi(w.y);
                o[c * 8 + 4] = o[c * 8 + 4] * f + p * bflo(w.z); o[c * 8 + 5] = o[c * 8 + 5] * f + p * bfhi(w.z); o[c * 8 + 6] = o[c * 8 + 6] * f + p * bflo(w.w); o[c * 8 + 7] = o[c * 8 + 7] * f + p * bfhi(w.w); }
        }
    }
    const float il = 1.0f / l;
#pragma unroll
    for (int c = 0; c < 8; ++c) { u32x4 w; w.x = pk2(o[c * 8 + 0] * il, o[c * 8 + 1] * il); w.y = pk2(o[c * 8 + 2] * il, o[c * 8 + 3] * il); w.z = pk2(o[c * 8 + 4] * il, o[c * 8 + 5] * il); w.w = pk2(o[c * 8 + 6] * il, o[c * 8 + 7] * il);
        *(u32x4*)(O + rowq + c * 8) = w; }
}

__device__ __forceinline__ void mix_phase(Frame& F) {
    unsigned char* ws = F.ws;
    const bf16* Z = (const bf16*)(ws + WS_Z);
    bf16* R = (bf16*)(ws + WS_R); bf16* KR = (bf16*)(ws + WS_KR); bf16* VR = (bf16*)(ws + WS_VR);
    bf16* KKo = (bf16*)(ws + WS_KK); bf16* BBo = (bf16*)(ws + WS_BB); float* WD = (float*)(ws + WS_WDEC); bf16* GB = (bf16*)(ws + WS_GB); float* RK = (float*)(ws + WS_RK);
    const bf16* bnd = (const bf16*)(ws + WS_BND);
    const bf16* LBW = (const bf16*)(ws + WS_LBW); const bf16* LBA = (const bf16*)(ws + WS_LBA); const bf16* LBG = (const bf16*)(ws + WS_LBG);
    const float* mixrkv = F.in[I_MIXRKV]; const float* w0 = F.in[I_W0]; const float* a0 = F.in[I_A0]; const float* k_k = F.in[I_KK]; const float* k_a = F.in[I_KA]; const float* r_k = F.in[I_RKP];
    const int lane = F.lane, n = lane & 15, q4 = lane >> 4;
    LAS float* stash = (LAS float*)(F.lds + RING_OFF) + F.wave * 2560;
    LAS float* keep = stash + 384;
    for (int item = blockIdx.x; item < 256; item += F.G) {
        const int pm = item >> 2, hp = item & 3;
        const int R0 = pm * 256 + F.wave * 32;
        if (q4 == 0) {
#pragma unroll
            for (int hh = 0; hh < 2; ++hh)
#pragma unroll
                for (int c = 0; c < 4; ++c) {
                    const int ch = (2 * hp + hh) * 64 + 16 * c + n; float vr = 0.f, vk = 0.f, vv = 0.f;
                    if ((R0 & (SEQ - 1)) != 0) {
                        if (F.wave == 0) { const bf16* bp = bnd + (size_t)(pm - 1) * 1536; vr = bf2f(bp[ch]); vk = bf2f(bp[512 + ch]); vv = bf2f(bp[1024 + ch]); }
                        else { const size_t o = (size_t)(R0 - 1) * 512 + ch; vr = bf2f(R[o]); vk = bf2f(KR[o]); vv = bf2f(VR[o]); }
                    }
                    stash[((hh * 4 + c) * 3 + 0) * 16 + n] = vr; stash[((hh * 4 + c) * 3 + 1) * 16 + n] = vk; stash[((hh * 4 + c) * 3 + 2) * 16 + n] = vv;
                }
        }
        asm volatile("s_waitcnt vmcnt(0) lgkmcnt(0)" ::: "memory"); __syncthreads();
#pragma unroll 1
        for (int g = 1; g >= 0; --g) {
            const int t0 = R0 + 16 * g;
            bf16x8 Af[9];
            {
                const int t = t0 + n; const bool first = (t & (SEQ - 1)) == 0;
#pragma unroll
                for (int s = 0; s < 9; ++s) {
                    const u32x4 z1 = *(const u32x4*)(Z + (size_t)t * ZP + 32 * s + 8 * q4);
                    u32x4 z2 = (u32x4){0u, 0u, 0u, 0u}; if (!first) z2 = *(const u32x4*)(Z + (size_t)(t - 1) * ZP + 288 + 32 * s + 8 * q4);
                    float hv[8] = { bflo(z1.x) + bflo(z2.x), bfhi(z1.x) + bfhi(z2.x), bflo(z1.y) + bflo(z2.y), bfhi(z1.y) + bfhi(z2.y), bflo(z1.z) + bflo(z2.z), bfhi(z1.z) + bfhi(z2.z), bflo(z1.w) + bflo(z2.w), bfhi(z1.w) + bfhi(z2.w) };
#pragma unroll
                    for (int i = 0; i < 8; ++i) { if (s < 2) { const float e = fast_exp2(hv[i] * (2.0f * LOG2E)); hv[i] = 1.0f - 2.0f * fast_rcp(e + 1.0f); } else if (s >= 4) hv[i] = sigmoidf_(hv[i]); }
                    u32x4 p; p.x = pk2(hv[0], hv[1]); p.y = pk2(hv[2], hv[3]); p.z = pk2(hv[4], hv[5]); p.w = pk2(hv[6], hv[7]);
                    Af[s] = __builtin_bit_cast(bf16x8, p);
                }
            }
#pragma unroll 1
            for (int hh = 0; hh < 2; ++hh) {
                const int hd = 2 * hp + hh;
                float n2[4] = {0.f, 0.f, 0.f, 0.f}, rks[4] = {0.f, 0.f, 0.f, 0.f};
#pragma unroll 1
                for (int c = 0; c < 4; ++c) {
                    const int ch = hd * 64 + 16 * c + n;
                    float oR[5], oK[5], oV[5];
                    if (q4 == 0 && g == 0) { oR[0] = stash[((hh * 4 + c) * 3 + 0) * 16 + n]; oK[0] = stash[((hh * 4 + c) * 3 + 1) * 16 + n]; oV[0] = stash[((hh * 4 + c) * 3 + 2) * 16 + n]; }
                    else { const size_t o = (size_t)(t0 + 4 * q4 - 1) * 512 + ch; oR[0] = bf2f(R[o]); oK[0] = bf2f(KR[o]); oV[0] = bf2f(VR[o]); }
#pragma unroll
                    for (int i = 0; i < 4; ++i) { const size_t o = (size_t)(t0 + 4 * q4 + i) * 512 + ch; oR[i + 1] = bf2f(R[o]); oK[i + 1] = bf2f(KR[o]); oV[i + 1] = bf2f(VR[o]); }
                    asm volatile("s_waitcnt vmcnt(0) lgkmcnt(0)" ::: "memory");
                    f32x4 aw = (f32x4){0.f, 0.f, 0.f, 0.f}, aa = aw, ag = aw;
#pragma unroll
                    for (int s = 0; s < 2; ++s) { const bf16x8 b = *(const bf16x8*)(LBW + (size_t)ch * 64 + 32 * s + 8 * q4); aw = __builtin_amdgcn_mfma_f32_16x16x32_bf16(Af[s], b, aw, 0, 0, 0); }
#pragma unroll
                    for (int s = 0; s < 2; ++s) { const bf16x8 b = *(const bf16x8*)(LBA + (size_t)ch * 64 + 32 * s + 8 * q4); aa = __builtin_amdgcn_mfma_f32_16x16x32_bf16(Af[2 + s], b, aa, 0, 0, 0); }
#pragma unroll
                    for (int s = 0; s < 5; ++s) { const bf16x8 b = *(const bf16x8*)(LBG + (size_t)ch * 160 + 32 * s + 8 * q4); ag = __builtin_amdgcn_mfma_f32_16x16x32_bf16(Af[4 + s], b, ag, 0, 0, 0); }
                    const float mr = mixrkv[ch], mk = mixrkv[512 + ch], mv = mixrkv[1024 + ch], w0c = w0[ch], a0c = a0[ch], kkc = k_k[ch], kac = k_a[ch], rkc = r_k[ch];
#pragma unroll
                    for (int i = 0; i < 4; ++i) {
                        const size_t o = (size_t)(t0 + 4 * q4 + i) * 512 + ch;
                        const float cr = oR[i + 1], ck = oK[i + 1], cv = oV[i + 1];
                        const float r_ = cr + (oR[i] - cr) * mr, k_ = ck + (oK[i] - ck) * mk, v_ = cv + (oV[i] - cv) * mv;
                        const float sg = sigmoidf_(w0c + aw[i]);
                        const float dec = fast_exp2(-0.6065306597126334f * LOG2E * sg);
                        const float a_ = sigmoidf_(a0c + aa[i]);
                        const float kr_ = k_ * kkc; n2[i] += kr_ * kr_;
                        const float kt_ = k_ * (1.0f + (a_ - 1.0f) * kac);
                        rks[i] += r_ * kt_ * rkc;
                        keep[((c * 4 + i) * 2 + 0) * 64 + lane] = kr_; keep[((c * 4 + i) * 2 + 1) * 64 + lane] = a_;
                        R[o] = (bf16)f2bf(r_); KR[o] = (bf16)f2bf(kt_); VR[o] = (bf16)f2bf(v_); WD[o] = dec; GB[o] = (bf16)f2bf(ag[i]);
                    }
                }
#pragma unroll
                for (int i = 0; i < 4; ++i) {
                    float a = n2[i], b = rks[i];
                    a += __shfl_xor(a, 1); a += __shfl_xor(a, 2); a += __shfl_xor(a, 4); a += __shfl_xor(a, 8);
                    b += __shfl_xor(b, 1); b += __shfl_xor(b, 2); b += __shfl_xor(b, 4); b += __shfl_xor(b, 8);
                    n2[i] = 1.0f / fmaxf(sqrtf(a), 1e-12f); rks[i] = b;
                }
                LDS_WAIT();
#pragma unroll 1
                for (int c = 0; c < 4; ++c) {
                    const int ch = hd * 64 + 16 * c + n;
#pragma unroll
                    for (int i = 0; i < 4; ++i) {
                        const size_t o = (size_t)(t0 + 4 * q4 + i) * 512 + ch;
                        const float kk_ = keep[((c * 4 + i) * 2 + 0) * 64 + lane] * n2[i], a_ = keep[((c * 4 + i) * 2 + 1) * 64 + lane];
                        KKo[o] = (bf16)f2bf(kk_); BBo[o] = (bf16)f2bf(kk_ * a_);
                    }
                }
                LDS_WAIT();
                if (n == 0) {
#pragma unroll
                    for (int i = 0; i < 4; ++i) RK[(size_t)(t0 + 4 * q4 + i) * 8 + hd] = rks[i];
                }
            }
        }
        __syncthreads();
    }
}


typedef float f32x4v __attribute__((ext_vector_type(4)));
#define MF4(a, b, c) __builtin_amdgcn_mfma_f32_16x16x4f32((a), (b), (c), 0, 0, 0)

__device__ __forceinline__ void mixc_phase(Frame& F) {
    unsigned char* ws = F.ws;
    const bf16* Z = (const bf16*)(ws + WS_Z);
    const bf16* R = (const bf16*)(ws + WS_R); const bf16* KR = (const bf16*)(ws + WS_KR); bf16* VR = (bf16*)(ws + WS_VR);
    bf16* GB = (bf16*)(ws + WS_GB); float* RK = (float*)(ws + WS_RK);
    const bf16* bnd = (const bf16*)(ws + WS_BND);
    const bf16* LBW = (const bf16*)(ws + WS_LBW); const bf16* LBA = (const bf16*)(ws + WS_LBA); const bf16* LBG = (const bf16*)(ws + WS_LBG);
    const float* mixrkv = F.in[I_MIXRKV]; const float* w0 = F.in[I_W0]; const float* a0 = F.in[I_A0]; const float* k_k = F.in[I_KK]; const float* k_a = F.in[I_KA]; const float* r_k = F.in[I_RKP];
    const int lane0 = F.lane;
    LAS float* xb = (LAS float*)(F.lds + RING_OFF + F.wave * 16384);
    LAS float* tt = xb; LAS float* rb = xb + 320; LAS float* stash = xb + 3 * 1088;
    LAS unsigned short* sa = (LAS unsigned short*)xb;
    for (int item = blockIdx.x; item < 256; item += F.G) {
        const int pm = item >> 2, hp = item & 3;
        const int R0 = pm * 256 + F.wave * 32;
        { int lane = lane0; asm volatile("" : "+v"(lane)); const int n = lane & 15, q4 = lane >> 4;
        if (q4 == 0) {
#pragma unroll
            for (int hh = 0; hh < 2; ++hh)
#pragma unroll
                for (int c = 0; c < 4; ++c) {
                    const int ch = (2 * hp + hh) * 64 + 16 * c + n; float vr = 0.f, vk = 0.f, vv = 0.f;
                    if ((R0 & (SEQ - 1)) != 0) {
                        if (F.wave == 0) { const bf16* bp = bnd + (size_t)(pm - 1) * 1536; vr = bf2f(bp[ch]); vk = bf2f(bp[512 + ch]); vv = bf2f(bp[1024 + ch]); }
                        else { const size_t o = (size_t)(R0 - 1) * 512 + ch; vr = bf2f(R[o]); vk = bf2f(KR[o]); vv = bf2f(VR[o]); }
                    }
                    stash[((hh * 4 + c) * 3 + 0) * 16 + n] = vr; stash[((hh * 4 + c) * 3 + 1) * 16 + n] = vk; stash[((hh * 4 + c) * 3 + 2) * 16 + n] = vv;
                }
        }
        }
        asm volatile("s_waitcnt vmcnt(0) lgkmcnt(0)" ::: "memory"); __syncthreads();
#pragma unroll 1
        for (int g = 1; g >= 0; --g) {
            const int t0 = R0 + 16 * g;
            bf16x8 Af[9];
            { int lane = lane0; asm volatile("" : "+v"(lane)); const int n = lane & 15, q4 = lane >> 4;
                const int t = t0 + n; const bool first = (t & (SEQ - 1)) == 0;
#pragma unroll
                for (int s = 0; s < 9; ++s) {
                    const u32x4 z1 = *(const u32x4*)(Z + (size_t)t * ZP + 32 * s + 8 * q4);
                    u32x4 z2 = (u32x4){0u, 0u, 0u, 0u}; if (!first) z2 = *(const u32x4*)(Z + (size_t)(t - 1) * ZP + 288 + 32 * s + 8 * q4);
                    float hv[8] = { bflo(z1.x) + bflo(z2.x), bfhi(z1.x) + bfhi(z2.x), bflo(z1.y) + bflo(z2.y), bfhi(z1.y) + bfhi(z2.y), bflo(z1.z) + bflo(z2.z), bfhi(z1.z) + bfhi(z2.z), bflo(z1.w) + bflo(z2.w), bfhi(z1.w) + bfhi(z2.w) };
#pragma unroll
                    for (int i = 0; i < 8; ++i) { if (s < 2) { const float e = fast_exp2(hv[i] * (2.0f * LOG2E)); hv[i] = 1.0f - 2.0f * fast_rcp(e + 1.0f); } else if (s >= 4) hv[i] = sigmoidf_(hv[i]); }
                    u32x4 p; p.x = pk2(hv[0], hv[1]); p.y = pk2(hv[2], hv[3]); p.z = pk2(hv[4], hv[5]); p.w = pk2(hv[6], hv[7]);
                    Af[s] = __builtin_bit_cast(bf16x8, p);
                }
            }
#pragma unroll 1
            for (int hh = 0; hh < 2; ++hh) {
                const int hd = 2 * hp + hh;
                int lane = lane0; asm volatile("" : "+v"(lane));
                const int n = lane & 15, q4 = lane >> 4;
                const int cid = ((t0 >> 12) * NH + hd) * 256 + ((t0 & (SEQ - 1)) >> 4);
                unsigned short rawR[4][5], rawK[4][5], rawV[4][5];
#pragma unroll
                for (int c = 0; c < 4; ++c) {
                    const int ch = hd * 64 + 16 * c + n;
                    if (q4 == 0 && g == 0) { rawR[c][0] = (unsigned short)(__builtin_bit_cast(unsigned, stash[((hh * 4 + c) * 3 + 0) * 16 + n]) >> 16); rawK[c][0] = (unsigned short)(__builtin_bit_cast(unsigned, stash[((hh * 4 + c) * 3 + 1) * 16 + n]) >> 16); rawV[c][0] = (unsigned short)(__builtin_bit_cast(unsigned, stash[((hh * 4 + c) * 3 + 2) * 16 + n]) >> 16); }
                    else { const size_t o = (size_t)(t0 + 4 * q4 - 1) * 512 + ch; rawR[c][0] = R[o]; rawK[c][0] = KR[o]; rawV[c][0] = VR[o]; }
#pragma unroll
                    for (int i = 0; i < 4; ++i) { const size_t o = (size_t)(t0 + 4 * q4 + i) * 512 + ch; rawR[c][i + 1] = R[o]; rawK[c][i + 1] = KR[o]; rawV[c][i + 1] = VR[o]; }
                }
                asm volatile("s_waitcnt vmcnt(0) lgkmcnt(0)" ::: "memory");
                float At[4][4], Rt[4][4], Bh[4][4], Kh[4][4], pC[4];
                float n2[4] = {0.f, 0.f, 0.f, 0.f}, rks[4] = {0.f, 0.f, 0.f, 0.f};
#pragma unroll
                for (int c = 0; c < 4; ++c) {
                    const int ch = hd * 64 + 16 * c + n;
                    float oR[5], oK[5], oV[5];
#pragma unroll
                    for (int i = 0; i < 5; ++i) { oR[i] = bf2f(rawR[c][i]); oK[i] = bf2f(rawK[c][i]); oV[i] = bf2f(rawV[c][i]); }
                    f32x4 aw = (f32x4){0.f, 0.f, 0.f, 0.f}, aa = aw, ag = aw;
#pragma unroll
                    for (int s = 0; s < 2; ++s) { const bf16x8 b = *(const bf16x8*)(LBW + (size_t)ch * 64 + 32 * s + 8 * q4); aw = __builtin_amdgcn_mfma_f32_16x16x32_bf16(Af[s], b, aw, 0, 0, 0); }
#pragma unroll
                    for (int s = 0; s < 2; ++s) { const bf16x8 b = *(const bf16x8*)(LBA + (size_t)ch * 64 + 32 * s + 8 * q4); aa = __builtin_amdgcn_mfma_f32_16x16x32_bf16(Af[2 + s], b, aa, 0, 0, 0); }
#pragma unroll
                    for (int s = 0; s < 5; ++s) { const bf16x8 b = *(const bf16x8*)(LBG + (size_t)ch * 160 + 32 * s + 8 * q4); ag = __builtin_amdgcn_mfma_f32_16x16x32_bf16(Af[4 + s], b, ag, 0, 0, 0); }
                    const float mr = mixrkv[ch], mk = mixrkv[512 + ch], mv = mixrkv[1024 + ch], w0c = w0[ch], a0c = a0[ch], kkc = k_k[ch], kac = k_a[ch], rkc = r_k[ch];
                    float wt[4], kr[4], as[4], kt[4], rr[4];
#pragma unroll
                    for (int i = 0; i < 4; ++i) {
                        const size_t o = (size_t)(t0 + 4 * q4 + i) * 512 + ch;
                        const float cr = oR[i + 1], ck = oK[i + 1], cv = oV[i + 1];
                        const float r_ = cr + (oR[i] - cr) * mr, k_ = ck + (oK[i] - ck) * mk, v_ = cv + (oV[i] - cv) * mv;
                        const float sg = sigmoidf_(w0c + aw[i]);
                        wt[i] = fast_exp2(-0.6065306597126334f * LOG2E * sg);
                        const float a_ = sigmoidf_(a0c + aa[i]);
                        const float kr_ = k_ * kkc; n2[i] += kr_ * kr_;
                        const float kt_ = k_ * (1.0f + (a_ - 1.0f) * kac);
                        rks[i] += r_ * kt_ * rkc;
                        kr[i] = kr_; as[i] = a_; kt[i] = kt_; rr[i] = r_;
                        VR[o] = (bf16)f2bf(v_); GB[o] = (bf16)f2bf(ag[i]);
                    }
                    {
                        const float p0 = wt[0], p1 = p0 * wt[1], p2 = p1 * wt[2], p3 = p2 * wt[3];
                        const float t1 = __shfl(p3, (lane + 48) & 63), t2 = __shfl(p3, (lane + 32) & 63), t3 = __shfl(p3, (lane + 16) & 63);
                        float E = 1.0f; if (q4 >= 1) E *= t1; if (q4 >= 2) E *= t2; if (q4 >= 3) E *= t3;
                        const float pm[4] = {E, p0 * E, p1 * E, p2 * E}; const float pp[4] = {p0 * E, p1 * E, p2 * E, p3 * E};
                        const float pc_ = __shfl(pp[3], 48 + n); pC[c] = pc_;
#pragma unroll
                        for (int i = 0; i < 4; ++i) {
                            const float ip = 1.0f / pp[i];
                            At[c][i] = kr[i] * pm[i]; Rt[c][i] = rr[i] * pp[i]; Bh[c][i] = kr[i] * as[i] * ip;
                            const float ktt = kt[i] * ip; Kh[c][i] = ktt * pc_;
                            xb[2 * 1088 + (4 * q4 + i) * 68 + 16 * c + n] = ktt;
                        }
                    }
                    asm volatile("" ::: "memory");
                }
#pragma unroll
                for (int i = 0; i < 4; ++i) {
                    float a = n2[i], b = rks[i];
                    a += __shfl_xor(a, 1); a += __shfl_xor(a, 2); a += __shfl_xor(a, 4); a += __shfl_xor(a, 8);
                    b += __shfl_xor(b, 1); b += __shfl_xor(b, 2); b += __shfl_xor(b, 4); b += __shfl_xor(b, 8);
                    n2[i] = 1.0f / fmaxf(sqrtf(a), 1e-12f); rks[i] = b;
                }
                if (n == 0) {
#pragma unroll
                    for (int i = 0; i < 4; ++i) RK[(size_t)(t0 + 4 * q4 + i) * 8 + hd] = rks[i];
                }
#pragma unroll
                for (int c = 0; c < 4; ++c)
#pragma unroll
                    for (int i = 0; i < 4; ++i) {
                        At[c][i] = -At[c][i] * n2[i]; const float bt = Bh[c][i] * n2[i]; Bh[c][i] = bt * pC[c];
                        xb[0 * 1088 + (4 * q4 + i) * 68 + 16 * c + n] = At[c][i]; xb[1 * 1088 + (4 * q4 + i) * 68 + 16 * c + n] = bt;
                    }
                { bf16* bkq = (bf16*)(ws + WS_BKQ) + (size_t)cid * 2048;
#pragma unroll
                  for (int c = 0; c < 4; ++c) { u32x4 w_; w_.x = pk2(Bh[c][0], Bh[c][1]); w_.y = pk2(Bh[c][2], Bh[c][3]); w_.z = pk2(Kh[c][0], Kh[c][1]); w_.w = pk2(Kh[c][2], Kh[c][3]);
                      *(u32x4*)(bkq + ((c * 16 + n) * 4 + q4) * 8) = w_; }
                  if (q4 == 0) { float* pc = (float*)(ws + WS_PC) + (size_t)cid * 64;
#pragma unroll
                      for (int c = 0; c < 4; ++c) pc[16 * c + n] = pC[c]; } }
                LDS_WAIT();
                f32x4v Aab = (f32x4v){0.f, 0.f, 0.f, 0.f}, Aak = Aab, Arb = Aab, Ark = Aab;
                {
                    f32x4v fa[4], fb[4], fk[4];
#pragma unroll
                    for (int s4 = 0; s4 < 4; ++s4) { fa[s4] = *(const LAS f32x4v*)(xb + 0 * 1088 + n * 68 + 16 * q4 + 4 * s4); fb[s4] = *(const LAS f32x4v*)(xb + 1 * 1088 + n * 68 + 16 * q4 + 4 * s4); fk[s4] = *(const LAS f32x4v*)(xb + 2 * 1088 + n * 68 + 16 * q4 + 4 * s4); }
#pragma unroll
                    for (int s4 = 0; s4 < 4; ++s4)
#pragma unroll
                        for (int e = 0; e < 4; ++e) { Aab = MF4(fa[s4][e], fb[s4][e], Aab); Aak = MF4(fa[s4][e], fk[s4][e], Aak); }
                    LDS_WAIT();
#pragma unroll
                    for (int c = 0; c < 4; ++c)
#pragma unroll
                        for (int i = 0; i < 4; ++i) xb[0 * 1088 + (4 * q4 + i) * 68 + 16 * c + n] = Rt[c][i];
                    LDS_WAIT();
#pragma unroll
                    for (int s4 = 0; s4 < 4; ++s4) fa[s4] = *(const LAS f32x4v*)(xb + 0 * 1088 + n * 68 + 16 * q4 + 4 * s4);
#pragma unroll
                    for (int s4 = 0; s4 < 4; ++s4)
#pragma unroll
                        for (int e = 0; e < 4; ++e) { Arb = MF4(fa[s4][e], fb[s4][e], Arb); Ark = MF4(fa[s4][e], fk[s4][e], Ark); }
                }
#pragma unroll
                for (int e = 0; e < 4; ++e) { const int tau = 4 * q4 + e; if (!(tau > n)) { Aab[e] = 0.f; Aak[e] = 0.f; } if (!(tau >= n)) { Arb[e] = 0.f; Ark[e] = 0.f; } }
                LDS_WAIT();
#pragma unroll
                for (int e = 0; e < 4; ++e) { tt[(4 * q4 + e) * 20 + n] = Aab[e]; rb[(4 * q4 + e) * 20 + n] = Arb[e]; }
                LDS_WAIT();
                f32x4v Tf, RBf;
                {
                    float Tc[16];
#pragma unroll
                    for (int tau = 0; tau < 16; ++tau) {
                        float acc = (tau == n) ? 1.0f : 0.0f;
#pragma unroll
                        for (int j4 = 0; j4 < (tau + 3) / 4; ++j4) { const f32x4v arow = *(const LAS f32x4v*)(tt + tau * 20 + 4 * j4);
#pragma unroll
                            for (int e = 0; e < 4; ++e) if (4 * j4 + e < tau) acc += arow[e] * Tc[4 * j4 + e]; }
                        Tc[tau] = acc;
                    }
                    RBf = *(const LAS f32x4v*)(rb + n * 20 + 4 * q4);
                    LDS_WAIT();
                    if (q4 == 0) {
#pragma unroll
                        for (int tau = 0; tau < 16; ++tau) tt[tau * 20 + n] = Tc[tau];
                    }
                    LDS_WAIT();
                    Tf = *(const LAS f32x4v*)(tt + n * 20 + 4 * q4);
                    LDS_WAIT();
                }
                f32x4v Ap[4], Rp[4], M1 = (f32x4v){0.f, 0.f, 0.f, 0.f}, M2 = Ark;
#pragma unroll
                for (int c = 0; c < 4; ++c) { f32x4v acc = (f32x4v){0.f, 0.f, 0.f, 0.f};
#pragma unroll
                    for (int s_ = 0; s_ < 4; ++s_) acc = MF4(Tf[s_], At[c][s_], acc);
                    Ap[c] = acc; }
#pragma unroll
                for (int s_ = 0; s_ < 4; ++s_) M1 = MF4(Tf[s_], Aak[s_], M1);
#pragma unroll
                for (int c = 0; c < 4; ++c) { f32x4v acc = (f32x4v){Rt[c][0], Rt[c][1], Rt[c][2], Rt[c][3]};
#pragma unroll
                    for (int s_ = 0; s_ < 4; ++s_) acc = MF4(RBf[s_], Ap[c][s_], acc);
                    Rp[c] = acc; }
#pragma unroll
                for (int s_ = 0; s_ < 4; ++s_) M2 = MF4(RBf[s_], M1[s_], M2);
#pragma unroll
                for (int pass = 0; pass < 2; ++pass) {
#pragma unroll
                    for (int c = 0; c < 4; ++c)
#pragma unroll
                        for (int i = 0; i < 4; ++i) { const float v_ = pass == 0 ? Ap[c][i] : Rp[c][i];
                            sa[(((c >> 1) * 4 + (n >> 2)) * 16 + 4 * q4 + i) * 8 + 4 * (c & 1) + (n & 3)] = (unsigned short)f2bf(v_); }
#pragma unroll
                    for (int e = 0; e < 4; ++e) { const float v_ = pass == 0 ? M1[e] : M2[e];
                        sa[((2 * 4 + (n >> 2)) * 16 + 4 * q4 + e) * 8 + (n & 3)] = (unsigned short)f2bf(v_); }
                    *(LAS u32x2*)(sa + ((2 * 4 + q4) * 16 + n) * 8 + 4) = (u32x2){0u, 0u};
                    LDS_WAIT();
                    bf16* dst = (bf16*)(ws + (pass == 0 ? WS_AQ : WS_RQ)) + (size_t)cid * 1536;
#pragma unroll
                    for (int s_ = 0; s_ < 3; ++s_) { const u32x4 w_ = *(const LAS u32x4*)(sa + (s_ * 64 + lane) * 8); *(u32x4*)(dst + (s_ * 64 + lane) * 8) = w_; }
                    LDS_WAIT();
                }
            }
        }
        __syncthreads();
    }
}

__device__ __forceinline__ void scan2_phase(Frame& F) {
    if (blockIdx.x >= 32 || F.wave >= 4) return;
    unsigned char* ws = F.ws;
    const int bh = blockIdx.x, wv = F.wave, lane = F.lane, col = lane & 15, q = lane >> 4;
    const int b = bh >> 3, h = bh & 7;
    const bf16* AQ = (const bf16*)(ws + WS_AQ) + (size_t)bh * 256 * 1536; const bf16* RQ = (const bf16*)(ws + WS_RQ) + (size_t)bh * 256 * 1536;
    const bf16* BKQ = (const bf16*)(ws + WS_BKQ) + (size_t)bh * 256 * 2048; const float* PC = (const float*)(ws + WS_PC) + (size_t)bh * 256 * 64;
    const bf16* VR = (const bf16*)(ws + WS_VR) + (size_t)b * SEQ * 512 + h * 64 + 16 * wv + col;
    bf16* Y = (bf16*)(ws + WS_YRAW) + (size_t)b * SEQ * 512 + h * 64 + 16 * wv + col;
    f32x4 st[4];
#pragma unroll
    for (int i = 0; i < 4; ++i) st[i] = (f32x4){0.f, 0.f, 0.f, 0.f};
    struct Ld { bf16x8 aq[3], rq[3], bk[4]; f32x4 pc[4]; unsigned short v[4]; };
    Ld cur, nxt;
#define SC_LOAD(L, ci) do { const int ci_ = (ci); \
        _Pragma("unroll") for (int s_ = 0; s_ < 3; ++s_) { L.aq[s_] = *(const bf16x8*)(AQ + (size_t)ci_ * 1536 + (s_ * 64 + lane) * 8); L.rq[s_] = *(const bf16x8*)(RQ + (size_t)ci_ * 1536 + (s_ * 64 + lane) * 8); } \
        _Pragma("unroll") for (int i_ = 0; i_ < 4; ++i_) { L.bk[i_] = *(const bf16x8*)(BKQ + (size_t)ci_ * 2048 + ((i_ * 16 + col) * 4 + q) * 8); L.pc[i_] = *(const f32x4*)(PC + (size_t)ci_ * 64 + 16 * i_ + 4 * q); \
            L.v[i_] = VR[(size_t)(ci_ * 16 + 4 * q + i_) * 512]; } } while (0)
    SC_LOAD(cur, 0);
    for (int ci = 0; ci < 256; ++ci) {
        SC_LOAD(nxt, ci + 1 < 256 ? ci + 1 : ci);
        bf16x8 sb[2];
#pragma unroll
        for (int s_ = 0; s_ < 2; ++s_) { u32x4 w_; w_.x = pg8::cvt_pk_bf16(st[2 * s_][0], st[2 * s_][1]); w_.y = pg8::cvt_pk_bf16(st[2 * s_][2], st[2 * s_][3]); w_.z = pg8::cvt_pk_bf16(st[2 * s_ + 1][0], st[2 * s_ + 1][1]); w_.w = pg8::cvt_pk_bf16(st[2 * s_ + 1][2], st[2 * s_ + 1][3]);
            sb[s_] = __builtin_bit_cast(bf16x8, w_); }
        const unsigned v01 = (unsigned)cur.v[0] | ((unsigned)cur.v[1] << 16), v23 = (unsigned)cur.v[2] | ((unsigned)cur.v[3] << 16);
        const bf16x8 vf = __builtin_bit_cast(bf16x8, ((u32x4){v01, v23, v01, v23}));
        f32x4 U = (f32x4){0.f, 0.f, 0.f, 0.f}, Yv = U;
        U = __builtin_amdgcn_mfma_f32_16x16x32_bf16(cur.aq[0], sb[0], U, 0, 0, 0); U = __builtin_amdgcn_mfma_f32_16x16x32_bf16(cur.aq[1], sb[1], U, 0, 0, 0); U = __builtin_amdgcn_mfma_f32_16x16x32_bf16(cur.aq[2], vf, U, 0, 0, 0);
        Yv = __builtin_amdgcn_mfma_f32_16x16x32_bf16(cur.rq[0], sb[0], Yv, 0, 0, 0); Yv = __builtin_amdgcn_mfma_f32_16x16x32_bf16(cur.rq[1], sb[1], Yv, 0, 0, 0); Yv = __builtin_amdgcn_mfma_f32_16x16x32_bf16(cur.rq[2], vf, Yv, 0, 0, 0);
        const bf16x8 uf = __builtin_bit_cast(bf16x8, ((u32x4){pg8::cvt_pk_bf16(U[0], U[1]), pg8::cvt_pk_bf16(U[2], U[3]), v01, v23}));
#pragma unroll
        for (int i = 0; i < 4; ++i) st[i] = __builtin_amdgcn_mfma_f32_16x16x32_bf16(cur.bk[i], uf, st[i] * cur.pc[i], 0, 0, 0);
#pragma unroll
        for (int e = 0; e < 4; ++e) Y[(size_t)(ci * 16 + 4 * q + e) * 512] = (bf16)f2bf(Yv[e]);
        cur = nxt;
    }
#undef SC_LOAD
}


__device__ __forceinline__ void scan3_phase(Frame& F) {
    if (blockIdx.x >= 32) return;
    constexpr int NS = 8, DA = 7, SLOT = 12544, O_AQ = 0, O_RQ = 3072, O_BK = 6144, O_PC = 10240, O_V = 10496;
    unsigned char* ws = F.ws;
    const int bh = blockIdx.x, lane = F.lane, b = bh >> 3, h = bh & 7;
    LAS unsigned char* ring = F.lds + RING_OFF;
    const char* AQ = (const char*)(ws + WS_AQ) + (size_t)bh * 256 * 3072; const char* RQ = (const char*)(ws + WS_RQ) + (size_t)bh * 256 * 3072;
    const char* BKQ = (const char*)(ws + WS_BKQ) + (size_t)bh * 256 * 4096; const char* PC = (const char*)(ws + WS_PC) + (size_t)bh * 256 * 256;
    const char* VRb = (const char*)(ws + WS_VR) + ((size_t)b * SEQ * 512 + h * 64) * 2;
#define SC_DMA(src, dstoff) __builtin_amdgcn_global_load_lds((const unsigned*)(src), (LAS unsigned*)(ring + (dstoff)), 16, 0, 0)
#define SC_WAITV(n) asm volatile("s_waitcnt vmcnt(" #n ")" ::: "memory")
    if (F.wave >= 4) {
        const int lw = F.wave - 4;
        if (lw == 0 || lw == 1) {
            const char* src = (lw == 0 ? AQ : RQ) + lane * 16; const int doff = (lw == 0 ? O_AQ : O_RQ);
#define SC_ISSUE(ci) do { const int cc_ = (ci) < 256 ? (ci) : 255; const int so_ = ((ci) & (NS - 1)) * SLOT + doff; const char* s_ = src + (size_t)cc_ * 3072; \
            SC_DMA(s_, so_); SC_DMA(s_ + 1024, so_ + 1024); SC_DMA(s_ + 2048, so_ + 2048); } while (0)
            for (int ci = 0; ci < DA; ++ci) SC_ISSUE(ci);
            SC_WAITV(18); __builtin_amdgcn_s_barrier();
            for (int ci = 0; ci < 256; ++ci) { SC_ISSUE(ci + DA); SC_WAITV(18); __builtin_amdgcn_s_barrier(); }
#undef SC_ISSUE
        } else if (lw == 2) {
            const char* src = BKQ + lane * 16;
#define SC_ISSUE(ci) do { const int cc_ = (ci) < 256 ? (ci) : 255; const int so_ = ((ci) & (NS - 1)) * SLOT + O_BK; const char* s_ = src + (size_t)cc_ * 4096; \
            SC_DMA(s_, so_); SC_DMA(s_ + 1024, so_ + 1024); SC_DMA(s_ + 2048, so_ + 2048); SC_DMA(s_ + 3072, so_ + 3072); } while (0)
            for (int ci = 0; ci < DA; ++ci) SC_ISSUE(ci);
            SC_WAITV(24); __builtin_amdgcn_s_barrier();
            for (int ci = 0; ci < 256; ++ci) { SC_ISSUE(ci + DA); SC_WAITV(24); __builtin_amdgcn_s_barrier(); }
#undef SC_ISSUE
        } else {
            const char* srcp = PC + (lane & 15) * 16; const char* srcv = VRb + (size_t)(lane >> 3) * 1024 + (lane & 7) * 16;
#define SC_ISSUE(ci) do { const int cc_ = (ci) < 256 ? (ci) : 255; const int so_ = ((ci) & (NS - 1)) * SLOT; \
            SC_DMA(srcp + (size_t)cc_ * 256, so_ + O_PC); SC_DMA(srcv + (size_t)cc_ * 16384, so_ + O_V); SC_DMA(srcv + (size_t)cc_ * 16384 + 8192, so_ + O_V + 1024); } while (0)
            for (int ci = 0; ci < DA; ++ci) SC_ISSUE(ci);
            SC_WAITV(18); __builtin_amdgcn_s_barrier();
            for (int ci = 0; ci < 256; ++ci) { SC_ISSUE(ci + DA); SC_WAITV(18); __builtin_amdgcn_s_barrier(); }
#undef SC_ISSUE
        }
    } else {
        const int wv = F.wave, col = lane & 15, q = lane >> 4;
        bf16* Y = (bf16*)(ws + WS_YRAW) + (size_t)b * SEQ * 512 + h * 64 + 16 * wv + col;
        f32x4 st[4];
#pragma unroll
        for (int i = 0; i < 4; ++i) st[i] = (f32x4){0.f, 0.f, 0.f, 0.f};
        __builtin_amdgcn_s_barrier();
        for (int ci = 0; ci < 256; ++ci) {
            const LAS unsigned char* sl = ring + (ci & (NS - 1)) * SLOT;
            bf16x8 aq[3], rq[3], bk[4]; f32x4 pc[4]; unsigned short vv[4];
#pragma unroll
            for (int s_ = 0; s_ < 3; ++s_) { aq[s_] = *(const LAS bf16x8*)(sl + O_AQ + (s_ * 64 + lane) * 16); rq[s_] = *(const LAS bf16x8*)(sl + O_RQ + (s_ * 64 + lane) * 16); }
#pragma unroll
            for (int i = 0; i < 4; ++i) { bk[i] = *(const LAS bf16x8*)(sl + O_BK + ((i * 16 + col) * 4 + q) * 16); pc[i] = *(const LAS f32x4*)(sl + O_PC + (16 * i + 4 * q) * 4);
                vv[i] = *(const LAS unsigned short*)(sl + O_V + (4 * q + i) * 128 + (16 * wv + col) * 2); }
            bf16x8 sb[2];
#pragma unroll
            for (int s_ = 0; s_ < 2; ++s_) { u32x4 w_; w_.x = pg8::cvt_pk_bf16(st[2 * s_][0], st[2 * s_][1]); w_.y = pg8::cvt_pk_bf16(st[2 * s_][2], st[2 * s_][3]); w_.z = pg8::cvt_pk_bf16(st[2 * s_ + 1][0], st[2 * s_ + 1][1]); w_.w = pg8::cvt_pk_bf16(st[2 * s_ + 1][2], st[2 * s_ + 1][3]);
                sb[s_] = __builtin_bit_cast(bf16x8, w_); }
            const unsigned v01 = (unsigned)vv[0] | ((unsigned)vv[1] << 16), v23 = (unsigned)vv[2] | ((unsigned)vv[3] << 16);
            const bf16x8 vf = __builtin_bit_cast(bf16x8, ((u32x4){v01, v23, v01, v23}));
            f32x4 U = (f32x4){0.f, 0.f, 0.f, 0.f}, Yv = U;
            U = __builtin_amdgcn_mfma_f32_16x16x32_bf16(aq[0], sb[0], U, 0, 0, 0); U = __builtin_amdgcn_mfma_f32_16x16x32_bf16(aq[1], sb[1], U, 0, 0, 0); U = __builtin_amdgcn_mfma_f32_16x16x32_bf16(aq[2], vf, U, 0, 0, 0);
            Yv = __builtin_amdgcn_mfma_f32_16x16x32_bf16(rq[0], sb[0], Yv, 0, 0, 0); Yv = __builtin_amdgcn_mfma_f32_16x16x32_bf16(rq[1], sb[1], Yv, 0, 0, 0); Yv = __builtin_amdgcn_mfma_f32_16x16x32_bf16(rq[2], vf, Yv, 0, 0, 0);
            const bf16x8 uf = __builtin_bit_cast(bf16x8, ((u32x4){pg8::cvt_pk_bf16(U[0], U[1]), pg8::cvt_pk_bf16(U[2], U[3]), v01, v23}));
#pragma unroll
            for (int i = 0; i < 4; ++i) st[i] = __builtin_amdgcn_mfma_f32_16x16x32_bf16(bk[i], uf, st[i] * pc[i], 0, 0, 0);
#pragma unroll
            for (int e = 0; e < 4; ++e) Y[(size_t)(ci * 16 + 4 * q + e) * 512] = (bf16)f2bf(Yv[e]);
            asm volatile("s_waitcnt lgkmcnt(0)" ::: "memory"); __builtin_amdgcn_s_barrier();
        }
    }
    asm volatile("s_waitcnt vmcnt(0)" ::: "memory");
#undef SC_DMA
#undef SC_WAITV
}

__device__ __forceinline__ float dpp_sum16(float x) {
    x += __builtin_bit_cast(float, __builtin_amdgcn_update_dpp(0, __builtin_bit_cast(int, x), 0xB1, 0xf, 0xf, true));
    x += __builtin_bit_cast(float, __builtin_amdgcn_update_dpp(0, __builtin_bit_cast(int, x), 0x4E, 0xf, 0xf, true));
    x += __builtin_bit_cast(float, __builtin_amdgcn_update_dpp(0, __builtin_bit_cast(int, x), 0x141, 0xf, 0xf, true));
    x += __builtin_bit_cast(float, __builtin_amdgcn_update_dpp(0, __builtin_bit_cast(int, x), 0x140, 0xf, 0xf, true));
    return x;
}
struct ScanBlk { u32x2 r[4], k[4], kk[4], bb[4]; f32x4 w[4]; unsigned v[4]; };
__device__ __forceinline__ void scan_phase(Frame& F) {
    if (F.wave >= 2) return;
    unsigned char* ws = F.ws;
    const bf16* R = (const bf16*)(ws + WS_R); const bf16* KR = (const bf16*)(ws + WS_KR); const bf16* VR = (const bf16*)(ws + WS_VR);
    const bf16* KK = (const bf16*)(ws + WS_KK); const bf16* BB = (const bf16*)(ws + WS_BB); const float* WD = (const float*)(ws + WS_WDEC);
    bf16* Y = (bf16*)(ws + WS_YRAW);
    for (int task = blockIdx.x * 2 + F.wave; task < 512; task += F.G * 2) {
        const int bh = task >> 4, rg = task & 15, b = bh >> 3, h = bh & 7;
        const int j = F.lane & 15, rr = F.lane >> 4, vi = 4 * rg + rr;
        const size_t base = (size_t)b * SEQ * 512 + h * 64;
        const size_t o4 = base + 4 * j, ov = base + vi;
        float s0 = 0.f, s1 = 0.f, s2 = 0.f, s3 = 0.f, ysel = 0.f;
        ScanBlk cur, nxt;
#define SCAN_LOAD(B, T0) do { _Pragma("unroll") for (int u_ = 0; u_ < 4; ++u_) { const size_t rw_ = (size_t)((T0) + u_) * 512; \
            B.r[u_] = *(const u32x2*)(R + o4 + rw_); B.k[u_] = *(const u32x2*)(KR + o4 + rw_); B.kk[u_] = *(const u32x2*)(KK + o4 + rw_); B.bb[u_] = *(const u32x2*)(BB + o4 + rw_); \
            B.w[u_] = *(const f32x4*)(WD + o4 + rw_); B.v[u_] = VR[ov + rw_]; } } while (0)
        SCAN_LOAD(cur, 0);
        for (int t0 = 0; t0 < SEQ; t0 += 4) {
            const int tn = (t0 + 4 < SEQ) ? t0 + 4 : t0;
            SCAN_LOAD(nxt, tn);
#pragma unroll
            for (int u = 0; u < 4; ++u) {
                const float kk0 = bflo(cur.kk[u].x), kk1 = bfhi(cur.kk[u].x), kk2 = bflo(cur.kk[u].y), kk3 = bfhi(cur.kk[u].y);
                float sa = (s0 * kk0 + s1 * kk1) + (s2 * kk2 + s3 * kk3);
                sa = dpp_sum16(sa);
                const float v_ = __builtin_bit_cast(float, cur.v[u] << 16);
                const float b0 = bflo(cur.bb[u].x), b1 = bfhi(cur.bb[u].x), b2 = bflo(cur.bb[u].y), b3 = bfhi(cur.bb[u].y);
                const float k0 = bflo(cur.k[u].x), k1 = bfhi(cur.k[u].x), k2 = bflo(cur.k[u].y), k3 = bfhi(cur.k[u].y);
                s0 = s0 * cur.w[u][0] + (v_ * k0 - sa * b0); s1 = s1 * cur.w[u][1] + (v_ * k1 - sa * b1); s2 = s2 * cur.w[u][2] + (v_ * k2 - sa * b2); s3 = s3 * cur.w[u][3] + (v_ * k3 - sa * b3);
                const float r0 = bflo(cur.r[u].x), r1 = bfhi(cur.r[u].x), r2 = bflo(cur.r[u].y), r3 = bfhi(cur.r[u].y);
                float y = (s0 * r0 + s1 * r1) + (s2 * r2 + s3 * r3);
                y = dpp_sum16(y);
                if (((t0 + u) & 15) == j) ysel = y;
            }
            if ((t0 & 15) == 12) Y[ov + (size_t)(t0 - 12 + j) * 512] = (bf16)f2bf(ysel);
            cur = nxt;
        }
#undef SCAN_LOAD
    }
}

__device__ __forceinline__ void e1_phase(Frame& F) {
    unsigned char* ws = F.ws;
    const bf16* Y = (const bf16*)(ws + WS_YRAW); const bf16* VR = (const bf16*)(ws + WS_VR); const bf16* GB = (const bf16*)(ws + WS_GB); const float* RK = (const float*)(ws + WS_RK);
    bf16* YB = (bf16*)(ws + WS_YB);
    const float* lnw = F.in[I_LNW]; const float* lnb = F.in[I_LNB];
    const int gw = F.vcu * NWAVES + F.wave, NGW = F.G * NWAVES, c0 = F.lane * 8;
    float lw[8], lb[8];
#pragma unroll
    for (int i = 0; i < 8; ++i) { lw[i] = lnw[c0 + i]; lb[i] = lnb[c0 + i]; }
    for (int m = gw; m < M; m += NGW) {
        const size_t o = (size_t)m * 512 + c0;
        const u32x4 yw = *(const u32x4*)(Y + o), vw = *(const u32x4*)(VR + o), gw_ = *(const u32x4*)(GB + o);
        const float rk = RK[(size_t)m * 8 + (F.lane >> 3)];
        float y[8] = { bflo(yw.x), bfhi(yw.x), bflo(yw.y), bfhi(yw.y), bflo(yw.z), bfhi(yw.z), bflo(yw.w), bfhi(yw.w) };
        const float v[8] = { bflo(vw.x), bfhi(vw.x), bflo(vw.y), bfhi(vw.y), bflo(vw.z), bfhi(vw.z), bflo(vw.w), bfhi(vw.w) };
        const float g[8] = { bflo(gw_.x), bfhi(gw_.x), bflo(gw_.y), bfhi(gw_.y), bflo(gw_.z), bfhi(gw_.z), bflo(gw_.w), bfhi(gw_.w) };
        float s = 0.f;
#pragma unroll
        for (int i = 0; i < 8; ++i) s += y[i];
        s += __shfl_xor(s, 1); s += __shfl_xor(s, 2); s += __shfl_xor(s, 4);
        const float mu = s * (1.0f / 64.0f); float q = 0.f;
#pragma unroll
        for (int i = 0; i < 8; ++i) { y[i] -= mu; q += y[i] * y[i]; }
        q += __shfl_xor(q, 1); q += __shfl_xor(q, 2); q += __shfl_xor(q, 4);
        const float rstd = 1.0f / sqrtf(q * (1.0f / 64.0f) + 64.0f * 1e-5f);
        float ov[8];
#pragma unroll
        for (int i = 0; i < 8; ++i) ov[i] = (y[i] * rstd * lw[i] + lb[i] + rk * v[i]) * g[i];
        u32x4 w; w.x = pk2(ov[0], ov[1]); w.y = pk2(ov[2], ov[3]); w.z = pk2(ov[4], ov[5]); w.w = pk2(ov[6], ov[7]);
        *(u32x4*)(YB + o) = w;
    }
}

__device__ __forceinline__ void fin_phase(Frame& F) {
    const f32x4* gf = (const f32x4*)F.in[I_NFIN] + F.lane;
    const int gw = F.vcu * NWAVES + F.wave, NGW = F.G * NWAVES;
    f32x4 gg[4];
#pragma unroll
    for (int j = 0; j < 4; ++j) gg[j] = gf[64 * j];
    for (int m = gw; m < M; m += NGW) {
        f32x4* xr = (f32x4*)(F.out + (size_t)m * D) + F.lane; f32x4 v[4]; float s = 0.f;
#pragma unroll
        for (int j = 0; j < 4; ++j) { v[j] = xr[64 * j]; s += (v[j].x * v[j].x + v[j].y * v[j].y) + (v[j].z * v[j].z + v[j].w * v[j].w); }
        s = wave_sum(s);
        const float rs = 1.0f / sqrtf(s * (1.0f / D) + RMS_EPS);
#pragma unroll
        for (int j = 0; j < 4; ++j) xr[64 * j] = v[j] * rs * gg[j];
    }
}


#ifdef DBG_OUT
__device__ __forceinline__ void dbg_phase(Frame& F) {
    const int gw = F.vcu * NWAVES + F.wave, NGW = F.G * NWAVES;
    for (int m = gw; m < M; m += NGW) {
        float* o = F.out + (size_t)m * D;
        for (int c = F.lane; c < D; c += 64) {
            bf16 v;
            if (DBG_OUT == 1) v = ((const bf16*)(F.ws + WS_MRG))[(size_t)m * D + c];
            else if (DBG_OUT == 2) v = ((const bf16*)(F.ws + WS_SGA))[(size_t)m * D + c];
            else if (DBG_OUT == 3) v = c < 512 ? ((const bf16*)(F.ws + WS_Q))[(size_t)m * 512 + c] : ((const bf16*)(F.ws + WS_K))[(size_t)m * 512 + c - 512];
            else if (DBG_OUT == 4) v = c < 512 ? ((const bf16*)(F.ws + WS_V))[(size_t)m * 512 + c] : ((const bf16*)(F.ws + WS_R))[(size_t)m * 512 + c - 512];
            else if (DBG_OUT == 5) v = c < 512 ? ((const bf16*)(F.ws + WS_KR))[(size_t)m * 512 + c] : ((const bf16*)(F.ws + WS_VR))[(size_t)m * 512 + c - 512];
            else if (DBG_OUT == 6) v = c < 768 ? ((const bf16*)(F.ws + WS_Z))[(size_t)m * ZP + c] : (bf16)0;
            else if (DBG_OUT == 7) v = ((const bf16*)(F.ws + WS_SGB))[(size_t)m * D + c];
            else if (DBG_OUT == 9) v = ((const bf16*)(F.ws + WS_WG))[(size_t)(m & 2047) * D + c];
            else v = ((const bf16*)(F.ws + WS_XB))[(size_t)m * D + c];
            o[c] = bf2f(v);
        }
    }
}
#endif
struct Args { const float* in[31]; float* out; unsigned char* ws; int ph_lo, ph_hi; };
constexpr int N_PHASES = 14;

#ifndef MK_N_LAUNCHES
#define MK_N_LAUNCHES 1
#endif

__global__ void __launch_bounds__(NWAVES * 64, 2) mk_fwd(Args args) {
    extern __shared__ __attribute__((aligned(16))) unsigned char lds[];
    Frame F;
    F.lds = (LAS unsigned char*)lds; F.MISC = (volatile LAS unsigned*)(F.lds + MISC_OFF);
    F.tid = threadIdx.x; F.lane = F.tid & 63; F.wave = __builtin_amdgcn_readfirstlane(F.tid >> 6);
    F.G = gridDim.x; { const int bx = blockIdx.x; F.vcu = (F.G % 8 == 0) ? (bx % 8) * (F.G / 8) + bx / 8 : bx; }
    F.in = args.in;
    F.out = args.out; F.ws = args.ws; F.ctl = (unsigned*)(args.ws + WS_CTL);
    unsigned char* ws = args.ws;
    for (int u = F.tid; u < (LDS_BYTES - LDSCTL_OFF) / 4; u += NWAVES * 64) ((LAS unsigned*)(F.lds + LDSCTL_OFF))[u] = 0u;
    __syncthreads();
    XcdBarrier bar; bar.bar = F.ctl + CW_BAR; bar.x = 0; bar.st = nullptr;
    if (MK_N_LAUNCHES == 1) bar = xcd_barrier_post(F.ctl + CW_BAR, F.MISC + 8);
    const int lo = args.ph_lo, hi = args.ph_hi;
#ifndef PH_MASK
#define PH_MASK 0xFFFFFFFFu
#endif
#define IN(k) (((PH_MASK >> (k)) & 1u) && lo <= (k) && (k) < hi)
#ifdef TPROBE
#define SEAM(k) do { if (IN(k) && IN((k) + 1)) xcd_barrier(bar); \
    if (blockIdx.x == 0 && F.tid == 0) { const unsigned long long t_ = __builtin_amdgcn_s_memrealtime(); if ((k) + 1 == TPROBE) ((unsigned long long*)(ws + WS_RK - 64))[0] = t_; if ((k) == TPROBE) ((unsigned long long*)(ws + WS_RK - 64))[1] = t_; } } while (0)
#else
#define SEAM(k) do { if (IN(k) && IN((k) + 1)) xcd_barrier(bar); } while (0)
#endif
    float* ssq1 = (float*)(ws + OFF_SSQ1); float* ssq2 = (float*)(ws + WS_SSQ2); float* ssq3 = (float*)(ws + WS_SSQ3);
#ifdef SKIP_MID
    ssq3 = ssq2;
#endif
    bf16* XB = (bf16*)(ws + WS_XB); bf16* ACT = (bf16*)(ws + WS_ACT);
    const int bx = (int)blockIdx.x;

    if (IN(0)) { p0_prologue(F); } SEAM(0);
    if (IN(1)) { pg8::Gemm g{XB, (const bf16*)(ws + WS_WGU1), M, N_GU, D}; pg8::StaticOrder S; S.init(M, N_GU, F.G, bx);
        pg8::EpiSwiGLU<1> E{ACT, FF, ssq1}; pg8::gemm_phase<pg8::EpiSwiGLU<1>, pg8::StaticOrder, true, true>(F.lds + RING_OFF, g, S, E);
        if (F.G == 256 && bx >= 128) conv_range(F, CV0, CV1, (bx - 128) * NWAVES + F.wave, 128 * NWAVES);
        else if (F.G != 256) conv_range(F, CV0, CV1, bx * NWAVES + F.wave, F.G * NWAVES); } SEAM(1);
    if (IN(2)) { pg8::Gemm g{ACT, (const bf16*)(ws + WS_WD1), M, D, FF}; pg8::StaticOrder S; S.init(M, D, F.G, bx);
        pg8::EpiResid E{F.in[I_X], F.out, XB, ssq2, 0.5f}; pg8::gemm_phase<pg8::EpiResid, pg8::StaticOrder, true, true>(F.lds + RING_OFF, g, S, E); } SEAM(2);
    if (IN(3)) { pg8::Gemm g{XB, (const bf16*)(ws + WS_WIN), M, N_IN, D}; pg8::StaticOrder S; S.init(M, N_IN, F.G, bx);
        pg8::EpiProj E{(bf16*)(ws + WS_Q), (bf16*)(ws + WS_Z), ssq2, (float*)(ws + OFF_KMEAN), (bf16*)(ws + WS_BND)};
        pg8::gemm_phase<pg8::EpiProj, pg8::StaticOrder, true, true>(F.lds + RING_OFF, g, S, E); } SEAM(3);
#ifdef ATT_SIMPLE
    if (IN(4)) { attn_simple(F); } SEAM(4);
#else
    if (IN(4)) { const attn_body::AttnTensors AT{(const bf16*)(ws + WS_Q), (const bf16*)(ws + WS_K), (const bf16*)(ws + WS_V), (bf16*)(ws + WS_Q), (const float*)(ws + OFF_KMEAN), F.in[I_RELB]};
        const attn_body::StaticOrder S((int)F.G, bx); attn_body::attn_phase<attn_body::StaticOrder>((char*)lds + RING_OFF, AT, S); } SEAM(4);
#endif
#ifdef SCAN_DIRECT
    if (IN(5)) { mix_phase(F); } SEAM(5);
    if (IN(6)) { scan_phase(F); } SEAM(6);
#else
    if (IN(5)) { mixc_phase(F); } SEAM(5);
    if (IN(6)) {
        if (bx < 32) scan3_phase(F);
        else {
            pg8::StaticOrder S; S.init(M, D, F.G - 32, bx - 32);
            { pg8::Gemm g{XB, (const bf16*)(ws + WS_WG), M, D, D};
              pg8::EpiGate<0> E{(bf16*)(ws + WS_SGA), nullptr, nullptr, ssq2}; pg8::gemm_phase<pg8::EpiGate<0>, pg8::StaticOrder, true, true>(F.lds + RING_OFF, g, S, E); }
            asm volatile("s_waitcnt vmcnt(0)" ::: "memory"); __syncthreads();
            { pg8::Gemm g{(const bf16*)(ws + WS_Q), (const bf16*)(ws + WS_WA), M, D, 512};
              pg8::EpiGate<1> E{(bf16*)(ws + WS_MRG), (const bf16*)(ws + WS_SGA), nullptr, nullptr}; pg8::gemm_phase<pg8::EpiGate<1>, pg8::StaticOrder, true, true>(F.lds + RING_OFF, g, S, E); }
            if (bx >= 64) conv_range(F, CV1, CV2, (bx - 64) * NWAVES + F.wave, (F.G - 64) * NWAVES);
        } } SEAM(6);
#endif
    if (IN(7)) { e1_phase(F);
        pg8::Gemm g{XB, (const bf16*)(ws + WS_WG) + (size_t)D * D, M, D, D}; pg8::StaticOrder S; S.init(M, D, F.G, bx);
        pg8::EpiGate<0> E{(bf16*)(ws + WS_SGB), nullptr, nullptr, ssq2}; pg8::gemm_phase<pg8::EpiGate<0>, pg8::StaticOrder, true, true>(F.lds + RING_OFF, g, S, E); } SEAM(7);
    if (IN(9)) { pg8::Gemm g{(const bf16*)(ws + WS_YB), (const bf16*)(ws + WS_WB), M, D, 512}; pg8::StaticOrder S; S.init(M, D, F.G, bx);
        pg8::EpiGate<2> E{(bf16*)(ws + WS_MRG), (const bf16*)(ws + WS_SGB), nullptr, nullptr}; pg8::gemm_phase<pg8::EpiGate<2>, pg8::StaticOrder, true, true>(F.lds + RING_OFF, g, S, E); } SEAM(9);
    if (IN(10)) { pg8::Gemm g{(const bf16*)(ws + WS_MRG), (const bf16*)(ws + WS_WOUT), M, D, D}; pg8::StaticOrder S; S.init(M, D, F.G, bx);
        pg8::EpiResid E{F.out, F.out, XB, ssq3, 1.0f}; pg8::gemm_phase<pg8::EpiResid, pg8::StaticOrder, true, true>(F.lds + RING_OFF, g, S, E); } SEAM(10);
    if (IN(11)) { pg8::Gemm g{XB, (const bf16*)(ws + WS_WGU2), M, N_GU, D}; pg8::StaticOrder S; S.init(M, N_GU, F.G, bx);
        pg8::EpiSwiGLU<16> E{ACT, FF, ssq3}; pg8::gemm_phase<pg8::EpiSwiGLU<16>, pg8::StaticOrder, true, true>(F.lds + RING_OFF, g, S, E); } SEAM(11);
    if (IN(12)) { pg8::Gemm g{ACT, (const bf16*)(ws + WS_WD2), M, D, FF}; pg8::StaticOrder S; S.init(M, D, F.G, bx);
        pg8::EpiResid E{F.out, F.out, nullptr, nullptr, 0.5f}; pg8::gemm_phase<pg8::EpiResid, pg8::StaticOrder, true, true>(F.lds + RING_OFF, g, S, E); } SEAM(12);
#ifdef DBG_OUT
    if (IN(13)) { dbg_phase(F); }
#else
    if (IN(13)) { fin_phase(F); }
#ifdef TPROBE
    if (blockIdx.x == 0) { asm volatile("s_waitcnt vmcnt(0)" ::: "memory"); __syncthreads(); if (F.tid == 0) { const unsigned long long* tp = (const unsigned long long*)(ws + WS_RK - 64); F.out[(size_t)(F.vcu * NWAVES) * D] += (float)(tp[1] - tp[0]) * 0.01f * TSCALE; } }
#endif
#endif
#undef IN
#undef SEAM
}

extern "C" void kernel_launch(void* const* d_in, const int* in_sizes, int n_in, void* d_out, int out_size, void* d_ws, size_t ws_size, hipStream_t stream) {
    static int grid = 0;
    if (grid == 0) {
        if (n_in != 31 || out_size != M * D || ws_size < WS_END) { fprintf(stderr, "kernel_launch: unexpected shapes: n_in %d out %d ws %zu\n", n_in, out_size, ws_size); grid = -1; return; }
        int dev = 0, cus = 0;
        if (hipGetDevice(&dev) != hipSuccess || hipDeviceGetAttribute(&cus, hipDeviceAttributeMultiprocessorCount, dev) != hipSuccess) { grid = -1; return; }
        if (hipFuncSetAttribute((const void*)mk_fwd, hipFuncAttributeMaxDynamicSharedMemorySize, LDS_BYTES) != hipSuccess) { fprintf(stderr, "kernel_launch: hipFuncSetAttribute failed\n"); grid = -1; return; }
        int per_cu = 0;
        if (hipOccupancyMaxActiveBlocksPerMultiprocessor(&per_cu, (const void*)mk_fwd, NWAVES * 64, LDS_BYTES) != hipSuccess || per_cu < 1) fprintf(stderr, "kernel_launch: occupancy query says %d\n", per_cu);
        (void)hipGetLastError();
        grid = cus;
    }
    if (grid < 0) return;
    (void)hipMemsetAsync((char*)d_ws + WS_CTL, 0, CTL_ZERO_BYTES, stream);
    Args a{};
    for (int i = 0; i < 31; ++i) a.in[i] = (const float*)d_in[i];
    a.out = (float*)d_out; a.ws = (unsigned char*)d_ws;
#if MK_N_LAUNCHES == 1
    a.ph_lo = 0; a.ph_hi = N_PHASES;
    hipLaunchKernelGGL(mk_fwd, dim3(grid), dim3(NWAVES * 64), LDS_BYTES, stream, a);
#else
    for (int p = 0; p < N_PHASES; ++p) { a.ph_lo = p; a.ph_hi = p + 1; hipLaunchKernelGGL(mk_fwd, dim3(grid), dim3(NWAVES * 64), LDS_BYTES, stream, a); }
#endif
}
```

```cpp
#include <hip/hip_runtime.h>
#include <cstdio>
#include <cstdint>

#define LAS __attribute__((address_space(3)))
#define GAS __attribute__((address_space(1)))
typedef unsigned short bf16;
typedef short bf16x8 __attribute__((ext_vector_type(8)));
typedef float f32x4 __attribute__((ext_vector_type(4)));
typedef float f32x2 __attribute__((ext_vector_type(2)));
typedef unsigned u32x4 __attribute__((ext_vector_type(4)));
typedef unsigned u32x2 __attribute__((ext_vector_type(2)));

constexpr int M = 16384, D = 1024, FF = 2816, SEQ = 4096, NBATCH = 4, NH = 8, HD = 64, WR = 512;
constexpr int N_GU = 2 * FF;
constexpr int N_IN = 3840;
constexpr int N_GATE = 2048;
constexpr int ZP = 768;
constexpr float RMS_EPS = 1e-6f;
constexpr float LOG2E = 1.4426950408889634f;
constexpr float C2 = 0.125f * LOG2E;

constexpr size_t MiB = 1u << 20;
constexpr size_t WS_CTL = 0, CTL_ZERO_BYTES = 1 * MiB;
constexpr int CW_TMO = 0, CW_BAR = 4096;
constexpr size_t OFF_SSQ1 = 65536, OFF_SSQ2 = 131072, OFF_SSQ3 = 196608, OFF_SSQ4 = 262144, OFF_KMEAN = 327680;
constexpr size_t WS_RK = 1 * MiB;
constexpr size_t WS_BND = 1 * MiB + 512 * 1024;
constexpr size_t WS_WGU1 = 2 * MiB, WS_WD1 = 13 * MiB, WS_WIN = 18 * MiB + 512 * 1024, WS_WG = 26 * MiB, WS_WA = 30 * MiB, WS_WB = 31 * MiB,
                 WS_WOUT = 32 * MiB, WS_WGU2 = 34 * MiB, WS_WD2 = 45 * MiB, WS_LBW = 50 * MiB + 512 * 1024, WS_LBA = WS_LBW + 65536, WS_LBG = WS_LBA + 65536;
constexpr size_t WS_XB = 51 * MiB;
constexpr size_t WS_ACT = 83 * MiB;
constexpr size_t WS_Q = 83 * MiB, WS_K = 99 * MiB, WS_V = 115 * MiB, WS_R = 131 * MiB, WS_KR = 147 * MiB, WS_VR = 163 * MiB;
constexpr size_t WS_Z = 179 * MiB;
constexpr size_t WS_WDEC = 203 * MiB;
constexpr size_t WS_GB = 235 * MiB;
constexpr size_t WS_KK = WS_K, WS_BB = WS_V;
constexpr size_t WS_YRAW = WS_Z;
constexpr size_t WS_YB = WS_GB;
constexpr size_t WS_SGA = 131 * MiB, WS_SGB = 203 * MiB;
constexpr size_t WS_MRG = WS_SGA;
constexpr size_t WS_AQ = 2 * MiB;
constexpr size_t WS_BKQ = 99 * MiB;
constexpr size_t WS_RQ = 203 * MiB;
constexpr size_t WS_PC = 227 * MiB;
constexpr size_t WS_SSQ2 = 251 * MiB, WS_SSQ3 = 252 * MiB, WS_SSQ4 = 253 * MiB;
constexpr size_t WS_END = 256 * MiB;

typedef __bf16 bf16x2_hw __attribute__((ext_vector_type(2)));
__device__ __forceinline__ unsigned pk2(float lo, float hi) { const f32x2 v = {lo, hi}; const bf16x2_hw b = __builtin_convertvector(v, bf16x2_hw); return __builtin_bit_cast(unsigned, b); }
__device__ __forceinline__ unsigned f2bf(float f) { return pk2(f, 0.0f) & 0xffffu; }
__device__ __forceinline__ float bflo(unsigned w) { return __builtin_bit_cast(float, w << 16); }
__device__ __forceinline__ float bfhi(unsigned w) { return __builtin_bit_cast(float, w & 0xffff0000u); }
__device__ __forceinline__ float bf2f(bf16 h) { return __builtin_bit_cast(float, (unsigned)h << 16); }
__device__ __forceinline__ float fast_exp2(float x) { return __builtin_amdgcn_exp2f(x); }
__device__ __forceinline__ float fast_rcp(float x) { return __builtin_amdgcn_rcpf(x); }
__device__ __forceinline__ float sigmoidf_(float x) { return fast_rcp(1.0f + fast_exp2(-x * LOG2E)); }
#define LDS_WAIT() asm volatile("s_waitcnt lgkmcnt(0)" ::: "memory")
#define VM_WAIT() asm volatile("s_waitcnt vmcnt(0)" ::: "memory")

namespace pg8 {
#define PG8_LAS __attribute__((address_space(3)))
typedef unsigned short bf16_t;
constexpr int BM = 256, BK = 64, HALF = 128, HTB = HALF * BK * 2, STAGE_BYTES = 8 * HTB, NXCD = 8, WGM = 8;
__host__ __device__ __forceinline__ int lds_byte(int r, int c) { const int st = (r >> 4) * 2 + (c >> 5), rr = r & 15, cc = c & 31, ob = rr * 64 + cc * 2; return st * 1024 + (ob ^ (((ob >> 9) & 1) << 5)); }
__host__ __device__ __forceinline__ void stage_rc(int b, int& R, int& C) { const int st = b / 1024, sb = b % 1024, swz = sb ^ (((sb >> 9) & 1) << 5); R = (st >> 1) * 16 + swz / 64; C = (st & 1) * 32 + (swz % 64) / 2; }
__host__ __device__ __forceinline__ int perm32(int rho) { const int n = rho >> 4, i = rho & 15; return 8 * (i >> 2) + 4 * n + (i & 3); }
struct Unit { int pm, pn; };
struct Gemm { const bf16_t* A; const bf16_t* Bt; int M, N, K; };
struct StaticOrder {
    int nM, nN, nwg, G, c;
    __host__ __device__ void init(int M_, int N_, int G_, int c_) { nM = M_ / BM; nN = N_ / BM; nwg = nM * nN; G = G_; c = c_; }
    __host__ __device__ bool next(int i, Unit& u) const {
        const long L = (long)i * G + c; if (L >= nwg) return false;
        int wgid = (int)L; { const int q = nwg / NXCD, r = nwg % NXCD, xcd = wgid % NXCD, off = wgid / NXCD; wgid = (xcd < r ? xcd * (q + 1) : r * (q + 1) + (xcd - r) * q) + off; }
        const int nig = WGM * nN, gid = wgid / nig, fm = gid * WGM, gsz = (nM - fm) < WGM ? (nM - fm) : WGM;
        u.pm = fm + ((wgid % nig) % gsz); u.pn = (wgid % nig) / gsz; return true;
    }
    __device__ __forceinline__ void a_ready(const Unit&) const {}
    __device__ __forceinline__ void done(const Unit&) const {}
};
typedef __bf16 bf16x2_t __attribute__((ext_vector_type(2)));
__device__ __forceinline__ unsigned cvt_pk_bf16(float lo, float hi) { const f32x2 v = {lo, hi}; const bf16x2_t b = __builtin_convertvector(v, bf16x2_t); return __builtin_bit_cast(unsigned, b); }


template <int NP> __device__ __forceinline__ float row_ssq(const float* p, int row) {
    if (NP == 1) return p[row];
    const f32x4* q = (const f32x4*)(p + (size_t)row * 16); const f32x4 a = q[0], b = q[1], c = q[2], d = q[3];
    return (((a[0] + a[1]) + (a[2] + a[3])) + ((b[0] + b[1]) + (b[2] + b[3]))) + (((c[0] + c[1]) + (c[2] + c[3])) + ((d[0] + d[1]) + (d[2] + d[3])));
}
template <int NP> struct EpiSwiGLU {
    static constexpr bool PERM = true, AFTER_DRAIN = false;
    bf16_t* O; int ldc; const float* ssq;
    __device__ __forceinline__ void operator()(const f32x4 (&acc)[2][2][4][2], const Unit& u, int wr, int wc, int fr, int fq) const {
        const int row0 = u.pm * BM + wr * 64 + fr, col0 = u.pn * 128 + wc * 32 + 8 * fq;
#pragma unroll
        for (int ai = 0; ai < 2; ++ai)
#pragma unroll
            for (int m = 0; m < 4; ++m) {
                const int row = row0 + ai * HALF + m * 16;
                const float rs = 1.0f / sqrtf(row_ssq<NP>(ssq, row) * (1.0f / D) + RMS_EPS);
                float o[8];
#pragma unroll
                for (int n = 0; n < 2; ++n)
#pragma unroll
                    for (int i = 0; i < 4; ++i) { const float g = acc[ai][0][m][n][i] * rs, up = acc[ai][1][m][n][i] * rs; o[n * 4 + i] = g * sigmoidf_(g) * up; }
                u32x4 w; w.x = cvt_pk_bf16(o[0], o[1]); w.y = cvt_pk_bf16(o[2], o[3]); w.z = cvt_pk_bf16(o[4], o[5]); w.w = cvt_pk_bf16(o[6], o[7]);
                *(u32x4*)(O + (size_t)row * ldc + col0) = w;
            }
    }
};
struct EpiResid {
    static constexpr bool PERM = false, AFTER_DRAIN = false;
    const float* xin; float* xout; bf16_t* xb; float* ssq; float alpha;
    __device__ __forceinline__ void operator()(const f32x4 (&acc)[2][2][4][2], const Unit& u, int wr, int wc, int fr, int fq) const {
        const int row0 = u.pm * BM + wr * 64 + fr, col0 = u.pn * BM + wc * 32 + 4 * fq;
#pragma unroll
        for (int ai = 0; ai < 2; ++ai)
#pragma unroll
            for (int m = 0; m < 4; ++m) {
                const int row = row0 + ai * HALF + m * 16; const size_t off = (size_t)row * D + col0; float s = 0.f;
#pragma unroll
                for (int bj = 0; bj < 2; ++bj)
#pragma unroll
                    for (int n = 0; n < 2; ++n) {
                        const f32x4 v = *(const f32x4*)(xin + off + bj * HALF + n * 16) + acc[ai][bj][m][n] * alpha;
                        *(f32x4*)(xout + off + bj * HALF + n * 16) = v;
                        s += (v[0] * v[0] + v[1] * v[1]) + (v[2] * v[2] + v[3] * v[3]);
                        if (xb) { u32x2 w; w.x = cvt_pk_bf16(v[0], v[1]); w.y = cvt_pk_bf16(v[2], v[3]); *(u32x2*)(xb + off + bj * HALF + n * 16) = w; }
                    }
                s += __shfl_xor(s, 16); s += __shfl_xor(s, 32);
                if (fq == 0 && ssq) ssq[(size_t)row * 16 + u.pn * 4 + wc] = s;
                asm volatile("" ::: "memory");
            }
    }
};
struct EpiProj {
    static constexpr bool PERM = true, AFTER_DRAIN = false;
    bf16_t* arr0; bf16_t* zbuf; const float* ssq; float* kmean; bf16_t* bnd;
    __device__ __forceinline__ void operator()(const f32x4 (&acc)[2][2][4][2], const Unit& u, int wr, int wc, int fr, int fq) const {
        const int pn = u.pn; const int row0 = u.pm * BM + wr * 64 + fr;
        bf16_t* dst; int pitch, colt;
        if (pn < 12) { dst = arr0 + (size_t)(pn >> 1) * ((size_t)M * 512); pitch = 512; colt = (pn & 1) * 256; } else { dst = zbuf; pitch = ZP; colt = (pn - 12) * 256; }
        const float sc = (pn < 2) ? C2 : 1.0f; const int col0 = colt + wc * 32 + 8 * fq;
        const bool is_k = (pn == 2 || pn == 3), is_rkv = (pn >= 6 && pn < 12);
        float cs[2][8];
#pragma unroll
        for (int bj = 0; bj < 2; ++bj)
#pragma unroll
            for (int i = 0; i < 8; ++i) cs[bj][i] = 0.f;
#pragma unroll
        for (int ai = 0; ai < 2; ++ai)
#pragma unroll
            for (int m = 0; m < 4; ++m) {
                const int row = row0 + ai * HALF + m * 16;
                const float rs = sc / sqrtf(row_ssq<16>(ssq, row) * (1.0f / D) + RMS_EPS);
#pragma unroll
                for (int bj = 0; bj < 2; ++bj) {
                    float o[8];
#pragma unroll
                    for (int n = 0; n < 2; ++n)
#pragma unroll
                        for (int i = 0; i < 4; ++i) { o[n * 4 + i] = acc[ai][bj][m][n][i] * rs; cs[bj][n * 4 + i] += o[n * 4 + i]; }
                    u32x4 w; w.x = cvt_pk_bf16(o[0], o[1]); w.y = cvt_pk_bf16(o[2], o[3]); w.z = cvt_pk_bf16(o[4], o[5]); w.w = cvt_pk_bf16(o[6], o[7]);
                    *(u32x4*)(dst + (size_t)row * pitch + col0 + bj * HALF) = w;
                    if (is_rkv && ai == 1 && m == 3 && wr == 1 && fr == 15) *(u32x4*)(bnd + (size_t)u.pm * 1536 + (pn - 6) * 256 + wc * 32 + 8 * fq + bj * HALF) = w;
                }
            }
        if (is_k) {
#pragma unroll
            for (int bj = 0; bj < 2; ++bj)
#pragma unroll
                for (int i = 0; i < 8; ++i) { float v = cs[bj][i]; v += __shfl_xor(v, 1); v += __shfl_xor(v, 2); v += __shfl_xor(v, 4); v += __shfl_xor(v, 8);
                    if (fr == 0) { const int col = (pn - 2) * 256 + bj * HALF + wc * 32 + 8 * fq + i; atomicAdd(kmean + ((size_t)((u.pm >> 4) * NH + (col >> 6)) * 16 + (u.pm & 15)) * 64 + (col & 63), v); } }
        }
    }
};
template <int MODE> struct EpiGate {
    static constexpr bool PERM = true, AFTER_DRAIN = false;
    bf16_t* out; const bf16_t* gate; bf16_t* out2; const float* ssq;
    __device__ __forceinline__ void operator()(const f32x4 (&acc)[2][2][4][2], const Unit& u, int wr, int wc, int fr, int fq) const {
        const int row0 = u.pm * BM + wr * 64 + fr; int pn = u.pn; bf16_t* dst = out;
        if (MODE == 0 && pn >= 4) { pn -= 4; dst = out2; }
        const int col0 = pn * BM + wc * 32 + 8 * fq;
#pragma unroll
        for (int ai = 0; ai < 2; ++ai)
#pragma unroll
            for (int m = 0; m < 4; ++m) {
                const int row = row0 + ai * HALF + m * 16;
                float rs = 1.0f; if (MODE == 0) rs = 1.0f / sqrtf(row_ssq<16>(ssq, row) * (1.0f / D) + RMS_EPS);
#pragma unroll
                for (int bj = 0; bj < 2; ++bj) {
                    const size_t off = (size_t)row * D + col0 + bj * HALF; float o[8];
#pragma unroll
                    for (int n = 0; n < 2; ++n)
#pragma unroll
                        for (int i = 0; i < 4; ++i) o[n * 4 + i] = acc[ai][bj][m][n][i];
                    if (MODE == 0) {
#pragma unroll
                        for (int i = 0; i < 8; ++i) o[i] = sigmoidf_(o[i] * rs);
                    } else {
                        const u32x4 g = *(const u32x4*)(gate + off);
                        o[0] *= bflo(g.x); o[1] *= bfhi(g.x); o[2] *= bflo(g.y); o[3] *= bfhi(g.y); o[4] *= bflo(g.z); o[5] *= bfhi(g.z); o[6] *= bflo(g.w); o[7] *= bfhi(g.w);
                        if (MODE == 2) { const u32x4 p = *(const u32x4*)(dst + off);
                            o[0] += bflo(p.x); o[1] += bfhi(p.x); o[2] += bflo(p.y); o[3] += bfhi(p.y); o[4] += bflo(p.z); o[5] += bfhi(p.z); o[6] += bflo(p.w); o[7] += bfhi(p.w); }
                    }
                    u32x4 w; w.x = cvt_pk_bf16(o[0], o[1]); w.y = cvt_pk_bf16(o[2], o[3]); w.z = cvt_pk_bf16(o[4], o[5]); w.w = cvt_pk_bf16(o[6], o[7]);
                    *(u32x4*)(dst + off) = w;
                }
            }
    }
};

template <class Epi, class Sched, bool ALIGN_EPI = false, bool SP2 = false>
__device__ __forceinline__ void gemm_phase(PG8_LAS unsigned char* lds, const Gemm g, const Sched& S, const Epi& E) {
    const int tid = threadIdx.x, wid = __builtin_amdgcn_readfirstlane(tid >> 6), lane = tid & 63, wr = wid >> 2, wc = wid & 3, fr = lane & 15, fq = lane >> 4;
    const int K = g.K, nt = K / BK;
    unsigned voffA[2], voffB[2];
#pragma unroll
    for (int i = 0; i < 2; ++i) { int R, C; stage_rc(tid * 16 + i * 8192, R, C); const int Rb = Epi::PERM ? ((R & ~31) + perm32(R & 31)) : R;
        voffA[i] = (unsigned)(R * K + C) * 2u; voffB[i] = (unsigned)(Rb * K + C) * 2u; }
    const size_t kstep = (size_t)(BK * 2);
    const size_t hstep = (size_t)HALF * K * 2;
    const size_t tstep = 2 * hstep;
    const unsigned ldsw = (unsigned)wid * 1024u;
    const int aoff = lds_byte(wr * 64 + fr, fq * 8), boff = lds_byte(wc * 32 + fr, fq * 8);
#define PG8_SA(b, h) (((b) * 2 + (h)) * HTB)
#define PG8_SB(b, h) ((4 + (b) * 2 + (h)) * HTB)
#define PG8_STAGE(bufoff, gbase, voff) do { _Pragma("unroll") for (int _i = 0; _i < 2; ++_i) \
        __builtin_amdgcn_global_load_lds((const unsigned*)((const char*)(gbase) + (voff)[_i]), (PG8_LAS unsigned*)(lds + (bufoff) + ldsw + _i * 8192), 16, 0, 0); } while (0)
#define PG8_LDA(dst, b, h) do { _Pragma("unroll") for (int m = 0; m < 4; ++m) _Pragma("unroll") for (int k = 0; k < 2; ++k) dst[m][k] = *(const PG8_LAS bf16x8*)(lds + PG8_SA(b, h) + aoff + m * 2048 + k * 1024); } while (0)
#define PG8_LDB(dst, b, h) do { _Pragma("unroll") for (int n = 0; n < 2; ++n) _Pragma("unroll") for (int k = 0; k < 2; ++k) dst[n][k] = *(const PG8_LAS bf16x8*)(lds + PG8_SB(b, h) + boff + n * 2048 + k * 1024); } while (0)
#define PG8_MMA(ai, bj, At, Bt) do { __builtin_amdgcn_s_setprio(1); _Pragma("unroll") for (int m = 0; m < 4; ++m) _Pragma("unroll") for (int n = 0; n < 2; ++n) _Pragma("unroll") for (int k = 0; k < 2; ++k) \
        acc[ai][bj][m][n] = __builtin_amdgcn_mfma_f32_16x16x32_bf16(Bt[n][k], At[m][k], acc[ai][bj][m][n], 0, 0, 0); __builtin_amdgcn_s_setprio(0); } while (0)
#define PG8_WAIT_V(n) asm volatile("s_waitcnt vmcnt(" #n ")" ::: "memory")
#define PG8_WAIT_L(n) asm volatile("s_waitcnt lgkmcnt(" #n ")" ::: "memory")
#define PG8_BAR __builtin_amdgcn_s_barrier()
#define PG8_SCHED __builtin_amdgcn_sched_barrier(0)
    Unit cur, nxt; int ui = 0;
    if (!S.next(0, cur)) return;
    f32x4 acc[2][2][4][2];
#pragma unroll
    for (int a = 0; a < 2; ++a)
#pragma unroll
        for (int b = 0; b < 2; ++b)
#pragma unroll
            for (int m = 0; m < 4; ++m)
#pragma unroll
                for (int n = 0; n < 2; ++n) acc[a][b][m][n] = (f32x4){0.f, 0.f, 0.f, 0.f};
    bf16x8 At[4][2], B0[2][2], B1[2][2];
    const char* cA = (const char*)g.A + (size_t)cur.pm * tstep; const char* cB = (const char*)g.Bt + (size_t)cur.pn * tstep;
    S.a_ready(cur);
    if constexpr (SP2) {
        PG8_STAGE(PG8_SB(0, 0), cB, voffB); PG8_STAGE(PG8_SB(0, 1), cB + hstep, voffB); PG8_STAGE(PG8_SA(0, 0), cA, voffA); PG8_STAGE(PG8_SA(0, 1), cA + hstep, voffA);
        if (wr == 1) PG8_BAR;
        PG8_WAIT_V(2); PG8_BAR;
        PG8_STAGE(PG8_SB(1, 0), cB + kstep, voffB); PG8_STAGE(PG8_SA(1, 0), cA + kstep, voffA); PG8_STAGE(PG8_SB(1, 1), cB + hstep + kstep, voffB);
        PG8_WAIT_V(6); PG8_BAR;
    } else {
        PG8_STAGE(PG8_SB(0, 0), cB, voffB); PG8_STAGE(PG8_SA(0, 0), cA, voffA); PG8_STAGE(PG8_SB(0, 1), cB + hstep, voffB); PG8_STAGE(PG8_SA(0, 1), cA + hstep, voffA);
        if (wr == 1) PG8_BAR;
        PG8_WAIT_V(4); PG8_BAR;
        PG8_STAGE(PG8_SB(1, 0), cB + kstep, voffB); PG8_STAGE(PG8_SA(1, 0), cA + kstep, voffA); PG8_STAGE(PG8_SB(1, 1), cB + hstep + kstep, voffB);
        PG8_WAIT_V(6); PG8_BAR;
    }
    for (;;) {
        const bool has_next = S.next(ui + 1, nxt);
        const char* nA = has_next ? (const char*)g.A + (size_t)nxt.pm * tstep : cA; const char* nB = has_next ? (const char*)g.Bt + (size_t)nxt.pn * tstep : cB;
        for (int t = 0; t < nt; t += 2) {
            const bool last = (t == nt - 2);
            const char* a1 = cA + (size_t)(t + 1) * kstep;
            const char* a2 = last ? nA : cA + (size_t)(t + 2) * kstep; const char* b2 = last ? nB : cB + (size_t)(t + 2) * kstep;
            const char* a3 = a2 + kstep; const char* b3 = b2 + kstep;
            if (last && has_next) S.a_ready(nxt);
            if constexpr (SP2) {
            PG8_LDB(B0, 0, 0); PG8_LDB(B1, 0, 1); PG8_SCHED; PG8_LDA(At, 0, 0); PG8_STAGE(PG8_SA(1, 1), a1 + hstep, voffA);
            PG8_WAIT_V(8); PG8_WAIT_L(0); PG8_BAR; PG8_MMA(0, 0, At, B0); PG8_MMA(0, 1, At, B1); PG8_BAR; PG8_SCHED;
            PG8_LDA(At, 0, 1); PG8_STAGE(PG8_SB(0, 0), b2, voffB); PG8_STAGE(PG8_SB(0, 1), b2 + hstep, voffB); PG8_STAGE(PG8_SA(0, 0), a2, voffA);
            PG8_WAIT_V(8); PG8_WAIT_L(0); PG8_BAR; PG8_MMA(1, 0, At, B0); PG8_MMA(1, 1, At, B1); PG8_BAR; PG8_SCHED;
            PG8_LDB(B0, 1, 0); PG8_LDB(B1, 1, 1); PG8_SCHED; PG8_LDA(At, 1, 0); PG8_STAGE(PG8_SA(0, 1), a2 + hstep, voffA);
            PG8_WAIT_V(8); PG8_WAIT_L(0); PG8_BAR; PG8_MMA(0, 0, At, B0); PG8_MMA(0, 1, At, B1); PG8_BAR; PG8_SCHED;
            PG8_LDA(At, 1, 1); PG8_STAGE(PG8_SB(1, 0), b3, voffB); PG8_STAGE(PG8_SB(1, 1), b3 + hstep, voffB); PG8_STAGE(PG8_SA(1, 0), a3, voffA);
            PG8_WAIT_V(8); PG8_WAIT_L(0); PG8_BAR; PG8_MMA(1, 0, At, B0); PG8_MMA(1, 1, At, B1); PG8_BAR; PG8_SCHED;
            } else {
            PG8_LDB(B0, 0, 0); PG8_SCHED; PG8_LDA(At, 0, 0); PG8_STAGE(PG8_SA(1, 1), a1 + hstep, voffA);
            PG8_WAIT_L(8); PG8_BAR; PG8_WAIT_L(0); PG8_MMA(0, 0, At, B0); PG8_BAR; PG8_SCHED;
            PG8_LDB(B1, 0, 1); PG8_STAGE(PG8_SB(0, 0), b2, voffB);
            PG8_BAR; PG8_WAIT_L(0); PG8_MMA(0, 1, At, B1); PG8_BAR;
            PG8_LDA(At, 0, 1); PG8_STAGE(PG8_SA(0, 0), a2, voffA);
            PG8_BAR; PG8_WAIT_L(0); PG8_MMA(1, 0, At, B0); PG8_BAR; PG8_SCHED;
            PG8_STAGE(PG8_SB(0, 1), b2 + hstep, voffB);
            PG8_WAIT_V(6); PG8_BAR; PG8_MMA(1, 1, At, B1); PG8_BAR;
            PG8_LDB(B0, 1, 0); PG8_SCHED; PG8_LDA(At, 1, 0); PG8_STAGE(PG8_SA(0, 1), a2 + hstep, voffA);
            PG8_WAIT_L(8); PG8_BAR; PG8_WAIT_L(0); PG8_MMA(0, 0, At, B0); PG8_BAR; PG8_SCHED;
            PG8_LDB(B1, 1, 1); PG8_STAGE(PG8_SB(1, 0), b3, voffB);
            PG8_BAR; PG8_WAIT_L(0); PG8_MMA(0, 1, At, B1); PG8_BAR;
            PG8_LDA(At, 1, 1); PG8_STAGE(PG8_SA(1, 0), a3, voffA);
            PG8_BAR; PG8_WAIT_L(0); PG8_MMA(1, 0, At, B0); PG8_BAR; PG8_SCHED;
            PG8_STAGE(PG8_SB(1, 1), b3 + hstep, voffB);
            PG8_WAIT_V(6); PG8_BAR; PG8_MMA(1, 1, At, B1); PG8_BAR;
            }
        }
        if constexpr (ALIGN_EPI) { if (wr == 0) PG8_BAR; }
        if constexpr (!Epi::AFTER_DRAIN) { E(acc, cur, wr, wc, fr, fq); S.done(cur); }
        if (!has_next) break;
#pragma unroll
        for (int a = 0; a < 2; ++a)
#pragma unroll
            for (int b = 0; b < 2; ++b)
#pragma unroll
                for (int m = 0; m < 4; ++m)
#pragma unroll
                    for (int n = 0; n < 2; ++n) acc[a][b][m][n] = (f32x4){0.f, 0.f, 0.f, 0.f};
        cur = nxt; cA = nA; cB = nB; ++ui;
        if constexpr (ALIGN_EPI) { if (wr == 1) PG8_BAR; }
    }
    PG8_WAIT_V(0);
    if constexpr (!ALIGN_EPI) { if (wr == 0) PG8_BAR; }
    PG8_BAR;
#undef PG8_SA
#undef PG8_SB
#undef PG8_STAGE
#undef PG8_LDA
#undef PG8_LDB
#undef PG8_MMA
#undef PG8_WAIT_V
#undef PG8_WAIT_L
#undef PG8_BAR
#undef PG8_SCHED
}
}

#define XB_TMO      128
#define XB_XCNT(j)  (256  + 64 * (j))
#define XB_XSUB(j)  (1280 + 64 * (j))
#define XB_XGEN(j)  (2304 + 64 * (j))
#define XB_TOP      3328
#define XB_TOPGEN   3392
#define XCD_BAR_WORDS 3456
#define XB_SPIN_CAP (1u << 18)
__device__ __forceinline__ unsigned xb_ld(unsigned* p)              { return __hip_atomic_load(p, __ATOMIC_RELAXED, __HIP_MEMORY_SCOPE_AGENT); }
__device__ __forceinline__ unsigned xb_add(unsigned* p, unsigned v) { return __hip_atomic_fetch_add(p, v, __ATOMIC_RELAXED, __HIP_MEMORY_SCOPE_AGENT); }
__device__ __forceinline__ unsigned xb_xcc_id() { return (unsigned)__builtin_amdgcn_s_getreg((3 << 11) | 20) & 0xFu; }
#define XB_SPIN(cond, bar) do { unsigned _sp = 0; while (cond) { __builtin_amdgcn_s_sleep(1); \
    if ((++_sp & 255u) == 0u) { if (xb_ld(&(bar)[XB_TMO])) break; if (_sp > XB_SPIN_CAP) { atomicAdd(&(bar)[XB_TMO], 1u); break; } } } } while (0)
struct XcdBarrier { unsigned* bar; unsigned x; volatile LAS unsigned* st; };
__device__ __forceinline__ XcdBarrier xcd_barrier_post(unsigned* bar, volatile LAS unsigned* st) {
    XcdBarrier b; b.bar = bar; b.x = xb_xcc_id(); b.st = st;
    if (threadIdx.x == 0) (void)xb_add(&bar[XB_XCNT(b.x)], 1u);
    return b;
}
__device__ __forceinline__ void xcd_barrier_complete(unsigned* bar, unsigned x, unsigned& nloc, unsigned& nx) {
    const unsigned G = gridDim.x * gridDim.y * gridDim.z;
    unsigned sum, cnt, mine, sp = 0u;
    for (;;) {
        sum = 0u; cnt = 0u; mine = 0u;
#pragma unroll
        for (unsigned j = 0; j < 16; ++j) { const unsigned c = xb_ld(&bar[XB_XCNT(j)]); sum += c; cnt += (c > 0u) ? 1u : 0u; mine = (j == x) ? c : mine; }
        if (sum == G) break;
        __builtin_amdgcn_s_sleep(1);
        if ((++sp & 255u) == 0u) { if (xb_ld(&bar[XB_TMO])) break; if (sp > XB_SPIN_CAP) { atomicAdd(&bar[XB_TMO], 1u); break; } }
    }
    nloc = mine > 0u ? mine : 1u; nx = cnt > 0u ? cnt : 1u;
}
__device__ __forceinline__ void xcd_barrier(const XcdBarrier& b) {
    asm volatile("s_waitcnt vmcnt(0)" ::: "memory");
    __syncthreads();
    if (threadIdx.x == 0) {
        unsigned* bar = b.bar;
        __builtin_amdgcn_s_waitcnt(0);
        unsigned nloc = b.st[0], nx = b.st[1];
        if (nloc == 0u) { xcd_barrier_complete(bar, b.x, nloc, nx); b.st[0] = nloc; b.st[1] = nx; }
        const unsigned old = xb_add(&bar[XB_XSUB(b.x)], 1u);
        const unsigned gen = old / nloc;
        if (old + 1u == (gen + 1u) * nloc) {
            __builtin_amdgcn_fence(__ATOMIC_RELEASE, "agent");
            asm volatile("s_waitcnt vmcnt(0)" ::: "memory");
            const unsigned og = xb_add(&bar[XB_TOP], 1u);
            const unsigned tg = og / nx;
            if (og + 1u == (tg + 1u) * nx) xb_add(&bar[XB_TOPGEN], 1u);
            else XB_SPIN(xb_ld(&bar[XB_TOPGEN]) == tg, bar);
            __builtin_amdgcn_fence(__ATOMIC_ACQUIRE, "agent");
            xb_add(&bar[XB_XGEN(b.x)], 1u);
            asm volatile("s_waitcnt vmcnt(0)" ::: "memory");
        } else {
            XB_SPIN(xb_ld(&bar[XB_XGEN(b.x)]) == gen, bar);
            __builtin_amdgcn_fence(__ATOMIC_ACQUIRE, "agent");
            asm volatile("s_waitcnt vmcnt(0)" ::: "memory");
        }
    }
    __syncthreads();
}

constexpr int NWAVES = 8;
constexpr int RING_OFF = 0, RING_BYTES = 131072;
constexpr int LDSCTL_OFF = RING_BYTES, MISC_OFF = LDSCTL_OFF + 320;
constexpr int LDS_BYTES = 147456;

struct Frame {
    LAS unsigned char* lds; volatile LAS unsigned* MISC; unsigned* ctl;
    int tid, lane, wave, vcu, G;
    const float* const* in; float* out; unsigned char* ws;
};
enum { I_X = 0, I_RELB, I_NFFN1, I_F1G, I_F1U, I_F1D, I_NMIX, I_WIN, I_MIXRKV, I_MIXWAG, I_WLA, I_WLB, I_W0, I_ALA, I_ALB, I_A0, I_GLA, I_GLB, I_KK, I_KA, I_RKP, I_LNW, I_LNB,
       I_PA, I_PB, I_WOUT, I_NFFN2, I_F2G, I_F2U, I_F2D, I_NFIN };

__device__ __forceinline__ float wave_sum(float v) {
#pragma unroll
    for (int o = 1; o < 64; o <<= 1) v += __shfl_xor(v, o);
    return v;
}

__device__ __forceinline__ void tr_item(const float* W, int ldw, int c0, bf16* WT, int K, int drow0, int k0, const float* g, const float* mix, int mode, LAS float* scr, int lane) {
    float wv[32];
#pragma unroll
    for (int i = 0; i < 32; ++i) wv[i] = W[(size_t)(k0 + 2 * i + (lane >> 5)) * ldw + c0 + (lane & 31)];
#pragma unroll
    for (int i = 0; i < 32; ++i) { const int kk = 2 * i + (lane >> 5), k = k0 + kk; float s = g ? g[k] : 1.0f; if (mode == 1) s *= (1.0f - mix[k]); else if (mode == 2) s *= mix[k];
        scr[kk * 33 + (lane & 31)] = wv[i] * s; }
    LDS_WAIT(); asm volatile("" ::: "memory");
    const int c = lane & 7;
#pragma unroll
    for (int j = 0; j < 4; ++j) { const int n = (lane >> 3) + 8 * j; const LAS float* s = scr + (8 * c) * 33 + n;
        u32x4 o; o.x = pk2(s[0 * 33], s[1 * 33]); o.y = pk2(s[2 * 33], s[3 * 33]); o.z = pk2(s[4 * 33], s[5 * 33]); o.w = pk2(s[6 * 33], s[7 * 33]);
        *(u32x4*)(WT + (size_t)(drow0 + n) * K + k0 + 8 * c) = o; }
    LDS_WAIT(); asm volatile("" ::: "memory");
}
__device__ __forceinline__ void gu_item(const float* Wg, const float* Wu, const float* g, bf16* WT, int r, LAS float* scr, int lane) {
    const int kb = r / 176, nb = r % 176, pn = nb >> 3, bj = (nb >> 2) & 1, o = nb & 3;
    tr_item(bj ? Wu : Wg, FF, 128 * pn + 32 * o, WT, D, 32 * nb, 64 * kb, g, nullptr, 0, scr, lane);
}
constexpr int CJ0 = 16 * 176, CJ1 = 44 * 32, CJ2 = 16 * 96, CJ3 = 16 * 18, CJ4 = 16 * 64, CJ5 = 8 * 32, CJ6 = 8 * 32, CJ7 = 16 * 32, CJ8 = CJ0, CJ9 = CJ1;
constexpr int CV0 = CJ0, CV1 = CJ0 + CJ1 + CJ2 + CJ3 + CJ4 + CJ5 + CJ6 + CJ7, CV2 = CV1 + CJ8 + CJ9;
__device__ __forceinline__ void conv_item(Frame& F, int it, LAS float* scr) {
    unsigned char* ws = F.ws; int r = it;
    if (r < CJ0) { gu_item(F.in[I_F1G], F.in[I_F1U], F.in[I_NFFN1], (bf16*)(ws + WS_WGU1), r, scr, F.lane); return; } r -= CJ0;
    if (r < CJ1) { const int kb = r / 32, nb = r % 32; tr_item(F.in[I_F1D], D, 32 * nb, (bf16*)(ws + WS_WD1), FF, 32 * nb, 64 * kb, nullptr, nullptr, 0, scr, F.lane); return; } r -= CJ1;
    if (r < CJ2) { const int kb = r / 96, nb = r % 96; tr_item(F.in[I_WIN], 5120, 32 * nb, (bf16*)(ws + WS_WIN), D, 32 * nb, 64 * kb, F.in[I_NMIX], nullptr, 0, scr, F.lane); return; } r -= CJ2;
    if (r < CJ3) { const int kb = r / 18, nb = r % 18, md = nb < 9 ? 1 : 2, n9 = nb % 9;
        const float* W; int ldw, c0; const float* mix;
        if (n9 < 2) { W = F.in[I_WLA]; ldw = 64; c0 = 32 * n9; mix = F.in[I_MIXWAG]; }
        else if (n9 < 4) { W = F.in[I_ALA]; ldw = 64; c0 = 32 * (n9 - 2); mix = F.in[I_MIXWAG] + D; }
        else { W = F.in[I_GLA]; ldw = 160; c0 = 32 * (n9 - 4); mix = F.in[I_MIXWAG] + 2 * D; }
        tr_item(W, ldw, c0, (bf16*)(ws + WS_WIN), D, 3072 + 32 * nb, 64 * kb, F.in[I_NMIX], mix, md, scr, F.lane); return; } r -= CJ3;
    if (r < CJ4) { const int kb = r / 64, nb = r % 64; tr_item(F.in[I_WIN], 5120, 3072 + 32 * nb, (bf16*)(ws + WS_WG), D, 32 * nb, 64 * kb, F.in[I_NMIX], nullptr, 0, scr, F.lane); return; } r -= CJ4;
    if (r < CJ5) { const int kb = r / 32, nb = r % 32; tr_item(F.in[I_PA], D, 32 * nb, (bf16*)(ws + WS_WA), 512, 32 * nb, 64 * kb, nullptr, nullptr, 0, scr, F.lane); return; } r -= CJ5;
    if (r < CJ6) { const int kb = r / 32, nb = r % 32; tr_item(F.in[I_PB], D, 32 * nb, (bf16*)(ws + WS_WB), 512, 32 * nb, 64 * kb, nullptr, nullptr, 0, scr, F.lane); return; } r -= CJ6;
    if (r < CJ7) { const int kb = r / 32, nb = r % 32; tr_item(F.in[I_WOUT], D, 32 * nb, (bf16*)(ws + WS_WOUT), D, 32 * nb, 64 * kb, nullptr, nullptr, 0, scr, F.lane); return; } r -= CJ7;
    if (r < CJ8) { gu_item(F.in[I_F2G], F.in[I_F2U], F.in[I_NFFN2], (bf16*)(ws + WS_WGU2), r, scr, F.lane); return; } r -= CJ8;
    { const int kb = r / 32, nb = r % 32; tr_item(F.in[I_F2D], D, 32 * nb, (bf16*)(ws + WS_WD2), FF, 32 * nb, 64 * kb, nullptr, nullptr, 0, scr, F.lane); }
}
__device__ __forceinline__ void conv_range(Frame& F, int lo, int hi, int w, int nworkers) {
    LAS float* scr = (LAS float*)(F.lds + RING_OFF + F.wave * 16384);
    for (int it = lo + w; it < hi; it += nworkers) conv_item(F, it, scr);
}
__device__ __forceinline__ void p0_prologue(Frame& F) {
    const int gw = F.vcu * NWAVES + F.wave, NGW = F.G * NWAVES;
    unsigned char* ws = F.ws;
    conv_range(F, 0, CV0, gw, NGW);
    const int gt = F.vcu * 512 + F.tid, NGT = F.G * 512;
    { u32x4* z = (u32x4*)(ws + WS_WIN + (size_t)3648 * D * 2); for (int i = gt; i < 192 * D * 2 / 16; i += NGT) z[i] = (u32x4){0u, 0u, 0u, 0u}; }
    { bf16* lw = (bf16*)(ws + WS_LBW); bf16* la = (bf16*)(ws + WS_LBA); bf16* lg = (bf16*)(ws + WS_LBG);
      for (int i = gt; i < 512 * 64; i += NGT) { const int n = i >> 6, k = i & 63; lw[i] = (bf16)f2bf(F.in[I_WLB][k * 512 + n]); la[i] = (bf16)f2bf(F.in[I_ALB][k * 512 + n]); }
      for (int i = gt; i < 512 * 160; i += NGT) { const int n = i / 160, k = i % 160; lg[i] = (bf16)f2bf(F.in[I_GLB][k * 512 + n]); } }
    { const float* x = F.in[I_X]; bf16* xb = (bf16*)(ws + WS_XB); float* ssq = (float*)(ws + OFF_SSQ1);
      for (int m = gw; m < M; m += NGW) {
          const f32x4* xr = (const f32x4*)(x + (size_t)m * D) + F.lane; f32x4 v[4]; float s = 0.f;
#pragma unroll
          for (int j = 0; j < 4; ++j) { v[j] = xr[64 * j]; s += (v[j].x * v[j].x + v[j].y * v[j].y) + (v[j].z * v[j].z + v[j].w * v[j].w); }
          s = wave_sum(s); if (F.lane == 0) ssq[m] = s;
          unsigned long long* o8 = (unsigned long long*)(xb + (size_t)m * D) + F.lane;
#pragma unroll
          for (int j = 0; j < 4; ++j) o8[64 * j] = (unsigned long long)pk2(v[j].x, v[j].y) | ((unsigned long long)pk2(v[j].z, v[j].w) << 32);
      } }
}

__device__ __forceinline__ int t5_bucket(int n) {
    if (n < 16) return n < 0 ? 0 : n;
    int b = 16;
    b += (n >= 21); b += (n >= 27); b += (n >= 35); b += (n >= 46); b += (n >= 59); b += (n >= 77); b += (n >= 99); b += (n >= 128);
    b += (n >= 166); b += (n >= 216); b += (n >= 280); b += (n >= 363); b += (n >= 470); b += (n >= 609); b += (n >= 790);
    return b;
}

namespace attn_body {
typedef unsigned short bf16;
using bf16x8=__attribute__((ext_vector_type(8)))short;
using s16x4=__attribute__((ext_vector_type(4)))short;
using f32x16=__attribute__((ext_vector_type(16)))float;
using u32x4=__attribute__((ext_vector_type(4)))unsigned;
constexpr int BATCH=4,NHEAD=8,SEQ=4096,D=64,DM=NHEAD*D;
constexpr int NW=8,QBLK=32,QB=QBLK*NW,KVBLK=64,NQB=SEQ/QB;
constexpr int ATTN_PITCH=DM, ATTN_UNIT_ROWS=QB;
__device__ __forceinline__ int crow(int r,int hi){return (r&3)+8*(r>>2)+4*hi;}
#define SBAR() __builtin_amdgcn_sched_barrier(0)
typedef __attribute__((address_space(3))) float* lds_fptr;
typedef float f32x4_t __attribute__((ext_vector_type(4)));
__device__ __forceinline__ void cmask(f32x16&p0,f32x16&p1,int jb,int qrel,int hi){
  const float NEG=-INFINITY; int kb=64*jb+4*hi;
  #pragma unroll
  for(int r=0;r<16;++r){int kv=kb+(r&3)+8*(r>>2); if(kv>qrel)p0[r]=NEG; if(kv+32>qrel)p1[r]=NEG;}
}

constexpr int NSLOT=3, SLOTB=8192;
constexpr int LDS_K=0, LDS_V=NSLOT*SLOTB, LDS_WS=2*NSLOT*SLOTB, LDS_OST=LDS_WS+NW*64*4, LDS_RT=LDS_OST+NW*4096,LDS_KM=LDS_RT+1152*4,LDS_BYTES=LDS_KM+15*64*4;
constexpr float C2=0.125f*1.4426950408889634f, L2E=1.4426950408889634f;
__device__ __forceinline__ void glds16(const void*gsrc,unsigned lds_dst){unsigned keep;
  asm volatile("s_mov_b32 %0, m0\n\ts_mov_b32 m0, %2\n\ts_nop 0\n\tglobal_load_lds_dwordx4 %1, off\n\ts_mov_b32 m0, %0":"=&s"(keep):"v"(gsrc),"s"(lds_dst):"memory");}
__device__ __forceinline__ float max3f(float a,float b,float c){float r;asm("v_max3_f32 %0, %1, %2, %3":"=v"(r):"v"(a),"v"(b),"v"(c));return r;}
__device__ __forceinline__ float max2f(float a,float b){float r;asm("v_max_f32_e32 %0, %1, %2":"=v"(r):"v"(a),"v"(b));return r;}
__device__ __forceinline__ float fadd_s(float a,float b){float r;asm("v_add_f32_e32 %0, %1, %2":"=v"(r):"v"(a),"v"(b));return r;}
__device__ __forceinline__ float fsub_s(float a,float b){float r;asm("v_sub_f32_e32 %0, %1, %2":"=v"(r):"v"(a),"v"(b));return r;}
typedef float f32x2_t __attribute__((ext_vector_type(2))); typedef __bf16 bf16x2_t __attribute__((ext_vector_type(2)));
__device__ __forceinline__ unsigned cvtpk_s(float lo,float hi){f32x2_t v={lo,hi};bf16x2_t b=__builtin_convertvector(v,bf16x2_t);return __builtin_bit_cast(unsigned,b);}
#define WAIT_BAR(N) asm volatile("s_waitcnt vmcnt(" #N ") lgkmcnt(0)\n\ts_barrier":::"memory")

__device__ __forceinline__ void qkt(f32x16&p0,f32x16&p1,const char*Kslot,const bf16x8*qr,const f32x16&negm,int r32,int hi){
  const char*kb=Kslot+hi*1024+r32*16;
  #pragma unroll
  for(int d0=0;d0<4;++d0){
    const bf16x8 b0=*reinterpret_cast<const bf16x8*>(kb+d0*2048);
    const bf16x8 b1=*reinterpret_cast<const bf16x8*>(kb+d0*2048+512);
    if(d0==0){p0=__builtin_amdgcn_mfma_f32_32x32x16_bf16(b0,qr[0],negm,0,0,0);p1=__builtin_amdgcn_mfma_f32_32x32x16_bf16(b1,qr[0],negm,0,0,0);}
    else{p0=__builtin_amdgcn_mfma_f32_32x32x16_bf16(b0,qr[d0],p0,0,0,0);p1=__builtin_amdgcn_mfma_f32_32x32x16_bf16(b1,qr[d0],p1,0,0,0);}}
}
typedef __attribute__((address_space(3))) const char* lds_cptr;
typedef short v4i16_t __attribute__((ext_vector_type(4)));
__device__ __forceinline__ void kload8(bf16x8*kf,lds_cptr kp){
  kf[0]=*(const __attribute__((address_space(3))) bf16x8*)(kp);      kf[1]=*(const __attribute__((address_space(3))) bf16x8*)(kp+512);
  kf[2]=*(const __attribute__((address_space(3))) bf16x8*)(kp+2048); kf[3]=*(const __attribute__((address_space(3))) bf16x8*)(kp+2560);
  kf[4]=*(const __attribute__((address_space(3))) bf16x8*)(kp+4096); kf[5]=*(const __attribute__((address_space(3))) bf16x8*)(kp+4608);
  kf[6]=*(const __attribute__((address_space(3))) bf16x8*)(kp+6144); kf[7]=*(const __attribute__((address_space(3))) bf16x8*)(kp+6656);
}
__device__ __forceinline__ void kload2(bf16x8*kf,lds_cptr kp,int j){ kf[2*j]=*(const __attribute__((address_space(3))) bf16x8*)(kp+j*2048); kf[2*j+1]=*(const __attribute__((address_space(3))) bf16x8*)(kp+j*2048+512); }
__device__ __forceinline__ s16x4 vtr(lds_cptr p){ return __builtin_bit_cast(s16x4,__builtin_amdgcn_ds_read_tr16_b64_v4i16((__attribute__((address_space(3))) v4i16_t*)p)); }
__device__ __forceinline__ float rowmax(const f32x16&p0,const f32x16&p1){
  float a=max3f(p0[0],p0[1],p1[0]),b=max3f(p0[2],p0[3],p1[1]);a=max3f(a,p1[2],p1[3]);
  #pragma unroll
  for(int r=4;r<16;r+=4){a=max3f(a,p0[r],p0[r+1]);b=max3f(b,p0[r+2],p0[r+3]);a=max3f(a,p1[r],p1[r+1]);b=max3f(b,p1[r+2],p1[r+3]);}
  const float m=max2f(a,b);
  auto rr=__builtin_amdgcn_permlane32_swap(__float_as_uint(m),__float_as_uint(m),false,false);
  return max2f(__uint_as_float(rr[0]),__uint_as_float(rr[1]));
}
__device__ __forceinline__ void pv(f32x16*o,int vb,bf16x8 pa0,bf16x8 pa1,bf16x8 pa2,bf16x8 pa3){
  #pragma unroll
  for(int d0=0;d0<2;++d0){s16x4 lo[4],hi[4];
    #pragma unroll
    for(int ks=0;ks<4;++ks){
      asm volatile("ds_read_b64_tr_b16 %0,%1 offset:%c2":"=&v"(lo[ks]):"v"(vb),"i"(d0*4096+ks*1024):"memory");
      asm volatile("ds_read_b64_tr_b16 %0,%1 offset:%c2":"=&v"(hi[ks]):"v"(vb),"i"(d0*4096+ks*1024+512):"memory");}
    asm volatile("s_waitcnt lgkmcnt(0)":::"memory");SBAR();
    #define PK(k) (bf16x8){lo[k][0],lo[k][1],lo[k][2],lo[k][3],hi[k][0],hi[k][1],hi[k][2],hi[k][3]}
    o[d0]=__builtin_amdgcn_mfma_f32_32x32x16_bf16(pa0,PK(0),o[d0],0,0,0);
    o[d0]=__builtin_amdgcn_mfma_f32_32x32x16_bf16(pa1,PK(1),o[d0],0,0,0);
    o[d0]=__builtin_amdgcn_mfma_f32_32x32x16_bf16(pa2,PK(2),o[d0],0,0,0);
    o[d0]=__builtin_amdgcn_mfma_f32_32x32x16_bf16(pa3,PK(3),o[d0],0,0,0);
    #undef PK
  }
}

#ifndef ATTN_STORE16
#define ATTN_STORE16(p,v) (*(u32x4*)(p)=(v))
#endif
template<int THRL> __device__ __forceinline__ void attn_unit(int b,int h,int qb,const bf16*Q,const bf16*__restrict__ K,const bf16*__restrict__ V,bf16*O,char*shm,const float*__restrict__ kmsum,const float*__restrict__ relb){
  int tid_=threadIdx.x; asm volatile("":"+v"(tid_));
  const int tid=tid_,lane=tid&63,r32=lane&31,hi=lane>>5; const int wid=__builtin_amdgcn_readfirstlane(tid>>6);
  const long rowbase=(long)b*SEQ; const int q0=qb*QB;
  const bf16*Qw=Q+(rowbase+q0+wid*QBLK)*DM+h*D;
  const bf16*Kh=K+rowbase*DM+h*D,*Vh=V+rowbase*DM+h*D;
  const unsigned lds0=(unsigned)(uintptr_t)shm;
  float*wsf=(float*)(shm+LDS_WS)+wid*64;
  const bf16*ksrc=Kh+(long)lane*DM+wid*8;
  const bf16*vsrc=Vh+(long)(16*(wid&3)+(lane>>2))*DM+(wid>>2)*32+(lane&3)*8;
  const unsigned kdst=lds0+LDS_K+wid*1024, vdst=lds0+LDS_V+wid*1024;
  #define DMA_K(t,slot) glds16(ksrc+(long)PHYS(t)*KVBLK*DM,(unsigned)__builtin_amdgcn_readfirstlane(kdst+(slot)))
  #define DMA_V(t,slot) glds16(vsrc+(long)PHYS(t)*KVBLK*DM,(unsigned)__builtin_amdgcn_readfirstlane(vdst+(slot)))
  const int vb0=(int)(lds0+LDS_V)+((lane>>4)&1)*32+(lane&3)*8+(4*hi+((lane&15)>>2))*64;
  const char*Kbase=shm+LDS_K; bf16x8 kf[8];
  const lds_cptr shm3=(lds_cptr)shm; const lds_cptr kp0=shm3+LDS_K+hi*1024+r32*16; const lds_cptr vp0=shm3+LDS_V+((lane>>4)&1)*32+(lane&3)*8+(4*hi+((lane&15)>>2))*64;
  const int NT=(q0+QB)/KVBLK;
  const lds_fptr rt3=(lds_fptr)(shm+LDS_RT); const lds_fptr km3=(lds_fptr)(shm+LDS_KM);
  { for(int j=tid;j<1152;j+=512){ const int d=895-j; float v=0.f; if(d>=0&&d<790)v=(relb[t5_bucket(d)*NHEAD+h]-relb[31*NHEAD+h])*L2E; rt3[j]=v; }
    for(int i=tid;i<qb*64;i+=512)km3[i]=kmsum[i];
    asm volatile("s_waitcnt vmcnt(0) lgkmcnt(0)\n\ts_barrier":::"memory"); }
  unsigned selmask=0u; bool selcur=true;
  if(qb>0){
    bf16x8 qg[4]; { const bf16*Qg=Q+(rowbase+q0+wid*QBLK+(lane&31))*DM+h*D+(lane>>5)*8;
      #pragma unroll
      for(int d0=0;d0<4;++d0)qg[d0]=*reinterpret_cast<const bf16x8*>(Qg+d0*16); }
    float qf[32];
    #pragma unroll
    for(int d0=0;d0<4;++d0){
      #pragma unroll
      for(int j=0;j<8;++j)qf[8*d0+j]=__builtin_bit_cast(float,(unsigned)(unsigned short)qg[d0][j]<<16);}
    float g0=-INFINITY,g1=-INFINITY,g2=-INFINITY;int s0=-1,s1=-1,s2=-1;
    for(int n=0;n<qb;++n){ const lds_fptr kr=km3+n*64+8*(lane>>5); float acc=0.f;
      #pragma unroll
      for(int d0=0;d0<4;++d0){ const f32x4_t a=*(const __attribute__((address_space(3))) f32x4_t*)(kr+16*d0), c=*(const __attribute__((address_space(3))) f32x4_t*)(kr+16*d0+4);
        acc+=(qf[8*d0]*a[0]+qf[8*d0+1]*a[1])+(qf[8*d0+2]*a[2]+qf[8*d0+3]*a[3])+(qf[8*d0+4]*c[0]+qf[8*d0+5]*c[1])+(qf[8*d0+6]*c[2]+qf[8*d0+7]*c[3]); }
      acc+=__shfl_xor(acc,32);
      if(acc>g0){g2=g1;s2=s1;g1=g0;s1=s0;g0=acc;s0=n;} else if(acc>g1){g2=g1;s2=s1;g1=acc;s1=n;} else if(acc>g2){g2=acc;s2=n;} }
    if(s0>=0)selmask|=1u<<s0; if(s1>=0)selmask|=1u<<s1; if(s2>=0)selmask|=1u<<s2; }
  #define PHYS(t) (((t)<4)?(NT-4+(t)):((t)-4))
  DMA_K(0,0);DMA_V(0,0);DMA_K(1,SLOTB);
  bf16x8 qr[4];
  #pragma unroll
  for(int d0=0;d0<4;++d0)qr[d0]=*reinterpret_cast<const bf16x8*>(&Qw[(long)r32*DM+d0*16+hi*8]);
  float mhat=0.f,l_reg=0.f;f32x16 o[2];o[0]=f32x16{};o[1]=f32x16{};const f32x16 zero16=f32x16{};
  const int qrel=wid*QBLK+r32;
  #define BIASADD(P0,P1,kt0) do{ const lds_fptr rp_=rt3+(895-(q0+qrel)+(kt0)+4*hi); \
    _Pragma("unroll") for(int g_=0;g_<4;++g_){ SBAR(); \
      const float b0_=rp_[8*g_],b1_=rp_[8*g_+1],b2_=rp_[8*g_+2],b3_=rp_[8*g_+3],c0_=rp_[8*g_+32],c1_=rp_[8*g_+33],c2_=rp_[8*g_+34],c3_=rp_[8*g_+35]; \
      P0[4*g_]+=b0_;P0[4*g_+1]+=b1_;P0[4*g_+2]+=b2_;P0[4*g_+3]+=b3_;P1[4*g_]+=c0_;P1[4*g_+1]+=c1_;P1[4*g_+2]+=c2_;P1[4*g_+3]+=c3_; } SBAR(); }while(0)
  #define CMASK(P0,P1,t) do{ const int t_=(t); { const float nm_=selcur?-mhat:-1e30f; _Pragma("unroll") for(int r=0;r<16;++r){P0[r]+=nm_;P1[r]+=nm_;} } \
    if(t_<4){ BIASADD(P0,P1,q0+64*t_); cmask(P0,P1,t_,qrel,hi); } \
    else{ const int kt0_=64*(t_-4); if(q0+wid*QBLK-(kt0_+63)<790){ BIASADD(P0,P1,kt0_); } } }while(0)
  #define SELUPD(tn) do{ const int tn_=(tn); if(tn_>=4&&(tn_&3)==0){ selcur=((selmask>>((tn_-4)>>2))&1u)!=0u; } }while(0)
  bool resc=false;
  #define START(P0,P1) do{ const float rm=rowmax(P0,P1); resc=false; \
    { const float dl=rm; mhat=fadd_s(mhat,dl); \
      _Pragma("unroll") for(int r=0;r<16;++r){P0[r]=fsub_s(P0[r],dl);P1[r]=fsub_s(P1[r],dl);} \
      } \
    _Pragma("unroll") for(int r=0;r<16;++r)P0[r]=__builtin_amdgcn_exp2f(P0[r]); }while(0)
  #define RESC() do{ if(resc){ asm volatile("s_waitcnt lgkmcnt(0)":::"memory"); \
      _Pragma("unroll") for(int d_=0;d_<2;++d_) _Pragma("unroll") for(int r=0;r<16;++r)o[d_][r]*=wsf[crow(r,hi)]; } }while(0)
  f32x16 pA0,pA1,pB0,pB1;
  int sl_prev=0,sl_cur=0,sl_next=SLOTB;
  #define ROT() do{sl_prev=sl_cur;sl_cur=sl_next;sl_next=(sl_next==(NSLOT-1)*SLOTB)?0:sl_next+SLOTB;}while(0)
  DMA_K(2,2*SLOTB);
  WAIT_BAR(3);
  qkt(pA0,pA1,Kbase,qr,zero16,r32,hi);asm volatile("s_nop 15\n\ts_nop 7":"+v"(pA0),"+v"(pA1));CMASK(pA0,pA1,0);
  START(pA0,pA1);
  _Pragma("unroll") for(int r=0;r<16;++r)pA1[r]=__builtin_amdgcn_exp2f(pA1[r]);
  WAIT_BAR(0);
  DMA_K(3,0);DMA_V(1,SLOTB);
  ROT();
  kload8(kf,kp0+sl_cur);
  WAIT_BAR(2);
  s16x4 vlo[8],vhi[8]; u32x4 pw0,pw1,pw2,pw3;
  #define PKW(P,B) cvtpk_s(P[B],P[B+1])
  #define PAF(k) __builtin_bit_cast(bf16x8,pw##k)
  #define VFR(i) (bf16x8){vlo[i][0],vlo[i][1],vlo[i][2],vlo[i][3],vhi[i][0],vhi[i][1],vhi[i][2],vhi[i][3]}
  #define PIN(x) asm volatile("":"+v"(x))
  #define MX3(a,b,c) __builtin_fmaxf(__builtin_fmaxf((a),(b)),(c))
  #define GAPA(MF,A0,A1,A2,A3,W0,W1,PW) do{ MF; sacc+=A0; sacc+=A1; sacc+=A2; sacc+=A3; PIN(sacc); W0; W1; PIN(PW); SBAR(); }while(0)
  #define EX(v) __builtin_amdgcn_exp2f(v)
  #define GAPB(MF,X,B) do{ MF; X[B]=EX(X[B]); X[B+1]=EX(X[B+1]); X[B+2]=EX(X[B+2]); X[B+3]=EX(X[B+3]); PIN(X); SBAR(); }while(0)
  #define VRD(i) do{ vlo[i]=vtr(vp_+(((i)>>2)*4096+((i)&3)*1024)); vhi[i]=vtr(vp_+(((i)>>2)*4096+((i)&3)*1024+512)); }while(0)
  #define KRD(G,j) do{ if(G){ kload2(kf,kp0+sl_next,j); SBAR(); } }while(0)
  #define STEP(C0,C1,P0,P1,t,GK,GV,GL) do{ SBAR(); \
    const lds_cptr vp_=vp0+sl_prev; \
    VRD(0); SBAR(); float sacc=(P0[0]+P0[1]); \
    GAPA(C0=__builtin_amdgcn_mfma_f32_32x32x16_bf16(kf[0],qr[0],zero16,0,0,0), P0[2],P0[3],P0[4],P0[5],     pw0[0]=PKW(P0,0), pw0[1]=PKW(P0,2), pw0); \
    VRD(4); SBAR(); GAPA(C1=__builtin_amdgcn_mfma_f32_32x32x16_bf16(kf[1],qr[0],zero16,0,0,0), P0[6],P0[7],P0[8],P0[9],     pw0[2]=PKW(P0,4), pw0[3]=PKW(P0,6), pw0); \
    VRD(1); SBAR(); GAPA(C0=__builtin_amdgcn_mfma_f32_32x32x16_bf16(kf[2],qr[1],C0,0,0,0),   P0[10],P0[11],P0[12],P0[13], pw1[0]=PKW(P0,8), pw1[1]=PKW(P0,10), pw1); \
    VRD(5); SBAR(); GAPA(C1=__builtin_amdgcn_mfma_f32_32x32x16_bf16(kf[3],qr[1],C1,0,0,0),   P0[14],P0[15],P1[0],P1[1],   pw1[2]=PKW(P0,12),pw1[3]=PKW(P0,14), pw1); \
    VRD(2); SBAR(); GAPA(C0=__builtin_amdgcn_mfma_f32_32x32x16_bf16(kf[4],qr[2],C0,0,0,0),   P1[2],P1[3],P1[4],P1[5],     pw2[0]=PKW(P1,0), pw2[1]=PKW(P1,2), pw2); \
    VRD(6); SBAR(); GAPA(C1=__builtin_amdgcn_mfma_f32_32x32x16_bf16(kf[5],qr[2],C1,0,0,0),   P1[6],P1[7],P1[8],P1[9],     pw2[2]=PKW(P1,4), pw2[3]=PKW(P1,6), pw2); \
    VRD(3); SBAR(); GAPA(C0=__builtin_amdgcn_mfma_f32_32x32x16_bf16(kf[6],qr[3],C0,0,0,0),   P1[10],P1[11],P1[12],P1[13], pw3[0]=PKW(P1,8), pw3[1]=PKW(P1,10), pw3); \
    VRD(7); SBAR(); GAPA(C1=__builtin_amdgcn_mfma_f32_32x32x16_bf16(kf[7],qr[3],C1,0,0,0),   P1[14],P1[15],0.f,0.f,       pw3[2]=PKW(P1,12),pw3[3]=PKW(P1,14), pw3); \
    l_reg+=sacc; \
    if(GK){DMA_K((t)+3,sl_cur);} if(GV){DMA_V((t)+1,sl_next);} \
    CMASK(C0,C1,t); \
    { float a=MX3(C0[0],C0[1],C1[0]),b=MX3(C0[2],C0[3],C1[1]); a=MX3(a,C1[2],C1[3]); \
      _Pragma("unroll") for(int r=4;r<16;r+=4){a=MX3(a,C0[r],C0[r+1]);b=MX3(b,C0[r+2],C0[r+3]);a=MX3(a,C1[r],C1[r+1]);b=MX3(b,C1[r+2],C1[r+3]);} \
      float rm=__builtin_fmaxf(a,b); { auto rr=__builtin_amdgcn_permlane32_swap(__float_as_uint(rm),__float_as_uint(rm),false,false); rm=__builtin_fmaxf(__uint_as_float(rr[0]),__uint_as_float(rr[1])); } \
      resc=false; \
      if(__builtin_expect(__any(rm>(float)THRL),0)){ const float dl=__builtin_fmaxf(rm,0.f); mhat+=dl; \
        _Pragma("unroll") for(int r=0;r<16;++r){C0[r]-=dl;C1[r]-=dl;} \
        const float f=__builtin_amdgcn_exp2f(-dl); l_reg*=f; if(hi==0)wsf[r32]=f; resc=true; } } \
    SBAR(); \
    GAPB(o[0]=__builtin_amdgcn_mfma_f32_32x32x16_bf16(PAF(0),VFR(0),o[0],0,0,0), C0,0); \
    GAPB(o[1]=__builtin_amdgcn_mfma_f32_32x32x16_bf16(PAF(0),VFR(4),o[1],0,0,0), C0,4); \
    KRD(GL,0); GAPB(o[0]=__builtin_amdgcn_mfma_f32_32x32x16_bf16(PAF(1),VFR(1),o[0],0,0,0), C0,8); \
    KRD(GL,1); GAPB(o[1]=__builtin_amdgcn_mfma_f32_32x32x16_bf16(PAF(1),VFR(5),o[1],0,0,0), C0,12); \
    KRD(GL,2); GAPB(o[0]=__builtin_amdgcn_mfma_f32_32x32x16_bf16(PAF(2),VFR(2),o[0],0,0,0), C1,0); \
    KRD(GL,3); GAPB(o[1]=__builtin_amdgcn_mfma_f32_32x32x16_bf16(PAF(2),VFR(6),o[1],0,0,0), C1,4); \
    GAPB(o[0]=__builtin_amdgcn_mfma_f32_32x32x16_bf16(PAF(3),VFR(3),o[0],0,0,0), C1,8); \
    GAPB(o[1]=__builtin_amdgcn_mfma_f32_32x32x16_bf16(PAF(3),VFR(7),o[1],0,0,0), C1,12); \
    }while(0)
  int t=1;
  for(;t+5<NT;t+=2){
    STEP(pB0,pB1,pA0,pA1,t,true,true,true);     WAIT_BAR(2); RESC(); ROT(); SELUPD(t+1);
    STEP(pA0,pA1,pB0,pB1,t+1,true,true,true);   WAIT_BAR(2); RESC(); ROT(); SELUPD(t+2);
  }
  #define ENDW(tt) do{ if((tt)+3<NT){WAIT_BAR(2);} else if((tt)+2<NT){WAIT_BAR(1);} else {WAIT_BAR(0);} }while(0)
  for(;t+1<NT;t+=2){
    STEP(pB0,pB1,pA0,pA1,t,(t+3<NT),(t+1<NT),(t+1<NT));       ENDW(t);   RESC(); ROT(); SELUPD(t+1);
    STEP(pA0,pA1,pB0,pB1,t+1,(t+4<NT),(t+2<NT),(t+2<NT));     ENDW(t+1); RESC(); ROT(); SELUPD(t+2);
  }
  STEP(pB0,pB1,pA0,pA1,NT-1,false,false,false); RESC();
  { float sacc=pB0[0]+pB0[1]; _Pragma("unroll") for(int r=2;r<16;++r)sacc+=pB0[r]; _Pragma("unroll") for(int r=0;r<16;++r)sacc+=pB1[r]; l_reg+=sacc;
    pw0=(u32x4){PKW(pB0,0),PKW(pB0,2),PKW(pB0,4),PKW(pB0,6)};pw1=(u32x4){PKW(pB0,8),PKW(pB0,10),PKW(pB0,12),PKW(pB0,14)};pw2=(u32x4){PKW(pB1,0),PKW(pB1,2),PKW(pB1,4),PKW(pB1,6)};pw3=(u32x4){PKW(pB1,8),PKW(pB1,10),PKW(pB1,12),PKW(pB1,14)};
    SBAR(); pv(o,vb0+sl_cur,PAF(0),PAF(1),PAF(2),PAF(3)); }
  #undef PKW
  #undef PAF
  #undef VFR
  #undef PIN
  #undef MX3
  #undef GAPA
  #undef GAPB
  #undef EX
  #undef VRD
  #undef KRD
  #undef STEP
  #undef ENDW
  {auto rr=__builtin_amdgcn_permlane32_swap(__float_as_uint(l_reg),__float_as_uint(l_reg),false,false);l_reg=__uint_as_float(rr[0])+__uint_as_float(rr[1]);}
  if(hi==0)wsf[32+r32]=l_reg;asm volatile("s_waitcnt lgkmcnt(0)":::"memory");
  float rli[16];
  #pragma unroll
  for(int r=0;r<16;++r)rli[r]=__builtin_amdgcn_rcpf(wsf[32+crow(r,hi)]);
  bf16*Ow=O+(rowbase+q0+wid*QBLK)*DM+h*D;
  { bf16*stg=(bf16*)(shm+LDS_OST)+wid*2048;
    #pragma unroll
    for(int r=0;r<16;++r){const int orow=crow(r,hi);
      #pragma unroll
      for(int d0=0;d0<2;++d0)stg[orow*64+d0*32+r32]=(bf16)f2bf(o[d0][r]*rli[r]);}
    asm volatile("s_waitcnt lgkmcnt(0)":::"memory");
    #pragma unroll
    for(int i=0;i<4;++i){const int row=i*8+(lane>>3),ch=lane&7; const u32x4 v=*(const u32x4*)(stg+row*64+ch*8); ATTN_STORE16(Ow+(long)row*DM+ch*8,v);} }
  asm volatile("s_waitcnt lgkmcnt(0)\n\ts_barrier":::"memory");
  #undef DMA_K
  #undef DMA_V
  #undef CMASK
  #undef BIASADD
  #undef SELUPD
  #undef PHYS
  #undef START
  #undef RESC
  #undef ROT
}
constexpr int ATTN_LDS_BYTES=LDS_BYTES;
struct AttnTensors { const bf16* Q; const bf16* K; const bf16* V; bf16* O; const float* kmsum; const float* relb; };
struct AttnUnit { int bh; int qb; };
struct StaticOrder {
  int vcu;
  __device__ __forceinline__ explicit StaticOrder(int grid,int block):vcu((block%8)*(grid/8)+block/8){}
  __device__ __forceinline__ bool next(int i,AttnUnit&u)const{ if(i>=2)return false; const int s=vcu&7; u.bh=vcu>>3; u.qb=(i==0)?15-s:s; return true; }
  __device__ __forceinline__ void a_ready(const AttnUnit&)const{}
  __device__ __forceinline__ void done(const AttnUnit&)const{}
};
template<class Sched,int THRL=8> __device__ __forceinline__ void attn_phase(char*lds,const AttnTensors&T,const Sched&S){
  AttnUnit u;
  for(int i=0;S.next(i,u);++i){ S.a_ready(u); attn_unit<THRL>(u.bh/NHEAD,u.bh%NHEAD,u.qb,T.Q,T.K,T.V,T.O,lds,T.kmsum+(size_t)u.bh*16*64,T.relb); S.done(u); }
}
#undef SBAR
#undef WAIT_BAR
}

__device__ __forceinline__ void attn_simple(Frame& F) {
    LAS float* tab = (LAS float*)(F.lds + RING_OFF);
    const float* relb = F.in[I_RELB];
    for (int i = F.tid; i < 8 * 800; i += 512) { const int h = i / 800, d = i % 800; tab[i] = relb[t5_bucket(d) * NH + h] * LOG2E; }
    __syncthreads();
    const bf16* Q = (const bf16*)(F.ws + WS_Q); const bf16* K = (const bf16*)(F.ws + WS_K); const bf16* V = (const bf16*)(F.ws + WS_V); bf16* O = (bf16*)(F.ws + WS_Q);
    const float* kmean = (const float*)(F.ws + OFF_KMEAN);
    const int wv = blockIdx.x * NWAVES + F.wave;
    const int bh = wv >> 6, b = bh >> 3, h = bh & 7, q = (wv & 63) * 64 + F.lane, blk = q >> 8;
    const LAS float* tb = tab + h * 800;
    const size_t rowq = (size_t)(b * SEQ + q) * 512 + h * 64;
    float qf[64];
#pragma unroll
    for (int c = 0; c < 8; ++c) { const u32x4 w = *(const u32x4*)(Q + rowq + c * 8);
        qf[c * 8 + 0] = bflo(w.x); qf[c * 8 + 1] = bfhi(w.x); qf[c * 8 + 2] = bflo(w.y); qf[c * 8 + 3] = bfhi(w.y); qf[c * 8 + 4] = bflo(w.z); qf[c * 8 + 5] = bfhi(w.z); qf[c * 8 + 6] = bflo(w.w); qf[c * 8 + 7] = bfhi(w.w); }
    float g0 = -INFINITY, g1 = -INFINITY, g2 = -INFINITY; int s0 = -1, s1 = -1, s2 = -1;
    for (int n = 0; n < blk; ++n) {
        const float* km = kmean + ((size_t)bh * 16 + n) * 64; float gsum = 0.f;
#pragma unroll
        for (int d = 0; d < 64; ++d) gsum += qf[d] * km[d];
        if (gsum > g0) { g2 = g1; s2 = s1; g1 = g0; s1 = s0; g0 = gsum; s0 = n; }
        else if (gsum > g1) { g2 = g1; s2 = s1; g1 = gsum; s1 = n; }
        else if (gsum > g2) { g2 = gsum; s2 = n; }
    }
    float o[64];
#pragma unroll
    for (int d = 0; d < 64; ++d) o[d] = 0.f;
    float mx = -1e30f, l = 0.f;
    for (int pass = 0; pass < 4; ++pass) {
        const int jb = pass == 0 ? s0 : pass == 1 ? s1 : pass == 2 ? s2 : blk;
        const bool act = jb >= 0;
        const int jblk = act ? jb : 0;
        const int nkeys = (pass == 3) ? 256 : 256;
        if (pass < 3 && blk <= pass) continue;
        for (int kk = 0; kk < nkeys; ++kk) {
            const int kpos = jblk * 256 + kk;
            const size_t rowk = (size_t)(b * SEQ + kpos) * 512 + h * 64;
            float s = 0.f;
#pragma unroll
            for (int c = 0; c < 8; ++c) { const u32x4 w = *(const u32x4*)(K + rowk + c * 8);
                s += qf[c * 8 + 0] * bflo(w.x) + qf[c * 8 + 1] * bfhi(w.x) + qf[c * 8 + 2] * bflo(w.y) + qf[c * 8 + 3] * bfhi(w.y) + qf[c * 8 + 4] * bflo(w.z) + qf[c * 8 + 5] * bfhi(w.z) + qf[c * 8 + 6] * bflo(w.w) + qf[c * 8 + 7] * bfhi(w.w); }
            const int dist = q - kpos;
            const bool valid = act && dist >= 0;
            const int dcl = dist < 0 ? 0 : (dist > 799 ? 799 : dist);
            s += tb[dcl];
            if (!valid) s = -1e30f;
            const float mn = fmaxf(mx, s);
            const float f = fast_exp2(mx - mn), p = valid ? fast_exp2(s - mn) : 0.f;
            l = l * f + p; mx = mn;
#pragma unroll
            for (int c = 0; c < 8; ++c) { const u32x4 w = *(const u32x4*)(V + rowk + c * 8);
                o[c * 8 + 0] = o[c * 8 + 0] * f + p * bflo(w.x); o[c * 8 + 1] = o[c * 8 + 1] * f + p * bfhi(w.x); o[c * 8 + 2] = o[c * 8 + 2] * f + p * bflo(w.y); o[c * 8 + 3] = o[c * 8 + 3] * f + p * bfhi(w.y);
                o[c * 8 + 4] = o[c * 8 + 4] * f + p * bflo(w.z); o[c * 8 + 5] = o[c * 8 + 5] * f + p * bfhi(w.z); o[c * 8 + 6] = o[c * 8 + 6] * f + p * bflo(w.w); o[c * 8 + 7] = o[c * 8 + 7] * f + p * bfhi(w.w); }
        }
    }
    const float il = 1.0f / l;
#pragma unroll
    for (int c = 0; c < 8; ++c) { u32x4 w; w.x = pk2(o[c * 8 + 0] * il, o[c * 8 + 1] * il); w.y = pk2(o[c * 8 + 2] * il, o[c * 8 + 3] * il); w.z = pk2(o[c * 8 + 4] * il, o[c * 8 + 5] * il); w.w = pk2(o[c * 8 + 6] * il, o[c * 8 + 7] * il);
        *(u32x4*)(O + rowq + c * 8) = w; }
}

__device__ __forceinline__ void mix_phase(Frame& F) {
    unsigned char* ws = F.ws;
    const bf16* Z = (const bf16*)(ws + WS_Z);
    bf16* R = (bf16*)(ws + WS_R); bf16* KR = (bf16*)(ws + WS_KR); bf16* VR = (bf16*)(ws + WS_VR);
    bf16* KKo = (bf16*)(ws + WS_KK); bf16* BBo = (bf16*)(ws + WS_BB); float* WD = (float*)(ws + WS_WDEC); bf16* GB = (bf16*)(ws + WS_GB); float* RK = (float*)(ws + WS_RK);
    const bf16* bnd = (const bf16*)(ws + WS_BND);
    const bf16* LBW = (const bf16*)(ws + WS_LBW); const bf16* LBA = (const bf16*)(ws + WS_LBA); const bf16* LBG = (const bf16*)(ws + WS_LBG);
    const float* mixrkv = F.in[I_MIXRKV]; const float* w0 = F.in[I_W0]; const float* a0 = F.in[I_A0]; const float* k_k = F.in[I_KK]; const float* k_a = F.in[I_KA]; const float* r_k = F.in[I_RKP];
    const int lane = F.lane, n = lane & 15, q4 = lane >> 4;
    LAS float* stash = (LAS float*)(F.lds + RING_OFF) + F.wave * 2560;
    LAS float* keep = stash + 384;
    for (int item = blockIdx.x; item < 256; item += F.G) {
        const int pm = item >> 2, hp = item & 3;
        const int R0 = pm * 256 + F.wave * 32;
        if (q4 == 0) {
#pragma unroll
            for (int hh = 0; hh < 2; ++hh)
#pragma unroll
                for (int c = 0; c < 4; ++c) {
                    const int ch = (2 * hp + hh) * 64 + 16 * c + n; float vr = 0.f, vk = 0.f, vv = 0.f;
                    if ((R0 & (SEQ - 1)) != 0) {
                        if (F.wave == 0) { const bf16* bp = bnd + (size_t)(pm - 1) * 1536; vr = bf2f(bp[ch]); vk = bf2f(bp[512 + ch]); vv = bf2f(bp[1024 + ch]); }
                        else { const size_t o = (size_t)(R0 - 1) * 512 + ch; vr = bf2f(R[o]); vk = bf2f(KR[o]); vv = bf2f(VR[o]); }
                    }
                    stash[((hh * 4 + c) * 3 + 0) * 16 + n] = vr; stash[((hh * 4 + c) * 3 + 1) * 16 + n] = vk; stash[((hh * 4 + c) * 3 + 2) * 16 + n] = vv;
                }
        }
        asm volatile("s_waitcnt vmcnt(0) lgkmcnt(0)" ::: "memory"); __syncthreads();
#pragma unroll 1
        for (int g = 1; g >= 0; --g) {
            const int t0 = R0 + 16 * g;
            bf16x8 Af[9];
            {
                const int t = t0 + n; const bool first = (t & (SEQ - 1)) == 0;
#pragma unroll
                for (int s = 0; s < 9; ++s) {
                    const u32x4 z1 = *(const u32x4*)(Z + (size_t)t * ZP + 32 * s + 8 * q4);
                    u32x4 z2 = (u32x4){0u, 0u, 0u, 0u}; if (!first) z2 = *(const u32x4*)(Z + (size_t)(t - 1) * ZP + 288 + 32 * s + 8 * q4);
                    float hv[8] = { bflo(z1.x) + bflo(z2.x), bfhi(z1.x) + bfhi(z2.x), bflo(z1.y) + bflo(z2.y), bfhi(z1.y) + bfhi(z2.y), bflo(z1.z) + bflo(z2.z), bfhi(z1.z) + bfhi(z2.z), bflo(z1.w) + bflo(z2.w), bfhi(z1.w) + bfhi(z2.w) };
#pragma unroll
                    for (int i = 0; i < 8; ++i) { if (s < 2) { const float e = fast_exp2(hv[i] * (2.0f * LOG2E)); hv[i] = 1.0f - 2.0f * fast_rcp(e + 1.0f); } else if (s >= 4) hv[i] = sigmoidf_(hv[i]); }
                    u32x4 p; p.x = pk2(hv[0], hv[1]); p.y = pk2(hv[2], hv[3]); p.z = pk2(hv[4], hv[5]); p.w = pk2(hv[6], hv[7]);
                    Af[s] = __builtin_bit_cast(bf16x8, p);
                }
            }
#pragma unroll 1
            for (int hh = 0; hh < 2; ++hh) {
                const int hd = 2 * hp + hh;
                float n2[4] = {0.f, 0.f, 0.f, 0.f}, rks[4] = {0.f, 0.f, 0.f, 0.f};
#pragma unroll 1
                for (int c = 0; c < 4; ++c) {
                    const int ch = hd * 64 + 16 * c + n;
                    float oR[5], oK[5], oV[5];
                    if (q4 == 0 && g == 0) { oR[0] = stash[((hh * 4 + c) * 3 + 0) * 16 + n]; oK[0] = stash[((hh * 4 + c) * 3 + 1) * 16 + n]; oV[0] = stash[((hh * 4 + c) * 3 + 2) * 16 + n]; }
                    else { const size_t o = (size_t)(t0 + 4 * q4 - 1) * 512 + ch; oR[0] = bf2f(R[o]); oK[0] = bf2f(KR[o]); oV[0] = bf2f(VR[o]); }
#pragma unroll
                    for (int i = 0; i < 4; ++i) { const size_t o = (size_t)(t0 + 4 * q4 + i) * 512 + ch; oR[i + 1] = bf2f(R[o]); oK[i + 1] = bf2f(KR[o]); oV[i + 1] = bf2f(VR[o]); }
                    asm volatile("s_waitcnt vmcnt(0) lgkmcnt(0)" ::: "memory");
                    f32x4 aw = (f32x4){0.f, 0.f, 0.f, 0.f}, aa = aw, ag = aw;
#pragma unroll
                    for (int s = 0; s < 2; ++s) { const bf16x8 b = *(const bf16x8*)(LBW + (size_t)ch * 64 + 32 * s + 8 * q4); aw = __builtin_amdgcn_mfma_f32_16x16x32_bf16(Af[s], b, aw, 0, 0, 0); }
#pragma unroll
                    for (int s = 0; s < 2; ++s) { const bf16x8 b = *(const bf16x8*)(LBA + (size_t)ch * 64 + 32 * s + 8 * q4); aa = __builtin_amdgcn_mfma_f32_16x16x32_bf16(Af[2 + s], b, aa, 0, 0, 0); }
#pragma unroll
                    for (int s = 0; s < 5; ++s) { const bf16x8 b = *(const bf16x8*)(LBG + (size_t)ch * 160 + 32 * s + 8 * q4); ag = __builtin_amdgcn_mfma_f32_16x16x32_bf16(Af[4 + s], b, ag, 0, 0, 0); }
                    const float mr = mixrkv[ch], mk = mixrkv[512 + ch], mv = mixrkv[1024 + ch], w0c = w0[ch], a0c = a0[ch], kkc = k_k[ch], kac = k_a[ch], rkc = r_k[ch];
#pragma unroll
                    for (int i = 0; i < 4; ++i) {
                        const size_t o = (size_t)(t0 + 4 * q4 + i) * 512 + ch;
                        const float cr = oR[i + 1], ck = oK[i + 1], cv = oV[i + 1];
                        const float r_ = cr + (oR[i] - cr) * mr, k_ = ck + (oK[i] - ck) * mk, v_ = cv + (oV[i] - cv) * mv;
                        const float sg = sigmoidf_(w0c + aw[i]);
                        const float dec = fast_exp2(-0.6065306597126334f * LOG2E * sg);
                        const float a_ = sigmoidf_(a0c + aa[i]);
                        const float kr_ = k_ * kkc; n2[i] += kr_ * kr_;
                        const float kt_ = k_ * (1.0f + (a_ - 1.0f) * kac);
                        rks[i] += r_ * kt_ * rkc;
                        keep[((c * 4 + i) * 2 + 0) * 64 + lane] = kr_; keep[((c * 4 + i) * 2 + 1) * 64 + lane] = a_;
                        R[o] = (bf16)f2bf(r_); KR[o] = (bf16)f2bf(kt_); VR[o] = (bf16)f2bf(v_); WD[o] = dec; GB[o] = (bf16)f2bf(ag[i]);
                    }
                }
#pragma unroll
                for (int i = 0; i < 4; ++i) {
                    float a = n2[i], b = rks[i];
                    a += __shfl_xor(a, 1); a += __shfl_xor(a, 2); a += __shfl_xor(a, 4); a += __shfl_xor(a, 8);
                    b += __shfl_xor(b, 1); b += __shfl_xor(b, 2); b += __shfl_xor(b, 4); b += __shfl_xor(b, 8);
                    n2[i] = 1.0f / fmaxf(sqrtf(a), 1e-12f); rks[i] = b;
                }
                LDS_WAIT();
#pragma unroll 1
                for (int c = 0; c < 4; ++c) {
                    const int ch = hd * 64 + 16 * c + n;
#pragma unroll
                    for (int i = 0; i < 4; ++i) {
                        const size_t o = (size_t)(t0 + 4 * q4 + i) * 512 + ch;
                        const float kk_ = keep[((c * 4 + i) * 2 + 0) * 64 + lane] * n2[i], a_ = keep[((c * 4 + i) * 2 + 1) * 64 + lane];
                        KKo[o] = (bf16)f2bf(kk_); BBo[o] = (bf16)f2bf(kk_ * a_);
                    }
                }
                LDS_WAIT();
                if (n == 0) {
#pragma unroll
                    for (int i = 0; i < 4; ++i) RK[(size_t)(t0 + 4 * q4 + i) * 8 + hd] = rks[i];
                }
            }
        }
        __syncthreads();
    }
}


typedef float f32x4v __attribute__((ext_vector_type(4)));
#define MF4(a, b, c) __builtin_amdgcn_mfma_f32_16x16x4f32((a), (b), (c), 0, 0, 0)

__device__ __forceinline__ void mixc_phase(Frame& F) {
    unsigned char* ws = F.ws;
    const bf16* Z = (const bf16*)(ws + WS_Z);
    const bf16* R = (const bf16*)(ws + WS_R); const bf16* KR = (const bf16*)(ws + WS_KR); bf16* VR = (bf16*)(ws + WS_VR);
    bf16* GB = (bf16*)(ws + WS_GB); float* RK = (float*)(ws + WS_RK);
    const bf16* bnd = (const bf16*)(ws + WS_BND);
    const bf16* LBW = (const bf16*)(ws + WS_LBW); const bf16* LBA = (const bf16*)(ws + WS_LBA); const bf16* LBG = (const bf16*)(ws + WS_LBG);
    const float* mixrkv = F.in[I_MIXRKV]; const float* w0 = F.in[I_W0]; const float* a0 = F.in[I_A0]; const float* k_k = F.in[I_KK]; const float* k_a = F.in[I_KA]; const float* r_k = F.in[I_RKP];
    const int lane0 = F.lane;
    LAS float* xb = (LAS float*)(F.lds + RING_OFF + F.wave * 16384);
    LAS float* tt = xb; LAS float* rb = xb + 320; LAS float* stash = xb + 3 * 1088;
    LAS unsigned short* sa = (LAS unsigned short*)xb;
    for (int item = blockIdx.x; item < 256; item += F.G) {
        const int pm = item >> 2, hp = item & 3;
        const int R0 = pm * 256 + F.wave * 32;
        { int lane = lane0; asm volatile("" : "+v"(lane)); const int n = lane & 15, q4 = lane >> 4;
        if (q4 == 0) {
#pragma unroll
            for (int hh = 0; hh < 2; ++hh)
#pragma unroll
                for (int c = 0; c < 4; ++c) {
                    const int ch = (2 * hp + hh) * 64 + 16 * c + n; float vr = 0.f, vk = 0.f, vv = 0.f;
                    if ((R0 & (SEQ - 1)) != 0) {
                        if (F.wave == 0) { const bf16* bp = bnd + (size_t)(pm - 1) * 1536; vr = bf2f(bp[ch]); vk = bf2f(bp[512 + ch]); vv = bf2f(bp[1024 + ch]); }
                        else { const size_t o = (size_t)(R0 - 1) * 512 + ch; vr = bf2f(R[o]); vk = bf2f(KR[o]); vv = bf2f(VR[o]); }
                    }
                    stash[((hh * 4 + c) * 3 + 0) * 16 + n] = vr; stash[((hh * 4 + c) * 3 + 1) * 16 + n] = vk; stash[((hh * 4 + c) * 3 + 2) * 16 + n] = vv;
                }
        }
        }
        asm volatile("s_waitcnt vmcnt(0) lgkmcnt(0)" ::: "memory"); __syncthreads();
#pragma unroll 1
        for (int g = 1; g >= 0; --g) {
            const int t0 = R0 + 16 * g;
            bf16x8 Af[9];
            { int lane = lane0; asm volatile("" : "+v"(lane)); const int n = lane & 15, q4 = lane >> 4;
                const int t = t0 + n; const bool first = (t & (SEQ - 1)) == 0;
#pragma unroll
                for (int s = 0; s < 9; ++s) {
                    const u32x4 z1 = *(const u32x4*)(Z + (size_t)t * ZP + 32 * s + 8 * q4);
                    u32x4 z2 = (u32x4){0u, 0u, 0u, 0u}; if (!first) z2 = *(const u32x4*)(Z + (size_t)(t - 1) * ZP + 288 + 32 * s + 8 * q4);
                    float hv[8] = { bflo(z1.x) + bflo(z2.x), bfhi(z1.x) + bfhi(z2.x), bflo(z1.y) + bflo(z2.y), bfhi(z1.y) + bfhi(z2.y), bflo(z1.z) + bflo(z2.z), bfhi(z1.z) + bfhi(z2.z), bflo(z1.w) + bflo(z2.w), bfhi(z1.w) + bfhi(z2.w) };
#pragma unroll
                    for (int i = 0; i < 8; ++i) { if (s < 2) { const float e = fast_exp2(hv[i] * (2.0f * LOG2E)); hv[i] = 1.0f - 2.0f * fast_rcp(e + 1.0f); } else if (s >= 4) hv[i] = sigmoidf_(hv[i]); }
                    u32x4 p; p.x = pk2(hv[0], hv[1]); p.y = pk2(hv[2], hv[3]); p.z = pk2(hv[4], hv[5]); p.w = pk2(hv[6], hv[7]);
                    Af[s] = __builtin_bit_cast(bf16x8, p);
                }
            }
#pragma unroll 1
            for (int hh = 0; hh < 2; ++hh) {
                const int hd = 2 * hp + hh;
                int lane = lane0; asm volatile("" : "+v"(lane));
                const int n = lane & 15, q4 = lane >> 4;
                const int cid = ((t0 >> 12) * NH + hd) * 256 + ((t0 & (SEQ - 1)) >> 4);
                unsigned short rawR[4][5], rawK[4][5], rawV[4][5];
#pragma unroll
                for (int c = 0; c < 4; ++c) {
                    const int ch = hd * 64 + 16 * c + n;
                    if (q4 == 0 && g == 0) { rawR[c][0] = (unsigned short)(__builtin_bit_cast(unsigned, stash[((hh * 4 + c) * 3 + 0) * 16 + n]) >> 16); rawK[c][0] = (unsigned short)(__builtin_bit_cast(unsigned, stash[((hh * 4 + c) * 3 + 1) * 16 + n]) >> 16); rawV[c][0] = (unsigned short)(__builtin_bit_cast(unsigned, stash[((hh * 4 + c) * 3 + 2) * 16 + n]) >> 16); }
                    else { const size_t o = (size_t)(t0 + 4 * q4 - 1) * 512 + ch; rawR[c][0] = R[o]; rawK[c][0] = KR[o]; rawV[c][0] = VR[o]; }
#pragma unroll
                    for (int i = 0; i < 4; ++i) { const size_t o = (size_t)(t0 + 4 * q4 + i) * 512 + ch; rawR[c][i + 1] = R[o]; rawK[c][i + 1] = KR[o]; rawV[c][i + 1] = VR[o]; }
                }
                asm volatile("s_waitcnt vmcnt(0) lgkmcnt(0)" ::: "memory");
                float At[4][4], Rt[4][4], Bh[4][4], Kh[4][4], pC[4];
                float n2[4] = {0.f, 0.f, 0.f, 0.f}, rks[4] = {0.f, 0.f, 0.f, 0.f};
#pragma unroll
                for (int c = 0; c < 4; ++c) {
                    const int ch = hd * 64 + 16 * c + n;
                    float oR[5], oK[5], oV[5];
#pragma unroll
                    for (int i = 0; i < 5; ++i) { oR[i] = bf2f(rawR[c][i]); oK[i] = bf2f(rawK[c][i]); oV[i] = bf2f(rawV[c][i]); }
                    f32x4 aw = (f32x4){0.f, 0.f, 0.f, 0.f}, aa = aw, ag = aw;
#pragma unroll
                    for (int s = 0; s < 2; ++s) { const bf16x8 b = *(const bf16x8*)(LBW + (size_t)ch * 64 + 32 * s + 8 * q4); aw = __builtin_amdgcn_mfma_f32_16x16x32_bf16(Af[s], b, aw, 0, 0, 0); }
#pragma unroll
                    for (int s = 0; s < 2; ++s) { const bf16x8 b = *(const bf16x8*)(LBA + (size_t)ch * 64 + 32 * s + 8 * q4); aa = __builtin_amdgcn_mfma_f32_16x16x32_bf16(Af[2 + s], b, aa, 0, 0, 0); }
#pragma unroll
                    for (int s = 0; s < 5; ++s) { const bf16x8 b = *(const bf16x8*)(LBG + (size_t)ch * 160 + 32 * s + 8 * q4); ag = __builtin_amdgcn_mfma_f32_16x16x32_bf16(Af[4 + s], b, ag, 0, 0, 0); }
                    const float mr = mixrkv[ch], mk = mixrkv[512 + ch], mv = mixrkv[1024 + ch], w0c = w0[ch], a0c = a0[ch], kkc = k_k[ch], kac = k_a[ch], rkc = r_k[ch];
                    float wt[4], kr[4], as[4], kt[4], rr[4];
#pragma unroll
                    for (int i = 0; i < 4; ++i) {
                        const size_t o = (size_t)(t0 + 4 * q4 + i) * 512 + ch;
                        const float cr = oR[i + 1], ck = oK[i + 1], cv = oV[i + 1];
                        const float r_ = cr + (oR[i] - cr) * mr, k_ = ck + (oK[i] - ck) * mk, v_ = cv + (oV[i] - cv) * mv;
                        const float sg = sigmoidf_(w0c + aw[i]);
                        wt[i] = fast_exp2(-0.6065306597126334f * LOG2E * sg);
                        const float a_ = sigmoidf_(a0c + aa[i]);
                        const float kr_ = k_ * kkc; n2[i] += kr_ * kr_;
                        const float kt_ = k_ * (1.0f + (a_ - 1.0f) * kac);
                        rks[i] += r_ * kt_ * rkc;
                        kr[i] = kr_; as[i] = a_; kt[i] = kt_; rr[i] = r_;
                        VR[o] = (bf16)f2bf(v_); GB[o] = (bf16)f2bf(ag[i]);
                    }
                    {
                        const float p0 = wt[0], p1 = p0 * wt[1], p2 = p1 * wt[2], p3 = p2 * wt[3];
                        const float t1 = __shfl(p3, (lane + 48) & 63), t2 = __shfl(p3, (lane + 32) & 63), t3 = __shfl(p3, (lane + 16) & 63);
                        float E = 1.0f; if (q4 >= 1) E *= t1; if (q4 >= 2) E *= t2; if (q4 >= 3) E *= t3;
                        const float pm[4] = {E, p0 * E, p1 * E, p2 * E}; const float pp[4] = {p0 * E, p1 * E, p2 * E, p3 * E};
                        const float pc_ = __shfl(pp[3], 48 + n); pC[c] = pc_;
#pragma unroll
                        for (int i = 0; i < 4; ++i) {
                            const float ip = 1.0f / pp[i];
                            At[c][i] = kr[i] * pm[i]; Rt[c][i] = rr[i] * pp[i]; Bh[c][i] = kr[i] * as[i] * ip;
                            const float ktt = kt[i] * ip; Kh[c][i] = ktt * pc_;
                            xb[2 * 1088 + (4 * q4 + i) * 68 + 16 * c + n] = ktt;
                        }
                    }
                    asm volatile("" ::: "memory");
                }
#pragma unroll
                for (int i = 0; i < 4; ++i) {
                    float a = n2[i], b = rks[i];
                    a += __shfl_xor(a, 1); a += __shfl_xor(a, 2); a += __shfl_xor(a, 4); a += __shfl_xor(a, 8);
                    b += __shfl_xor(b, 1); b += __shfl_xor(b, 2); b += __shfl_xor(b, 4); b += __shfl_xor(b, 8);
                    n2[i] = 1.0f / fmaxf(sqrtf(a), 1e-12f); rks[i] = b;
                }
                if (n == 0) {
#pragma unroll
                    for (int i = 0; i < 4; ++i) RK[(size_t)(t0 + 4 * q4 + i) * 8 + hd] = rks[i];
                }
#pragma unroll
                for (int c = 0; c < 4; ++c)
#pragma unroll
                    for (int i = 0; i < 4; ++i) {
                        At[c][i] = -At[c][i] * n2[i]; const float bt = Bh[c][i] * n2[i]; Bh[c][i] = bt * pC[c];
                        xb[0 * 1088 + (4 * q4 + i) * 68 + 16 * c + n] = At[c][i]; xb[1 * 1088 + (4 * q4 + i) * 68 + 16 * c + n] = bt;
                    }
                { bf16* bkq = (bf16*)(ws + WS_BKQ) + (size_t)cid * 2048;
#pragma unroll
                  for (int c = 0; c < 4; ++c) { u32x4 w_; w_.x = pk2(Bh[c][0], Bh[c][1]); w_.y = pk2(Bh[c][2], Bh[c][3]); w_.z = pk2(Kh[c][0], Kh[c][1]); w_.w = pk2(Kh[c][2], Kh[c][3]);
                      *(u32x4*)(bkq + ((c * 16 + n) * 4 + q4) * 8) = w_; }
                  if (q4 == 0) { float* pc = (float*)(ws + WS_PC) + (size_t)cid * 64;
#pragma unroll
                      for (int c = 0; c < 4; ++c) pc[16 * c + n] = pC[c]; } }
                LDS_WAIT();
                f32x4v Aab = (f32x4v){0.f, 0.f, 0.f, 0.f}, Aak = Aab, Arb = Aab, Ark = Aab;
                {
                    f32x4v fa[4], fb[4], fk[4];
#pragma unroll
                    for (int s4 = 0; s4 < 4; ++s4) { fa[s4] = *(const LAS f32x4v*)(xb + 0 * 1088 + n * 68 + 16 * q4 + 4 * s4); fb[s4] = *(const LAS f32x4v*)(xb + 1 * 1088 + n * 68 + 16 * q4 + 4 * s4); fk[s4] = *(const LAS f32x4v*)(xb + 2 * 1088 + n * 68 + 16 * q4 + 4 * s4); }
#pragma unroll
                    for (int s4 = 0; s4 < 4; ++s4)
#pragma unroll
                        for (int e = 0; e < 4; ++e) { Aab = MF4(fa[s4][e], fb[s4][e], Aab); Aak = MF4(fa[s4][e], fk[s4][e], Aak); }
                    LDS_WAIT();
#pragma unroll
                    for (int c = 0; c < 4; ++c)
#pragma unroll
                        for (int i = 0; i < 4; ++i) xb[0 * 1088 + (4 * q4 + i) * 68 + 16 * c + n] = Rt[c][i];
                    LDS_WAIT();
#pragma unroll
                    for (int s4 = 0; s4 < 4; ++s4) fa[s4] = *(const LAS f32x4v*)(xb + 0 * 1088 + n * 68 + 16 * q4 + 4 * s4);
#pragma unroll
                    for (int s4 = 0; s4 < 4; ++s4)
#pragma unroll
                        for (int e = 0; e < 4; ++e) { Arb = MF4(fa[s4][e], fb[s4][e], Arb); Ark = MF4(fa[s4][e], fk[s4][e], Ark); }
                }
#pragma unroll
                for (int e = 0; e < 4; ++e) { const int tau = 4 * q4 + e; if (!(tau > n)) { Aab[e] = 0.f; Aak[e] = 0.f; } if (!(tau >= n)) { Arb[e] = 0.f; Ark[e] = 0.f; } }
                LDS_WAIT();
#pragma unroll
                for (int e = 0; e < 4; ++e) { tt[(4 * q4 + e) * 20 + n] = Aab[e]; rb[(4 * q4 + e) * 20 + n] = Arb[e]; }
                LDS_WAIT();
                f32x4v Tf, RBf;
                {
                    float Tc[16];
#pragma unroll
                    for (int tau = 0; tau < 16; ++tau) {
                        float acc = (tau == n) ? 1.0f : 0.0f;
#pragma unroll
                        for (int j4 = 0; j4 < (tau + 3) / 4; ++j4) { const f32x4v arow = *(const LAS f32x4v*)(tt + tau * 20 + 4 * j4);
#pragma unroll
                            for (int e = 0; e < 4; ++e) if (4 * j4 + e < tau) acc += arow[e] * Tc[4 * j4 + e]; }
                        Tc[tau] = acc;
                    }
                    RBf = *(const LAS f32x4v*)(rb + n * 20 + 4 * q4);
                    LDS_WAIT();
                    if (q4 == 0) {
#pragma unroll
                        for (int tau = 0; tau < 16; ++tau) tt[tau * 20 + n] = Tc[tau];
                    }
                    LDS_WAIT();
                    Tf = *(const LAS f32x4v*)(tt + n * 20 + 4 * q4);
                    LDS_WAIT();
                }
                f32x4v Ap[4], Rp[4], M1 = (f32x4v){0.f, 0.f, 0.f, 0.f}, M2 = Ark;
#pragma unroll
                for (int c = 0; c < 4; ++c) { f32x4v acc = (f32x4v){0.f, 0.f, 0.f, 0.f};
#pragma unroll
                    for (int s_ = 0; s_ < 4; ++s_) acc = MF4(Tf[s_], At[c][s_], acc);
                    Ap[c] = acc; }
#pragma unroll
                for (int s_ = 0; s_ < 4; ++s_) M1 = MF4(Tf[s_], Aak[s_], M1);
#pragma unroll
                for (int c = 0; c < 4; ++c) { f32x4v acc = (f32x4v){Rt[c][0], Rt[c][1], Rt[c][2], Rt[c][3]};
#pragma unroll
                    for (int s_ = 0; s_ < 4; ++s_) acc = MF4(RBf[s_], Ap[c][s_], acc);
                    Rp[c] = acc; }
#pragma unroll
                for (int s_ = 0; s_ < 4; ++s_) M2 = MF4(RBf[s_], M1[s_], M2);
#pragma unroll
                for (int pass = 0; pass < 2; ++pass) {
#pragma unroll
                    for (int c = 0; c < 4; ++c)
#pragma unroll
                        for (int i = 0; i < 4; ++i) { const float v_ = pass == 0 ? Ap[c][i] : Rp[c][i];
                            sa[(((c >> 1) * 4 + (n >> 2)) * 16 + 4 * q4 + i) * 8 + 4 * (c & 1) + (n & 3)] = (unsigned short)f2bf(v_); }
#pragma unroll
                    for (int e = 0; e < 4; ++e) { const float v_ = pass == 0 ? M1[e] : M2[e];
                        sa[((2 * 4 + (n >> 2)) * 16 + 4 * q4 + e) * 8 + (n & 3)] = (unsigned short)f2bf(v_); }
                    *(LAS u32x2*)(sa + ((2 * 4 + q4) * 16 + n) * 8 + 4) = (u32x2){0u, 0u};
                    LDS_WAIT();
                    bf16* dst = (bf16*)(ws + (pass == 0 ? WS_AQ : WS_RQ)) + (size_t)cid * 1536;
#pragma unroll
                    for (int s_ = 0; s_ < 3; ++s_) { const u32x4 w_ = *(const LAS u32x4*)(sa + (s_ * 64 + lane) * 8); *(u32x4*)(dst + (s_ * 64 + lane) * 8) = w_; }
                    LDS_WAIT();
                }
            }
        }
        __syncthreads();
    }
}

__device__ __forceinline__ void scan2_phase(Frame& F) {
    if (blockIdx.x >= 32 || F.wave >= 4) return;
    unsigned char* ws = F.ws;
    const int bh = blockIdx.x, wv = F.wave, lane = F.lane, col = lane & 15, q = lane >> 4;
    const int b = bh >> 3, h = bh & 7;
    const bf16* AQ = (const bf16*)(ws + WS_AQ) + (size_t)bh * 256 * 1536; const bf16* RQ = (const bf16*)(ws + WS_RQ) + (size_t)bh * 256 * 1536;
    const bf16* BKQ = (const bf16*)(ws + WS_BKQ) + (size_t)bh * 256 * 2048; const float* PC = (const float*)(ws + WS_PC) + (size_t)bh * 256 * 64;
    const bf16* VR = (const bf16*)(ws + WS_VR) + (size_t)b * SEQ * 512 + h * 64 + 16 * wv + col;
    bf16* Y = (bf16*)(ws + WS_YRAW) + (size_t)b * SEQ * 512 + h * 64 + 16 * wv + col;
    f32x4 st[4];
#pragma unroll
    for (int i = 0; i < 4; ++i) st[i] = (f32x4){0.f, 0.f, 0.f, 0.f};
    struct Ld { bf16x8 aq[3], rq[3], bk[4]; f32x4 pc[4]; unsigned short v[4]; };
    Ld cur, nxt;
#define SC_LOAD(L, ci) do { const int ci_ = (ci); \
        _Pragma("unroll") for (int s_ = 0; s_ < 3; ++s_) { L.aq[s_] = *(const bf16x8*)(AQ + (size_t)ci_ * 1536 + (s_ * 64 + lane) * 8); L.rq[s_] = *(const bf16x8*)(RQ + (size_t)ci_ * 1536 + (s_ * 64 + lane) * 8); } \
        _Pragma("unroll") for (int i_ = 0; i_ < 4; ++i_) { L.bk[i_] = *(const bf16x8*)(BKQ + (size_t)ci_ * 2048 + ((i_ * 16 + col) * 4 + q) * 8); L.pc[i_] = *(const f32x4*)(PC + (size_t)ci_ * 64 + 16 * i_ + 4 * q); \
            L.v[i_] = VR[(size_t)(ci_ * 16 + 4 * q + i_) * 512]; } } while (0)
    SC_LOAD(cur, 0);
    for (int ci = 0; ci < 256; ++ci) {
        SC_LOAD(nxt, ci + 1 < 256 ? ci + 1 : ci);
        bf16x8 sb[2];
#pragma unroll
        for (int s_ = 0; s_ < 2; ++s_) { u32x4 w_; w_.x = pg8::cvt_pk_bf16(st[2 * s_][0], st[2 * s_][1]); w_.y = pg8::cvt_pk_bf16(st[2 * s_][2], st[2 * s_][3]); w_.z = pg8::cvt_pk_bf16(st[2 * s_ + 1][0], st[2 * s_ + 1][1]); w_.w = pg8::cvt_pk_bf16(st[2 * s_ + 1][2], st[2 * s_ + 1][3]);
            sb[s_] = __builtin_bit_cast(bf16x8, w_); }
        const unsigned v01 = (unsigned)cur.v[0] | ((unsigned)cur.v[1] << 16), v23 = (unsigned)cur.v[2] | ((unsigned)cur.v[3] << 16);
        const bf16x8 vf = __builtin_bit_cast(bf16x8, ((u32x4){v01, v23, v01, v23}));
        f32x4 U = (f32x4){0.f, 0.f, 0.f, 0.f}, Yv = U;
        U = __builtin_amdgcn_mfma_f32_16x16x32_bf16(cur.aq[0], sb[0], U, 0, 0, 0); U = __builtin_amdgcn_mfma_f32_16x16x32_bf16(cur.aq[1], sb[1], U, 0, 0, 0); U = __builtin_amdgcn_mfma_f32_16x16x32_bf16(cur.aq[2], vf, U, 0, 0, 0);
        Yv = __builtin_amdgcn_mfma_f32_16x16x32_bf16(cur.rq[0], sb[0], Yv, 0, 0, 0); Yv = __builtin_amdgcn_mfma_f32_16x16x32_bf16(cur.rq[1], sb[1], Yv, 0, 0, 0); Yv = __builtin_amdgcn_mfma_f32_16x16x32_bf16(cur.rq[2], vf, Yv, 0, 0, 0);
        const bf16x8 uf = __builtin_bit_cast(bf16x8, ((u32x4){pg8::cvt_pk_bf16(U[0], U[1]), pg8::cvt_pk_bf16(U[2], U[3]), v01, v23}));
#pragma unroll
        for (int i = 0; i < 4; ++i) st[i] = __builtin_amdgcn_mfma_f32_16x16x32_bf16(cur.bk[i], uf, st[i] * cur.pc[i], 0, 0, 0);
#pragma unroll
        for (int e = 0; e < 4; ++e) Y[(size_t)(ci * 16 + 4 * q + e) * 512] = (bf16)f2bf(Yv[e]);
        cur = nxt;
    }
#undef SC_LOAD
}


__device__ __forceinline__ void scan3_phase(Frame& F) {
    if (blockIdx.x >= 32) return;
    constexpr int NS = 8, DA = 7, SLOT = 12544, O_AQ = 0, O_RQ = 3072, O_BK = 6144, O_PC = 10240, O_V = 10496;
    unsigned char* ws = F.ws;
    const int bh = blockIdx.x, lane = F.lane, b = bh >> 3, h = bh & 7;
    LAS unsigned char* ring = F.lds + RING_OFF;
    const char* AQ = (const char*)(ws + WS_AQ) + (size_t)bh * 256 * 3072; const char* RQ = (const char*)(ws + WS_RQ) + (size_t)bh * 256 * 3072;
    const char* BKQ = (const char*)(ws + WS_BKQ) + (size_t)bh * 256 * 4096; const char* PC = (const char*)(ws + WS_PC) + (size_t)bh * 256 * 256;
    const char* VRb = (const char*)(ws + WS_VR) + ((size_t)b * SEQ * 512 + h * 64) * 2;
#define SC_DMA(src, dstoff) __builtin_amdgcn_global_load_lds((const unsigned*)(src), (LAS unsigned*)(ring + (dstoff)), 16, 0, 0)
#define SC_WAITV(n) asm volatile("s_waitcnt vmcnt(" #n ")" ::: "memory")
    if (F.wave >= 4) {
        const int lw = F.wave - 4;
        if (lw == 0 || lw == 1) {
            const char* src = (lw == 0 ? AQ : RQ) + lane * 16; const int doff = (lw == 0 ? O_AQ : O_RQ);
#define SC_ISSUE(ci) do { const int cc_ = (ci) < 256 ? (ci) : 255; const int so_ = ((ci) & (NS - 1)) * SLOT + doff; const char* s_ = src + (size_t)cc_ * 3072; \
            SC_DMA(s_, so_); SC_DMA(s_ + 1024, so_ + 1024); SC_DMA(s_ + 2048, so_ + 2048); } while (0)
            for (int ci = 0; ci < DA; ++ci) SC_ISSUE(ci);
            SC_WAITV(18); __builtin_amdgcn_s_barrier();
            for (int ci = 0; ci < 256; ++ci) { SC_ISSUE(ci + DA); SC_WAITV(18); __builtin_amdgcn_s_barrier(); }
#undef SC_ISSUE
        } else if (lw == 2) {
            const char* src = BKQ + lane * 16;
#define SC_ISSUE(ci) do { const int cc_ = (ci) < 256 ? (ci) : 255; const int so_ = ((ci) & (NS - 1)) * SLOT + O_BK; const char* s_ = src + (size_t)cc_ * 4096; \
            SC_DMA(s_, so_); SC_DMA(s_ + 1024, so_ + 1024); SC_DMA(s_ + 2048, so_ + 2048); SC_DMA(s_ + 3072, so_ + 3072); } while (0)
            for (int ci = 0; ci < DA; ++ci) SC_ISSUE(ci);
            SC_WAITV(24); __builtin_amdgcn_s_barrier();
            for (int ci = 0; ci < 256; ++ci) { SC_ISSUE(ci + DA); SC_WAITV(24); __builtin_amdgcn_s_barrier(); }
#undef SC_ISSUE
        } else {
            const char* srcp = PC + (lane & 15) * 16; const char* srcv = VRb + (size_t)(lane >> 3) * 1024 + (lane & 7) * 16;
#define SC_ISSUE(ci) do { const int cc_ = (ci) < 256 ? (ci) : 255; const int so_ = ((ci) & (NS - 1)) * SLOT; \
            SC_DMA(srcp + (size_t)cc_ * 256, so_ + O_PC); SC_DMA(srcv + (size_t)cc_ * 16384, so_ + O_V); SC_DMA(srcv + (size_t)cc_ * 16384 + 8192, so_ + O_V + 1024); } while (0)
            for (int ci = 0; ci < DA; ++ci) SC_ISSUE(ci);
            SC_WAITV(18); __builtin_amdgcn_s_barrier();
            for (int ci = 0; ci < 256; ++ci) { SC_ISSUE(ci + DA); SC_WAITV(18); __builtin_amdgcn_s_barrier(); }
#undef SC_ISSUE
        }
    } else {
        const int wv = F.wave, col = lane & 15, q = lane >> 4;
        bf16* Y = (bf16*)(ws + WS_YRAW) + (size_t)b * SEQ * 512 + h * 64 + 16 * wv + col;
        f32x4 st[4];
#pragma unroll
        for (int i = 0; i < 4; ++i) st[i] = (f32x4){0.f, 0.f, 0.f, 0.f};
        __builtin_amdgcn_s_barrier();
        for (int ci = 0; ci < 256; ++ci) {
            const LAS unsigned char* sl = ring + (ci & (NS - 1)) * SLOT;
            bf16x8 aq[3], rq[3], bk[4]; f32x4 pc[4]; unsigned short vv[4];
#pragma unroll
            for (int s_ = 0; s_ < 3; ++s_) { aq[s_] = *(const LAS bf16x8*)(sl + O_AQ + (s_ * 64 + lane) * 16); rq[s_] = *(const LAS bf16x8*)(sl + O_RQ + (s_ * 64 + lane) * 16); }
#pragma unroll
            for (int i = 0; i < 4; ++i) { bk[i] = *(const LAS bf16x8*)(sl + O_BK + ((i * 16 + col) * 4 + q) * 16); pc[i] = *(const LAS f32x4*)(sl + O_PC + (16 * i + 4 * q) * 4);
                vv[i] = *(const LAS unsigned short*)(sl + O_V + (4 * q + i) * 128 + (16 * wv + col) * 2); }
            bf16x8 sb[2];
#pragma unroll
            for (int s_ = 0; s_ < 2; ++s_) { u32x4 w_; w_.x = pg8::cvt_pk_bf16(st[2 * s_][0], st[2 * s_][1]); w_.y = pg8::cvt_pk_bf16(st[2 * s_][2], st[2 * s_][3]); w_.z = pg8::cvt_pk_bf16(st[2 * s_ + 1][0], st[2 * s_ + 1][1]); w_.w = pg8::cvt_pk_bf16(st[2 * s_ + 1][2], st[2 * s_ + 1][3]);
                sb[s_] = __builtin_bit_cast(bf16x8, w_); }
            const unsigned v01 = (unsigned)vv[0] | ((unsigned)vv[1] << 16), v23 = (unsigned)vv[2] | ((unsigned)vv[3] << 16);
            const bf16x8 vf = __builtin_bit_cast(bf16x8, ((u32x4){v01, v23, v01, v23}));
            f32x4 U = (f32x4){0.f, 0.f, 0.f, 0.f}, Yv = U;
            U = __builtin_amdgcn_mfma_f32_16x16x32_bf16(aq[0], sb[0], U, 0, 0, 0); U = __builtin_amdgcn_mfma_f32_16x16x32_bf16(aq[1], sb[1], U, 0, 0, 0); U = __builtin_amdgcn_mfma_f32_16x16x32_bf16(aq[2], vf, U, 0, 0, 0);
            Yv = __builtin_amdgcn_mfma_f32_16x16x32_bf16(rq[0], sb[0], Yv, 0, 0, 0); Yv = __builtin_amdgcn_mfma_f32_16x16x32_bf16(rq[1], sb[1], Yv, 0, 0, 0); Yv = __builtin_amdgcn_mfma_f32_16x16x32_bf16(rq[2], vf, Yv, 0, 0, 0);
            const bf16x8 uf = __builtin_bit_cast(bf16x8, ((u32x4){pg8::cvt_pk_bf16(U[0], U[1]), pg8::cvt_pk_bf16(U[2], U[3]), v01, v23}));
#pragma unroll
            for (int i = 0; i < 4; ++i) st[i] = __builtin_amdgcn_mfma_f32_16x16x32_bf16(bk[i], uf, st[i] * pc[i], 0, 0, 0);
#pragma unroll
            for (int e = 0; e < 4; ++e) Y[(size_t)(ci * 16 + 4 * q + e) * 512] = (bf16)f2bf(Yv[e]);
            asm volatile("s_waitcnt lgkmcnt(0)" ::: "memory"); __builtin_amdgcn_s_barrier();
        }
    }
    asm volatile("s_waitcnt vmcnt(0)" ::: "memory");
#undef SC_DMA
#undef SC_WAITV
}

__device__ __forceinline__ float dpp_sum16(float x) {
    x += __builtin_bit_cast(float, __builtin_amdgcn_update_dpp(0, __builtin_bit_cast(int, x), 0xB1, 0xf, 0xf, true));
    x += __builtin_bit_cast(float, __builtin_amdgcn_update_dpp(0, __builtin_bit_cast(int, x), 0x4E, 0xf, 0xf, true));
    x += __builtin_bit_cast(float, __builtin_amdgcn_update_dpp(0, __builtin_bit_cast(int, x), 0x141, 0xf, 0xf, true));
    x += __builtin_bit_cast(float, __builtin_amdgcn_update_dpp(0, __builtin_bit_cast(int, x), 0x140, 0xf, 0xf, true));
    return x;
}
struct ScanBlk { u32x2 r[4], k[4], kk[4], bb[4]; f32x4 w[4]; unsigned v[4]; };
__device__ __forceinline__ void scan_phase(Frame& F) {
    if (F.wave >= 2) return;
    unsigned char* ws = F.ws;
    const bf16* R = (const bf16*)(ws + WS_R); const bf16* KR = (const bf16*)(ws + WS_KR); const bf16* VR = (const bf16*)(ws + WS_VR);
    const bf16* KK = (const bf16*)(ws + WS_KK); const bf16* BB = (const bf16*)(ws + WS_BB); const float* WD = (const float*)(ws + WS_WDEC);
    bf16* Y = (bf16*)(ws + WS_YRAW);
    for (int task = blockIdx.x * 2 + F.wave; task < 512; task += F.G * 2) {
        const int bh = task >> 4, rg = task & 15, b = bh >> 3, h = bh & 7;
        const int j = F.lane & 15, rr = F.lane >> 4, vi = 4 * rg + rr;
        const size_t base = (size_t)b * SEQ * 512 + h * 64;
        const size_t o4 = base + 4 * j, ov = base + vi;
        float s0 = 0.f, s1 = 0.f, s2 = 0.f, s3 = 0.f, ysel = 0.f;
        ScanBlk cur, nxt;
#define SCAN_LOAD(B, T0) do { _Pragma("unroll") for (int u_ = 0; u_ < 4; ++u_) { const size_t rw_ = (size_t)((T0) + u_) * 512; \
            B.r[u_] = *(const u32x2*)(R + o4 + rw_); B.k[u_] = *(const u32x2*)(KR + o4 + rw_); B.kk[u_] = *(const u32x2*)(KK + o4 + rw_); B.bb[u_] = *(const u32x2*)(BB + o4 + rw_); \
            B.w[u_] = *(const f32x4*)(WD + o4 + rw_); B.v[u_] = VR[ov + rw_]; } } while (0)
        SCAN_LOAD(cur, 0);
        for (int t0 = 0; t0 < SEQ; t0 += 4) {
            const int tn = (t0 + 4 < SEQ) ? t0 + 4 : t0;
            SCAN_LOAD(nxt, tn);
#pragma unroll
            for (int u = 0; u < 4; ++u) {
                const float kk0 = bflo(cur.kk[u].x), kk1 = bfhi(cur.kk[u].x), kk2 = bflo(cur.kk[u].y), kk3 = bfhi(cur.kk[u].y);
                float sa = (s0 * kk0 + s1 * kk1) + (s2 * kk2 + s3 * kk3);
                sa = dpp_sum16(sa);
                const float v_ = __builtin_bit_cast(float, cur.v[u] << 16);
                const float b0 = bflo(cur.bb[u].x), b1 = bfhi(cur.bb[u].x), b2 = bflo(cur.bb[u].y), b3 = bfhi(cur.bb[u].y);
                const float k0 = bflo(cur.k[u].x), k1 = bfhi(cur.k[u].x), k2 = bflo(cur.k[u].y), k3 = bfhi(cur.k[u].y);
                s0 = s0 * cur.w[u][0] + (v_ * k0 - sa * b0); s1 = s1 * cur.w[u][1] + (v_ * k1 - sa * b1); s2 = s2 * cur.w[u][2] + (v_ * k2 - sa * b2); s3 = s3 * cur.w[u][3] + (v_ * k3 - sa * b3);
                const float r0 = bflo(cur.r[u].x), r1 = bfhi(cur.r[u].x), r2 = bflo(cur.r[u].y), r3 = bfhi(cur.r[u].y);
                float y = (s0 * r0 + s1 * r1) + (s2 * r2 + s3 * r3);
                y = dpp_sum16(y);
                if (((t0 + u) & 15) == j) ysel = y;
            }
            if ((t0 & 15) == 12) Y[ov + (size_t)(t0 - 12 + j) * 512] = (bf16)f2bf(ysel);
            cur = nxt;
        }
#undef SCAN_LOAD
    }
}

__device__ __forceinline__ void e1_phase(Frame& F) {
    unsigned char* ws = F.ws;
    const bf16* Y = (const bf16*)(ws + WS_YRAW); const bf16* VR = (const bf16*)(ws + WS_VR); const bf16* GB = (const bf16*)(ws + WS_GB); const float* RK = (const float*)(ws + WS_RK);
    bf16* YB = (bf16*)(ws + WS_YB);
    const float* lnw = F.in[I_LNW]; const float* lnb = F.in[I_LNB];
    const int gw = F.vcu * NWAVES + F.wave, NGW = F.G * NWAVES, c0 = F.lane * 8;
    float lw[8], lb[8];
#pragma unroll
    for (int i = 0; i < 8; ++i) { lw[i] = lnw[c0 + i]; lb[i] = lnb[c0 + i]; }
    for (int m = gw; m < M; m += NGW) {
        const size_t o = (size_t)m * 512 + c0;
        const u32x4 yw = *(const u32x4*)(Y + o), vw = *(const u32x4*)(VR + o), gw_ = *(const u32x4*)(GB + o);
        const float rk = RK[(size_t)m * 8 + (F.lane >> 3)];
        float y[8] = { bflo(yw.x), bfhi(yw.x), bflo(yw.y), bfhi(yw.y), bflo(yw.z), bfhi(yw.z), bflo(yw.w), bfhi(yw.w) };
        const float v[8] = { bflo(vw.x), bfhi(vw.x), bflo(vw.y), bfhi(vw.y), bflo(vw.z), bfhi(vw.z), bflo(vw.w), bfhi(vw.w) };
        const float g[8] = { bflo(gw_.x), bfhi(gw_.x), bflo(gw_.y), bfhi(gw_.y), bflo(gw_.z), bfhi(gw_.z), bflo(gw_.w), bfhi(gw_.w) };
        float s = 0.f;
#pragma unroll
        for (int i = 0; i < 8; ++i) s += y[i];
        s += __shfl_xor(s, 1); s += __shfl_xor(s, 2); s += __shfl_xor(s, 4);
        const float mu = s * (1.0f / 64.0f); float q = 0.f;
#pragma unroll
        for (int i = 0; i < 8; ++i) { y[i] -= mu; q += y[i] * y[i]; }
        q += __shfl_xor(q, 1); q += __shfl_xor(q, 2); q += __shfl_xor(q, 4);
        const float rstd = 1.0f / sqrtf(q * (1.0f / 64.0f) + 64.0f * 1e-5f);
        float ov[8];
#pragma unroll
        for (int i = 0; i < 8; ++i) ov[i] = (y[i] * rstd * lw[i] + lb[i] + rk * v[i]) * g[i];
        u32x4 w; w.x = pk2(ov[0], ov[1]); w.y = pk2(ov[2], ov[3]); w.z = pk2(ov[4], ov[5]); w.w = pk2(ov[6], ov[7]);
        *(u32x4*)(YB + o) = w;
    }
}

__device__ __forceinline__ void fin_phase(Frame& F) {
    const f32x4* gf = (const f32x4*)F.in[I_NFIN] + F.lane;
    const int gw = F.vcu * NWAVES + F.wave, NGW = F.G * NWAVES;
    f32x4 gg[4];
#pragma unroll
    for (int j = 0; j < 4; ++j) gg[j] = gf[64 * j];
    for (int m = gw; m < M; m += NGW) {
        f32x4* xr = (f32x4*)(F.out + (size_t)m * D) + F.lane; f32x4 v[4]; float s = 0.f;
#pragma unroll
        for (int j = 0; j < 4; ++j) { v[j] = xr[64 * j]; s += (v[j].x * v[j].x + v[j].y * v[j].y) + (v[j].z * v[j].z + v[j].w * v[j].w); }
        s = wave_sum(s);
        const float rs = 1.0f / sqrtf(s * (1.0f / D) + RMS_EPS);
#pragma unroll
        for (int j = 0; j < 4; ++j) xr[64 * j] = v[j] * rs * gg[j];
    }
}


#ifdef DBG_OUT
__device__ __forceinline__ void dbg_phase(Frame& F) {
    const int gw = F.vcu * NWAVES + F.wave, NGW = F.G * NWAVES;
    for (int m = gw; m < M; m += NGW) {
        float* o = F.out + (size_t)m * D;
        for (int c = F.lane; c < D; c += 64) {
            bf16 v;
            if (DBG_OUT == 1) v = ((const bf16*)(F.ws + WS_MRG))[(size_t)m * D + c];
            else if (DBG_OUT == 2) v = ((const bf16*)(F.ws + WS_SGA))[(size_t)m * D + c];
            else if (DBG_OUT == 3) v = c < 512 ? ((const bf16*)(F.ws + WS_Q))[(size_t)m * 512 + c] : ((const bf16*)(F.ws + WS_K))[(size_t)m * 512 + c - 512];
            else if (DBG_OUT == 4) v = c < 512 ? ((const bf16*)(F.ws + WS_V))[(size_t)m * 512 + c] : ((const bf16*)(F.ws + WS_R))[(size_t)m * 512 + c - 512];
            else if (DBG_OUT == 5) v = c < 512 ? ((const bf16*)(F.ws + WS_KR))[(size_t)m * 512 + c] : ((const bf16*)(F.ws + WS_VR))[(size_t)m * 512 + c - 512];
            else if (DBG_OUT == 6) v = c < 768 ? ((const bf16*)(F.ws + WS_Z))[(size_t)m * ZP + c] : (bf16)0;
            else if (DBG_OUT == 7) v = ((const bf16*)(F.ws + WS_SGB))[(size_t)m * D + c];
            else if (DBG_OUT == 9) v = ((const bf16*)(F.ws + WS_WG))[(size_t)(m & 2047) * D + c];
            else v = ((const bf16*)(F.ws + WS_XB))[(size_t)m * D + c];
            o[c] = bf2f(v);
        }
    }
}
#endif
struct Args { const float* in[31]; float* out; unsigned char* ws; int ph_lo, ph_hi; };
constexpr int N_PHASES = 14;

#ifndef MK_N_LAUNCHES
#define MK_N_LAUNCHES 1
#endif

__global__ void __launch_bounds__(NWAVES * 64, 2) mk_fwd(Args args) {
    extern __shared__ __attribute__((aligned(16))) unsigned char lds[];
    Frame F;
    F.lds = (LAS unsigned char*)lds; F.MISC = (volatile LAS unsigned*)(F.lds + MISC_OFF);
    F.tid = threadIdx.x; F.lane = F.tid & 63; F.wave = __builtin_amdgcn_readfirstlane(F.tid >> 6);
    F.G = gridDim.x; { const int bx = blockIdx.x; F.vcu = (F.G % 8 == 0) ? (bx % 8) * (F.G / 8) + bx / 8 : bx; }
    F.in = args.in;
    F.out = args.out; F.ws = args.ws; F.ctl = (unsigned*)(args.ws + WS_CTL);
    unsigned char* ws = args.ws;
    for (int u = F.tid; u < (LDS_BYTES - LDSCTL_OFF) / 4; u += NWAVES * 64) ((LAS unsigned*)(F.lds + LDSCTL_OFF))[u] = 0u;
    __syncthreads();
    XcdBarrier bar; bar.bar = F.ctl + CW_BAR; bar.x = 0; bar.st = nullptr;
    if (MK_N_LAUNCHES == 1) bar = xcd_barrier_post(F.ctl + CW_BAR, F.MISC + 8);
    const int lo = args.ph_lo, hi = args.ph_hi;
#ifdef TPROBE
    if (TPROBE == 0 && blockIdx.x == 0 && F.tid == 0) ((unsigned long long*)(ws + WS_RK - 64))[0] = __builtin_amdgcn_s_memrealtime();
#endif
#ifndef PH_MASK
#define PH_MASK 0xFFFFFFFFu
#endif
#define IN(k) (((PH_MASK >> (k)) & 1u) && lo <= (k) && (k) < hi)
#ifdef TPROBE
#define SEAM(k) do { if (IN(k) && IN((k) + 1)) xcd_barrier(bar); \
    if (blockIdx.x == 0 && F.tid == 0) { const unsigned long long t_ = __builtin_amdgcn_s_memrealtime(); if ((k) + 1 == TPROBE) ((unsigned long long*)(ws + WS_RK - 64))[0] = t_; if ((k) == TPROBE) ((unsigned long long*)(ws + WS_RK - 64))[1] = t_; } } while (0)
#else
#define SEAM(k) do { if (IN(k) && IN((k) + 1)) xcd_barrier(bar); } while (0)
#endif
    float* ssq1 = (float*)(ws + OFF_SSQ1); float* ssq2 = (float*)(ws + WS_SSQ2); float* ssq3 = (float*)(ws + WS_SSQ3);
#ifdef SKIP_MID
    ssq3 = ssq2;
#endif
    bf16* XB = (bf16*)(ws + WS_XB); bf16* ACT = (bf16*)(ws + WS_ACT);
    const int bx = (int)blockIdx.x;

    if (IN(0)) { p0_prologue(F); } SEAM(0);
    if (IN(1)) { pg8::Gemm g{XB, (const bf16*)(ws + WS_WGU1), M, N_GU, D}; pg8::StaticOrder S; S.init(M, N_GU, F.G, bx);
        pg8::EpiSwiGLU<1> E{ACT, FF, ssq1}; pg8::gemm_phase<pg8::EpiSwiGLU<1>, pg8::StaticOrder, true, true>(F.lds + RING_OFF, g, S, E);
        if (F.G == 256 && bx >= 128) conv_range(F, CV0, CV1, (bx - 128) * NWAVES + F.wave, 128 * NWAVES);
        else if (F.G != 256) conv_range(F, CV0, CV1, bx * NWAVES + F.wave, F.G * NWAVES); } SEAM(1);
    if (IN(2)) { pg8::Gemm g{ACT, (const bf16*)(ws + WS_WD1), M, D, FF}; pg8::StaticOrder S; S.init(M, D, F.G, bx);
        pg8::EpiResid E{F.in[I_X], F.out, XB, ssq2, 0.5f}; pg8::gemm_phase<pg8::EpiResid, pg8::StaticOrder, true, true>(F.lds + RING_OFF, g, S, E); } SEAM(2);
    if (IN(3)) { pg8::Gemm g{XB, (const bf16*)(ws + WS_WIN), M, N_IN, D}; pg8::StaticOrder S; S.init(M, N_IN, F.G, bx);
        pg8::EpiProj E{(bf16*)(ws + WS_Q), (bf16*)(ws + WS_Z), ssq2, (float*)(ws + OFF_KMEAN), (bf16*)(ws + WS_BND)};
        pg8::gemm_phase<pg8::EpiProj, pg8::StaticOrder, true, true>(F.lds + RING_OFF, g, S, E); } SEAM(3);
#ifdef ATT_SIMPLE
    if (IN(4)) { attn_simple(F); } SEAM(4);
#else
    if (IN(4)) { const attn_body::AttnTensors AT{(const bf16*)(ws + WS_Q), (const bf16*)(ws + WS_K), (const bf16*)(ws + WS_V), (bf16*)(ws + WS_Q), (const float*)(ws + OFF_KMEAN), F.in[I_RELB]};
        const attn_body::StaticOrder S((int)F.G, bx); attn_body::attn_phase<attn_body::StaticOrder>((char*)lds + RING_OFF, AT, S); } SEAM(4);
#endif
#ifdef SCAN_DIRECT
    if (IN(5)) { mix_phase(F); } SEAM(5);
    if (IN(6)) { scan_phase(F); } SEAM(6);
#else
    if (IN(5)) { mixc_phase(F); } SEAM(5);
    if (IN(6)) {
        if (bx < 32) scan3_phase(F);
        else {
            pg8::StaticOrder S; S.init(M, D, F.G - 32, bx - 32);
            { pg8::Gemm g{XB, (const bf16*)(ws + WS_WG), M, D, D};
              pg8::EpiGate<0> E{(bf16*)(ws + WS_SGA), nullptr, nullptr, ssq2}; pg8::gemm_phase<pg8::EpiGate<0>, pg8::StaticOrder, true, true>(F.lds + RING_OFF, g, S, E); }
            asm volatile("s_waitcnt vmcnt(0)" ::: "memory"); __syncthreads();
            { pg8::Gemm g{(const bf16*)(ws + WS_Q), (const bf16*)(ws + WS_WA), M, D, 512};
              pg8::EpiGate<1> E{(bf16*)(ws + WS_MRG), (const bf16*)(ws + WS_SGA), nullptr, nullptr}; pg8::gemm_phase<pg8::EpiGate<1>, pg8::StaticOrder, true, true>(F.lds + RING_OFF, g, S, E); }
            if (bx >= 64) conv_range(F, CV1, CV2, (bx - 64) * NWAVES + F.wave, (F.G - 64) * NWAVES);
        } } SEAM(6);
#endif
    if (IN(7)) { e1_phase(F);
        pg8::Gemm g{XB, (const bf16*)(ws + WS_WG) + (size_t)D * D, M, D, D}; pg8::StaticOrder S; S.init(M, D, F.G, bx);
        pg8::EpiGate<0> E{(bf16*)(ws + WS_SGB), nullptr, nullptr, ssq2}; pg8::gemm_phase<pg8::EpiGate<0>, pg8::StaticOrder, true, true>(F.lds + RING_OFF, g, S, E); } SEAM(7);
    if (IN(9)) { pg8::Gemm g{(const bf16*)(ws + WS_YB), (const bf16*)(ws + WS_WB), M, D, 512}; pg8::StaticOrder S; S.init(M, D, F.G, bx);
        pg8::EpiGate<2> E{(bf16*)(ws + WS_MRG), (const bf16*)(ws + WS_SGB), nullptr, nullptr}; pg8::gemm_phase<pg8::EpiGate<2>, pg8::StaticOrder, true, true>(F.lds + RING_OFF, g, S, E); } SEAM(9);
    if (IN(10)) { pg8::Gemm g{(const bf16*)(ws + WS_MRG), (const bf16*)(ws + WS_WOUT), M, D, D}; pg8::StaticOrder S; S.init(M, D, F.G, bx);
        pg8::EpiResid E{F.out, F.out, XB, ssq3, 1.0f}; pg8::gemm_phase<pg8::EpiResid, pg8::StaticOrder, true, true>(F.lds + RING_OFF, g, S, E); } SEAM(10);
    if (IN(11)) { pg8::Gemm g{XB, (const bf16*)(ws + WS_WGU2), M, N_GU, D}; pg8::StaticOrder S; S.init(M, N_GU, F.G, bx);
        pg8::EpiSwiGLU<16> E{ACT, FF, ssq3}; pg8::gemm_phase<pg8::EpiSwiGLU<16>, pg8::StaticOrder, true, true>(F.lds + RING_OFF, g, S, E); } SEAM(11);
    if (IN(12)) { pg8::Gemm g{ACT, (const bf16*)(ws + WS_WD2), M, D, FF}; pg8::StaticOrder S; S.init(M, D, F.G, bx);
        pg8::EpiResid E{F.out, F.out, nullptr, nullptr, 0.5f}; pg8::gemm_phase<pg8::EpiResid, pg8::StaticOrder, true, true>(F.lds + RING_OFF, g, S, E); } SEAM(12);
#ifdef DBG_OUT
    if (IN(13)) { dbg_phase(F); }
#else
    if (IN(13)) { fin_phase(F); }
#ifdef TPROBE
    if (blockIdx.x == 0) { asm volatile("s_waitcnt vmcnt(0)" ::: "memory"); __syncthreads(); if (F.tid == 0) { const unsigned long long* tp = (const unsigned long long*)(ws + WS_RK - 64); F.out[(size_t)(F.vcu * NWAVES) * D] += (float)(tp[1] - tp[0]) * 0.01f * TSCALE; } }
#endif
#endif
#undef IN
#undef SEAM
}

extern "C" void kernel_launch(void* const* d_in, const int* in_sizes, int n_in, void* d_out, int out_size, void* d_ws, size_t ws_size, hipStream_t stream) {
    static int grid = 0;
    if (grid == 0) {
        if (n_in != 31 || out_size != M * D || ws_size < WS_END) { fprintf(stderr, "kernel_launch: unexpected shapes: n_in %d out %d ws %zu\n", n_in, out_size, ws_size); grid = -1; return; }
        int dev = 0, cus = 0;
        if (hipGetDevice(&dev) != hipSuccess || hipDeviceGetAttribute(&cus, hipDeviceAttributeMultiprocessorCount, dev) != hipSuccess) { grid = -1; return; }
        if (hipFuncSetAttribute((const void*)mk_fwd, hipFuncAttributeMaxDynamicSharedMemorySize, LDS_BYTES) != hipSuccess) { fprintf(stderr, "kernel_launch: hipFuncSetAttribute failed\n"); grid = -1; return; }
        int per_cu = 0;
        if (hipOccupancyMaxActiveBlocksPerMultiprocessor(&per_cu, (const void*)mk_fwd, NWAVES * 64, LDS_BYTES) != hipSuccess || per_cu < 1) fprintf(stderr, "kernel_launch: occupancy query says %d\n", per_cu);
        (void)hipGetLastError();
        grid = cus;
    }
    if (grid < 0) return;
    (void)hipMemsetAsync((char*)d_ws + WS_CTL, 0, CTL_ZERO_BYTES, stream);
    Args a{};
    for (int i = 0; i < 31; ++i) a.in[i] = (const float*)d_in[i];
    a.out = (float*)d_out; a.ws = (unsigned char*)d_ws;
#if MK_N_LAUNCHES == 1
    a.ph_lo = 0; a.ph_hi = N_PHASES;
    hipLaunchKernelGGL(mk_fwd, dim3(grid), dim3(NWAVES * 64), LDS_BYTES, stream, a);
#else
    for (int p = 0; p < N_PHASES; ++p) { a.ph_lo = p; a.ph_hi = p + 1; hipLaunchKernelGGL(mk_fwd, dim3(grid), dim3(NWAVES * 64), LDS_BYTES, stream, a); }
#endif
}
```
